# Optimizing an MI355X kernel written in HIP

```python
import math
import jax, jax.numpy as jnp
from jax import lax
import numpy as np

D_MODEL = 2048
BATCH = 8
SEQ = 2048
DEPTH = 1

CHUNK = 64

HEAD_DIM = 128
ATT_HEADS = (D_MODEL // 2) // HEAD_DIM
ATT_KV_HEADS = 2
ATT_GROUP = ATT_HEADS // ATT_KV_HEADS
ATT_WIDTH = ATT_HEADS * HEAD_DIM
KV_WIDTH = ATT_KV_HEADS * HEAD_DIM
IDX_HEADS = 16
IDX_DIM = 64
IDX_TOPK_MAX = 256

SSM_WIDTH = D_MODEL // 2
SSM_GROUP = 16
SSM_GROUPS = SSM_WIDTH // SSM_GROUP
SSM_STATE = 64
DT_MIN = 1e-3
DT_MAX = 1e-1

N_BRANCH = 2

N_EXPERTS = 32
TOP_K = 4
D_FF = D_MODEL
SWIGLU_LIMIT = 7.0
SWIGLU_ALPHA = 1.702
MOE_BLOCK = 512

RMS_EPS = 1e-6
IN_WIDTH = ATT_WIDTH + 2 * KV_WIDTH + IDX_HEADS * IDX_DIM + IDX_DIM + IDX_HEADS + SSM_WIDTH + N_BRANCH * D_MODEL

kernel_name = "hybrid_dsa_s5_moe_chunk_causal_block"


def _rmsnorm(x, g):
    xf = x.astype(jnp.float32)
    y = xf * lax.rsqrt(jnp.mean(xf * xf, axis=-1, keepdims=True) + RMS_EPS)
    return (y * g.astype(jnp.float32)).astype(x.dtype)


def _split_in_proj(p):
    widths = [ATT_WIDTH, KV_WIDTH, KV_WIDTH, IDX_HEADS * IDX_DIM, IDX_DIM, IDX_HEADS, SSM_WIDTH, N_BRANCH * D_MODEL]
    outs, off = [], 0
    for w in widths:
        outs.append(p[..., off:off + w])
        off += w
    return outs


def _alibi_slopes():
    return 2.0 ** (-8.0 * jnp.arange(1, ATT_HEADS + 1, dtype=jnp.float32) / ATT_HEADS)


def _dsa_branch(q, k, v, iq, ik, iw, q_g, k_g, k_top):
    Bb, S, _ = q.shape
    dt = q.dtype
    q = _rmsnorm(q.reshape(Bb, S, ATT_KV_HEADS, ATT_GROUP, HEAD_DIM), q_g)
    k = _rmsnorm(k.reshape(Bb, S, ATT_KV_HEADS, HEAD_DIM), k_g)
    v = v.reshape(Bb, S, ATT_KV_HEADS, HEAD_DIM)
    iq = iq.reshape(Bb, S, IDX_HEADS, IDX_DIM)
    iw = iw.astype(jnp.float32) * (IDX_HEADS ** -0.5)
    key_chunk = jnp.arange(S) // CHUNK
    slopes = _alibi_slopes().reshape(ATT_KV_HEADS, ATT_GROUP)
    gather = jax.vmap(lambda t, i: t[i])

    def one_chunk(ci):
        q0 = ci * CHUNK
        qb = lax.dynamic_slice_in_dim(q, q0, CHUNK, axis=1)
        iqb = lax.dynamic_slice_in_dim(iq, q0, CHUNK, axis=1)
        iwb = lax.dynamic_slice_in_dim(iw, q0, CHUNK, axis=1)
        logits = jnp.einsum('bqhd,bsd->bqhs', iqb, ik).astype(jnp.float32) * (IDX_DIM ** -0.5)
        score = jnp.einsum('bqhs,bqh->bqs', jax.nn.relu(logits), iwb)
        score = jnp.where(key_chunk[None, None, :] <= ci, score, -jnp.inf)
        _, sel = lax.top_k(score, k_top)
        k_sel = gather(k, sel)
        v_sel = gather(v, sel)
        s = jnp.einsum('bqgrd,bqkgd->bqgrk', qb, k_sel).astype(jnp.float32) * (HEAD_DIM ** -0.5)
        t_pos = q0 + jnp.arange(CHUNK)
        dist = jnp.abs(t_pos[None, :, None] - sel).astype(jnp.float32)
        s = s - slopes[None, None, :, :, None] * dist[:, :, None, None, :]
        ok = (sel // CHUNK) <= ci
        s = jnp.where(ok[:, :, None, None, :], s, -jnp.inf)
        p = jax.nn.softmax(s, axis=-1).astype(dt)
        o = jnp.einsum('bqgrk,bqkgd->bqgrd', p, v_sel)
        return o.reshape(Bb, CHUNK, ATT_WIDTH)

    out = lax.map(one_chunk, jnp.arange(S // CHUNK))
    return out.transpose(1, 0, 2, 3).reshape(Bb, S, ATT_WIDTH)


def _cplx_combine(e1, e2):
    a1r, a1i, b1r, b1i = e1
    a2r, a2i, b2r, b2i = e2
    ar = a2r * a1r - a2i * a1i
    ai = a2r * a1i + a2i * a1r
    br = a2r * b1r - a2i * b1i + b2r
    bi = a2r * b1i + a2i * b1r + b2i
    return ar, ai, br, bi


def _s5_branch(u, a_re, a_im, log_dt, b_re, b_im, c_re, c_im, d_skip, w_glu, b_glu):
    Bb, S, _ = u.shape
    f32 = jnp.float32
    uf = u.astype(f32).reshape(Bb, S, SSM_GROUPS, SSM_GROUP)
    a_re = a_re.astype(f32)
    a_im = a_im.astype(f32)
    step = jnp.exp(log_dt.astype(f32))[:, None]
    mag = jnp.exp(step * a_re)
    ang = step * a_im
    abar_re = mag * jnp.cos(ang)
    abar_im = mag * jnp.sin(ang)
    den = a_re * a_re + a_im * a_im
    num_re = abar_re - 1.0
    num_im = abar_im
    coef_re = ((num_re * a_re + num_im * a_im) / den)[:, :, None]
    coef_im = ((num_im * a_re - num_re * a_im) / den)[:, :, None]
    b_re = b_re.astype(f32)
    b_im = b_im.astype(f32)
    bbar_re = coef_re * b_re - coef_im * b_im
    bbar_im = coef_re * b_im + coef_im * b_re
    bu_re = jnp.einsum('bsgp,gnp->bsgn', uf, bbar_re)
    bu_im = jnp.einsum('bsgp,gnp->bsgn', uf, bbar_im)
    shp = bu_re.shape
    _, _, h_re, h_im = lax.associative_scan(
        _cplx_combine,
        (jnp.broadcast_to(abar_re, shp), jnp.broadcast_to(abar_im, shp), bu_re, bu_im),
        axis=1)
    y = (jnp.einsum('bsgn,gpn->bsgp', h_re, c_re.astype(f32))
         - jnp.einsum('bsgn,gpn->bsgp', h_im, c_im.astype(f32))
         + d_skip.astype(f32) * uf)
    y = jax.nn.gelu(y.reshape(Bb, S, SSM_WIDTH))
    y = y * jax.nn.sigmoid(y @ w_glu.astype(f32) + b_glu.astype(f32))
    return y.astype(u.dtype)


def _moe_ffn(h, w_router, b_router, w_gate_up, b_gate_up, w_down, b_down):
    Bb, S, D = h.shape
    T = Bb * S
    ht = h.reshape(T, D)
    logits = (ht @ w_router + b_router).astype(jnp.float32)
    top_val, top_idx = lax.top_k(logits, TOP_K)
    gates = jax.nn.softmax(top_val, axis=-1)
    A = T * TOP_K
    e_flat = top_idx.reshape(A)
    tok_flat = jnp.repeat(jnp.arange(T, dtype=jnp.int32), TOP_K)
    g_flat = gates.reshape(A)
    order = jnp.argsort(e_flat)
    e_sorted = e_flat[order]
    tok_sorted = tok_flat[order]
    g_sorted = g_flat[order]
    counts = jnp.bincount(e_flat, length=N_EXPERTS)
    padded = (counts + MOE_BLOCK - 1) // MOE_BLOCK * MOE_BLOCK
    start = jnp.cumsum(counts) - counts
    pend = jnp.cumsum(padded)
    pstart = pend - padded
    dest = pstart[e_sorted] + (jnp.arange(A) - start[e_sorted])
    P = A + N_EXPERTS * MOE_BLOCK
    n_blocks = P // MOE_BLOCK
    tok_buf = jnp.full((P,), T, dtype=jnp.int32).at[dest].set(tok_sorted)
    g_buf = jnp.zeros((P,), jnp.float32).at[dest].set(g_sorted)
    block_e = jnp.minimum(jnp.searchsorted(pend, jnp.arange(n_blocks) * MOE_BLOCK, side='right'),
                          N_EXPERTS - 1)
    ht_pad = jnp.concatenate([ht, jnp.zeros((1, D), ht.dtype)], axis=0)

    def block_fn(args):
        rows, e = args
        xb = ht_pad[rows]
        gu = xb @ w_gate_up[e] + b_gate_up[e]
        gate = jnp.minimum(gu[:, :D_FF], SWIGLU_LIMIT)
        up = jnp.clip(gu[:, D_FF:], -SWIGLU_LIMIT, SWIGLU_LIMIT)
        act = (up + 1.0) * (gate * jax.nn.sigmoid(SWIGLU_ALPHA * gate))
        return act @ w_down[e] + b_down[e]

    y = lax.map(block_fn, (tok_buf.reshape(n_blocks, MOE_BLOCK), block_e))
    y = y.reshape(P, D) * g_buf[:, None].astype(y.dtype)
    out = jnp.zeros((T + 1, D), y.dtype).at[tok_buf].add(y)[:T]
    return out.reshape(Bb, S, D)


def setup_inputs(seed: int = 0) -> dict:
    key = jax.random.key(seed)
    ks = jax.random.split(key, 32)
    f32 = jnp.float32
    nrm = lambda k, shape, s: jax.random.normal(k, shape, f32) * s
    L, D = DEPTH, D_MODEL
    n_idx = jnp.arange(SSM_STATE, dtype=f32)
    return {
        "x": nrm(ks[0], (BATCH, SEQ, D), 1.0),
        "c": nrm(ks[1], (BATCH, D), 1.0),
        "w_ada": nrm(ks[2], (L, D, 6 * D), D ** -0.5),
        "b_ada": nrm(ks[3], (L, 6 * D), 0.02),
        "norm1_g": 1.0 + nrm(ks[4], (L, D), 0.02),
        "w_in": nrm(ks[5], (L, D, IN_WIDTH), D ** -0.5),
        "q_norm_g": 1.0 + nrm(ks[6], (L, HEAD_DIM), 0.02),
        "k_norm_g": 1.0 + nrm(ks[7], (L, HEAD_DIM), 0.02),
        "ssm_a_re": -0.5 + nrm(ks[8], (L, SSM_GROUPS, SSM_STATE), 0.01),
        "ssm_a_im": math.pi * n_idx[None, None, :] + nrm(ks[9], (L, SSM_GROUPS, SSM_STATE), 0.01),
        "ssm_log_dt": jax.random.uniform(ks[10], (L, SSM_GROUPS), f32, math.log(DT_MIN), math.log(DT_MAX)),
        "ssm_b_re": nrm(ks[11], (L, SSM_GROUPS, SSM_STATE, SSM_GROUP), (2 * SSM_GROUP) ** -0.5),
        "ssm_b_im": nrm(ks[12], (L, SSM_GROUPS, SSM_STATE, SSM_GROUP), (2 * SSM_GROUP) ** -0.5),
        "ssm_c_re": nrm(ks[13], (L, SSM_GROUPS, SSM_GROUP, SSM_STATE), (2 * SSM_STATE) ** -0.5),
        "ssm_c_im": nrm(ks[14], (L, SSM_GROUPS, SSM_GROUP, SSM_STATE), (2 * SSM_STATE) ** -0.5),
        "ssm_d": nrm(ks[15], (L, SSM_GROUPS, SSM_GROUP), 1.0),
        "w_glu": nrm(ks[16], (L, SSM_WIDTH, SSM_WIDTH), SSM_WIDTH ** -0.5),
        "b_glu": nrm(ks[17], (L, SSM_WIDTH), 0.02),
        "w_proj_a": nrm(ks[18], (L, ATT_WIDTH, D), ATT_WIDTH ** -0.5),
        "w_proj_b": nrm(ks[19], (L, SSM_WIDTH, D), SSM_WIDTH ** -0.5),
        "w_out": nrm(ks[20], (L, D, D), D ** -0.5),
        "norm2_g": 1.0 + nrm(ks[21], (L, D), 0.02),
        "w_router": nrm(ks[22], (L, D, N_EXPERTS), D ** -0.5),
        "b_router": nrm(ks[23], (L, N_EXPERTS), 0.01),
        "w_gate_up": nrm(ks[24], (L, N_EXPERTS, D, 2 * D_FF), D ** -0.5),
        "b_gate_up": nrm(ks[25], (L, N_EXPERTS, 2 * D_FF), 0.02),
        "w_down": nrm(ks[26], (L, N_EXPERTS, D_FF, D), D_FF ** -0.5),
        "b_down": nrm(ks[27], (L, N_EXPERTS, D), 0.02),
    }


def reference(x, c, w_ada, b_ada, norm1_g, w_in, q_norm_g, k_norm_g, ssm_a_re, ssm_a_im, ssm_log_dt,
              ssm_b_re, ssm_b_im, ssm_c_re, ssm_c_im, ssm_d, w_glu, b_glu, w_proj_a, w_proj_b, w_out,
              norm2_g, w_router, b_router, w_gate_up, b_gate_up, w_down, b_down):
    Bb, S, D = x.shape
    k_top = min(IDX_TOPK_MAX, S // 4)
    cond = jax.nn.silu(c)
    for l in range(DEPTH):
        mod = (cond @ w_ada[l] + b_ada[l])[:, None, :]
        sh1, sc1, gt1, sh2, sc2, gt2 = jnp.split(mod, 6, axis=-1)
        h = _rmsnorm(x, norm1_g[l]) * (1.0 + sc1) + sh1
        proj = h @ w_in[l]
        q, k, v, iq, ik, iw, u, gate_logits = _split_in_proj(proj)
        y_att = _dsa_branch(q, k, v, iq, ik, iw, q_norm_g[l], k_norm_g[l], k_top)
        y_ssm = _s5_branch(u, ssm_a_re[l], ssm_a_im[l], ssm_log_dt[l], ssm_b_re[l], ssm_b_im[l],
                           ssm_c_re[l], ssm_c_im[l], ssm_d[l], w_glu[l], b_glu[l])
        g_all = jax.nn.sigmoid(gate_logits.astype(jnp.float32)).astype(x.dtype)
        g_att = g_all[..., :D]
        g_ssm = g_all[..., D:]
        merged = g_att * (y_att @ w_proj_a[l]) + g_ssm * (y_ssm @ w_proj_b[l])
        x = x + gt1 * (merged @ w_out[l])
        h2 = _rmsnorm(x, norm2_g[l]) * (1.0 + sc2) + sh2
        x = x + gt2 * _moe_ffn(h2, w_router[l], b_router[l], w_gate_up[l], b_gate_up[l], w_down[l], b_down[l])
    return x
```

```cpp
#include <hip/hip_runtime.h>
#include <cstdio>
#include <cstdint>

#define GAS __attribute__((address_space(1)))
#define LAS __attribute__((address_space(3)))
typedef unsigned short bf16;
typedef unsigned v4u __attribute__((ext_vector_type(4)));
typedef unsigned v2u __attribute__((ext_vector_type(2)));
typedef float f32x2 __attribute__((ext_vector_type(2)));
typedef float f32x4 __attribute__((ext_vector_type(4)));
typedef float f32x16 __attribute__((ext_vector_type(16)));
typedef short bf16x8 __attribute__((ext_vector_type(8)));
typedef short s16x4 __attribute__((ext_vector_type(4)));
typedef __bf16 bf16x2_t __attribute__((ext_vector_type(2)));

constexpr int DM = 2048, NB = 8, SEQ = 2048, T = NB * SEQ;
constexpr int CHUNK = 64, NCHUNK = SEQ / CHUNK;
constexpr int HD = 128, NQH = 8, NKVH = 2, ATTW = 1024, KVW = 256;
constexpr int IDXH = 16, IDXD = 64, TOPK = 256;
constexpr int SSMW = 1024, SSMG = 64, SSMP = 16, SSMN = 64;
constexpr int NEXP = 32, MOEK = 4, DFF = 2048;
constexpr int INW = 7760, INW_PAD = 7936;
constexpr int MODW = 6 * DM;
constexpr float RMS_EPS = 1e-6f;
constexpr int SL = 32, NSC = SEQ / SL, SROWS = NB * NSC;
constexpr int UA_LD = SL * 16 + 128;
constexpr int MOE_ROWS = T * MOEK + NEXP * 256;
constexpr int NWAVES = 8, NTHR = 512;

constexpr size_t MiB = 1u << 20;
constexpr size_t WS_CTL = 0, CTL_ZERO_BYTES = 1 * MiB;
constexpr size_t WS_MOD = 1 * MiB;
constexpr size_t WS_WRP = 2 * MiB;
constexpr size_t WS_BRP = 4 * MiB;
constexpr size_t WS_BBAR = 5 * MiB;
constexpr size_t WS_POW = 6 * MiB;
constexpr size_t WS_KT = 9 * MiB;
constexpr size_t WS_ASGE = 14 * MiB;
constexpr size_t WS_ASGP = WS_ASGE + 256 * 1024;
constexpr size_t WS_ASGG = WS_ASGP + 256 * 1024;
constexpr size_t WS_SLOT = WS_ASGG + 256 * 1024;
constexpr size_t WS_ROWG = 15 * MiB;
constexpr size_t WS_RSTD = 15 * MiB + 512 * 1024;
constexpr size_t WS_WIN = 16 * MiB;
constexpr size_t WS_WIN8 = 27 * MiB;
constexpr size_t WS_WGLU = 47 * MiB;
constexpr size_t WS_WA = 49 * MiB;
constexpr size_t WS_WB = 53 * MiB;
constexpr size_t WS_WO = 57 * MiB;
constexpr size_t WS_BTS = 65 * MiB;
constexpr size_t WS_BTY = 97 * MiB;
constexpr size_t WS_HN = 241 * MiB;
constexpr size_t WS_X1 = 241 * MiB;
constexpr size_t WS_HN8 = 980 * MiB;
constexpr size_t WS_Q = 305 * MiB;
constexpr size_t WS_K = 337 * MiB;
constexpr size_t WS_V = 345 * MiB;
constexpr size_t WS_IQ = 353 * MiB;
constexpr size_t WS_IK = 385 * MiB;
constexpr size_t WS_IW = 387 * MiB;
constexpr size_t WS_UA = 788 * MiB;
constexpr size_t WS_GATES = 424 * MiB;
constexpr size_t WS_SC = 552 * MiB;
constexpr size_t WS_SEL = 680 * MiB;
constexpr size_t WS_YA = 684 * MiB;
constexpr size_t WS_SBUF = 852 * MiB;
constexpr size_t WS_YG = 724 * MiB;
constexpr size_t WS_YS = 756 * MiB;
constexpr size_t WS_MRG = 788 * MiB;
constexpr size_t WS_MG = 916 * MiB;
constexpr size_t WS_H2 = 980 * MiB;
constexpr size_t WS_XS = 1044 * MiB;
constexpr size_t WS_LIST = WS_XS + 64 * MiB;
constexpr size_t WS_GLIST = WS_XS + 66 * MiB;
constexpr size_t WS_ACT = 1332 * MiB;
constexpr size_t WS_YE = 1620 * MiB;
constexpr size_t WS_WGU = 1908 * MiB;
constexpr size_t WS_WD = 2420 * MiB;
constexpr size_t WS_END = 2676 * MiB;
constexpr int CW_CNT = 1024;
constexpr int CW_CVQ = 2048;
constexpr int NCONV = 112;
constexpr int CW_BAR = 4096;
constexpr int RING_BYTES = 131072;
constexpr int LDSCTL_OFF = RING_BYTES, MISC_OFF = LDSCTL_OFF + 320;
constexpr int LDS_BYTES = 147456;

#define LDS_WAIT() asm volatile("s_waitcnt lgkmcnt(0)" ::: "memory")
#define VM_WAIT() asm volatile("s_waitcnt vmcnt(0)" ::: "memory")
#define RLX_AGENT __ATOMIC_RELAXED, __HIP_MEMORY_SCOPE_AGENT

__device__ __forceinline__ unsigned pk2(float lo, float hi) { f32x2 v = {lo, hi}; bf16x2_t b = __builtin_convertvector(v, bf16x2_t); return __builtin_bit_cast(unsigned, b); }
__device__ __forceinline__ float bf2f(unsigned h) { return __builtin_bit_cast(float, h << 16); }
__device__ __forceinline__ float bflo(unsigned w) { return __builtin_bit_cast(float, w << 16); }
__device__ __forceinline__ float bfhi(unsigned w) { return __builtin_bit_cast(float, w & 0xffff0000u); }
__device__ __forceinline__ float wave_sum(float v) {
#pragma unroll
    for (int o = 1; o < 64; o <<= 1) v += __shfl_xor(v, o);
    return v;
}
constexpr float F8_WSCALE = 256.0f, F8_ASCALE = 4.0f, F8_DESCALE = 1.0f / (256.0f * 4.0f);
constexpr float F8_YSCALE = 8.0f;
constexpr float F8_MSCALE = 16.0f, F8_MDESCALE = 1.0f / (256.0f * 16.0f);
__device__ __forceinline__ unsigned pk4_fp8(float a, float b, float c, float d) { int w = 0; a = __builtin_amdgcn_fmed3f(a, -448.f, 448.f); b = __builtin_amdgcn_fmed3f(b, -448.f, 448.f); c = __builtin_amdgcn_fmed3f(c, -448.f, 448.f); d = __builtin_amdgcn_fmed3f(d, -448.f, 448.f);
    w = __builtin_amdgcn_cvt_pk_fp8_f32(a, b, w, false); w = __builtin_amdgcn_cvt_pk_fp8_f32(c, d, w, true); return (unsigned)w; }
__device__ __forceinline__ unsigned pk4_fp8_nc(float a, float b, float c, float d) { int w = 0; w = __builtin_amdgcn_cvt_pk_fp8_f32(a, b, w, false); w = __builtin_amdgcn_cvt_pk_fp8_f32(c, d, w, true); return (unsigned)w; }
__device__ __forceinline__ float sigmoidf_(float x) { return __builtin_amdgcn_rcpf(1.0f + __builtin_amdgcn_exp2f(x * -1.4426950408889634f)); }
__device__ __forceinline__ float sigmoid1702(float x) { return __builtin_amdgcn_rcpf(1.0f + __builtin_amdgcn_exp2f(x * (-1.702f * 1.4426950408889634f))); }

namespace pg8 {
#define PG8_LAS __attribute__((address_space(3)))
typedef unsigned short bf16_t;
typedef short bf16x8 __attribute__((ext_vector_type(8)));
typedef float f32x4 __attribute__((ext_vector_type(4)));
typedef unsigned u32x4 __attribute__((ext_vector_type(4)));
constexpr int BM = 256, BK = 64, HALF = 128, HTB = HALF * BK * 2, STAGE_BYTES = 8 * HTB, NXCD = 8, WGM = 8;

__host__ __device__ __forceinline__ int lds_byte(int r, int c) { const int st = (r >> 4) * 2 + (c >> 5), rr = r & 15, cc = c & 31, ob = rr * 64 + cc * 2; return st * 1024 + (ob ^ (((ob >> 9) & 1) << 5)); }
__host__ __device__ __forceinline__ void stage_rc(int b, int& R, int& C) { const int st = b / 1024, sb = b % 1024, swz = sb ^ (((sb >> 9) & 1) << 5); R = (st >> 1) * 16 + swz / 64; C = (st & 1) * 32 + (swz % 64) / 2; }
__host__ __device__ __forceinline__ int perm32(int rho) { const int n = rho >> 4, i = rho & 15; return 8 * (i >> 2) + 4 * n + (i & 3); }

struct Unit { int pm, pn; };
struct Gemm { const bf16_t* A; const bf16_t* Bt; int lda, ldb, K; const PG8_LAS unsigned short* rows; };

struct StaticOrder {
    int nM, nN, nwg, G, c;
    __host__ __device__ void init(int M, int N, int G_, int c_) { nM = M / BM; nN = N / BM; nwg = nM * nN; G = G_; c = c_; }
    __host__ __device__ bool next(int i, Unit& u) const {
        const long L = (long)i * G + c; if (L >= nwg) return false;
        int wgid = (int)L; { const int q = nwg / NXCD, r = nwg % NXCD, xcd = wgid % NXCD, off = wgid / NXCD; wgid = (xcd < r ? xcd * (q + 1) : r * (q + 1) + (xcd - r) * q) + off; }
        const int nig = WGM * nN, gid = wgid / nig, fm = gid * WGM, gsz = (nM - fm) < WGM ? (nM - fm) : WGM;
        u.pm = fm + ((wgid % nig) % gsz); u.pn = (wgid % nig) / gsz; return true;
    }
    __device__ __forceinline__ void a_ready(const Unit&) const {}
    __device__ __forceinline__ void done(const Unit&) const {}
};

typedef int i32x4 __attribute__((ext_vector_type(4)));
typedef int i32x8 __attribute__((ext_vector_type(8)));
template <bool F8> struct FragT;
template <> struct FragT<false> { bf16x8 k0, k1; };
template <> struct FragT<true> { i32x8 v; };
template <bool F8> __device__ __forceinline__ FragT<F8> ldfrag(const PG8_LAS unsigned char* p) {
    if constexpr (F8) { const i32x4 lo = *(const PG8_LAS i32x4*)p, hi = *(const PG8_LAS i32x4*)(p + 1024); FragT<true> f; f.v = __builtin_shufflevector(lo, hi, 0, 1, 2, 3, 4, 5, 6, 7); return f; }
    else { FragT<false> f; f.k0 = *(const PG8_LAS bf16x8*)p; f.k1 = *(const PG8_LAS bf16x8*)(p + 1024); return f; }
}
template <bool F8> __device__ __forceinline__ f32x4 mma1(const FragT<F8>& b, const FragT<F8>& a, f32x4 c) {
#if defined(__HIP_DEVICE_COMPILE__)
    if constexpr (F8) { asm volatile("v_mfma_f32_16x16x128_f8f6f4 %0, %1, %2, %0" : "+v"(c) : "v"(b.v), "v"(a.v)); return c; }
#else
    if constexpr (F8) { return c; }
#endif
    else { c = __builtin_amdgcn_mfma_f32_16x16x32_bf16(b.k0, a.k0, c, 0, 0, 0); return __builtin_amdgcn_mfma_f32_16x16x32_bf16(b.k1, a.k1, c, 0, 0, 0); }
}
template <class Epi, class Sched, bool ALIGN_EPI = false, bool SP2 = false, bool F8 = false, bool GATHER = false>
__device__ __forceinline__ void gemm_phase(PG8_LAS unsigned char* lds, const Gemm g, const Sched& S, const Epi& E) {
    const int tid = threadIdx.x, wid = __builtin_amdgcn_readfirstlane(tid >> 6), lane = tid & 63, wr = wid >> 2, wc = wid & 3, fr = lane & 15, fq = lane >> 4;
    const int K = g.K, nt = K / BK;
    unsigned voffA[2], voffB[2];
#pragma unroll
    for (int i = 0; i < 2; ++i) { int R, C; stage_rc(tid * 16 + i * 8192, R, C); const int Rb = Epi::PERM ? ((R & ~31) + perm32(R & 31)) : R;
        voffA[i] = (unsigned)(R * g.lda + C) * 2u; voffB[i] = (unsigned)(Rb * g.ldb + C) * 2u; }
    unsigned gC0[2] = {0u, 0u}, gC1[2] = {0u, 0u}, gN0[2] = {0u, 0u}, gN1[2] = {0u, 0u}; int gR[2] = {0, 0}; unsigned gCb[2] = {0u, 0u};
    if constexpr (GATHER) {
#pragma unroll
        for (int i = 0; i < 2; ++i) { int R, C; stage_rc(tid * 16 + i * 8192, R, C); gR[i] = R; gCb[i] = (unsigned)C * 2u; } }
#define PG8_GROWS(d0, d1, slot) do { _Pragma("unroll") for (int _i = 0; _i < 2; ++_i) { \
        d0[_i] = (unsigned)g.rows[(slot) * 256 + gR[_i]] * (unsigned)(g.lda * 2) + gCb[_i]; d1[_i] = (unsigned)g.rows[(slot) * 256 + 128 + gR[_i]] * (unsigned)(g.lda * 2) + gCb[_i]; } } while (0)
    const size_t kstep = (size_t)(BK * 2);
    const size_t hstepA = (size_t)HALF * g.lda * 2, hstepB = (size_t)HALF * g.ldb * 2;
    const size_t tstepA = 2 * hstepA, tstepB = 2 * hstepB;
    const unsigned ldsw = (unsigned)wid * 1024u;
    const int aoff = lds_byte(wr * 64 + fr, fq * 8), boff = lds_byte(wc * 32 + fr, fq * 8);
#define PG8_SA(b, h) (((b) * 2 + (h)) * HTB)
#define PG8_SB(b, h) ((4 + (b) * 2 + (h)) * HTB)
#define PG8_STAGE(bufoff, gbase, voff) do { _Pragma("unroll") for (int _i = 0; _i < 2; ++_i) \
        __builtin_amdgcn_global_load_lds((const unsigned*)((const char*)(gbase) + (voff)[_i]), (PG8_LAS unsigned*)(lds + (bufoff) + ldsw + _i * 8192), 16, 0, 0); } while (0)
#define PG8_STAGE2(bufoff, gbase, o0, o1) do { \
        __builtin_amdgcn_global_load_lds((const unsigned*)((const char*)(gbase) + (o0)), (PG8_LAS unsigned*)(lds + (bufoff) + ldsw), 16, 0, 0); \
        __builtin_amdgcn_global_load_lds((const unsigned*)((const char*)(gbase) + (o1)), (PG8_LAS unsigned*)(lds + (bufoff) + ldsw + 8192), 16, 0, 0); } while (0)
#define PG8_STAGE_A(bufoff, kb, h, nx) do { if constexpr (GATHER) { \
        if ((h) == 0) PG8_STAGE2(bufoff, kb, ((nx) ? gN0[0] : gC0[0]), ((nx) ? gN0[1] : gC0[1])); else PG8_STAGE2(bufoff, kb, ((nx) ? gN1[0] : gC1[0]), ((nx) ? gN1[1] : gC1[1])); \
        } else { PG8_STAGE(bufoff, (kb) + ((h) ? hstepA : (size_t)0), voffA); } } while (0)
#define PG8_LDA(dst, b, h) do { _Pragma("unroll") for (int m = 0; m < 4; ++m) dst[m] = ldfrag<F8>(lds + PG8_SA(b, h) + aoff + m * 2048); } while (0)
#define PG8_LDB(dst, b, h) do { _Pragma("unroll") for (int n = 0; n < 2; ++n) dst[n] = ldfrag<F8>(lds + PG8_SB(b, h) + boff + n * 2048); } while (0)
#define PG8_MMA(ai, bj, At, Bt) do { __builtin_amdgcn_s_setprio(1); _Pragma("unroll") for (int m = 0; m < 4; ++m) _Pragma("unroll") for (int n = 0; n < 2; ++n) \
        acc[ai][bj][m][n] = mma1<F8>(Bt[n], At[m], acc[ai][bj][m][n]); __builtin_amdgcn_s_setprio(0); } while (0)
#define PG8_WAIT_V(n) asm volatile("s_waitcnt vmcnt(" #n ")" ::: "memory")
#define PG8_WAIT_L(n) asm volatile("s_waitcnt lgkmcnt(" #n ")" ::: "memory")
#define PG8_BAR __builtin_amdgcn_s_barrier()
#define PG8_SCHED __builtin_amdgcn_sched_barrier(0)
    Unit cur, nxt; int ui = 0;
    if (!S.next(0, cur)) return;
    f32x4 acc[2][2][4][2];
#pragma unroll
    for (int a = 0; a < 2; ++a)
#pragma unroll
        for (int b = 0; b < 2; ++b)
#pragma unroll
            for (int m = 0; m < 4; ++m)
#pragma unroll
                for (int n = 0; n < 2; ++n) acc[a][b][m][n] = (f32x4){0.f, 0.f, 0.f, 0.f};
    FragT<F8> At[4], B0[2], B1[2];
    const char* cA = (const char*)g.A + (GATHER ? (size_t)0 : (size_t)cur.pm * tstepA); const char* cB = (const char*)g.Bt + (size_t)cur.pn * tstepB;
    if constexpr (GATHER) { PG8_GROWS(gC0, gC1, 0); }
    S.a_ready(cur);
    if constexpr (SP2) {
        PG8_STAGE(PG8_SB(0, 0), cB, voffB); PG8_STAGE(PG8_SB(0, 1), cB + hstepB, voffB); PG8_STAGE_A(PG8_SA(0, 0), cA, 0, false); PG8_STAGE_A(PG8_SA(0, 1), cA, 1, false);
        if (wr == 1) PG8_BAR;
        PG8_WAIT_V(2); PG8_BAR;
        PG8_STAGE(PG8_SB(1, 0), cB + kstep, voffB); PG8_STAGE_A(PG8_SA(1, 0), cA + kstep, 0, false); PG8_STAGE(PG8_SB(1, 1), cB + hstepB + kstep, voffB);
        PG8_WAIT_V(6); PG8_BAR;
    } else {
        PG8_STAGE(PG8_SB(0, 0), cB, voffB); PG8_STAGE_A(PG8_SA(0, 0), cA, 0, false); PG8_STAGE(PG8_SB(0, 1), cB + hstepB, voffB); PG8_STAGE_A(PG8_SA(0, 1), cA, 1, false);
        if (wr == 1) PG8_BAR;
        PG8_WAIT_V(4); PG8_BAR;
        PG8_STAGE(PG8_SB(1, 0), cB + kstep, voffB); PG8_STAGE_A(PG8_SA(1, 0), cA + kstep, 0, false); PG8_STAGE(PG8_SB(1, 1), cB + hstepB + kstep, voffB);
        PG8_WAIT_V(6); PG8_BAR;
    }
    for (;;) {
        const bool has_next = S.next(ui + 1, nxt);
        const char* nA = (has_next && !GATHER) ? (const char*)g.A + (size_t)nxt.pm * tstepA : cA; const char* nB = has_next ? (const char*)g.Bt + (size_t)nxt.pn * tstepB : cB;
        if constexpr (GATHER) { if (has_next) { PG8_GROWS(gN0, gN1, ui + 1); } else { gN0[0] = gC0[0]; gN0[1] = gC0[1]; gN1[0] = gC1[0]; gN1[1] = gC1[1]; } }
        for (int t = 0; t < nt; t += 2) {
            const bool last = (t == nt - 2);
            const char* a1 = cA + (size_t)(t + 1) * kstep;
            const char* a2 = last ? nA : cA + (size_t)(t + 2) * kstep; const char* b2 = last ? nB : cB + (size_t)(t + 2) * kstep;
            const char* a3 = a2 + kstep; const char* b3 = b2 + kstep;
            if (last && has_next) S.a_ready(nxt);
            if constexpr (Epi::CHAIN) { if (t == Epi::MID_T) {
                if constexpr (F8) asm volatile("s_nop 15\n\ts_nop 15" ::: "memory");
                int fr_ = fr, fq_ = fq; asm volatile("" : "+v"(fr_), "+v"(fq_)); E.mid(acc, cur, wr, wc, fr_, fq_); } }
            if constexpr (SP2) {
            PG8_LDB(B0, 0, 0); PG8_LDB(B1, 0, 1); PG8_SCHED; PG8_LDA(At, 0, 0); PG8_STAGE_A(PG8_SA(1, 1), a1, 1, false);
            PG8_WAIT_V(8); PG8_WAIT_L(0); PG8_BAR; PG8_MMA(0, 0, At, B0); PG8_MMA(0, 1, At, B1); PG8_BAR; PG8_SCHED;
            PG8_LDA(At, 0, 1); PG8_STAGE(PG8_SB(0, 0), b2, voffB); PG8_STAGE(PG8_SB(0, 1), b2 + hstepB, voffB); PG8_STAGE_A(PG8_SA(0, 0), a2, 0, last);
            PG8_WAIT_V(8); PG8_WAIT_L(0); PG8_BAR; PG8_MMA(1, 0, At, B0); PG8_MMA(1, 1, At, B1); PG8_BAR; PG8_SCHED;
            PG8_LDB(B0, 1, 0); PG8_LDB(B1, 1, 1); PG8_SCHED; PG8_LDA(At, 1, 0); PG8_STAGE_A(PG8_SA(0, 1), a2, 1, last);
            PG8_WAIT_V(8); PG8_WAIT_L(0); PG8_BAR; PG8_MMA(0, 0, At, B0); PG8_MMA(0, 1, At, B1); PG8_BAR; PG8_SCHED;
            PG8_LDA(At, 1, 1); PG8_STAGE(PG8_SB(1, 0), b3, voffB); PG8_STAGE(PG8_SB(1, 1), b3 + hstepB, voffB); PG8_STAGE_A(PG8_SA(1, 0), a3, 0, last);
            PG8_WAIT_V(8); PG8_WAIT_L(0); PG8_BAR; PG8_MMA(1, 0, At, B0); PG8_MMA(1, 1, At, B1); PG8_BAR; PG8_SCHED;
            } else {
            PG8_LDB(B0, 0, 0); PG8_SCHED; PG8_LDA(At, 0, 0); PG8_STAGE_A(PG8_SA(1, 1), a1, 1, false);
            PG8_WAIT_L(8); PG8_BAR; PG8_WAIT_L(0); PG8_MMA(0, 0, At, B0); PG8_BAR; PG8_SCHED;
            PG8_LDB(B1, 0, 1); PG8_STAGE(PG8_SB(0, 0), b2, voffB);
            PG8_BAR; PG8_WAIT_L(0); PG8_MMA(0, 1, At, B1); PG8_BAR;
            PG8_LDA(At, 0, 1); PG8_STAGE_A(PG8_SA(0, 0), a2, 0, last);
            PG8_BAR; PG8_WAIT_L(0); PG8_MMA(1, 0, At, B0); PG8_BAR; PG8_SCHED;
            PG8_STAGE(PG8_SB(0, 1), b2 + hstepB, voffB);
            PG8_WAIT_V(6); PG8_BAR; PG8_MMA(1, 1, At, B1); PG8_BAR;
            PG8_LDB(B0, 1, 0); PG8_SCHED; PG8_LDA(At, 1, 0); PG8_STAGE_A(PG8_SA(0, 1), a2, 1, last);
            PG8_WAIT_L(8); PG8_BAR; PG8_WAIT_L(0); PG8_MMA(0, 0, At, B0); PG8_BAR; PG8_SCHED;
            PG8_LDB(B1, 1, 1); PG8_STAGE(PG8_SB(1, 0), b3, voffB);
            PG8_BAR; PG8_WAIT_L(0); PG8_MMA(0, 1, At, B1); PG8_BAR;
            PG8_LDA(At, 1, 1); PG8_STAGE_A(PG8_SA(1, 0), a3, 0, last);
            PG8_BAR; PG8_WAIT_L(0); PG8_MMA(1, 0, At, B0); PG8_BAR; PG8_SCHED;
            PG8_STAGE(PG8_SB(1, 1), b3 + hstepB, voffB);
            PG8_WAIT_V(6); PG8_BAR; PG8_MMA(1, 1, At, B1); PG8_BAR;
            }
        }
        if constexpr (ALIGN_EPI) { if (wr == 0) PG8_BAR; }
        if constexpr (F8) asm volatile("s_nop 15\n\ts_nop 15" ::: "memory");
        { int fr_ = fr, fq_ = fq; asm volatile("" : "+v"(fr_), "+v"(fq_));
          E(acc, cur, wr, wc, fr_, fq_); } S.done(cur);
        if (!has_next) break;
#pragma unroll
        for (int a = 0; a < 2; ++a)
#pragma unroll
            for (int b = 0; b < 2; ++b)
#pragma unroll
                for (int m = 0; m < 4; ++m)
#pragma unroll
                    for (int n = 0; n < 2; ++n) acc[a][b][m][n] = (f32x4){0.f, 0.f, 0.f, 0.f};
        cur = nxt; cA = nA; cB = nB; ++ui;
        if constexpr (GATHER) { gC0[0] = gN0[0]; gC0[1] = gN0[1]; gC1[0] = gN1[0]; gC1[1] = gN1[1]; }
        if constexpr (ALIGN_EPI) { if (wr == 1) PG8_BAR; }
    }
    PG8_WAIT_V(0);
    if constexpr (!ALIGN_EPI) { if (wr == 0) PG8_BAR; }
    PG8_BAR;
#undef PG8_SA
#undef PG8_SB
#undef PG8_STAGE
#undef PG8_STAGE2
#undef PG8_STAGE_A
#undef PG8_GROWS
#undef PG8_LDA
#undef PG8_LDB
#undef PG8_MMA
#undef PG8_WAIT_V
#undef PG8_WAIT_L
#undef PG8_BAR
#undef PG8_SCHED
}
}

#define XB_TMO      128
#define XB_XCNT(j)  (256  + 64 * (j))
#define XB_XSUB(j)  (1280 + 64 * (j))
#define XB_XGEN(j)  (2304 + 64 * (j))
#define XB_TOP      3328
#define XB_TOPGEN   3392
#define XCD_BAR_WORDS 3456
#define XB_SPIN_CAP (1u << 18)

__device__ __forceinline__ unsigned xb_ld(unsigned* p)              { return __hip_atomic_load(p, __ATOMIC_RELAXED, __HIP_MEMORY_SCOPE_AGENT); }
__device__ __forceinline__ unsigned xb_add(unsigned* p, unsigned v) { return __hip_atomic_fetch_add(p, v, __ATOMIC_RELAXED, __HIP_MEMORY_SCOPE_AGENT); }
__device__ __forceinline__ unsigned xb_xcc_id() { return (unsigned)__builtin_amdgcn_s_getreg((3 << 11) | 20) & 0xFu; }
#define XB_SPIN(cond, bar) do { unsigned _sp = 0; while (cond) { __builtin_amdgcn_s_sleep(1); \
    if ((++_sp & 255u) == 0u) { if (xb_ld(&(bar)[XB_TMO])) break; if (_sp > XB_SPIN_CAP) { atomicAdd(&(bar)[XB_TMO], 1u); break; } } } } while (0)

struct XcdBarrier { unsigned* bar; unsigned x; volatile LAS unsigned* st; };

__device__ __forceinline__ XcdBarrier xcd_barrier_post(unsigned* bar, volatile LAS unsigned* st) {
    XcdBarrier b; b.bar = bar; b.x = xb_xcc_id(); b.st = st;
    if (threadIdx.x == 0) (void)xb_add(&bar[XB_XCNT(b.x)], 1u);
    return b;
}
__device__ __forceinline__ void xcd_barrier_complete(unsigned* bar, unsigned x, unsigned& nloc, unsigned& nx) {
    const unsigned G = gridDim.x * gridDim.y * gridDim.z;
    unsigned sum, cnt, mine, sp = 0u;
    for (;;) {
        sum = 0u; cnt = 0u; mine = 0u;
#pragma unroll
        for (unsigned j = 0; j < 16; ++j) { const unsigned c = xb_ld(&bar[XB_XCNT(j)]); sum += c; cnt += (c > 0u) ? 1u : 0u; mine = (j == x) ? c : mine; }
        if (sum == G) break;
        __builtin_amdgcn_s_sleep(1);
        if ((++sp & 255u) == 0u) { if (xb_ld(&bar[XB_TMO])) break; if (sp > XB_SPIN_CAP) { atomicAdd(&bar[XB_TMO], 1u); break; } }
    }
    nloc = mine > 0u ? mine : 1u; nx = cnt > 0u ? cnt : 1u;
}
__device__ __forceinline__ void xcd_barrier(const XcdBarrier& b) {
    asm volatile("s_waitcnt vmcnt(0)" ::: "memory");
    __syncthreads();
    if (threadIdx.x == 0) {
        unsigned* bar = b.bar;
        __builtin_amdgcn_s_waitcnt(0);
        unsigned nloc = b.st[0], nx = b.st[1];
        if (nloc == 0u) { xcd_barrier_complete(bar, b.x, nloc, nx); b.st[0] = nloc; b.st[1] = nx; }
        const unsigned old = xb_add(&bar[XB_XSUB(b.x)], 1u);
        const unsigned gen = old / nloc;
        if (old + 1u == (gen + 1u) * nloc) {
            __builtin_amdgcn_fence(__ATOMIC_RELEASE, "agent");
            asm volatile("s_waitcnt vmcnt(0)" ::: "memory");
            const unsigned og = xb_add(&bar[XB_TOP], 1u);
            const unsigned tg = og / nx;
            if (og + 1u == (tg + 1u) * nx) xb_add(&bar[XB_TOPGEN], 1u);
            else XB_SPIN(xb_ld(&bar[XB_TOPGEN]) == tg, bar);
            __builtin_amdgcn_fence(__ATOMIC_ACQUIRE, "agent");
            xb_add(&bar[XB_XGEN(b.x)], 1u);
            asm volatile("s_waitcnt vmcnt(0)" ::: "memory");
        } else {
            XB_SPIN(xb_ld(&bar[XB_XGEN(b.x)]) == gen, bar);
            __builtin_amdgcn_fence(__ATOMIC_ACQUIRE, "agent");
            asm volatile("s_waitcnt vmcnt(0)" ::: "memory");
        }
    }
    __syncthreads();
}

using pg8::Unit;
__device__ __forceinline__ v4u pack8(const f32x4& a, const f32x4& b) { v4u w; w.x = pk2(a[0], a[1]); w.y = pk2(a[2], a[3]); w.z = pk2(b[0], b[1]); w.w = pk2(b[2], b[3]); return w; }
__device__ __forceinline__ float gelu_tanh(float y) { const float u2 = 1.5957691216f * (y + 0.044715f * y * y * y); return y * __builtin_amdgcn_rcpf(1.0f + __builtin_amdgcn_exp2f(u2 * -1.4426950408889634f)); }

struct EpiInProjA {
    static constexpr bool PERM = true, CHAIN = false;
    bf16 *Q, *K, *IQ, *IK; float* IW;
    __device__ __forceinline__ void operator()(const f32x4 (&acc)[2][2][4][2], const Unit& u, int wr, int wc, int fr, int fq) const {
        const int pn = u.pn, row0 = u.pm * 256 + wr * 64 + fr, cl0 = wc * 32 + 8 * fq;
        if (pn < 9) {
            bf16* dst; int ld, coff; float sc = 1.f;
            if (pn < 4) { dst = Q; ld = 1024; coff = pn * 256; } else if (pn == 4) { dst = K; ld = 256; coff = 0; } else { dst = IQ; ld = 1024; coff = (pn - 5) * 256; sc = 0.125f; }
#pragma unroll
            for (int ai = 0; ai < 2; ++ai)
#pragma unroll
                for (int m = 0; m < 4; ++m) { bf16* rowp = dst + (size_t)(row0 + ai * 128 + m * 16) * ld + coff + cl0;
#pragma unroll
                    for (int bj = 0; bj < 2; ++bj) *(v4u*)(rowp + bj * 128) = pack8(acc[ai][bj][m][0] * sc, acc[ai][bj][m][1] * sc); }
        } else {
#pragma unroll
            for (int ai = 0; ai < 2; ++ai)
#pragma unroll
                for (int m = 0; m < 4; ++m) { const int row = row0 + ai * 128 + m * 16;
                    if (cl0 < 64) *(v4u*)(IK + (size_t)row * 64 + cl0) = pack8(acc[ai][0][m][0], acc[ai][0][m][1]);
                    else if (cl0 < 80) { float* p = IW + (size_t)row * 16 + (cl0 - 64); *(f32x4*)p = acc[ai][0][m][0] * 0.25f; *(f32x4*)(p + 4) = acc[ai][0][m][1] * 0.25f; } }
        }
    }
};
struct EpiInProjB {
    static constexpr bool PERM = true, CHAIN = false;
    bf16 *V, *UA; unsigned char* GATES;
    __device__ __forceinline__ void operator()(const f32x4 (&acc)[2][2][4][2], const Unit& u, int wr, int wc, int fr, int fq) const {
        const int pn = u.pn, row0 = u.pm * 256 + wr * 64 + fr, cl0 = wc * 32 + 8 * fq;
        if (pn >= 5) {
            const int coff = (pn - 5) * 256 + cl0;
#pragma unroll
            for (int ai = 0; ai < 2; ++ai)
#pragma unroll
                for (int m = 0; m < 4; ++m) { unsigned char* rowp = GATES + (size_t)(row0 + ai * 128 + m * 16) * 4096 + coff;
#pragma unroll
                    for (int bj = 0; bj < 2; ++bj) { const f32x4 v0 = acc[ai][bj][m][0] * F8_DESCALE, v1 = acc[ai][bj][m][1] * F8_DESCALE; unsigned c[8];
#pragma unroll
                        for (int e = 0; e < 4; ++e) { c[e] = (unsigned)fminf(fmaxf(sigmoidf_(v0[e]) * 255.0f + 0.5f, 1.0f), 255.0f); c[4 + e] = (unsigned)fminf(fmaxf(sigmoidf_(v1[e]) * 255.0f + 0.5f, 1.0f), 255.0f); }
                        v2u w; w.x = c[0] | (c[1] << 8) | (c[2] << 16) | (c[3] << 24); w.y = c[4] | (c[5] << 8) | (c[6] << 16) | (c[7] << 24);
                        *(v2u*)(rowp + bj * 128) = w; } }
        } else if (pn == 0) {
#pragma unroll
            for (int ai = 0; ai < 2; ++ai)
#pragma unroll
                for (int m = 0; m < 4; ++m) { bf16* rowp = V + (size_t)(row0 + ai * 128 + m * 16) * 256 + cl0;
#pragma unroll
                    for (int bj = 0; bj < 2; ++bj) *(v4u*)(rowp + bj * 128) = pack8(acc[ai][bj][m][0] * F8_DESCALE, acc[ai][bj][m][1] * F8_DESCALE); }
        } else {
#pragma unroll
            for (int ai = 0; ai < 2; ++ai)
#pragma unroll
                for (int m = 0; m < 4; ++m) { const int row = row0 + ai * 128 + m * 16, b = row >> 11, t = row & 2047, c = t >> 5, i = t & 31;
#pragma unroll
                    for (int bj = 0; bj < 2; ++bj) { const int ch0 = (pn - 1) * 256 + bj * 128 + cl0, g = ch0 >> 4, p0 = ch0 & 15;
                        *(v4u*)(UA + ((size_t)(g * SROWS + b * NSC + c)) * UA_LD + i * 16 + p0) = pack8(acc[ai][bj][m][0] * F8_DESCALE, acc[ai][bj][m][1] * F8_DESCALE); } }
        }
    }
};

struct EpiSsmS {
    static constexpr bool PERM = false, CHAIN = false;
    float* SBUF;
    __device__ __forceinline__ void operator()(const f32x4 (&acc)[2][2][4][2], const Unit& u, int wr, int wc, int fr, int fq) const {
#pragma unroll
        for (int ai = 0; ai < 2; ++ai)
#pragma unroll
            for (int m = 0; m < 4; ++m) { const int rl = ai * 128 + wr * 64 + m * 16 + fr;
#pragma unroll
                for (int n = 0; n < 2; ++n) *(f32x4*)(SBUF + ((size_t)(u.pm * 256 + rl)) * 128 + wc * 32 + 16 * n + 4 * fq) = acc[ai][0][m][n]; }
    }
};

struct EpiSsmY {
    static constexpr bool PERM = true, CHAIN = false;
    bf16* YG;
    __device__ __forceinline__ void operator()(const f32x4 (&acc)[2][2][4][2], const Unit& u, int wr, int wc, int fr, int fq) const {
        const int g = u.pm >> 1, rt = u.pm & 1, ct = u.pn & 1;
#pragma unroll
        for (int ai = 0; ai < 2; ++ai)
#pragma unroll
            for (int m = 0; m < 4; ++m) { const int r = rt * 256 + ai * 128 + wr * 64 + m * 16 + fr, b = r >> 6, c = r & 63;
#pragma unroll
                for (int bj = 0; bj < 2; ++bj) { const int cl = bj * 128 + wc * 32 + 8 * fq, j = 16 * ct + (cl >> 4), p0 = cl & 15; const int t = b * 2048 + SL * c + j;
                    f32x4 v0 = acc[ai][bj][m][0], v1 = acc[ai][bj][m][1];
#pragma unroll
                    for (int e = 0; e < 4; ++e) { v0[e] = gelu_tanh(v0[e]); v1[e] = gelu_tanh(v1[e]); }
                    *(v4u*)(YG + (size_t)t * 1024 + 16 * g + p0) = pack8(v0, v1); } }
    }
};

struct EpiGlu {
    static constexpr bool PERM = true, CHAIN = false;
    const bf16* YG; unsigned char* YS; const float* bias;
    __device__ __forceinline__ void operator()(const f32x4 (&acc)[2][2][4][2], const Unit& u, int wr, int wc, int fr, int fq) const {
        const int row0 = u.pm * 256 + wr * 64 + fr, col0 = u.pn * 256 + wc * 32 + 8 * fq;
        f32x4 bv[2][2];
#pragma unroll
        for (int bj = 0; bj < 2; ++bj) { bv[bj][0] = *(const f32x4*)(bias + col0 + bj * 128); bv[bj][1] = *(const f32x4*)(bias + col0 + bj * 128 + 4); }
#pragma unroll
        for (int ai = 0; ai < 2; ++ai) { v4u ygv[4][2];
#pragma unroll
            for (int m = 0; m < 4; ++m)
#pragma unroll
                for (int bj = 0; bj < 2; ++bj) ygv[m][bj] = *(const v4u*)(YG + (size_t)(row0 + ai * 128 + m * 16) * 1024 + col0 + bj * 128);
#pragma unroll
            for (int m = 0; m < 4; ++m) { const size_t ro = (size_t)(row0 + ai * 128 + m * 16) * 1024;
#pragma unroll
                for (int bj = 0; bj < 2; ++bj) { const int col = col0 + bj * 128; const v4u yg = ygv[m][bj]; f32x4 z0 = acc[ai][bj][m][0] + bv[bj][0], z1 = acc[ai][bj][m][1] + bv[bj][1];
                    z0[0] = bflo(yg.x) * sigmoidf_(z0[0]); z0[1] = bfhi(yg.x) * sigmoidf_(z0[1]); z0[2] = bflo(yg.y) * sigmoidf_(z0[2]); z0[3] = bfhi(yg.y) * sigmoidf_(z0[3]);
                    z1[0] = bflo(yg.z) * sigmoidf_(z1[0]); z1[1] = bfhi(yg.z) * sigmoidf_(z1[1]); z1[2] = bflo(yg.w) * sigmoidf_(z1[2]); z1[3] = bfhi(yg.w) * sigmoidf_(z1[3]);
                    z0 = z0 * F8_MSCALE; z1 = z1 * F8_MSCALE; v2u w8; w8.x = pk4_fp8(z0[0], z0[1], z0[2], z0[3]); w8.y = pk4_fp8(z1[0], z1[1], z1[2], z1[3]); *(v2u*)(YS + 2 * ro + col) = w8; } } }
    }
};

struct EpiProjAB {
    static constexpr bool PERM = true, CHAIN = true; static constexpr int MID_T = 8;
    const unsigned char* GATES; unsigned char* MG;
    __device__ __forceinline__ void mid(f32x4 (&acc)[2][2][4][2], const Unit& u, int wr, int wc, int fr, int fq) const {
        int row0 = u.pm * 256 + wr * 64 + fr, col0 = u.pn * 256 + wc * 32 + 8 * fq; asm volatile("" : "+v"(row0), "+v"(col0));
#pragma unroll
        for (int ai = 0; ai < 2; ++ai)
#pragma unroll
            for (int m = 0; m < 4; ++m) { const size_t row = (size_t)(row0 + ai * 128 + m * 16);
#pragma unroll
                for (int bj = 0; bj < 2; ++bj) { const int col = col0 + bj * 128; const v2u ga = *(const v2u*)(GATES + row * 4096 + col), gs = *(const v2u*)(GATES + row * 4096 + 2048 + col);
                    f32x4& a0 = acc[ai][bj][m][0]; f32x4& a1 = acc[ai][bj][m][1];
#pragma unroll
                    for (int e = 0; e < 4; ++e) { a0[e] *= (float)((ga.x >> (8 * e)) & 0xffu) * __builtin_amdgcn_rcpf((float)((gs.x >> (8 * e)) & 0xffu));
                                                  a1[e] *= (float)((ga.y >> (8 * e)) & 0xffu) * __builtin_amdgcn_rcpf((float)((gs.y >> (8 * e)) & 0xffu)); } } }
    }
    __device__ __forceinline__ void operator()(const f32x4 (&acc)[2][2][4][2], const Unit& u, int wr, int wc, int fr, int fq) const {
        int row0 = u.pm * 256 + wr * 64 + fr, col0 = u.pn * 256 + wc * 32 + 8 * fq; asm volatile("" : "+v"(row0), "+v"(col0));
        constexpr float SC = F8_MDESCALE * F8_MSCALE * (1.0f / 255.0f);
        v2u gsv[2][4][2];
#pragma unroll
        for (int ai = 0; ai < 2; ++ai)
#pragma unroll
            for (int m = 0; m < 4; ++m)
#pragma unroll
                for (int bj = 0; bj < 2; ++bj) gsv[ai][m][bj] = *(const v2u*)(GATES + (size_t)(row0 + ai * 128 + m * 16) * 4096 + 2048 + col0 + bj * 128);
#pragma unroll
        for (int ai = 0; ai < 2; ++ai)
#pragma unroll
            for (int m = 0; m < 4; ++m) { const size_t row = (size_t)(row0 + ai * 128 + m * 16);
#pragma unroll
                for (int bj = 0; bj < 2; ++bj) { const int col = col0 + bj * 128; const v2u gs = gsv[ai][m][bj]; const f32x4 a0 = acc[ai][bj][m][0] * SC, a1 = acc[ai][bj][m][1] * SC;
                    v2u w8; w8.x = pk4_fp8(a0[0] * (float)(gs.x & 0xffu), a0[1] * (float)((gs.x >> 8) & 0xffu), a0[2] * (float)((gs.x >> 16) & 0xffu), a0[3] * (float)(gs.x >> 24));
                    w8.y = pk4_fp8(a1[0] * (float)(gs.y & 0xffu), a1[1] * (float)((gs.y >> 8) & 0xffu), a1[2] * (float)((gs.y >> 16) & 0xffu), a1[3] * (float)(gs.y >> 24));
                    *(v2u*)(MG + row * 2048 + col) = w8; } }
    }
};

struct EpiOut {
    static constexpr bool PERM = true, CHAIN = false;
    const float* X; const float* MOD; bf16* X1;
    __device__ __forceinline__ void operator()(const f32x4 (&acc)[2][2][4][2], const Unit& u, int wr, int wc, int fr, int fq) const {
        const int row0 = u.pm * 256 + wr * 64 + fr, col0 = u.pn * 256 + wc * 32 + 8 * fq;
        const float* gt1 = MOD + (size_t)(u.pm >> 3) * MODW + 2 * DM;
        f32x4 gv[2][2];
#pragma unroll
        for (int bj = 0; bj < 2; ++bj) { gv[bj][0] = *(const f32x4*)(gt1 + col0 + bj * 128); gv[bj][1] = *(const f32x4*)(gt1 + col0 + bj * 128 + 4); }
#pragma unroll
        for (int ai = 0; ai < 2; ++ai) { f32x4 xv[4][2][2];
#pragma unroll
            for (int m = 0; m < 4; ++m)
#pragma unroll
                for (int bj = 0; bj < 2; ++bj) { const float* xp = X + (size_t)(row0 + ai * 128 + m * 16) * 2048 + col0 + bj * 128; xv[m][bj][0] = *(const f32x4*)xp; xv[m][bj][1] = *(const f32x4*)(xp + 4); }
#pragma unroll
            for (int m = 0; m < 4; ++m) { const size_t ro = (size_t)(row0 + ai * 128 + m * 16) * 2048;
#pragma unroll
                for (int bj = 0; bj < 2; ++bj) { const int col = col0 + bj * 128;
                    const f32x4 o0 = xv[m][bj][0] + gv[bj][0] * (acc[ai][bj][m][0] * F8_MDESCALE), o1 = xv[m][bj][1] + gv[bj][1] * (acc[ai][bj][m][1] * F8_MDESCALE);
                    *(v4u*)(X1 + ro + col) = pack8(o0, o1); } } }
    }
};

struct EpiGateUp {
    static constexpr bool PERM = true, CHAIN = false;
    const float* bgu; unsigned char* ACT;
    __device__ __forceinline__ void operator()(const f32x4 (&acc)[2][2][4][2], const Unit& u, int wr, int wc, int fr, int fq) const {
        const int e = u.pn >> 4, ct = u.pn & 15, row0 = u.pm * 256 + wr * 64 + fr, col = ct * 128 + wc * 32 + 8 * fq;
        const float* bg = bgu + (size_t)e * 4096 + col; const f32x4 g0 = *(const f32x4*)bg, g1 = *(const f32x4*)(bg + 4);
        const f32x4 u0 = (*(const f32x4*)(bg + 2048) + 1.0f) * F8_ASCALE, u1 = (*(const f32x4*)(bg + 2052) + 1.0f) * F8_ASCALE;
        constexpr float D4 = F8_DESCALE * F8_ASCALE;
#pragma unroll
        for (int ai = 0; ai < 2; ++ai)
#pragma unroll
            for (int m = 0; m < 4; ++m) { f32x4 ga = acc[ai][0][m][0] * F8_DESCALE + g0, gb = acc[ai][0][m][1] * F8_DESCALE + g1, ua = acc[ai][1][m][0] * D4 + u0, ub = acc[ai][1][m][1] * D4 + u1;
#pragma unroll
                for (int q = 0; q < 4; ++q) { float gg = fminf(ga[q], 7.0f), uu = __builtin_amdgcn_fmed3f(ua[q], -6.0f * F8_ASCALE, 8.0f * F8_ASCALE); ga[q] = uu * (gg * sigmoid1702(gg));
                    gg = fminf(gb[q], 7.0f); uu = __builtin_amdgcn_fmed3f(ub[q], -6.0f * F8_ASCALE, 8.0f * F8_ASCALE); gb[q] = uu * (gg * sigmoid1702(gg)); }
                v2u w; w.x = pk4_fp8_nc(ga[0], ga[1], ga[2], ga[3]); w.y = pk4_fp8_nc(gb[0], gb[1], gb[2], gb[3]);
                *(v2u*)(ACT + (size_t)(row0 + ai * 128 + m * 16) * 2048 + col) = w; }
    }
};

struct EpiDown {
    static constexpr bool PERM = true, CHAIN = false;
    const float* bd; const float* GLIST; const LAS int* mt; unsigned char* YE;
    __device__ __forceinline__ void operator()(const f32x4 (&acc)[2][2][4][2], const Unit& u, int wr, int wc, int fr, int fq) const {
        const int e = (u.pn >> 3) & 31, ct = u.pn & 7, row0 = u.pm * 256 + wr * 64 + fr, col0 = ct * 256 + wc * 32 + 8 * fq, ne = mt[32 + e], i0 = row0 - mt[e];
        f32x4 bv[2][2]; float grv[2][4];
#pragma unroll
        for (int bj = 0; bj < 2; ++bj) { const float* bp = bd + (size_t)e * 2048 + col0 + bj * 128; bv[bj][0] = *(const f32x4*)bp; bv[bj][1] = *(const f32x4*)(bp + 4); }
#pragma unroll
        for (int ai = 0; ai < 2; ++ai)
#pragma unroll
            for (int m = 0; m < 4; ++m) { const int idx = i0 + ai * 128 + m * 16; const bool ok = idx >= 0 && idx < ne && idx < T; const float gl = GLIST[(size_t)e * T + (ok ? idx : 0)]; grv[ai][m] = ok ? gl * F8_YSCALE : 0.f; }
#pragma unroll
        for (int ai = 0; ai < 2; ++ai)
#pragma unroll
            for (int m = 0; m < 4; ++m) { const size_t row = (size_t)(row0 + ai * 128 + m * 16); const float gr = grv[ai][m];
#pragma unroll
                for (int bj = 0; bj < 2; ++bj) { const int col = col0 + bj * 128;
                    const f32x4 y0 = (acc[ai][bj][m][0] * F8_DESCALE + bv[bj][0]) * gr, y1 = (acc[ai][bj][m][1] * F8_DESCALE + bv[bj][1]) * gr;
                    v2u w8; w8.x = pk4_fp8(y0[0], y0[1], y0[2], y0[3]); w8.y = pk4_fp8(y1[0], y1[1], y1[2], y1[3]); *(v2u*)(YE + row * 2048 + col) = w8; } }
    }
};

struct SsmSOrder {
    int G, c;
    __device__ __forceinline__ bool next(int i, Unit& u) const { const int L = i * G + c; if (L >= 2 * SSMG) return false; u.pm = L; u.pn = L >> 1; return true; }
    __device__ __forceinline__ void a_ready(const Unit&) const {}
    __device__ __forceinline__ void done(const Unit&) const {}
};
struct SsmYOrder {
    int G, c;
    __device__ __forceinline__ bool next(int i, Unit& u) const { const int L = i * G + c; if (L >= 256) return false; const int g = L >> 2; u.pm = 2 * g + ((L >> 1) & 1); u.pn = 2 * g + (L & 1); return true; }
    __device__ __forceinline__ void a_ready(const Unit&) const {}
    __device__ __forceinline__ void done(const Unit&) const {}
};
struct MoeOrder {
    const LAS int* rbe; int nrb, sh, G, c;
    __device__ __forceinline__ bool next(int i, Unit& u) const {
        int rb, ct;
        if (G == 256) { const int x = c & 7, m = c >> 3, st = i * 8 + x, rbq = m >> 3, ctq = m & 7;
            if (sh == 4) { rb = 4 * (st >> 1) + rbq; ct = 8 * (st & 1) + ctq; } else { rb = 4 * st + rbq; ct = ctq; } }
        else { const int L = i * G + c; rb = L >> sh; ct = L & ((1 << sh) - 1); }
        if (rb >= nrb) return false;
        const int e = __builtin_amdgcn_readfirstlane(rbe[rb]);
        u.pm = rb; u.pn = (e << sh) + ct; return true; }
    __device__ __forceinline__ void a_ready(const Unit&) const {}
    __device__ __forceinline__ void done(const Unit&) const {}
};

struct Args { const float* in[28]; float* out; unsigned char* ws; int ph_lo, ph_hi; };
enum { I_X = 0, I_C, I_WADA, I_BADA, I_N1G, I_WIN, I_QG, I_KG, I_ARE, I_AIM, I_LDT, I_BRE, I_BIM, I_CRE, I_CIM, I_SD, I_WGLU, I_BGLU, I_WPA, I_WPB, I_WOUT, I_N2G, I_WR, I_BR, I_WGU, I_BGU, I_WD, I_BD };

__device__ __forceinline__ int crow(int r, int hi) { return (r & 3) + 8 * (r >> 2) + 4 * hi; }

__device__ __forceinline__ void ph0_adaln(const Args& a, LAS unsigned char* lds, int tid, int G, int bid) {
    LAS float* cond = (LAS float*)lds;
    LAS float* red = (LAS float*)(lds + 65536);
    const float* c = a.in[I_C]; const float* W = a.in[I_WADA]; const float* bada = a.in[I_BADA]; float* MOD = (float*)(a.ws + WS_MOD);
    bool have = false;
    for (int ub = bid; ub < MODW / 64; ub += G) {
        if (!have) { for (int i = tid; i < NB * DM; i += NTHR) { const int b = i >> 11, k = i & 2047; const float v = c[i]; cond[k * 8 + b] = v / (1.0f + expf(-v)); } __syncthreads(); have = true; }
        const int cc = tid & 63, col = ub * 64 + cc, kq = tid >> 6;
        float acc[8];
#pragma unroll
        for (int b = 0; b < 8; ++b) acc[b] = 0.f;
        const float* wp = W + (size_t)(kq * 256) * MODW + col;
        for (int k = 0; k < 256; k += 64) {
            float w[64];
#pragma unroll
            for (int q = 0; q < 64; ++q) w[q] = wp[(size_t)(k + q) * MODW];
#pragma unroll
            for (int q = 0; q < 64; ++q) { const f32x4 c0 = *(const LAS f32x4*)(cond + (kq * 256 + k + q) * 8), c1 = *(const LAS f32x4*)(cond + (kq * 256 + k + q) * 8 + 4);
                acc[0] += w[q] * c0[0]; acc[1] += w[q] * c0[1]; acc[2] += w[q] * c0[2]; acc[3] += w[q] * c0[3];
                acc[4] += w[q] * c1[0]; acc[5] += w[q] * c1[1]; acc[6] += w[q] * c1[2]; acc[7] += w[q] * c1[3]; }
        }
#pragma unroll
        for (int b = 0; b < 8; ++b) red[(kq * 8 + b) * 64 + cc] = acc[b];
        __syncthreads();
        { const int b = tid >> 6;
          float s = 0.f;
#pragma unroll
          for (int q = 0; q < 8; ++q) s += red[(q * 8 + b) * 64 + cc];
          MOD[(size_t)b * MODW + col] = s + bada[col]; }
        __syncthreads();
    }
    __syncthreads();
}
__device__ __forceinline__ void tr_item(const float* W, int ldw, int K, int srccol, int nvalid, bf16* WT, size_t dstrow0, int k0, LAS float* scr, int lane) {
    const int nn = lane & 31; const bool ok = nn < nvalid;
#pragma unroll 8
    for (int i = 0; i < 32; ++i) { const int kk = 2 * i + (lane >> 5); scr[kk * 33 + nn] = ok ? W[(size_t)(k0 + kk) * ldw + srccol + nn] : 0.f; }
    LDS_WAIT(); asm volatile("" ::: "memory");
    const int c = lane & 7;
#pragma unroll
    for (int j = 0; j < 4; ++j) { const int n = (lane >> 3) + 8 * j; const LAS float* s = scr + (8 * c) * 33 + n;
        v4u o; o.x = pk2(s[0 * 33], s[1 * 33]); o.y = pk2(s[2 * 33], s[3 * 33]); o.z = pk2(s[4 * 33], s[5 * 33]); o.w = pk2(s[6 * 33], s[7 * 33]);
        *(v4u*)(WT + (dstrow0 + n) * K + k0 + 8 * c) = o; }
    LDS_WAIT(); asm volatile("" ::: "memory");
}
__device__ __forceinline__ void tr128_f8(const float* W, int ldw, int srccol, unsigned char* WT, size_t dstrow0, int K, int k0, LAS unsigned char* tile, int lane) {
    const float* src = W + (size_t)k0 * ldw + srccol + 2 * lane;
    f32x2 va[16], vb[16], vc[16], vd[16];
#define CV_LOAD(v, kb) do { _Pragma("unroll") for (int j = 0; j < 16; ++j) v[j] = __builtin_nontemporal_load((const f32x2*)(src + (size_t)((kb) * 16 + j) * ldw)); } while (0)
#define CV_PUT(v, kb) do { v4u a, b; \
        a.x = pk4_fp8(v[0][0] * F8_WSCALE, v[1][0] * F8_WSCALE, v[2][0] * F8_WSCALE, v[3][0] * F8_WSCALE); a.y = pk4_fp8(v[4][0] * F8_WSCALE, v[5][0] * F8_WSCALE, v[6][0] * F8_WSCALE, v[7][0] * F8_WSCALE); \
        a.z = pk4_fp8(v[8][0] * F8_WSCALE, v[9][0] * F8_WSCALE, v[10][0] * F8_WSCALE, v[11][0] * F8_WSCALE); a.w = pk4_fp8(v[12][0] * F8_WSCALE, v[13][0] * F8_WSCALE, v[14][0] * F8_WSCALE, v[15][0] * F8_WSCALE); \
        b.x = pk4_fp8(v[0][1] * F8_WSCALE, v[1][1] * F8_WSCALE, v[2][1] * F8_WSCALE, v[3][1] * F8_WSCALE); b.y = pk4_fp8(v[4][1] * F8_WSCALE, v[5][1] * F8_WSCALE, v[6][1] * F8_WSCALE, v[7][1] * F8_WSCALE); \
        b.z = pk4_fp8(v[8][1] * F8_WSCALE, v[9][1] * F8_WSCALE, v[10][1] * F8_WSCALE, v[11][1] * F8_WSCALE); b.w = pk4_fp8(v[12][1] * F8_WSCALE, v[13][1] * F8_WSCALE, v[14][1] * F8_WSCALE, v[15][1] * F8_WSCALE); \
        const int n0 = 2 * lane, n1 = 2 * lane + 1; \
        *(LAS v4u*)(tile + n0 * 128 + ((((kb)) ^ (n0 & 7)) << 4)) = a; *(LAS v4u*)(tile + n1 * 128 + ((((kb)) ^ (n1 & 7)) << 4)) = b; } while (0)
    CV_LOAD(va, 0); CV_LOAD(vb, 1); CV_LOAD(vc, 2);
    CV_LOAD(vd, 3); CV_PUT(va, 0); CV_LOAD(va, 4); CV_PUT(vb, 1); CV_LOAD(vb, 5); CV_PUT(vc, 2); CV_LOAD(vc, 6); CV_PUT(vd, 3); CV_LOAD(vd, 7);
    CV_PUT(va, 4); CV_PUT(vb, 5); CV_PUT(vc, 6); CV_PUT(vd, 7);
#undef CV_LOAD
#undef CV_PUT
    LDS_WAIT(); asm volatile("" ::: "memory");
    const int c = lane & 7;
#pragma unroll
    for (int j = 0; j < 16; ++j) { const int n = (lane >> 3) + 8 * j; const v4u o = *(const LAS v4u*)(tile + n * 128 + ((c ^ (n & 7)) << 4));
        *(v4u*)(WT + (dstrow0 + n) * K + k0 + 16 * c) = o; }
    LDS_WAIT(); asm volatile("" ::: "memory");
}
constexpr int CV_GU1 = 16 * 32, CV_GU = 32 * CV_GU1, CV_D1 = 16 * 16, CV_DN = 32 * CV_D1, CV_PA = 8 * 16, CV_PB = 8 * 16, CV_WO = 16 * 16, CV_ITEMS = CV_PA + CV_PB + CV_WO + CV_GU + CV_DN;
__device__ __forceinline__ void cv_item(const Args& a, int it, LAS unsigned char* tile, int lane) {
    if (it < CV_PA) { const int kt = it >> 4, nt = it & 15; tr128_f8(a.in[I_WPA], 2048, 128 * nt, (unsigned char*)(a.ws + WS_WA), (size_t)128 * nt, 2048, 128 * kt, tile, lane); return; } it -= CV_PA;
    if (it < CV_PB) { const int kt = it >> 4, nt = it & 15; tr128_f8(a.in[I_WPB], 2048, 128 * nt, (unsigned char*)(a.ws + WS_WA + 1024), (size_t)128 * nt, 2048, 128 * kt, tile, lane); return; } it -= CV_PB;
    if (it < CV_WO) { const int kt = it >> 4, nt = it & 15; tr128_f8(a.in[I_WOUT], 2048, 128 * nt, (unsigned char*)(a.ws + WS_WO), (size_t)128 * nt, 2048, 128 * kt, tile, lane); return; } it -= CV_WO;
    if (it < CV_GU) { const int e = it / CV_GU1, q = it % CV_GU1, kt = q >> 5, nt = q & 31, d0 = 128 * nt, ct = d0 >> 8; const int src = (d0 & 128) ? (2048 + 128 * ct) : (128 * ct);
        tr128_f8(a.in[I_WGU] + (size_t)e * 2048 * 4096, 4096, src, (unsigned char*)(a.ws + WS_WGU), (size_t)e * 4096 + d0, 2048, 128 * kt, tile, lane); }
    else { const int r = it - CV_GU, e = r / CV_D1, q = r % CV_D1, kt = q >> 4, nt = q & 15;
        tr128_f8(a.in[I_WD] + (size_t)e * 2048 * 2048, 2048, 128 * nt, (unsigned char*)(a.ws + WS_WD), (size_t)e * 2048 + 128 * nt, 2048, 128 * kt, tile, lane); }
}
__device__ __forceinline__ void ph0_transposes(const Args& a, LAS unsigned char* lds, int wave, int lane, int G, int bid) {
    LAS float* scr = (LAS float*)(lds + wave * 16384);
    const int gw = wave * G + bid, NGW = G * NWAVES;
    constexpr int I_IN = 32 * 80, I_GL = 16 * 32, I_IN8 = 16 * 42;
    constexpr int NITEMS = I_IN + I_GL + I_IN8;
    for (int it = gw; it < NITEMS; it += NGW) {
        int r = it;
        if (r < I_IN) { const int kb = r / 80, nb = r % 80, d0 = 32 * nb; int src, nv = 32;
            if (d0 < 1280) src = d0; else if (d0 < 2304) src = 1536 + (d0 - 1280); else if (d0 < 2368) src = 2560 + (d0 - 2304); else if (d0 == 2368) { src = 2624; nv = 16; } else { src = 0; nv = 0; }
            tr_item(a.in[I_WIN], INW, DM, src, nv, (bf16*)(a.ws + WS_WIN), (size_t)d0, 64 * kb, scr, lane); continue; } r -= I_IN;
        if (r < I_GL) { const int kb = r / 32, nb = r % 32; tr_item(a.in[I_WGLU], 1024, 1024, 32 * nb, 32, (bf16*)(a.ws + WS_WGLU), (size_t)32 * nb, 64 * kb, scr, lane); continue; } r -= I_GL;
        { const int kt = r / 42, nt = r % 42; const int src = nt < 2 ? 1280 + 128 * nt : (nt < 10 ? 2640 + 128 * (nt - 2) : 3664 + 128 * (nt - 10));
          tr128_f8(a.in[I_WIN], INW, src, (unsigned char*)(a.ws + WS_WIN8), (size_t)128 * nt, 2048, 128 * kt, lds + wave * 16384, lane); }
    }
}
__device__ __forceinline__ void cv_queue(const Args& a, LAS unsigned char* lds, int wave, int lane) {
    unsigned* ctr = (unsigned*)(a.ws + WS_CTL) + CW_CVQ;
    for (;;) { int it = 0; if (lane == 0) it = (int)__hip_atomic_fetch_add(ctr, 1u, RLX_AGENT); it = __builtin_amdgcn_readfirstlane(it); if (it >= CV_ITEMS) break; cv_item(a, it, lds + wave * 16384, lane); }
}
__device__ __forceinline__ void cexp_d(double zr, double zi, double& er, double& ei) {
    const double s = 1.0 / 1024.0; zr *= s; zi *= s;
    double wr = 1.0, wi = 0.0;
#pragma unroll
    for (int k = 10; k >= 1; --k) { const double tr = (zr * wr - zi * wi) / (double)k, ti = (zr * wi + zi * wr) / (double)k; wr = 1.0 + tr; wi = ti; }
#pragma unroll
    for (int q = 0; q < 10; ++q) { const double tr = wr * wr - wi * wi, ti = 2.0 * wr * wi; wr = tr; wi = ti; }
    er = wr; ei = wi;
}
__device__ __forceinline__ void ph0_ssm_consts(const Args& a, int tid, int G, int bid) {
    float* BBAR = (float*)(a.ws + WS_BBAR); float* POW = (float*)(a.ws + WS_POW);
    for (int idx = bid * NTHR + tid; idx < SSMG * SSMN; idx += G * NTHR) {
        const int g = idx >> 6, n = idx & 63;
        double st, dummy; cexp_d((double)a.in[I_LDT][g], 0.0, st, dummy);
        const double are = (double)a.in[I_ARE][idx], aim = (double)a.in[I_AIM][idx];
        double er, ei; cexp_d(st * are, st * aim, er, ei);
        const double den = are * are + aim * aim, nr = er - 1.0, ni = ei;
        const double cr = (nr * are + ni * aim) / den, ci = (ni * are - nr * aim) / den;
#pragma unroll 4
        for (int p = 0; p < 16; ++p) { const double br = (double)a.in[I_BRE][(size_t)idx * 16 + p], bi = (double)a.in[I_BIM][(size_t)idx * 16 + p];
            BBAR[((size_t)idx * 16 + p) * 2 + 0] = (float)(cr * br - ci * bi); BBAR[((size_t)idx * 16 + p) * 2 + 1] = (float)(cr * bi + ci * br); }
        double pr = 1.0, pi = 0.0;
        for (int t = 0; t <= 64; ++t) { POW[(((size_t)g * 65 + t) * 64 + n) * 2 + 0] = (float)pr; POW[(((size_t)g * 65 + t) * 64 + n) * 2 + 1] = (float)pi;
            const double tr = pr * er - pi * ei, ti = pr * ei + pi * er; pr = tr; pi = ti; }
    }
}

__device__ __forceinline__ void ph1_norm(const Args& a, int wave, int lane, int G, int bid) {
    const float* MOD = (const float*)(a.ws + WS_MOD);
    const int gw = bid * NWAVES + wave, NGW = G * NWAVES;
    {
        const float* X = a.in[I_X]; const float* g1 = a.in[I_N1G]; bf16* HN = (bf16*)(a.ws + WS_HN); unsigned char* HN8 = (unsigned char*)(a.ws + WS_HN8);
        const int RPW = (T + NGW - 1) / NGW, r0 = gw * RPW, r1 = min(T, r0 + RPW);
        f32x4 vn[8], pa[8], pb[8]; int curb = -1;
        if (r0 < r1) { const f32x4* xr = (const f32x4*)(X + (size_t)r0 * DM) + 2 * lane;
#pragma unroll
            for (int j = 0; j < 4; ++j) { vn[2 * j] = xr[128 * j]; vn[2 * j + 1] = xr[128 * j + 1]; } }
        for (int row = r0; row < r1; ++row) {
            const int b = row >> 11;
            f32x4 v[8]; float s = 0.f;
#pragma unroll
            for (int j = 0; j < 8; ++j) { v[j] = vn[j]; s += (v[j][0] * v[j][0] + v[j][1] * v[j][1]) + (v[j][2] * v[j][2] + v[j][3] * v[j][3]); }
            if (row + 1 < r1) { const f32x4* xr = (const f32x4*)(X + (size_t)(row + 1) * DM) + 2 * lane;
#pragma unroll
                for (int j = 0; j < 4; ++j) { vn[2 * j] = xr[128 * j]; vn[2 * j + 1] = xr[128 * j + 1]; } }
            if (b != curb) { curb = b; const f32x4* gp = (const f32x4*)g1 + 2 * lane; const f32x4* shp = (const f32x4*)(MOD + (size_t)b * MODW) + 2 * lane; const f32x4* scp = (const f32x4*)(MOD + (size_t)b * MODW + DM) + 2 * lane;
#pragma unroll
                for (int j = 0; j < 4; ++j) { pa[2 * j] = gp[128 * j] * (scp[128 * j] + 1.0f); pa[2 * j + 1] = gp[128 * j + 1] * (scp[128 * j + 1] + 1.0f); pb[2 * j] = shp[128 * j]; pb[2 * j + 1] = shp[128 * j + 1]; } }
            const float rstd = 1.0f / sqrtf(wave_sum(s) * (1.0f / DM) + RMS_EPS);
            v4u* o16 = (v4u*)(HN + (size_t)row * DM) + lane; v2u* o8 = (v2u*)(HN8 + (size_t)row * DM) + lane; v4u w[4]; v2u w8[4];
#pragma unroll
            for (int j = 0; j < 4; ++j) { const f32x4 y0 = (v[2 * j] * rstd) * pa[2 * j] + pb[2 * j], y1 = (v[2 * j + 1] * rstd) * pa[2 * j + 1] + pb[2 * j + 1];
                w[j].x = pk2(y0[0], y0[1]); w[j].y = pk2(y0[2], y0[3]); w[j].z = pk2(y1[0], y1[1]); w[j].w = pk2(y1[2], y1[3]);
                w8[j].x = pk4_fp8(y0[0] * F8_ASCALE, y0[1] * F8_ASCALE, y0[2] * F8_ASCALE, y0[3] * F8_ASCALE); w8[j].y = pk4_fp8(y1[0] * F8_ASCALE, y1[1] * F8_ASCALE, y1[2] * F8_ASCALE, y1[3] * F8_ASCALE); }
#pragma unroll
            for (int j = 0; j < 4; ++j) { o16[64 * j] = w[j]; o8[64 * j] = w8[j]; }
        }
    }
}
__device__ __forceinline__ void ph1_small(const Args& a, int tid, int wave, int lane, int G, int bid) {
    const float* MOD = (const float*)(a.ws + WS_MOD);
    const int gw = bid * NWAVES + wave, NGW = G * NWAVES;
    {
        const float* g2 = a.in[I_N2G]; const float* wr = a.in[I_WR]; const float* br = a.in[I_BR]; float* WRP = (float*)(a.ws + WS_WRP); float* BRP = (float*)(a.ws + WS_BRP);
        for (int base = bid * NTHR + tid; base < NB * DM * NEXP; base += 4 * G * NTHR) { float v[4];
#pragma unroll
            for (int u = 0; u < 4; ++u) { const int idx = base + u * G * NTHR, ic = idx < NB * DM * NEXP ? idx : 0, b = ic >> 16, k = (ic >> 5) & 2047; v[u] = g2[k] * (1.0f + MOD[(size_t)b * MODW + 4 * DM + k]) * wr[ic & 65535]; }
#pragma unroll
            for (int u = 0; u < 4; ++u) { const int idx = base + u * G * NTHR; if (idx < NB * DM * NEXP) WRP[idx] = v[u]; } }
        for (int o = (wave == 2 ? bid : NB * NEXP); o < NB * NEXP; o += G) { const int b = o >> 5, e = o & 31; float s = 0.f;
#pragma unroll 8
            for (int k = lane; k < DM; k += 64) s += MOD[(size_t)b * MODW + 3 * DM + k] * wr[k * 32 + e];
            s = wave_sum(s); if (lane == 0) BRP[o] = s + br[e]; }
    }
    {
        const float* cre = a.in[I_CRE]; const float* cim = a.in[I_CIM]; const float* BBAR = (const float*)(a.ws + WS_BBAR); const float* POW = (const float*)(a.ws + WS_POW); float* KT = (float*)(a.ws + WS_KT);
        for (int idx = (tid < 128 ? bid * 128 + tid : SSMG * SL * 16); idx < SSMG * SL * 16; idx += G * 128) {
            const int g = idx >> 9, tau = (idx >> 4) & 31, p = idx & 15; float s[16];
#pragma unroll
            for (int q = 0; q < 16; ++q) s[q] = 0.f;
#pragma unroll 8
            for (int n = 0; n < 64; ++n) { const float cr = cre[((size_t)g * 16 + p) * 64 + n], ci = cim[((size_t)g * 16 + p) * 64 + n];
                const float pr = POW[(((size_t)g * 65 + tau) * 64 + n) * 2], pi = POW[(((size_t)g * 65 + tau) * 64 + n) * 2 + 1];
                const float er = cr * pr - ci * pi, ei = cr * pi + ci * pr;
                const f32x4* bp = (const f32x4*)(BBAR + ((size_t)g * 64 + n) * 32);
#pragma unroll
                for (int q = 0; q < 8; ++q) { const f32x4 bb = bp[q]; s[2 * q] += er * bb[0] - ei * bb[1]; s[2 * q + 1] += er * bb[2] - ei * bb[3]; } }
            { const float dv = (tau == 0) ? a.in[I_SD][g * 16 + p] : 0.0f;
#pragma unroll
              for (int q = 0; q < 16; ++q) s[q] += (q == p) ? dv : 0.0f; }
            float* kp = KT + (((size_t)g * 64 + tau) * 16 + p) * 16;
#pragma unroll
            for (int q = 0; q < 4; ++q) *(f32x4*)(kp + 4 * q) = (f32x4){s[4 * q], s[4 * q + 1], s[4 * q + 2], s[4 * q + 3]}; }
    }
}

__device__ __forceinline__ void qknorm_body(const Args& a, int wave, int lane, int G, int bid) {
    const int gw = bid * NWAVES + wave, NGW = G * NWAVES;
    {   bf16* Q = (bf16*)(a.ws + WS_Q); bf16* K = (bf16*)(a.ws + WS_K); const float* qg = a.in[I_QG]; const float* kg = a.in[I_KG];
        const float qs = 0.08838834764831845f * 1.4426950408889634f;
        const int l32 = lane & 31; float qgv[16], kgv[8];
#pragma unroll
        for (int e = 0; e < 16; ++e) qgv[e] = qg[((16 * lane) & 127) + e];
#pragma unroll
        for (int e = 0; e < 8; ++e) kgv[e] = kg[((8 * l32) & 127) + e];
        for (int row0 = gw; row0 < T; row0 += 4 * NGW) {
            v4u qa[4], qb[4], ka[4];
#pragma unroll
            for (int u = 0; u < 4; ++u) { const int row = min(row0 + u * NGW, T - 1); const v4u* qp = (const v4u*)(Q + (size_t)row * 1024 + 16 * lane); qa[u] = qp[0]; qb[u] = qp[1]; ka[u] = *(const v4u*)(K + (size_t)row * 256 + 8 * l32); }
#pragma unroll
            for (int u = 0; u < 4; ++u) { const int row = row0 + u * NGW; if (row < T) {
                {   v4u* qp = (v4u*)(Q + (size_t)row * 1024 + 16 * lane); const v4u w0 = qa[u], w1 = qb[u]; float f[16];
                    f[0] = bflo(w0.x); f[1] = bfhi(w0.x); f[2] = bflo(w0.y); f[3] = bfhi(w0.y); f[4] = bflo(w0.z); f[5] = bfhi(w0.z); f[6] = bflo(w0.w); f[7] = bfhi(w0.w);
                    f[8] = bflo(w1.x); f[9] = bfhi(w1.x); f[10] = bflo(w1.y); f[11] = bfhi(w1.y); f[12] = bflo(w1.z); f[13] = bfhi(w1.z); f[14] = bflo(w1.w); f[15] = bfhi(w1.w);
                    float s = 0.f;
#pragma unroll
                    for (int e = 0; e < 16; ++e) s += f[e] * f[e];
                    s += __shfl_xor(s, 1); s += __shfl_xor(s, 2); s += __shfl_xor(s, 4);
                    const float rs = qs / sqrtf(s * (1.0f / 128.0f) + RMS_EPS);
#pragma unroll
                    for (int e = 0; e < 16; ++e) f[e] = f[e] * rs * qgv[e];
                    v4u o0, o1; o0.x = pk2(f[0], f[1]); o0.y = pk2(f[2], f[3]); o0.z = pk2(f[4], f[5]); o0.w = pk2(f[6], f[7]); o1.x = pk2(f[8], f[9]); o1.y = pk2(f[10], f[11]); o1.z = pk2(f[12], f[13]); o1.w = pk2(f[14], f[15]);
                    qp[0] = o0; qp[1] = o1; }
                {   v4u* kp = (v4u*)(K + (size_t)row * 256 + 8 * l32); const v4u w0 = ka[u]; float f[8];
                    f[0] = bflo(w0.x); f[1] = bfhi(w0.x); f[2] = bflo(w0.y); f[3] = bfhi(w0.y); f[4] = bflo(w0.z); f[5] = bfhi(w0.z); f[6] = bflo(w0.w); f[7] = bfhi(w0.w);
                    float s = 0.f;
#pragma unroll
                    for (int e = 0; e < 8; ++e) s += f[e] * f[e];
                    s += __shfl_xor(s, 1); s += __shfl_xor(s, 2); s += __shfl_xor(s, 4); s += __shfl_xor(s, 8);
                    const float rs = 1.0f / sqrtf(s * (1.0f / 128.0f) + RMS_EPS);
#pragma unroll
                    for (int e = 0; e < 8; ++e) f[e] = f[e] * rs * kgv[e];
                    v4u o0; o0.x = pk2(f[0], f[1]); o0.y = pk2(f[2], f[3]); o0.z = pk2(f[4], f[5]); o0.w = pk2(f[6], f[7]);
                    if (lane < 32) kp[0] = o0; } } }
        }
    }
}
__device__ __forceinline__ void bty_body(const Args& a, int tid, int G, int bid) {
    const float* KT = (const float*)(a.ws + WS_KT); const float* POW = (const float*)(a.ws + WS_POW); const float* cre = a.in[I_CRE]; const float* cim = a.in[I_CIM]; bf16* BTY = (bf16*)(a.ws + WS_BTY);
    constexpr int RPG = SL * 16; const int NA = SSMG * RPG * 64, NBC = SSMG * RPG * 16, ST = G * NTHR;
    for (int base = bid * NTHR + tid; base < NA; base += 4 * ST) {
        f32x4 lo[4], hi[4];
#pragma unroll
        for (int u = 0; u < 4; ++u) { const int idx = base + u * ST, ic = idx < NA ? idx : 0, cc = ic & 63, rr = (ic >> 6) & (RPG - 1), g = ic >> 15, j = rr >> 4, p = rr & 15, i = cc >> 1, d = j >= i ? j - i : 0;
            const float* kp = KT + (((size_t)g * 64 + d) * 16 + p) * 16 + (cc & 1) * 8; lo[u] = *(const f32x4*)kp; hi[u] = *(const f32x4*)(kp + 4); }
#pragma unroll
        for (int u = 0; u < 4; ++u) { const int idx = base + u * ST; if (idx < NA) { const int cc = idx & 63, rr = (idx >> 6) & (RPG - 1), g = idx >> 15, j = rr >> 4, i = cc >> 1; const bool ok = j >= i;
            v4u o; o.x = ok ? pk2(lo[u][0], lo[u][1]) : 0u; o.y = ok ? pk2(lo[u][2], lo[u][3]) : 0u; o.z = ok ? pk2(hi[u][0], hi[u][1]) : 0u; o.w = ok ? pk2(hi[u][2], hi[u][3]) : 0u;
            *(v4u*)(BTY + ((size_t)g * RPG + rr) * UA_LD + 8 * cc) = o; } }
    }
    for (int base = bid * NTHR + tid; base < NBC; base += 4 * ST) {
        f32x4 cr[4], ci[4], p0[4], p1[4];
#pragma unroll
        for (int u = 0; u < 4; ++u) { const int idx = base + u * ST, ic = idx < NBC ? idx : 0, cq = ic & 15, rr = (ic >> 4) & (RPG - 1), g = ic >> 13, j = rr >> 4, p = rr & 15;
            cr[u] = *(const f32x4*)(cre + ((size_t)g * 16 + p) * 64 + 4 * cq); ci[u] = *(const f32x4*)(cim + ((size_t)g * 16 + p) * 64 + 4 * cq);
            const float* pw = POW + (((size_t)g * 65 + (j + 1)) * 64 + 4 * cq) * 2; p0[u] = *(const f32x4*)pw; p1[u] = *(const f32x4*)(pw + 4); }
#pragma unroll
        for (int u = 0; u < 4; ++u) { const int idx = base + u * ST; if (idx < NBC) { const int cq = idx & 15, rr = (idx >> 4) & (RPG - 1), g = idx >> 13;
            v4u o; o.x = pk2(cr[u][0] * p0[u][0] - ci[u][0] * p0[u][1], -(cr[u][0] * p0[u][1] + ci[u][0] * p0[u][0])); o.y = pk2(cr[u][1] * p0[u][2] - ci[u][1] * p0[u][3], -(cr[u][1] * p0[u][3] + ci[u][1] * p0[u][2]));
            o.z = pk2(cr[u][2] * p1[u][0] - ci[u][2] * p1[u][1], -(cr[u][2] * p1[u][1] + ci[u][2] * p1[u][0])); o.w = pk2(cr[u][3] * p1[u][2] - ci[u][3] * p1[u][3], -(cr[u][3] * p1[u][3] + ci[u][3] * p1[u][2]));
            *(v4u*)(BTY + ((size_t)g * RPG + rr) * UA_LD + SL * 16 + 8 * cq) = o; } }
    }
}
__device__ __forceinline__ void bts_body(const Args& a, int tid, int G, int bid) {
    const float* BBAR = (const float*)(a.ws + WS_BBAR); const float* POW = (const float*)(a.ws + WS_POW); bf16* BTS = (bf16*)(a.ws + WS_BTS);
    constexpr int CPR = SL * 16 / 8; const int NCH = SSMG * 256 * CPR, ST = G * NTHR;
    for (int base = bid * NTHR + tid; base < NCH; base += 4 * ST) {
        f32x4 bb[4][4]; f32x2 pw[4];
#pragma unroll
        for (int u = 0; u < 4; ++u) { const int idx = base + u * ST, ic = idx < NCH ? idx : 0, cc = ic % CPR, rr = (ic / CPR) & 127, g = ic / (CPR * 256), col0 = 8 * cc, i = col0 >> 4, pp0 = col0 & 15, n = rr >> 1;
            pw[u] = *(const f32x2*)(POW + (((size_t)g * 65 + (SL - 1 - i)) * 64 + n) * 2); const f32x4* bp = (const f32x4*)(BBAR + (((size_t)g * 64 + n) * 16 + pp0) * 2);
#pragma unroll
            for (int q = 0; q < 4; ++q) bb[u][q] = bp[q]; }
#pragma unroll
        for (int u = 0; u < 4; ++u) { const int idx = base + u * ST; if (idx < NCH) { const int cc = idx % CPR, rr = (idx / CPR) & 255, g = idx / (CPR * 256); const bool live = rr < 128, part = rr & 1; const float pr = pw[u][0], pi = pw[u][1]; float f[8];
#pragma unroll
            for (int q = 0; q < 4; ++q) { f[2 * q] = part ? (pr * bb[u][q][1] + pi * bb[u][q][0]) : (pr * bb[u][q][0] - pi * bb[u][q][1]); f[2 * q + 1] = part ? (pr * bb[u][q][3] + pi * bb[u][q][2]) : (pr * bb[u][q][2] - pi * bb[u][q][3]); }
            v4u o; o.x = live ? pk2(f[0], f[1]) : 0u; o.y = live ? pk2(f[2], f[3]) : 0u; o.z = live ? pk2(f[4], f[5]) : 0u; o.w = live ? pk2(f[6], f[7]) : 0u;
            *(v4u*)(BTS + ((size_t)g * 256 + rr) * (SL * 16) + 8 * cc) = o; } }
    }
}

namespace att {
constexpr int D = 128, NW = 8, QBLK = 32, KVBLK = 64, LDK = 256;
constexpr float THR2 = 11.5415603f;
constexpr size_t SHM_V = KVBLK * D * 2, SHM_K = KVBLK * D * 2, SHM_ATTN = 2 * SHM_V + 2 * SHM_K + NW * 64 * 4;
using u32x4 = __attribute__((ext_vector_type(4))) unsigned;
#define KSWZ(row, colB) ((row) * 256 + ((colB) ^ (((row) & 7) << 4)))
#define SBAR() __builtin_amdgcn_sched_barrier(0)
__device__ __forceinline__ unsigned cvtpk(float lo, float hi) { unsigned r; asm volatile("v_cvt_pk_bf16_f32 %0, %1, %2" : "=v"(r) : "v"(lo), "v"(hi)); return r; }

__device__ __forceinline__ void amask(f32x16& p0, f32x16& p1, unsigned mw0, unsigned mw1, float dq, float nslope, int hi) {
  const unsigned s0 = mw0 >> (4 * hi), s1 = mw1 >> (4 * hi);
#pragma unroll
  for (int r = 0; r < 16; ++r) { const int c = (r & 3) + 8 * (r >> 2);
    const float v = fmaf(nslope, fabsf(dq - (float)c), p0[r]); p0[r] = (s0 & (1u << c)) ? v : -INFINITY;
    const float w = fmaf(nslope, fabsf(dq - (float)(c + 32)), p1[r]); p1[r] = (s1 & (1u << c)) ? w : -INFINITY; }
}
__device__ __forceinline__ void partialSM(f32x16& p0, f32x16& p1, float& m_reg, float& mn, float& alpha) {
  float pmax = p0[0];
#pragma unroll
  for (int r = 1; r < 16; ++r) pmax = fmaxf(pmax, p0[r]);
#pragma unroll
  for (int r = 0; r < 16; ++r) pmax = fmaxf(pmax, p1[r]);
  { auto rr = __builtin_amdgcn_permlane32_swap(__float_as_uint(pmax), __float_as_uint(pmax), false, false);
    pmax = fmaxf(__uint_as_float(rr[0]), __uint_as_float(rr[1])); }
  if (__builtin_expect(__all(pmax - m_reg <= THR2), 1)) { mn = m_reg; alpha = 1.f; }
  else { mn = fmaxf(m_reg, pmax); alpha = __builtin_amdgcn_exp2f(m_reg - mn); m_reg = mn; }
#pragma unroll
  for (int r = 0; r < 16; ++r) p0[r] = p0[r] - mn;
#pragma unroll
  for (int r = 0; r < 16; ++r) p1[r] = p1[r] - mn;
#pragma unroll
  for (int r = 0; r < 16; ++r) p0[r] = __builtin_amdgcn_exp2f(p0[r]);
}
__device__ __forceinline__ void finishSM(f32x16& p0, f32x16& p1, float alpha, float& l_reg, bf16x8& pa0, bf16x8& pa1, bf16x8& pa2, bf16x8& pa3) {
#pragma unroll
  for (int r = 0; r < 16; ++r) p1[r] = __builtin_amdgcn_exp2f(p1[r]);
  float ps = 0;
#pragma unroll
  for (int r = 0; r < 16; ++r) ps += p0[r];
#pragma unroll
  for (int r = 0; r < 16; ++r) ps += p1[r];
  { auto rr = __builtin_amdgcn_permlane32_swap(__float_as_uint(ps), __float_as_uint(ps), false, false);
    ps = __uint_as_float(rr[0]) + __uint_as_float(rr[1]); }
  l_reg = l_reg * alpha + ps;
#define PK4(P, BASE, OUT) do { unsigned a0 = cvtpk(P[BASE + 0], P[BASE + 1]), a1 = cvtpk(P[BASE + 2], P[BASE + 3]);   \
    unsigned b0 = cvtpk(P[BASE + 4], P[BASE + 5]), b1 = cvtpk(P[BASE + 6], P[BASE + 7]);                              \
    auto r0 = __builtin_amdgcn_permlane32_swap(a0, b0, false, false); auto r1 = __builtin_amdgcn_permlane32_swap(a1, b1, false, false); \
    u32x4 w = {r0[0], r1[0], r0[1], r1[1]}; OUT = *reinterpret_cast<bf16x8*>(&w); } while (0)
  PK4(p0, 0, pa0); PK4(p0, 8, pa1); PK4(p1, 0, pa2); PK4(p1, 8, pa3);
#undef PK4
}
__device__ __forceinline__ void qkt(f32x16& p0, f32x16& p1, const bf16* Ks, const bf16x8* qr, int r32, int hi) {
  p0 = f32x16{}; p1 = f32x16{};
#pragma unroll
  for (int d0 = 0; d0 < 8; ++d0) { int cb = (d0 * 16 + hi * 8) * 2;
    bf16x8 b0 = *reinterpret_cast<const bf16x8*>((const char*)Ks + KSWZ(r32, cb));
    bf16x8 b1 = *reinterpret_cast<const bf16x8*>((const char*)Ks + KSWZ(32 + r32, cb));
    p0 = __builtin_amdgcn_mfma_f32_32x32x16_bf16(b0, qr[d0], p0, 0, 0, 0);
    p1 = __builtin_amdgcn_mfma_f32_32x32x16_bf16(b1, qr[d0], p1, 0, 0, 0); }
}
__device__ __forceinline__ int v_st(int k, int c) { const int kk = (k & ~0xC) | ((k & 4) << 1) | ((k & 8) >> 1); return ((kk >> 3) * 4 + (c >> 5)) * 512 + ((kk & 7) * 32 + (c & 31)) * 2; }
__device__ __forceinline__ int v_rd_base(int lane) { return ((lane & 3) << 3) | (((lane >> 2) & 3) << 6) | (((lane >> 4) & 1) << 5) | (((lane >> 5) & 1) << 8); }
constexpr int v_rd_off(int d0, int ks, int half) { return d0 * 512 + ks * 4096 + half * 2048; }
template <int OFF> __device__ __forceinline__ s16x4 tr_read(int vb) {
  s16x4 r; asm volatile("ds_read_b64_tr_b16 %0, %1 offset:%2" : "=&v"(r) : "v"(vb), "i"(OFF) : "memory"); return r;
}
template <int D0> __device__ __forceinline__ void pv_one(f32x16& od, int vb, bf16x8 pa0, bf16x8 pa1, bf16x8 pa2, bf16x8 pa3) {
  const s16x4 l0 = tr_read<v_rd_off(D0, 0, 0)>(vb), h0 = tr_read<v_rd_off(D0, 0, 1)>(vb), l1 = tr_read<v_rd_off(D0, 1, 0)>(vb), h1 = tr_read<v_rd_off(D0, 1, 1)>(vb);
  const s16x4 l2 = tr_read<v_rd_off(D0, 2, 0)>(vb), h2 = tr_read<v_rd_off(D0, 2, 1)>(vb), l3 = tr_read<v_rd_off(D0, 3, 0)>(vb), h3 = tr_read<v_rd_off(D0, 3, 1)>(vb);
  asm volatile("s_waitcnt lgkmcnt(0)" ::: "memory"); SBAR();
#define PK(L, H) (bf16x8){L[0], L[1], L[2], L[3], H[0], H[1], H[2], H[3]}
  od = __builtin_amdgcn_mfma_f32_32x32x16_bf16(pa0, PK(l0, h0), od, 0, 0, 0);
  od = __builtin_amdgcn_mfma_f32_32x32x16_bf16(pa1, PK(l1, h1), od, 0, 0, 0);
  od = __builtin_amdgcn_mfma_f32_32x32x16_bf16(pa2, PK(l2, h2), od, 0, 0, 0);
  od = __builtin_amdgcn_mfma_f32_32x32x16_bf16(pa3, PK(l3, h3), od, 0, 0, 0);
#undef PK
}
__device__ __forceinline__ void pv_d0(f32x16* o, int vb, bf16x8 pa0, bf16x8 pa1, bf16x8 pa2, bf16x8 pa3) {
  pv_one<0>(o[0], vb, pa0, pa1, pa2, pa3); pv_one<1>(o[1], vb, pa0, pa1, pa2, pa3); pv_one<2>(o[2], vb, pa0, pa1, pa2, pa3); pv_one<3>(o[3], vb, pa0, pa1, pa2, pa3);
}

__device__ __forceinline__ void attn_unit(const bf16* __restrict__ Qlane, const bf16* __restrict__ Kh, const bf16* __restrict__ Vh, unsigned char* __restrict__ Ow, int ldo,
                                          const unsigned* __restrict__ selbase, unsigned selo, int qpos, float nslope, int NT, int NTreal, char* lds) {
  const int tid = threadIdx.x, wid = tid >> 6, lane = tid & 63, r32 = lane & 31, hi = lane >> 5;
  bf16* V_lds = (bf16*)lds; bf16* K_lds = (bf16*)(lds + 2 * SHM_V);
  float* ws = (float*)(lds + 2 * SHM_V + 2 * SHM_K) + wid * 64; float* li_l = ws; float* al_l = ws + 32;
  float m_reg = -1e30f, l_reg = 0; f32x16 o[4] = {}; bf16x8 qr[8];
#pragma unroll
  for (int d0 = 0; d0 < 8; ++d0) qr[d0] = *reinterpret_cast<const bf16x8*>(Qlane + d0 * 16);
  const int sr = tid >> 4, sc = (tid & 15) * 8, vst0 = v_st(sr, sc), vst1 = v_st(32 + sr, sc);
  const int vb0 = (int)(uintptr_t)V_lds + v_rd_base(lane);
  const int soffb = (sr * LDK + sc) * 2;
  const __amdgpu_buffer_rsrc_t rsK = __builtin_amdgcn_make_buffer_rsrc((void*)Kh, 0, 1 << 20, 0x00020000), rsV = __builtin_amdgcn_make_buffer_rsrc((void*)Vh, 0, 1 << 20, 0x00020000);
  const float dqb = (float)(qpos - 4 * hi);
  struct { bf16x8 vs0, vs1, ks0, ks1; } sr_[2];
#define SLOAD(i, k0) do { const int so_ = (k0) * (LDK * 2); \
    sr_[i].vs0 = __builtin_bit_cast(bf16x8, __builtin_amdgcn_raw_buffer_load_b128(rsV, soffb, so_, 0)); sr_[i].vs1 = __builtin_bit_cast(bf16x8, __builtin_amdgcn_raw_buffer_load_b128(rsV, soffb, so_ + 32 * LDK * 2, 0)); \
    sr_[i].ks0 = __builtin_bit_cast(bf16x8, __builtin_amdgcn_raw_buffer_load_b128(rsK, soffb, so_, 0)); sr_[i].ks1 = __builtin_bit_cast(bf16x8, __builtin_amdgcn_raw_buffer_load_b128(rsK, soffb, so_ + 32 * LDK * 2, 0)); } while (0)
#define SWRITE(b, i) do { *(bf16x8*)((char*)V_lds + (b) * SHM_V + vst0) = sr_[i].vs0;          \
    *(bf16x8*)((char*)V_lds + (b) * SHM_V + vst1) = sr_[i].vs1; int kc = sc * 2;               \
    *(bf16x8*)((char*)K_lds + (b) * SHM_K + KSWZ(sr, kc)) = sr_[i].ks0;                       \
    *(bf16x8*)((char*)K_lds + (b) * SHM_K + KSWZ(32 + sr, kc)) = sr_[i].ks1; } while (0)
#define SWAIT() asm volatile("s_waitcnt vmcnt(4)" ::: "memory")
#define RESC(a) do { if (__any((a) < 1.f)) { if (hi == 0) al_l[r32] = (a); asm volatile("s_waitcnt lgkmcnt(0)" ::: "memory"); \
    _Pragma("unroll") for (int d = 0; d < 4; ++d) _Pragma("unroll") for (int r = 0; r < 16; ++r) o[d][r] *= al_l[crow(r, hi)]; } } while (0)
#define MASKW(j, m0, m1) do { const v2u mm_ = *reinterpret_cast<const v2u*>(selbase + (selo + 2u * (unsigned)(j))); const bool in_ = (j) < NTreal; m0 = in_ ? mm_.x : 0u; m1 = in_ ? mm_.y : 0u; } while (0)
  f32x16 pA0, pA1, pB0, pB1; float mnA, mnB, alA, alB; bf16x8 pa0, pa1, pa2, pa3; unsigned ma0, ma1, mb0, mb1;
  constexpr int SE = 0, SO = 1;
  SLOAD(SE, 0); MASKW(0, ma0, ma1); MASKW(1, mb0, mb1); asm volatile("s_waitcnt vmcnt(0)" ::: "memory"); SWRITE(0, SE); __syncthreads();
  qkt(pA0, pA1, K_lds, qr, r32, hi); amask(pA0, pA1, ma0, ma1, dqb, nslope, hi); partialSM(pA0, pA1, m_reg, mnA, alA);
  SLOAD(SO, KVBLK); if (2 < NT) SLOAD(SE, 2 * KVBLK);
  SWAIT(); SWRITE(1, SO); __syncthreads();
  for (int j = 1; j + 1 < NT; j += 2) {
    SBAR(); qkt(pB0, pB1, (bf16*)((char*)K_lds + SHM_K), qr, r32, hi);
    finishSM(pA0, pA1, alA, l_reg, pa0, pa1, pa2, pa3); SBAR();
    MASKW(j + 1, ma0, ma1); SLOAD(SO, (j + 2) * KVBLK); SBAR();
    pv_d0(o, vb0, pa0, pa1, pa2, pa3); amask(pB0, pB1, mb0, mb1, dqb - (float)(64 * j), nslope, hi); partialSM(pB0, pB1, m_reg, mnB, alB);
    __syncthreads(); SWAIT(); SWRITE(0, SE);
    RESC(alB); __syncthreads();
    SBAR(); qkt(pA0, pA1, K_lds, qr, r32, hi);
    finishSM(pB0, pB1, alB, l_reg, pa0, pa1, pa2, pa3); SBAR();
    MASKW(j + 2, mb0, mb1); if (j + 3 < NT) SLOAD(SE, (j + 3) * KVBLK); SBAR();
    pv_d0(o, vb0 + (int)SHM_V, pa0, pa1, pa2, pa3); amask(pA0, pA1, ma0, ma1, dqb - (float)(64 * (j + 1)), nslope, hi); partialSM(pA0, pA1, m_reg, mnA, alA);
    __syncthreads(); SWAIT(); SWRITE(1, SO);
    RESC(alA); __syncthreads();
  }
  SBAR(); qkt(pB0, pB1, (bf16*)((char*)K_lds + SHM_K), qr, r32, hi);
  finishSM(pA0, pA1, alA, l_reg, pa0, pa1, pa2, pa3); SBAR();
  SBAR();
  pv_d0(o, vb0, pa0, pa1, pa2, pa3); amask(pB0, pB1, mb0, mb1, dqb - (float)(64 * (NT - 1)), nslope, hi); partialSM(pB0, pB1, m_reg, mnB, alB);
  __syncthreads(); RESC(alB);
  finishSM(pB0, pB1, alB, l_reg, pa0, pa1, pa2, pa3); SBAR();
  pv_d0(o, vb0 + (int)SHM_V, pa0, pa1, pa2, pa3);
  if (hi == 0) li_l[r32] = l_reg; asm volatile("s_waitcnt lgkmcnt(0)" ::: "memory");
  float rli[16];
#pragma unroll
  for (int r = 0; r < 16; ++r) rli[r] = __builtin_amdgcn_rcpf(li_l[crow(r, hi)]);
  unsigned ob = (unsigned)(4 * hi * ldo + r32); asm volatile("" : "+v"(ob));
#pragma unroll
  for (int r = 0; r < 16; ++r) { const int orow0 = crow(r, 0);
#pragma unroll
    for (int d0 = 0; d0 < 4; ++d0) Ow[ob + (unsigned)(orow0 * ldo + d0 * 32)] = (unsigned char)(__builtin_amdgcn_cvt_pk_fp8_f32(__builtin_amdgcn_fmed3f(o[d0][r] * rli[r] * F8_MSCALE, -448.f, 448.f), 0.f, 0, false) & 0xff); }
  __syncthreads();
#undef SLOAD
#undef SWRITE
#undef SWAIT
#undef RESC
#undef MASKW
}
#undef KSWZ
#undef SBAR
}

__device__ __forceinline__ void ph4a_unit(const Args& a, LAS unsigned char* lds, int tid, int wave, int lane, int b, int ci, int p0, int np) {
    const bf16* IQ = (const bf16*)(a.ws + WS_IQ); const bf16* IK = (const bf16*)(a.ws + WS_IK); const float* IW = (const float*)(a.ws + WS_IW); float* SC = (float*)(a.ws + WS_SC);
    const int tok0 = b * SEQ + ci * CHUNK;
    __syncthreads();
    for (int i = tid; i < 64 * 128; i += NTHR) { const int q = i >> 7, ch = i & 127, head = ch >> 3, c8 = ch & 7;
        const v4u v = *(const v4u*)(IQ + ((size_t)tok0 + q) * 1024 + ch * 8);
        *(LAS v4u*)(lds + q * 2048 + ((head ^ ((q >> 3) & 1)) * 128) + ((c8 ^ (q & 7)) * 16)) = v; }
    __syncthreads();
    const int qt = wave & 1, q = qt * 32 + (lane & 31), hh = lane >> 5; const size_t tokq = (size_t)tok0 + q;
    float wgt[16];
#pragma unroll
    for (int h4 = 0; h4 < 4; ++h4) { const f32x4 w4 = *(const f32x4*)(IW + tokq * 16 + 4 * h4); wgt[4 * h4] = w4[0]; wgt[4 * h4 + 1] = w4[1]; wgt[4 * h4 + 2] = w4[2]; wgt[4 * h4 + 3] = w4[3]; }
    const LAS unsigned char* qb = lds + q * 2048; const int hx = ((q >> 3) & 1) * 128; int offk[4];
#pragma unroll
    for (int kk = 0; kk < 4; ++kk) offk[kk] = ((2 * kk + hh) ^ (q & 7)) * 16;
    int it = wave >> 1;
    bf16x8 ak[2][4];
    if (it < np) { const bf16* kp = IK + ((size_t)b * SEQ + (p0 + it) * 64 + (lane & 31)) * 64 + hh * 8;
#pragma unroll
        for (int kk = 0; kk < 4; ++kk) { ak[0][kk] = *(const bf16x8*)(kp + kk * 16); ak[1][kk] = *(const bf16x8*)(kp + 32 * 64 + kk * 16); } }
    for (; it < np; it += 4) {
        bf16x8 an[2][4]; const bool more = it + 4 < np;
        { const int itn = more ? it + 4 : it; const bf16* kp = IK + ((size_t)b * SEQ + (p0 + itn) * 64 + (lane & 31)) * 64 + hh * 8;
#pragma unroll
          for (int kk = 0; kk < 4; ++kk) { an[0][kk] = *(const bf16x8*)(kp + kk * 16); an[1][kk] = *(const bf16x8*)(kp + 32 * 64 + kk * 16); } }
        float s0[16], s1[16];
#pragma unroll
        for (int i = 0; i < 16; ++i) { s0[i] = 0.f; s1[i] = 0.f; }
        bf16x8 bfc[4]; f32x16 a0, a1;
#pragma unroll
        for (int kk = 0; kk < 4; ++kk) bfc[kk] = *(const LAS bf16x8*)(qb + hx + offk[kk]);
#pragma unroll
        for (int i = 0; i < 16; ++i) { a0[i] = 0.f; a1[i] = 0.f; }
#pragma unroll
        for (int kk = 0; kk < 4; ++kk) { a0 = __builtin_amdgcn_mfma_f32_32x32x16_bf16(ak[0][kk], bfc[kk], a0, 0, 0, 0); a1 = __builtin_amdgcn_mfma_f32_32x32x16_bf16(ak[1][kk], bfc[kk], a1, 0, 0, 0); }
#pragma unroll
        for (int kk = 0; kk < 4; ++kk) bfc[kk] = *(const LAS bf16x8*)(qb + ((1 * 128) ^ hx) + offk[kk]);
#pragma unroll
        for (int h = 0; h < 16; ++h) { f32x16 b0, b1; bf16x8 bfn[4];
            if (h + 1 < 16) {
#pragma unroll
                for (int i = 0; i < 16; ++i) { b0[i] = 0.f; b1[i] = 0.f; }
#pragma unroll
                for (int kk = 0; kk < 4; ++kk) { b0 = __builtin_amdgcn_mfma_f32_32x32x16_bf16(ak[0][kk], bfc[kk], b0, 0, 0, 0); b1 = __builtin_amdgcn_mfma_f32_32x32x16_bf16(ak[1][kk], bfc[kk], b1, 0, 0, 0); }
                if (h + 2 < 16) { const int hb = ((h + 2) * 128) ^ hx;
#pragma unroll
                    for (int kk = 0; kk < 4; ++kk) bfn[kk] = *(const LAS bf16x8*)(qb + hb + offk[kk]); } }
            __builtin_amdgcn_sched_barrier(0);
            const float wh = wgt[h];
#pragma unroll
            for (int i = 0; i < 16; ++i) { s0[i] = fmaf(wh, fmaxf(a0[i], 0.f), s0[i]); asm volatile("" : "+v"(s0[i])); s1[i] = fmaf(wh, fmaxf(a1[i], 0.f), s1[i]); asm volatile("" : "+v"(s1[i])); }
            if (h + 1 < 16) { a0 = b0; a1 = b1; }
            if (h + 2 < 16) {
#pragma unroll
                for (int kk = 0; kk < 4; ++kk) bfc[kk] = bfn[kk]; }
            __builtin_amdgcn_sched_barrier(0); }
        float* op = SC + tokq * 2048 + (p0 + it) * 64 + 4 * hh;
#pragma unroll
        for (int i4 = 0; i4 < 4; ++i4) { *(f32x4*)(op + 8 * i4) = (f32x4){s0[4 * i4], s0[4 * i4 + 1], s0[4 * i4 + 2], s0[4 * i4 + 3]};
            *(f32x4*)(op + 32 + 8 * i4) = (f32x4){s1[4 * i4], s1[4 * i4 + 1], s1[4 * i4 + 2], s1[4 * i4 + 3]}; }
#pragma unroll
        for (int kk = 0; kk < 4; ++kk) { ak[0][kk] = an[0][kk]; ak[1][kk] = an[1][kk]; }
    }
}
__device__ __forceinline__ void ph4a_decode(int u, int& b, int& ci, int& p0, int& np) {
    if (u < 128) { b = u & 7; ci = 16 + (u >> 3); p0 = 0; np = 16; }
    else { const int v = 16 - ((u - 128) >> 4), w = (u - 128) & 15; b = w & 7; if (w >> 3) { ci = 15 + v; p0 = 16; np = v; } else { ci = v - 1; p0 = 0; np = v; } }
}
__device__ __forceinline__ void ph4a_body(const Args& a, LAS unsigned char* lds, int tid, int wave, int lane, int G, int bid) {
    int b, ci, p0, np;
    if (G == 256) { ph4a_decode(bid, b, ci, p0, np); ph4a_unit(a, lds, tid, wave, lane, b, ci, p0, np);
        if (bid >= 128) { ph4a_decode(511 - bid, b, ci, p0, np); ph4a_unit(a, lds, tid, wave, lane, b, ci, p0, np); } }
    else for (int u = bid; u < 384; u += G) { ph4a_decode(u, b, ci, p0, np); ph4a_unit(a, lds, tid, wave, lane, b, ci, p0, np); }
    __syncthreads();
}
template <int NVM> __device__ __forceinline__ int cnt_ge(const unsigned (&key)[32], unsigned cand) {
    unsigned c0 = 0, c1 = 0, c2 = 0, c3 = 0;
#pragma unroll
    for (int i = 0; i < NVM; i += 4) {
        asm("v_cmp_ge_u32 vcc, %1, %2\n\tv_addc_co_u32 %0, vcc, 0, %0, vcc" : "+v"(c0) : "v"(key[i]), "v"(cand) : "vcc");
        asm("v_cmp_ge_u32 vcc, %1, %2\n\tv_addc_co_u32 %0, vcc, 0, %0, vcc" : "+v"(c1) : "v"(key[i + 1]), "v"(cand) : "vcc");
        asm("v_cmp_ge_u32 vcc, %1, %2\n\tv_addc_co_u32 %0, vcc, 0, %0, vcc" : "+v"(c2) : "v"(key[i + 2]), "v"(cand) : "vcc");
        asm("v_cmp_ge_u32 vcc, %1, %2\n\tv_addc_co_u32 %0, vcc, 0, %0, vcc" : "+v"(c3) : "v"(key[i + 3]), "v"(cand) : "vcc"); }
    const unsigned c = (c0 + c1) + (c2 + c3);
    int tot = 0;
#pragma unroll
    for (int b = 0; b < 6; ++b) tot += __builtin_popcountll(__ballot((c >> b) & 1u)) << b;
    return tot;
}
template <int NVM> __device__ __forceinline__ unsigned sel_thr(const unsigned (&key)[32]) {
    unsigned Tt = 0u;
    for (int bit = 31; bit >= 0; --bit) { const unsigned cand = Tt | (1u << bit); const int cnt = cnt_ge<NVM>(key, cand);
        if (cnt >= TOPK) { Tt = cand; if (cnt == TOPK) break; } }
    return Tt;
}
__device__ __forceinline__ void ph4b_body(const Args& a, int wave, int lane, int G, int bid) {
    const float* SC = (const float*)(a.ws + WS_SC); unsigned long long* SEL = (unsigned long long*)(a.ws + WS_SEL);
    const int gw = bid * NWAVES + wave, NGW = G * NWAVES;
    float raw[32]; unsigned key[32];
#define SEL_ROW(idx, row, nv) const int bb_ = (idx) >> 11; int t_ = (idx) & 2047; if (bb_ & 1) t_ = 2047 - t_; const size_t row = (size_t)bb_ * SEQ + t_; const int nv = (t_ >> 6) + 1;
    int idx = gw;
    if (idx < T) { SEL_ROW(idx, row, nv) const float* sp = SC + row * 2048 + lane;
#pragma unroll
        for (int i = 0; i < 32; ++i) raw[i] = sp[64 * (i < nv ? i : nv - 1)]; }
    for (; idx < T; idx += NGW) {
        SEL_ROW(idx, row, nv)
#pragma unroll
        for (int i = 0; i < 32; ++i) { const unsigned uu = __float_as_uint(raw[i]); const unsigned kk = (uu & 0x80000000u) ? ~uu : (uu | 0x80000000u); key[i] = (i < nv) ? kk : 0u; }
        if (idx + NGW < T) { SEL_ROW(idx + NGW, rown, nvn) const float* sp = SC + rown * 2048 + lane;
#pragma unroll
            for (int i = 0; i < 32; ++i) raw[i] = sp[64 * (i < nvn ? i : nvn - 1)]; }
        unsigned Tt = 0u;
        if (nv > 4) { if (nv <= 8) Tt = sel_thr<8>(key); else if (nv <= 16) Tt = sel_thr<16>(key); else if (nv <= 24) Tt = sel_thr<24>(key); else Tt = sel_thr<32>(key); }
        unsigned long long myw = 0ull;
#pragma unroll
        for (int i = 0; i < 32; ++i) { const unsigned long long bm = __ballot(key[i] >= Tt); if (lane == i) myw = bm; }
        if (lane < nv) SEL[row * 32 + lane] = myw;
    }
#undef SEL_ROW
}

__device__ __forceinline__ void ph5_body(const Args& a, char* ldsg, int wave, int lane, int G, int bid) {
    const bf16* Q = (const bf16*)(a.ws + WS_Q); const bf16* K = (const bf16*)(a.ws + WS_K); const bf16* V = (const bf16*)(a.ws + WS_V);
    const unsigned* SELW = (const unsigned*)(a.ws + WS_SEL); unsigned char* YA = (unsigned char*)(a.ws + WS_YA);
    for (int L = bid; L < NB * NCHUNK * NKVH; L += G) {
        const int Lr = L & 255, ci = (L < 256) ? 31 - (Lr >> 4) : (Lr >> 4), b = (Lr >> 1) & 7, g = Lr & 1;
        const int head = g * 4 + (wave >> 1), qpos = ci * 64 + (wave & 1) * 32 + (lane & 31); const size_t tokq = (size_t)b * SEQ + qpos;
        const int NTreal = ci + 1, NT = NTreal + (NTreal & 1);
        const float nslope = -1.4426950408889634f * exp2f(-(float)(head + 1));
        att::attn_unit(Q + tokq * 1024 + head * 128 + (lane >> 5) * 8, K + (size_t)b * SEQ * 256 + g * 128, V + (size_t)b * SEQ * 256 + g * 128,
                       YA + ((size_t)b * SEQ + ci * 64 + (wave & 1) * 32) * 2048 + head * 128, 2048, SELW + ((size_t)b * SEQ + ci * 64) * 64, (unsigned)(((wave & 1) * 32 + (lane & 31)) * 64), qpos, nslope, NT, NTreal, ldsg);
    }
}

__device__ __forceinline__ void ph7_body(const Args& a, int tid, int G, int bid) {
    const float* POW = (const float*)(a.ws + WS_POW); const float* SBUF = (const float*)(a.ws + WS_SBUF); bf16* UA = (bf16*)(a.ws + WS_UA);
    for (int idx = bid * NTHR + tid; idx < SSMG * NB * SSMN; idx += G * NTHR) {
        const int n = idx & 63, b = (idx >> 6) & 7, g = idx >> 9;
        const float ar = POW[(((size_t)g * 65 + SL) * 64 + n) * 2], ai = POW[(((size_t)g * 65 + SL) * 64 + n) * 2 + 1];
        float hr = 0.f, hi = 0.f;
#pragma unroll 1
        for (int c0 = 0; c0 < NSC; c0 += 64) {
            f32x2 sv[64];
#pragma unroll
            for (int c = 0; c < 64; ++c) sv[c] = *(const f32x2*)(SBUF + ((size_t)g * SROWS + b * NSC + c0 + c) * 128 + 2 * n);
#pragma unroll
            for (int c = 0; c < 64; ++c) { const size_t row = (size_t)g * SROWS + b * NSC + c0 + c;
                *(unsigned*)(UA + row * UA_LD + SL * 16 + 2 * n) = pk2(hr, hi);
                const float nr = ar * hr - ai * hi + sv[c][0], ni = ar * hi + ai * hr + sv[c][1]; hr = nr; hi = ni; }
        }
    }
}

__device__ __forceinline__ void ph12_body(const Args& a, LAS unsigned char* lds, int tid, int wave, int lane, int G, int bid, size_t alt) {
    const bf16* X1 = (const bf16*)(a.ws + WS_X1); const float* WRP = (const float*)(a.ws + WS_WRP); const float* BRP = (const float*)(a.ws + WS_BRP); float* RSTD = (float*)(a.ws + (alt ? WS_SC : WS_RSTD));
    unsigned* CNT = (unsigned*)(a.ws + WS_CTL) + CW_CNT + (alt ? 64 : 0); int* ASGE = (int*)(a.ws + (alt ? WS_SC + MiB : WS_ASGE)); int* ASGP = (int*)(a.ws + (alt ? WS_SC + 2 * MiB : WS_ASGP));
    int* LIST = (int*)(a.ws + (alt ? WS_SC + 4 * MiB : WS_LIST)); float* GLIST = (float*)(a.ws + (alt ? WS_SC + 8 * MiB : WS_GLIST)); unsigned char* XS = (unsigned char*)(a.ws + (alt ? WS_SC + 16 * MiB : WS_XS));
    const float* MOD = (const float*)(a.ws + WS_MOD); const float* g2 = a.in[I_N2G];
    LAS float* xs = (LAS float*)lds;
    LAS float* part = (LAS float*)(lds + 65792); LAS float* logit = (LAS float*)(lds + 65792 + 32768);
    LAS float* rstdL = (LAS float*)(lds + 65792 + 32768 + 4352); LAS unsigned* lcnt = (LAS unsigned*)(rstdL + 32); LAS unsigned* base = lcnt + 32;
    for (int tile = bid; tile < T / 32; tile += G) {
        const int t0 = tile * 32, b = t0 >> 11; const int lrow = tid >> 4, cg = tid & 15;
        f32x16 acc;
#pragma unroll
        for (int i = 0; i < 16; ++i) acc[i] = 0.f;
        float ss = 0.f;
        if (tid < 32) lcnt[tid] = 0u;
        for (int ch = 0; ch < 4; ++ch) {
            f32x4 v[8]; const v2u* xr = (const v2u*)(X1 + (size_t)(t0 + lrow) * DM + ch * 512) + cg;
#pragma unroll
            for (int j = 0; j < 8; ++j) { const v2u w = xr[16 * j]; v[j] = (f32x4){bflo(w.x), bfhi(w.x), bflo(w.y), bfhi(w.y)}; ss += (v[j][0] * v[j][0] + v[j][1] * v[j][1]) + (v[j][2] * v[j][2] + v[j][3] * v[j][3]); }
            float wv[32]; const float* wp = WRP + (size_t)b * (DM * NEXP) + (size_t)(ch * 512 + 64 * wave + (lane >> 5)) * NEXP + (lane & 31);
#pragma unroll
            for (int q = 0; q < 32; ++q) wv[q] = wp[2 * q * NEXP];
            __syncthreads();
#pragma unroll
            for (int j = 0; j < 8; ++j)
#pragma unroll
                for (int e = 0; e < 4; ++e) xs[lrow * 513 + cg * 4 + 64 * j + e] = v[j][e];
            __syncthreads();
            const LAS float* xq = xs + (lane & 31) * 513 + 64 * wave + (lane >> 5);
#pragma unroll
            for (int q = 0; q < 32; ++q) acc = __builtin_amdgcn_mfma_f32_32x32x2f32(xq[2 * q], wv[q], acc, 0, 0, 0);
        }
        ss += __shfl_xor(ss, 1); ss += __shfl_xor(ss, 2); ss += __shfl_xor(ss, 4); ss += __shfl_xor(ss, 8);
        if (cg == 0) { const float rstd = 1.0f / sqrtf(ss * (1.0f / DM) + RMS_EPS); rstdL[lrow] = rstd; RSTD[t0 + lrow] = rstd; }
#pragma unroll
        for (int i = 0; i < 16; ++i) part[(wave * 16 + i) * 64 + lane] = acc[i];
        __syncthreads();
#pragma unroll
        for (int z = 0; z < 2; ++z) { const int o = tid + 512 * z, tk = o >> 5, e = o & 31, hh = (tk >> 2) & 1, i = (tk & 3) + 4 * (tk >> 3), ln = e + 32 * hh; float s = 0.f;
#pragma unroll
            for (int w = 0; w < 8; ++w) s += part[(w * 16 + i) * 64 + ln];
            logit[tk * 33 + e] = rstdL[tk] * s + BRP[b * 32 + e]; }
        __syncthreads();
        LAS float* selv = (LAS float*)(base + 32);
        int rk[4]; float mv[4], gt[4]; unsigned rr[4];
        const int ex = lane & 31;
#pragma unroll
        for (int j = 0; j < 4; ++j) { const int tk = wave * 4 + j; const float v = logit[tk * 33 + ex]; int r = 0;
#pragma unroll
            for (int e2 = 0; e2 < 32; ++e2) { const float u = logit[tk * 33 + e2]; r += ((u > v) || (u == v && e2 < ex)) ? 1 : 0; }
            rk[j] = r; mv[j] = v; if (lane < 32 && r < 4) selv[tk * 4 + r] = v; }
        LDS_WAIT(); asm volatile("" ::: "memory");
#pragma unroll
        for (int j = 0; j < 4; ++j) { const int tk = wave * 4 + j; gt[j] = 0.f; rr[j] = 0u;
            if (lane < 32 && rk[j] < 4) { const float v0 = selv[tk * 4], v1 = selv[tk * 4 + 1], v2 = selv[tk * 4 + 2], v3 = selv[tk * 4 + 3];
                const float den = 1.0f + expf(v1 - v0) + expf(v2 - v0) + expf(v3 - v0); gt[j] = expf(mv[j] - v0) / den;
                rr[j] = __hip_atomic_fetch_add(lcnt + ex, 1u, __ATOMIC_RELAXED, __HIP_MEMORY_SCOPE_WORKGROUP); } }
        __syncthreads();
        if (tid < 32) base[tid] = __hip_atomic_fetch_add(CNT + tid, lcnt[tid], RLX_AGENT);
        __syncthreads();
#pragma unroll
        for (int j = 0; j < 4; ++j) if (lane < 32 && rk[j] < 4) { const int tk = t0 + wave * 4 + j, as = tk * 4 + rk[j], pos = (int)(base[ex] + rr[j]); ASGE[as] = ex; ASGP[as] = pos;
            if (pos < T) { LIST[ex * T + pos] = tk; GLIST[ex * T + pos] = gt[j]; } }
        { const f32x4* gp = (const f32x4*)g2 + 2 * lane; const f32x4* shp = (const f32x4*)(MOD + (size_t)b * MODW + 3 * DM) + 2 * lane; const f32x4* scp = (const f32x4*)(MOD + (size_t)b * MODW + 4 * DM) + 2 * lane;
          v4u xw[4][4]; f32x4 pa[8], pb[8];
#pragma unroll
          for (int j = 0; j < 4; ++j) { const v4u* xr = (const v4u*)(X1 + (size_t)(t0 + wave * 4 + j) * DM) + lane;
#pragma unroll
              for (int q = 0; q < 4; ++q) xw[j][q] = xr[64 * q]; }
#pragma unroll
          for (int q = 0; q < 4; ++q)
#pragma unroll
              for (int h = 0; h < 2; ++h) { pa[2 * q + h] = gp[128 * q + h] * (scp[128 * q + h] + 1.0f) * F8_ASCALE; pb[2 * q + h] = shp[128 * q + h] * F8_ASCALE; }
#pragma unroll
          for (int j = 0; j < 4; ++j) { const int tk = wave * 4 + j; const float rstd = rstdL[tk]; v2u o[4];
#pragma unroll
              for (int q = 0; q < 4; ++q) { const v4u w = xw[j][q]; const f32x4 x0 = {bflo(w.x), bfhi(w.x), bflo(w.y), bfhi(w.y)}, x1 = {bflo(w.z), bfhi(w.z), bflo(w.w), bfhi(w.w)};
                  const f32x4 y0 = (x0 * rstd) * pa[2 * q] + pb[2 * q], y1 = (x1 * rstd) * pa[2 * q + 1] + pb[2 * q + 1];
                  o[q].x = pk4_fp8(y0[0], y0[1], y0[2], y0[3]); o[q].y = pk4_fp8(y1[0], y1[1], y1[2], y1[3]); }
              v2u* dst = (v2u*)(XS + (size_t)(t0 + tk) * DM) + lane;
#pragma unroll
              for (int q = 0; q < 4; ++q) dst[64 * q] = o[q]; } }
        __syncthreads();
    }
}

constexpr int LDS_MOE = RING_BYTES + 1024;
__device__ __forceinline__ void moe_tables(const Args& a, LAS unsigned char* lds, int tid) {
    LAS int* off = (LAS int*)(lds + LDS_MOE); LAS int* cnt = off + 32; LAS int* nrbp = off + 64; LAS int* rbe = off + 96;
    if (tid == 0) { unsigned* CNT = (unsigned*)(a.ws + WS_CTL) + CW_CNT; int o = 0, rb = 0;
        for (int e = 0; e < NEXP; ++e) { const int c = (int)__hip_atomic_load(CNT + e, RLX_AGENT); cnt[e] = c; off[e] = o; const int nb = (c + 255) >> 8;
            for (int q = 0; q < nb; ++q) { if (rb < 320) rbe[rb] = e; ++rb; } o += nb * 256; }
        nrbp[0] = rb < 288 ? rb : 288; }
    __syncthreads();
}
constexpr int LDS_ROWS = RING_BYTES + 3072, ROWS_CAP = (LDS_BYTES - LDS_ROWS) / 512;
template <class Sched> __device__ __forceinline__ void moe_rows(const Args& a, LAS unsigned char* lds, int tid, const Sched& S) {
    const LAS int* off = (const LAS int*)(lds + LDS_MOE); const LAS int* cnt = off + 32; const int* LIST = (const int*)(a.ws + WS_LIST);
    LAS unsigned short* rows = (LAS unsigned short*)(lds + LDS_ROWS);
    pg8::Unit u;
    for (int i = 0; i < ROWS_CAP && S.next(i, u); ++i) { const int e = (u.pn >> 4) & 31, idx = (u.pm - (off[e] >> 8)) * 256 + (tid & 255);
        if (tid < 256) { int tok = (idx >= 0 && idx < cnt[e] && idx < T) ? LIST[e * T + idx] : 0; rows[i * 256 + tid] = (unsigned short)min(max(tok, 0), T - 1); } }
    __syncthreads();
}

typedef float f32x2v __attribute__((ext_vector_type(2)));
__device__ __forceinline__ void ph16_acc8(f32x4& a0, f32x4& a1, v2u w) {
    const f32x2v p0 = __builtin_amdgcn_cvt_pk_f32_fp8((int)w.x, false), p1 = __builtin_amdgcn_cvt_pk_f32_fp8((int)w.x, true), p2 = __builtin_amdgcn_cvt_pk_f32_fp8((int)w.y, false), p3 = __builtin_amdgcn_cvt_pk_f32_fp8((int)w.y, true);
    a0[0] += p0[0]; a0[1] += p0[1]; a0[2] += p1[0]; a0[3] += p1[1]; a1[0] += p2[0]; a1[1] += p2[1]; a1[2] += p3[0]; a1[3] += p3[1];
}
#define PH16_SLOT(k) min(max(off[ASGE[row * 4 + (k)] & 31] + ASGP[row * 4 + (k)], 0), MOE_ROWS - 1)
__device__ __forceinline__ void ph16_row(const LAS int* off, const int* ASGE, const int* ASGP, const unsigned char* YE, const bf16* X1, int row, int lane, f32x4 (&acc)[8], f32x4 (&xv)[8]) {
    const int s0 = PH16_SLOT(0), s1 = PH16_SLOT(1), s2 = PH16_SLOT(2), s3 = PH16_SLOT(3);
    const v2u* y0 = (const v2u*)(YE + (size_t)s0 * DM) + lane; const v2u* y1 = (const v2u*)(YE + (size_t)s1 * DM) + lane; const v2u* y2 = (const v2u*)(YE + (size_t)s2 * DM) + lane; const v2u* y3 = (const v2u*)(YE + (size_t)s3 * DM) + lane;
    const v4u* xi = (const v4u*)(X1 + (size_t)row * DM) + lane;
#pragma unroll
    for (int j = 0; j < 4; ++j) { const v2u w0 = y0[64 * j], w1 = y1[64 * j], w2 = y2[64 * j], w3 = y3[64 * j]; const v4u xw = xi[64 * j];
        acc[2 * j] = (f32x4){0.f, 0.f, 0.f, 0.f}; acc[2 * j + 1] = (f32x4){0.f, 0.f, 0.f, 0.f};
        ph16_acc8(acc[2 * j], acc[2 * j + 1], w0); ph16_acc8(acc[2 * j], acc[2 * j + 1], w1); ph16_acc8(acc[2 * j], acc[2 * j + 1], w2); ph16_acc8(acc[2 * j], acc[2 * j + 1], w3);
        acc[2 * j] = acc[2 * j] * (1.0f / F8_YSCALE); acc[2 * j + 1] = acc[2 * j + 1] * (1.0f / F8_YSCALE);
        xv[2 * j] = (f32x4){bflo(xw.x), bfhi(xw.x), bflo(xw.y), bfhi(xw.y)}; xv[2 * j + 1] = (f32x4){bflo(xw.z), bfhi(xw.z), bflo(xw.w), bfhi(xw.w)}; }
}
__device__ __forceinline__ void ph16_body(const Args& a, LAS unsigned char* lds, int tid, int wave, int lane, int G, int bid, float* OUT) {
    moe_tables(a, lds, tid); const LAS int* off = (const LAS int*)(lds + LDS_MOE);
    const float* MOD = (const float*)(a.ws + WS_MOD); const int* ASGE = (const int*)(a.ws + WS_ASGE); const int* ASGP = (const int*)(a.ws + WS_ASGP); const unsigned char* YE = (const unsigned char*)(a.ws + WS_YE); const bf16* X1 = (const bf16*)(a.ws + WS_X1);
    const int gw = bid * NWAVES + wave, NGW = G * NWAVES;
    for (int row = gw; row < T; row += 2 * NGW) {
        const int rowB = row + NGW; const bool hasB = rowB < T;
        f32x4 aA[8], xA[8], aB[8], xB[8];
        ph16_row(off, ASGE, ASGP, YE, X1, row, lane, aA, xA);
        if (hasB) ph16_row(off, ASGE, ASGP, YE, X1, rowB, lane, aB, xB);
        { const f32x4* gp = (const f32x4*)(MOD + (size_t)(row >> 11) * MODW + 5 * DM) + 2 * lane; f32x4* xo = (f32x4*)(OUT + (size_t)row * DM) + 2 * lane;
#pragma unroll
          for (int j = 0; j < 4; ++j) { xo[128 * j] = xA[2 * j] + gp[128 * j] * aA[2 * j]; xo[128 * j + 1] = xA[2 * j + 1] + gp[128 * j + 1] * aA[2 * j + 1]; } }
        if (hasB) { const f32x4* gp = (const f32x4*)(MOD + (size_t)(rowB >> 11) * MODW + 5 * DM) + 2 * lane; f32x4* xo = (f32x4*)(OUT + (size_t)rowB * DM) + 2 * lane;
#pragma unroll
          for (int j = 0; j < 4; ++j) { xo[128 * j] = xB[2 * j] + gp[128 * j] * aB[2 * j]; xo[128 * j + 1] = xB[2 * j + 1] + gp[128 * j + 1] * aB[2 * j + 1]; } }
    }
}

#ifndef PROBE_REP
#define PROBE_REP 0
#endif
#ifndef MK_ONE_LAUNCH
#define MK_ONE_LAUNCH 1
#endif
constexpr int NPH = 13;
__global__ void __launch_bounds__(NTHR, 2) fwd(Args args) {
    extern __shared__ __attribute__((aligned(16))) unsigned char lds_raw[];
    LAS unsigned char* lds = (LAS unsigned char*)lds_raw;
    const int tid = threadIdx.x, lane = tid & 63, wave = __builtin_amdgcn_readfirstlane(tid >> 6);
    const int G = gridDim.x, bid = blockIdx.x;
    volatile LAS unsigned* MISC = (volatile LAS unsigned*)(lds + MISC_OFF);
    for (int u = tid; u < (LDS_BYTES - LDSCTL_OFF) / 4; u += NTHR) ((LAS unsigned*)(lds + LDSCTL_OFF))[u] = 0u;
    __syncthreads();
    unsigned char* ws = args.ws;
    unsigned* ctl = (unsigned*)(ws + WS_CTL);
    const int lo = args.ph_lo, hi = args.ph_hi;
    XcdBarrier bar; bar.bar = ctl + CW_BAR; bar.x = 0; bar.st = nullptr;
    if (hi - lo > 1) bar = xcd_barrier_post(ctl + CW_BAR, MISC + 8);
#define IN(k) (lo <= (k) && (k) < hi)
#define REPS(k) _Pragma("unroll") for (int rep_ = 0; rep_ < 1 + ((PROBE_REP >> (k)) & 1); ++rep_)
#define SEAM(k) do { if (IN(k) && IN((k) + 1)) xcd_barrier(bar); } while (0)

    if (IN(0)) REPS(0) { ph0_ssm_consts(args, tid, G, (bid + 8) % G);
         ph0_adaln(args, lds, tid, G, bid); }
    SEAM(0);
    if (IN(1)) REPS(1) {
        if (bid & 1) { ph1_small(args, tid, wave, lane, G, bid); bts_body(args, tid, G, bid); ph0_transposes(args, lds, wave, lane, G, bid); ph1_norm(args, wave, lane, G, bid); }
        else { ph1_norm(args, wave, lane, G, bid); ph0_transposes(args, lds, wave, lane, G, bid); ph1_small(args, tid, wave, lane, G, bid); bts_body(args, tid, G, bid); } __syncthreads(); }
    SEAM(1);
    if (IN(2)) REPS(2) {
        const int Gg = (G > 2 * NCONV) ? G - NCONV : G;
        if (bid < Gg) {
            { pg8::Gemm g{(const bf16*)(ws + WS_HN), (const bf16*)(ws + WS_WIN), DM, DM, DM}; pg8::StaticOrder S; S.init(T, 2560, Gg, bid);
              EpiInProjA E{(bf16*)(ws + WS_Q), (bf16*)(ws + WS_K), (bf16*)(ws + WS_IQ), (bf16*)(ws + WS_IK), (float*)(ws + WS_IW)};
              pg8::gemm_phase<EpiInProjA, pg8::StaticOrder, true, true>(lds, g, S, E); }
            { pg8::Gemm g{(const bf16*)(ws + WS_HN8), (const bf16*)(ws + WS_WIN8), DM / 2, DM / 2, DM / 2}; pg8::StaticOrder S; S.init(T, 5376, Gg, bid);
              EpiInProjB E{(bf16*)(ws + WS_V), (bf16*)(ws + WS_UA), (unsigned char*)(ws + WS_GATES)};
              pg8::gemm_phase<EpiInProjB, pg8::StaticOrder, true, true, true>(lds, g, S, E); } }
        cv_queue(args, lds, wave, lane); }
    SEAM(2);
    if (IN(3)) REPS(3) {
        ph4a_body(args, lds, tid, wave, lane, G, bid);
        { pg8::Gemm g{(const bf16*)(ws + WS_UA), (const bf16*)(ws + WS_BTS), UA_LD, SL * 16, SL * 16}; SsmSOrder S{G, (G - 1) - bid}; EpiSsmS E{(float*)(ws + WS_SBUF)};
          pg8::gemm_phase<EpiSsmS, SsmSOrder, true, true>(lds, g, S, E); }
        qknorm_body(args, wave, lane, G, bid); bty_body(args, tid, G, bid); }
    SEAM(3);
    if (IN(4)) REPS(4) { ph4b_body(args, wave, lane, G, bid); ph7_body(args, tid, G, bid); }
    SEAM(4);
    if (IN(5)) REPS(5) {
        ph5_body(args, (char*)lds_raw, wave, lane, G, bid);
        { pg8::Gemm g{(const bf16*)(ws + WS_UA), (const bf16*)(ws + WS_BTY), UA_LD, UA_LD, UA_LD}; SsmYOrder S{G, bid}; EpiSsmY E{(bf16*)(ws + WS_YG)};
          pg8::gemm_phase<EpiSsmY, SsmYOrder, true, true>(lds, g, S, E); } }
    SEAM(5);
    if (IN(6)) REPS(6) {
        pg8::Gemm g{(const bf16*)(ws + WS_YG), (const bf16*)(ws + WS_WGLU), 1024, 1024, 1024}; pg8::StaticOrder S; S.init(T, 1024, G, bid);
        EpiGlu E{(const bf16*)(ws + WS_YG), (unsigned char*)(ws + WS_YA + 1024), args.in[I_BGLU]};
        pg8::gemm_phase<EpiGlu, pg8::StaticOrder, true, true>(lds, g, S, E); }
    SEAM(6);
    if (IN(7)) REPS(7) {
        pg8::StaticOrder S; S.init(T, DM, G, bid);
        pg8::Gemm g{(const bf16*)(ws + WS_YA), (const bf16*)(ws + WS_WA), 1024, 1024, 1024}; EpiProjAB E{(const unsigned char*)(ws + WS_GATES), (unsigned char*)(ws + WS_MG)};
        pg8::gemm_phase<EpiProjAB, pg8::StaticOrder, true, true, true>(lds, g, S, E); }
    SEAM(7);
    if (IN(8)) REPS(8) {
        pg8::Gemm g{(const bf16*)(ws + WS_MG), (const bf16*)(ws + WS_WO), DM / 2, DM / 2, DM / 2}; pg8::StaticOrder S; S.init(T, DM, G, bid);
        EpiOut E{args.in[I_X], (const float*)(ws + WS_MOD), (bf16*)(ws + WS_X1)};
        pg8::gemm_phase<EpiOut, pg8::StaticOrder, true, true, true>(lds, g, S, E); }
    SEAM(8);
    if (IN(9)) REPS(9) ph12_body(args, lds, tid, wave, lane, G, bid, (size_t)rep_);
    SEAM(9);
    if (IN(10)) REPS(10) {
        moe_tables(args, lds, tid);
        const LAS int* mt = (const LAS int*)(lds + LDS_MOE); MoeOrder S{mt + 96, mt[64], 4, G, bid};
        moe_rows(args, lds, tid, S);
        pg8::Gemm g{(const bf16*)(ws + WS_XS), (const bf16*)(ws + WS_WGU), DM / 2, DM / 2, DM / 2, (const LAS unsigned short*)(lds + LDS_ROWS)}; EpiGateUp E{args.in[I_BGU], (unsigned char*)(ws + WS_ACT)};
        pg8::gemm_phase<EpiGateUp, MoeOrder, true, true, true, true>(lds, g, S, E); }
    SEAM(10);
    if (IN(11)) REPS(11) {
        moe_tables(args, lds, tid);
        const LAS int* mt = (const LAS int*)(lds + LDS_MOE); MoeOrder S{mt + 96, mt[64], 3, G, bid};
        pg8::Gemm g{(const bf16*)(ws + WS_ACT), (const bf16*)(ws + WS_WD), DM / 2, DM / 2, DM / 2}; EpiDown E{args.in[I_BD], (const float*)(ws + WS_GLIST), mt, (unsigned char*)(ws + WS_YE)};
        pg8::gemm_phase<EpiDown, MoeOrder, true, true, true>(lds, g, S, E); }
    SEAM(11);
    if (IN(12)) REPS(12) ph16_body(args, lds, tid, wave, lane, G, bid, rep_ ? (float*)(ws + WS_SC) : args.out);
#if defined(PROBE_BAR)
    if (hi - lo > 1) { _Pragma("unroll 1") for (int q = 0; q < PROBE_BAR; ++q) xcd_barrier(bar); }
#endif
#undef IN
#undef SEAM
}

extern "C" void kernel_launch(void* const* d_in, const int* in_sizes, int n_in, void* d_out, int out_size, void* d_ws, size_t ws_size, hipStream_t stream) {
    static int grid = 0;
    if (grid == 0) {
        if (n_in != 28 || out_size != T * DM || ws_size < WS_END) { fprintf(stderr, "kernel_launch: unexpected shapes (n_in %d out %d ws %zu)\n", n_in, out_size, ws_size); grid = -1; return; }
        int dev = 0, cus = 0, per_cu = 0;
        if (hipGetDevice(&dev) != hipSuccess || hipDeviceGetAttribute(&cus, hipDeviceAttributeMultiprocessorCount, dev) != hipSuccess) { grid = -1; return; }
        if (hipFuncSetAttribute((const void*)fwd, hipFuncAttributeMaxDynamicSharedMemorySize, LDS_BYTES) != hipSuccess) { fprintf(stderr, "kernel_launch: hipFuncSetAttribute failed\n"); grid = -1; return; }
        if (hipOccupancyMaxActiveBlocksPerMultiprocessor(&per_cu, (const void*)fwd, NTHR, LDS_BYTES) != hipSuccess || per_cu < 1) { fprintf(stderr, "kernel_launch: occupancy query says %d\n", per_cu); (void)hipGetLastError(); grid = -1; return; }
        if (cus * ROWS_CAP < 288 * 16) { fprintf(stderr, "kernel_launch: too few CUs (%d) for the gather lists\n", cus); grid = -1; return; }
        grid = cus;
    }
    if (grid < 0) return;
    (void)hipMemsetAsync((char*)d_ws + WS_CTL, 0, CTL_ZERO_BYTES, stream);
    Args a{};
    for (int i = 0; i < 28; ++i) a.in[i] = (const float*)d_in[i];
    a.out = (float*)d_out; a.ws = (unsigned char*)d_ws;
#if MK_ONE_LAUNCH
    a.ph_lo = 0; a.ph_hi = NPH;
    hipLaunchKernelGGL(fwd, dim3(grid), dim3(NTHR), LDS_BYTES, stream, a);
#else
    for (int p = 0; p < NPH; ++p) { a.ph_lo = p; a.ph_hi = p + 1; hipLaunchKernelGGL(fwd, dim3(grid), dim3(NTHR), LDS_BYTES, stream, a); }
#endif
}
```

```cpp
#include <hip/hip_runtime.h>
#include <cstdio>
#include <cstdint>

#define GAS __attribute__((address_space(1)))
#define LAS __attribute__((address_space(3)))
typedef unsigned short bf16;
typedef unsigned v4u __attribute__((ext_vector_type(4)));
typedef unsigned v2u __attribute__((ext_vector_type(2)));
typedef float f32x2 __attribute__((ext_vector_type(2)));
typedef float f32x4 __attribute__((ext_vector_type(4)));
typedef float f32x16 __attribute__((ext_vector_type(16)));
typedef short bf16x8 __attribute__((ext_vector_type(8)));
typedef short s16x4 __attribute__((ext_vector_type(4)));
typedef __bf16 bf16x2_t __attribute__((ext_vector_type(2)));

constexpr int DM = 2048, NB = 8, SEQ = 2048, T = NB * SEQ;
constexpr int CHUNK = 64, NCHUNK = SEQ / CHUNK;
constexpr int HD = 128, NQH = 8, NKVH = 2, ATTW = 1024, KVW = 256;
constexpr int IDXH = 16, IDXD = 64, TOPK = 256;
constexpr int SSMW = 1024, SSMG = 64, SSMP = 16, SSMN = 64;
constexpr int NEXP = 32, MOEK = 4, DFF = 2048;
constexpr int INW = 7760, INW_PAD = 7936;
constexpr int MODW = 6 * DM;
constexpr float RMS_EPS = 1e-6f;
constexpr int SL = 32, NSC = SEQ / SL, SROWS = NB * NSC;
constexpr int UA_LD = SL * 16 + 128;
constexpr int MOE_ROWS = T * MOEK + NEXP * 256;
constexpr int NWAVES = 8, NTHR = 512;

constexpr size_t MiB = 1u << 20;
constexpr size_t WS_CTL = 0, CTL_ZERO_BYTES = 1 * MiB;
constexpr size_t WS_MOD = 1 * MiB;
constexpr size_t WS_WRP = 2 * MiB;
constexpr size_t WS_BRP = 4 * MiB;
constexpr size_t WS_BBAR = 5 * MiB;
constexpr size_t WS_POW = 6 * MiB;
constexpr size_t WS_KT = 9 * MiB;
constexpr size_t WS_ASGE = 14 * MiB;
constexpr size_t WS_ASGP = WS_ASGE + 256 * 1024;
constexpr size_t WS_ASGG = WS_ASGP + 256 * 1024;
constexpr size_t WS_SLOT = WS_ASGG + 256 * 1024;
constexpr size_t WS_ROWG = 15 * MiB;
constexpr size_t WS_RSTD = 15 * MiB + 512 * 1024;
constexpr size_t WS_WIN = 16 * MiB;
constexpr size_t WS_WIN8 = 27 * MiB;
constexpr size_t WS_WGLU = 47 * MiB;
constexpr size_t WS_WA = 49 * MiB;
constexpr size_t WS_WB = 53 * MiB;
constexpr size_t WS_WO = 57 * MiB;
constexpr size_t WS_BTS = 65 * MiB;
constexpr size_t WS_BTY = 97 * MiB;
constexpr size_t WS_HN = 241 * MiB;
constexpr size_t WS_X1 = 241 * MiB;
constexpr size_t WS_HN8 = 980 * MiB;
constexpr size_t WS_Q = 305 * MiB;
constexpr size_t WS_K = 337 * MiB;
constexpr size_t WS_V = 345 * MiB;
constexpr size_t WS_IQ = 353 * MiB;
constexpr size_t WS_IK = 385 * MiB;
constexpr size_t WS_IW = 387 * MiB;
constexpr size_t WS_UA = 788 * MiB;
constexpr size_t WS_GATES = 424 * MiB;
constexpr size_t WS_SC = 552 * MiB;
constexpr size_t WS_SEL = 680 * MiB;
constexpr size_t WS_YA = 684 * MiB;
constexpr size_t WS_SBUF = 852 * MiB;
constexpr size_t WS_YG = 724 * MiB;
constexpr size_t WS_YS = 756 * MiB;
constexpr size_t WS_MRG = 788 * MiB;
constexpr size_t WS_MG = 916 * MiB;
constexpr size_t WS_H2 = 980 * MiB;
constexpr size_t WS_XS = 1044 * MiB;
constexpr size_t WS_LIST = WS_XS + 64 * MiB;
constexpr size_t WS_GLIST = WS_XS + 66 * MiB;
constexpr size_t WS_ACT = 1332 * MiB;
constexpr size_t WS_YE = 1620 * MiB;
constexpr size_t WS_WGU = 1908 * MiB;
constexpr size_t WS_WD = 2420 * MiB;
constexpr size_t WS_END = 2676 * MiB;
constexpr int CW_CNT = 1024;
constexpr int CW_CVQ = 2048;
constexpr int NCONV = 112;
constexpr int CW_BAR = 4096;
constexpr int RING_BYTES = 131072;
constexpr int LDSCTL_OFF = RING_BYTES, MISC_OFF = LDSCTL_OFF + 320;
constexpr int LDS_BYTES = 147456;

#define LDS_WAIT() asm volatile("s_waitcnt lgkmcnt(0)" ::: "memory")
#define VM_WAIT() asm volatile("s_waitcnt vmcnt(0)" ::: "memory")
#define RLX_AGENT __ATOMIC_RELAXED, __HIP_MEMORY_SCOPE_AGENT

__device__ __forceinline__ unsigned pk2(float lo, float hi) { f32x2 v = {lo, hi}; bf16x2_t b = __builtin_convertvector(v, bf16x2_t); return __builtin_bit_cast(unsigned, b); }
__device__ __forceinline__ float bf2f(unsigned h) { return __builtin_bit_cast(float, h << 16); }
__device__ __forceinline__ float bflo(unsigned w) { return __builtin_bit_cast(float, w << 16); }
__device__ __forceinline__ float bfhi(unsigned w) { return __builtin_bit_cast(float, w & 0xffff0000u); }
__device__ __forceinline__ float wave_sum(float v) {
#pragma unroll
    for (int o = 1; o < 64; o <<= 1) v += __shfl_xor(v, o);
    return v;
}
constexpr float F8_WSCALE = 256.0f, F8_ASCALE = 4.0f, F8_DESCALE = 1.0f / (256.0f * 4.0f);
constexpr float F8_YSCALE = 8.0f;
constexpr float F8_MSCALE = 16.0f, F8_MDESCALE = 1.0f / (256.0f * 16.0f);
__device__ __forceinline__ unsigned pk4_fp8(float a, float b, float c, float d) { int w = 0; a = __builtin_amdgcn_fmed3f(a, -448.f, 448.f); b = __builtin_amdgcn_fmed3f(b, -448.f, 448.f); c = __builtin_amdgcn_fmed3f(c, -448.f, 448.f); d = __builtin_amdgcn_fmed3f(d, -448.f, 448.f);
    w = __builtin_amdgcn_cvt_pk_fp8_f32(a, b, w, false); w = __builtin_amdgcn_cvt_pk_fp8_f32(c, d, w, true); return (unsigned)w; }
__device__ __forceinline__ unsigned pk4_fp8_nc(float a, float b, float c, float d) { int w = 0; w = __builtin_amdgcn_cvt_pk_fp8_f32(a, b, w, false); w = __builtin_amdgcn_cvt_pk_fp8_f32(c, d, w, true); return (unsigned)w; }
__device__ __forceinline__ float sigmoidf_(float x) { return __builtin_amdgcn_rcpf(1.0f + __builtin_amdgcn_exp2f(x * -1.4426950408889634f)); }
__device__ __forceinline__ float sigmoid1702(float x) { return __builtin_amdgcn_rcpf(1.0f + __builtin_amdgcn_exp2f(x * (-1.702f * 1.4426950408889634f))); }

namespace pg8 {
#define PG8_LAS __attribute__((address_space(3)))
typedef unsigned short bf16_t;
typedef short bf16x8 __attribute__((ext_vector_type(8)));
typedef float f32x4 __attribute__((ext_vector_type(4)));
typedef unsigned u32x4 __attribute__((ext_vector_type(4)));
constexpr int BM = 256, BK = 64, HALF = 128, HTB = HALF * BK * 2, STAGE_BYTES = 8 * HTB, NXCD = 8, WGM = 8;

__host__ __device__ __forceinline__ int lds_byte(int r, int c) { const int st = (r >> 4) * 2 + (c >> 5), rr = r & 15, cc = c & 31, ob = rr * 64 + cc * 2; return st * 1024 + (ob ^ (((ob >> 9) & 1) << 5)); }
__host__ __device__ __forceinline__ void stage_rc(int b, int& R, int& C) { const int st = b / 1024, sb = b % 1024, swz = sb ^ (((sb >> 9) & 1) << 5); R = (st >> 1) * 16 + swz / 64; C = (st & 1) * 32 + (swz % 64) / 2; }
__host__ __device__ __forceinline__ int perm32(int rho) { const int n = rho >> 4, i = rho & 15; return 8 * (i >> 2) + 4 * n + (i & 3); }

struct Unit { int pm, pn; };
struct Gemm { const bf16_t* A; const bf16_t* Bt; int lda, ldb, K; const PG8_LAS unsigned short* rows; };

struct StaticOrder {
    int nM, nN, nwg, G, c;
    __host__ __device__ void init(int M, int N, int G_, int c_) { nM = M / BM; nN = N / BM; nwg = nM * nN; G = G_; c = c_; }
    __host__ __device__ bool next(int i, Unit& u) const {
        const long L = (long)i * G + c; if (L >= nwg) return false;
        int wgid = (int)L; { const int q = nwg / NXCD, r = nwg % NXCD, xcd = wgid % NXCD, off = wgid / NXCD; wgid = (xcd < r ? xcd * (q + 1) : r * (q + 1) + (xcd - r) * q) + off; }
        const int nig = WGM * nN, gid = wgid / nig, fm = gid * WGM, gsz = (nM - fm) < WGM ? (nM - fm) : WGM;
        u.pm = fm + ((wgid % nig) % gsz); u.pn = (wgid % nig) / gsz; return true;
    }
    __device__ __forceinline__ void a_ready(const Unit&) const {}
    __device__ __forceinline__ void done(const Unit&) const {}
};

typedef int i32x4 __attribute__((ext_vector_type(4)));
typedef int i32x8 __attribute__((ext_vector_type(8)));
template <bool F8> struct FragT;
template <> struct FragT<false> { bf16x8 k0, k1; };
template <> struct FragT<true> { i32x8 v; };
template <bool F8> __device__ __forceinline__ FragT<F8> ldfrag(const PG8_LAS unsigned char* p) {
    if constexpr (F8) { const i32x4 lo = *(const PG8_LAS i32x4*)p, hi = *(const PG8_LAS i32x4*)(p + 1024); FragT<true> f; f.v = __builtin_shufflevector(lo, hi, 0, 1, 2, 3, 4, 5, 6, 7); return f; }
    else { FragT<false> f; f.k0 = *(const PG8_LAS bf16x8*)p; f.k1 = *(const PG8_LAS bf16x8*)(p + 1024); return f; }
}
template <bool F8> __device__ __forceinline__ f32x4 mma1(const FragT<F8>& b, const FragT<F8>& a, f32x4 c) {
#if defined(__HIP_DEVICE_COMPILE__)
    if constexpr (F8) { asm volatile("v_mfma_f32_16x16x128_f8f6f4 %0, %1, %2, %0" : "+v"(c) : "v"(b.v), "v"(a.v)); return c; }
#else
    if constexpr (F8) { return c; }
#endif
    else { c = __builtin_amdgcn_mfma_f32_16x16x32_bf16(b.k0, a.k0, c, 0, 0, 0); return __builtin_amdgcn_mfma_f32_16x16x32_bf16(b.k1, a.k1, c, 0, 0, 0); }
}
template <class Epi, class Sched, bool ALIGN_EPI = false, bool SP2 = false, bool F8 = false, bool GATHER = false>
__device__ __forceinline__ void gemm_phase(PG8_LAS unsigned char* lds, const Gemm g, const Sched& S, const Epi& E) {
    const int tid = threadIdx.x, wid = __builtin_amdgcn_readfirstlane(tid >> 6), lane = tid & 63, wr = wid >> 2, wc = wid & 3, fr = lane & 15, fq = lane >> 4;
    const int K = g.K, nt = K / BK;
    unsigned voffA[2], voffB[2];
#pragma unroll
    for (int i = 0; i < 2; ++i) { int R, C; stage_rc(tid * 16 + i * 8192, R, C); const int Rb = Epi::PERM ? ((R & ~31) + perm32(R & 31)) : R;
        voffA[i] = (unsigned)(R * g.lda + C) * 2u; voffB[i] = (unsigned)(Rb * g.ldb + C) * 2u; }
    unsigned gC0[2] = {0u, 0u}, gC1[2] = {0u, 0u}, gN0[2] = {0u, 0u}, gN1[2] = {0u, 0u}; int gR[2] = {0, 0}; unsigned gCb[2] = {0u, 0u};
    if constexpr (GATHER) {
#pragma unroll
        for (int i = 0; i < 2; ++i) { int R, C; stage_rc(tid * 16 + i * 8192, R, C); gR[i] = R; gCb[i] = (unsigned)C * 2u; } }
#define PG8_GROWS(d0, d1, slot) do { _Pragma("unroll") for (int _i = 0; _i < 2; ++_i) { \
        d0[_i] = (unsigned)g.rows[(slot) * 256 + gR[_i]] * (unsigned)(g.lda * 2) + gCb[_i]; d1[_i] = (unsigned)g.rows[(slot) * 256 + 128 + gR[_i]] * (unsigned)(g.lda * 2) + gCb[_i]; } } while (0)
    const size_t kstep = (size_t)(BK * 2);
    const size_t hstepA = (size_t)HALF * g.lda * 2, hstepB = (size_t)HALF * g.ldb * 2;
    const size_t tstepA = 2 * hstepA, tstepB = 2 * hstepB;
    const unsigned ldsw = (unsigned)wid * 1024u;
    const int aoff = lds_byte(wr * 64 + fr, fq * 8), boff = lds_byte(wc * 32 + fr, fq * 8);
#define PG8_SA(b, h) (((b) * 2 + (h)) * HTB)
#define PG8_SB(b, h) ((4 + (b) * 2 + (h)) * HTB)
#define PG8_STAGE(bufoff, gbase, voff) do { _Pragma("unroll") for (int _i = 0; _i < 2; ++_i) \
        __builtin_amdgcn_global_load_lds((const unsigned*)((const char*)(gbase) + (voff)[_i]), (PG8_LAS unsigned*)(lds + (bufoff) + ldsw + _i * 8192), 16, 0, 0); } while (0)
#define PG8_STAGE2(bufoff, gbase, o0, o1) do { \
        __builtin_amdgcn_global_load_lds((const unsigned*)((const char*)(gbase) + (o0)), (PG8_LAS unsigned*)(lds + (bufoff) + ldsw), 16, 0, 0); \
        __builtin_amdgcn_global_load_lds((const unsigned*)((const char*)(gbase) + (o1)), (PG8_LAS unsigned*)(lds + (bufoff) + ldsw + 8192), 16, 0, 0); } while (0)
#define PG8_STAGE_A(bufoff, kb, h, nx) do { if constexpr (GATHER) { \
        if ((h) == 0) PG8_STAGE2(bufoff, kb, ((nx) ? gN0[0] : gC0[0]), ((nx) ? gN0[1] : gC0[1])); else PG8_STAGE2(bufoff, kb, ((nx) ? gN1[0] : gC1[0]), ((nx) ? gN1[1] : gC1[1])); \
        } else { PG8_STAGE(bufoff, (kb) + ((h) ? hstepA : (size_t)0), voffA); } } while (0)
#define PG8_LDA(dst, b, h) do { _Pragma("unroll") for (int m = 0; m < 4; ++m) dst[m] = ldfrag<F8>(lds + PG8_SA(b, h) + aoff + m * 2048); } while (0)
#define PG8_LDB(dst, b, h) do { _Pragma("unroll") for (int n = 0; n < 2; ++n) dst[n] = ldfrag<F8>(lds + PG8_SB(b, h) + boff + n * 2048); } while (0)
#define PG8_MMA(ai, bj, At, Bt) do { __builtin_amdgcn_s_setprio(1); _Pragma("unroll") for (int m = 0; m < 4; ++m) _Pragma("unroll") for (int n = 0; n < 2; ++n) \
        acc[ai][bj][m][n] = mma1<F8>(Bt[n], At[m], acc[ai][bj][m][n]); __builtin_amdgcn_s_setprio(0); } while (0)
#define PG8_WAIT_V(n) asm volatile("s_waitcnt vmcnt(" #n ")" ::: "memory")
#define PG8_WAIT_L(n) asm volatile("s_waitcnt lgkmcnt(" #n ")" ::: "memory")
#define PG8_BAR __builtin_amdgcn_s_barrier()
#define PG8_SCHED __builtin_amdgcn_sched_barrier(0)
    Unit cur, nxt; int ui = 0;
    if (!S.next(0, cur)) return;
    f32x4 acc[2][2][4][2];
#pragma unroll
    for (int a = 0; a < 2; ++a)
#pragma unroll
        for (int b = 0; b < 2; ++b)
#pragma unroll
            for (int m = 0; m < 4; ++m)
#pragma unroll
                for (int n = 0; n < 2; ++n) acc[a][b][m][n] = (f32x4){0.f, 0.f, 0.f, 0.f};
    FragT<F8> At[4], B0[2], B1[2];
    const char* cA = (const char*)g.A + (GATHER ? (size_t)0 : (size_t)cur.pm * tstepA); const char* cB = (const char*)g.Bt + (size_t)cur.pn * tstepB;
    if constexpr (GATHER) { PG8_GROWS(gC0, gC1, 0); }
    S.a_ready(cur);
    if constexpr (SP2) {
        PG8_STAGE(PG8_SB(0, 0), cB, voffB); PG8_STAGE(PG8_SB(0, 1), cB + hstepB, voffB); PG8_STAGE_A(PG8_SA(0, 0), cA, 0, false); PG8_STAGE_A(PG8_SA(0, 1), cA, 1, false);
        if (wr == 1) PG8_BAR;
        PG8_WAIT_V(2); PG8_BAR;
        PG8_STAGE(PG8_SB(1, 0), cB + kstep, voffB); PG8_STAGE_A(PG8_SA(1, 0), cA + kstep, 0, false); PG8_STAGE(PG8_SB(1, 1), cB + hstepB + kstep, voffB);
        PG8_WAIT_V(6); PG8_BAR;
    } else {
        PG8_STAGE(PG8_SB(0, 0), cB, voffB); PG8_STAGE_A(PG8_SA(0, 0), cA, 0, false); PG8_STAGE(PG8_SB(0, 1), cB + hstepB, voffB); PG8_STAGE_A(PG8_SA(0, 1), cA, 1, false);
        if (wr == 1) PG8_BAR;
        PG8_WAIT_V(4); PG8_BAR;
        PG8_STAGE(PG8_SB(1, 0), cB + kstep, voffB); PG8_STAGE_A(PG8_SA(1, 0), cA + kstep, 0, false); PG8_STAGE(PG8_SB(1, 1), cB + hstepB + kstep, voffB);
        PG8_WAIT_V(6); PG8_BAR;
    }
    for (;;) {
        const bool has_next = S.next(ui + 1, nxt);
        const char* nA = (has_next && !GATHER) ? (const char*)g.A + (size_t)nxt.pm * tstepA : cA; const char* nB = has_next ? (const char*)g.Bt + (size_t)nxt.pn * tstepB : cB;
        if constexpr (GATHER) { if (has_next) { PG8_GROWS(gN0, gN1, ui + 1); } else { gN0[0] = gC0[0]; gN0[1] = gC0[1]; gN1[0] = gC1[0]; gN1[1] = gC1[1]; } }
        for (int t = 0; t < nt; t += 2) {
            const bool last = (t == nt - 2);
            const char* a1 = cA + (size_t)(t + 1) * kstep;
            const char* a2 = last ? nA : cA + (size_t)(t + 2) * kstep; const char* b2 = last ? nB : cB + (size_t)(t + 2) * kstep;
            const char* a3 = a2 + kstep; const char* b3 = b2 + kstep;
            if (last && has_next) S.a_ready(nxt);
            if constexpr (Epi::CHAIN) { if (t == Epi::MID_T) {
                if constexpr (F8) asm volatile("s_nop 15\n\ts_nop 15" ::: "memory");
                int fr_ = fr, fq_ = fq; asm volatile("" : "+v"(fr_), "+v"(fq_)); E.mid(acc, cur, wr, wc, fr_, fq_); } }
            if constexpr (SP2) {
            PG8_LDB(B0, 0, 0); PG8_LDB(B1, 0, 1); PG8_SCHED; PG8_LDA(At, 0, 0); PG8_STAGE_A(PG8_SA(1, 1), a1, 1, false);
            PG8_WAIT_V(8); PG8_WAIT_L(0); PG8_BAR; PG8_MMA(0, 0, At, B0); PG8_MMA(0, 1, At, B1); PG8_BAR; PG8_SCHED;
            PG8_LDA(At, 0, 1); PG8_STAGE(PG8_SB(0, 0), b2, voffB); PG8_STAGE(PG8_SB(0, 1), b2 + hstepB, voffB); PG8_STAGE_A(PG8_SA(0, 0), a2, 0, last);
            PG8_WAIT_V(8); PG8_WAIT_L(0); PG8_BAR; PG8_MMA(1, 0, At, B0); PG8_MMA(1, 1, At, B1); PG8_BAR; PG8_SCHED;
            PG8_LDB(B0, 1, 0); PG8_LDB(B1, 1, 1); PG8_SCHED; PG8_LDA(At, 1, 0); PG8_STAGE_A(PG8_SA(0, 1), a2, 1, last);
            PG8_WAIT_V(8); PG8_WAIT_L(0); PG8_BAR; PG8_MMA(0, 0, At, B0); PG8_MMA(0, 1, At, B1); PG8_BAR; PG8_SCHED;
            PG8_LDA(At, 1, 1); PG8_STAGE(PG8_SB(1, 0), b3, voffB); PG8_STAGE(PG8_SB(1, 1), b3 + hstepB, voffB); PG8_STAGE_A(PG8_SA(1, 0), a3, 0, last);
            PG8_WAIT_V(8); PG8_WAIT_L(0); PG8_BAR; PG8_MMA(1, 0, At, B0); PG8_MMA(1, 1, At, B1); PG8_BAR; PG8_SCHED;
            } else {
            PG8_LDB(B0, 0, 0); PG8_SCHED; PG8_LDA(At, 0, 0); PG8_STAGE_A(PG8_SA(1, 1), a1, 1, false);
            PG8_WAIT_L(8); PG8_BAR; PG8_WAIT_L(0); PG8_MMA(0, 0, At, B0); PG8_BAR; PG8_SCHED;
            PG8_LDB(B1, 0, 1); PG8_STAGE(PG8_SB(0, 0), b2, voffB);
            PG8_BAR; PG8_WAIT_L(0); PG8_MMA(0, 1, At, B1); PG8_BAR;
            PG8_LDA(At, 0, 1); PG8_STAGE_A(PG8_SA(0, 0), a2, 0, last);
            PG8_BAR; PG8_WAIT_L(0); PG8_MMA(1, 0, At, B0); PG8_BAR; PG8_SCHED;
            PG8_STAGE(PG8_SB(0, 1), b2 + hstepB, voffB);
            PG8_WAIT_V(6); PG8_BAR; PG8_MMA(1, 1, At, B1); PG8_BAR;
            PG8_LDB(B0, 1, 0); PG8_SCHED; PG8_LDA(At, 1, 0); PG8_STAGE_A(PG8_SA(0, 1), a2, 1, last);
            PG8_WAIT_L(8); PG8_BAR; PG8_WAIT_L(0); PG8_MMA(0, 0, At, B0); PG8_BAR; PG8_SCHED;
            PG8_LDB(B1, 1, 1); PG8_STAGE(PG8_SB(1, 0), b3, voffB);
            PG8_BAR; PG8_WAIT_L(0); PG8_MMA(0, 1, At, B1); PG8_BAR;
            PG8_LDA(At, 1, 1); PG8_STAGE_A(PG8_SA(1, 0), a3, 0, last);
            PG8_BAR; PG8_WAIT_L(0); PG8_MMA(1, 0, At, B0); PG8_BAR; PG8_SCHED;
            PG8_STAGE(PG8_SB(1, 1), b3 + hstepB, voffB);
            PG8_WAIT_V(6); PG8_BAR; PG8_MMA(1, 1, At, B1); PG8_BAR;
            }
        }
        if constexpr (ALIGN_EPI) { if (wr == 0) PG8_BAR; }
        if constexpr (F8) asm volatile("s_nop 15\n\ts_nop 15" ::: "memory");
        { int fr_ = fr, fq_ = fq; asm volatile("" : "+v"(fr_), "+v"(fq_));
          E(acc, cur, wr, wc, fr_, fq_); } S.done(cur);
        if (!has_next) break;
#pragma unroll
        for (int a = 0; a < 2; ++a)
#pragma unroll
            for (int b = 0; b < 2; ++b)
#pragma unroll
                for (int m = 0; m < 4; ++m)
#pragma unroll
                    for (int n = 0; n < 2; ++n) acc[a][b][m][n] = (f32x4){0.f, 0.f, 0.f, 0.f};
        cur = nxt; cA = nA; cB = nB; ++ui;
        if constexpr (GATHER) { gC0[0] = gN0[0]; gC0[1] = gN0[1]; gC1[0] = gN1[0]; gC1[1] = gN1[1]; }
        if constexpr (ALIGN_EPI) { if (wr == 1) PG8_BAR; }
    }
    PG8_WAIT_V(0);
    if constexpr (!ALIGN_EPI) { if (wr == 0) PG8_BAR; }
    PG8_BAR;
#undef PG8_SA
#undef PG8_SB
#undef PG8_STAGE
#undef PG8_STAGE2
#undef PG8_STAGE_A
#undef PG8_GROWS
#undef PG8_LDA
#undef PG8_LDB
#undef PG8_MMA
#undef PG8_WAIT_V
#undef PG8_WAIT_L
#undef PG8_BAR
#undef PG8_SCHED
}
}

#define XB_TMO      128
#define XB_XCNT(j)  (256  + 64 * (j))
#define XB_XSUB(j)  (1280 + 64 * (j))
#define XB_XGEN(j)  (2304 + 64 * (j))
#define XB_TOP      3328
#define XB_TOPGEN   3392
#define XCD_BAR_WORDS 3456
#define XB_SPIN_CAP (1u << 18)

__device__ __forceinline__ unsigned xb_ld(unsigned* p)              { return __hip_atomic_load(p, __ATOMIC_RELAXED, __HIP_MEMORY_SCOPE_AGENT); }
__device__ __forceinline__ unsigned xb_add(unsigned* p, unsigned v) { return __hip_atomic_fetch_add(p, v, __ATOMIC_RELAXED, __HIP_MEMORY_SCOPE_AGENT); }
__device__ __forceinline__ unsigned xb_xcc_id() { return (unsigned)__builtin_amdgcn_s_getreg((3 << 11) | 20) & 0xFu; }
#define XB_SPIN(cond, bar) do { unsigned _sp = 0; while (cond) { __builtin_amdgcn_s_sleep(1); \
    if ((++_sp & 255u) == 0u) { if (xb_ld(&(bar)[XB_TMO])) break; if (_sp > XB_SPIN_CAP) { atomicAdd(&(bar)[XB_TMO], 1u); break; } } } } while (0)

struct XcdBarrier { unsigned* bar; unsigned x; volatile LAS unsigned* st; };

__device__ __forceinline__ XcdBarrier xcd_barrier_post(unsigned* bar, volatile LAS unsigned* st) {
    XcdBarrier b; b.bar = bar; b.x = xb_xcc_id(); b.st = st;
    if (threadIdx.x == 0) (void)xb_add(&bar[XB_XCNT(b.x)], 1u);
    return b;
}
__device__ __forceinline__ void xcd_barrier_complete(unsigned* bar, unsigned x, unsigned& nloc, unsigned& nx) {
    const unsigned G = gridDim.x * gridDim.y * gridDim.z;
    unsigned sum, cnt, mine, sp = 0u;
    for (;;) {
        sum = 0u; cnt = 0u; mine = 0u;
#pragma unroll
        for (unsigned j = 0; j < 16; ++j) { const unsigned c = xb_ld(&bar[XB_XCNT(j)]); sum += c; cnt += (c > 0u) ? 1u : 0u; mine = (j == x) ? c : mine; }
        if (sum == G) break;
        __builtin_amdgcn_s_sleep(1);
        if ((++sp & 255u) == 0u) { if (xb_ld(&bar[XB_TMO])) break; if (sp > XB_SPIN_CAP) { atomicAdd(&bar[XB_TMO], 1u); break; } }
    }
    nloc = mine > 0u ? mine : 1u; nx = cnt > 0u ? cnt : 1u;
}
__device__ __forceinline__ void xcd_barrier(const XcdBarrier& b) {
    asm volatile("s_waitcnt vmcnt(0)" ::: "memory");
    __syncthreads();
    if (threadIdx.x == 0) {
        unsigned* bar = b.bar;
        __builtin_amdgcn_s_waitcnt(0);
        unsigned nloc = b.st[0], nx = b.st[1];
        if (nloc == 0u) { xcd_barrier_complete(bar, b.x, nloc, nx); b.st[0] = nloc; b.st[1] = nx; }
        const unsigned old = xb_add(&bar[XB_XSUB(b.x)], 1u);
        const unsigned gen = old / nloc;
        if (old + 1u == (gen + 1u) * nloc) {
            __builtin_amdgcn_fence(__ATOMIC_RELEASE, "agent");
            asm volatile("s_waitcnt vmcnt(0)" ::: "memory");
            const unsigned og = xb_add(&bar[XB_TOP], 1u);
            const unsigned tg = og / nx;
            if (og + 1u == (tg + 1u) * nx) xb_add(&bar[XB_TOPGEN], 1u);
            else XB_SPIN(xb_ld(&bar[XB_TOPGEN]) == tg, bar);
            __builtin_amdgcn_fence(__ATOMIC_ACQUIRE, "agent");
            xb_add(&bar[XB_XGEN(b.x)], 1u);
            asm volatile("s_waitcnt vmcnt(0)" ::: "memory");
        } else {
            XB_SPIN(xb_ld(&bar[XB_XGEN(b.x)]) == gen, bar);
            __builtin_amdgcn_fence(__ATOMIC_ACQUIRE, "agent");
            asm volatile("s_waitcnt vmcnt(0)" ::: "memory");
        }
    }
    __syncthreads();
}

using pg8::Unit;
__device__ __forceinline__ v4u pack8(const f32x4& a, const f32x4& b) { v4u w; w.x = pk2(a[0], a[1]); w.y = pk2(a[2], a[3]); w.z = pk2(b[0], b[1]); w.w = pk2(b[2], b[3]); return w; }
__device__ __forceinline__ float gelu_tanh(float y) { const float u2 = 1.5957691216f * (y + 0.044715f * y * y * y); return y * __builtin_amdgcn_rcpf(1.0f + __builtin_amdgcn_exp2f(u2 * -1.4426950408889634f)); }

struct EpiInProjA {
    static constexpr bool PERM = true, CHAIN = false;
    bf16 *Q, *K, *IQ, *IK; float* IW;
    __device__ __forceinline__ void operator()(const f32x4 (&acc)[2][2][4][2], const Unit& u, int wr, int wc, int fr, int fq) const {
        const int pn = u.pn, row0 = u.pm * 256 + wr * 64 + fr, cl0 = wc * 32 + 8 * fq;
        if (pn < 9) {
            bf16* dst; int ld, coff; float sc = 1.f;
            if (pn < 4) { dst = Q; ld = 1024; coff = pn * 256; } else if (pn == 4) { dst = K; ld = 256; coff = 0; } else { dst = IQ; ld = 1024; coff = (pn - 5) * 256; sc = 0.125f; }
#pragma unroll
            for (int ai = 0; ai < 2; ++ai)
#pragma unroll
                for (int m = 0; m < 4; ++m) { bf16* rowp = dst + (size_t)(row0 + ai * 128 + m * 16) * ld + coff + cl0;
#pragma unroll
                    for (int bj = 0; bj < 2; ++bj) *(v4u*)(rowp + bj * 128) = pack8(acc[ai][bj][m][0] * sc, acc[ai][bj][m][1] * sc); }
        } else {
#pragma unroll
            for (int ai = 0; ai < 2; ++ai)
#pragma unroll
                for (int m = 0; m < 4; ++m) { const int row = row0 + ai * 128 + m * 16;
                    if (cl0 < 64) *(v4u*)(IK + (size_t)row * 64 + cl0) = pack8(acc[ai][0][m][0], acc[ai][0][m][1]);
                    else if (cl0 < 80) { float* p = IW + (size_t)row * 16 + (cl0 - 64); *(f32x4*)p = acc[ai][0][m][0] * 0.25f; *(f32x4*)(p + 4) = acc[ai][0][m][1] * 0.25f; } }
        }
    }
};
struct EpiInProjB {
    static constexpr bool PERM = true, CHAIN = false;
    bf16 *V, *UA; unsigned char* GATES;
    __device__ __forceinline__ void operator()(const f32x4 (&acc)[2][2][4][2], const Unit& u, int wr, int wc, int fr, int fq) const {
        const int pn = u.pn, row0 = u.pm * 256 + wr * 64 + fr, cl0 = wc * 32 + 8 * fq;
        if (pn >= 5) {
            const int coff = (pn - 5) * 256 + cl0;
#pragma unroll
            for (int ai = 0; ai < 2; ++ai)
#pragma unroll
                for (int m = 0; m < 4; ++m) { unsigned char* rowp = GATES + (size_t)(row0 + ai * 128 + m * 16) * 4096 + coff;
#pragma unroll
                    for (int bj = 0; bj < 2; ++bj) { const f32x4 v0 = acc[ai][bj][m][0] * F8_DESCALE, v1 = acc[ai][bj][m][1] * F8_DESCALE; unsigned c[8];
#pragma unroll
                        for (int e = 0; e < 4; ++e) { c[e] = (unsigned)fminf(fmaxf(sigmoidf_(v0[e]) * 255.0f + 0.5f, 1.0f), 255.0f); c[4 + e] = (unsigned)fminf(fmaxf(sigmoidf_(v1[e]) * 255.0f + 0.5f, 1.0f), 255.0f); }
                        v2u w; w.x = c[0] | (c[1] << 8) | (c[2] << 16) | (c[3] << 24); w.y = c[4] | (c[5] << 8) | (c[6] << 16) | (c[7] << 24);
                        *(v2u*)(rowp + bj * 128) = w; } }
        } else if (pn == 0) {
#pragma unroll
            for (int ai = 0; ai < 2; ++ai)
#pragma unroll
                for (int m = 0; m < 4; ++m) { bf16* rowp = V + (size_t)(row0 + ai * 128 + m * 16) * 256 + cl0;
#pragma unroll
                    for (int bj = 0; bj < 2; ++bj) *(v4u*)(rowp + bj * 128) = pack8(acc[ai][bj][m][0] * F8_DESCALE, acc[ai][bj][m][1] * F8_DESCALE); }
        } else {
#pragma unroll
            for (int ai = 0; ai < 2; ++ai)
#pragma unroll
                for (int m = 0; m < 4; ++m) { const int row = row0 + ai * 128 + m * 16, b = row >> 11, t = row & 2047, c = t >> 5, i = t & 31;
#pragma unroll
                    for (int bj = 0; bj < 2; ++bj) { const int ch0 = (pn - 1) * 256 + bj * 128 + cl0, g = ch0 >> 4, p0 = ch0 & 15;
                        *(v4u*)(UA + ((size_t)(g * SROWS + b * NSC + c)) * UA_LD + i * 16 + p0) = pack8(acc[ai][bj][m][0] * F8_DESCALE, acc[ai][bj][m][1] * F8_DESCALE); } }
        }
    }
};

struct EpiSsmS {
    static constexpr bool PERM = false, CHAIN = false;
    float* SBUF;
    __device__ __forceinline__ void operator()(const f32x4 (&acc)[2][2][4][2], const Unit& u, int wr, int wc, int fr, int fq) const {
#pragma unroll
        for (int ai = 0; ai < 2; ++ai)
#pragma unroll
            for (int m = 0; m < 4; ++m) { const int rl = ai * 128 + wr * 64 + m * 16 + fr;
#pragma unroll
                for (int n = 0; n < 2; ++n) *(f32x4*)(SBUF + ((size_t)(u.pm * 256 + rl)) * 128 + wc * 32 + 16 * n + 4 * fq) = acc[ai][0][m][n]; }
    }
};

struct EpiSsmY {
    static constexpr bool PERM = true, CHAIN = false;
    bf16* YG;
    __device__ __forceinline__ void operator()(const f32x4 (&acc)[2][2][4][2], const Unit& u, int wr, int wc, int fr, int fq) const {
        const int g = u.pm >> 1, rt = u.pm & 1, ct = u.pn & 1;
#pragma unroll
        for (int ai = 0; ai < 2; ++ai)
#pragma unroll
            for (int m = 0; m < 4; ++m) { const int r = rt * 256 + ai * 128 + wr * 64 + m * 16 + fr, b = r >> 6, c = r & 63;
#pragma unroll
                for (int bj = 0; bj < 2; ++bj) { const int cl = bj * 128 + wc * 32 + 8 * fq, j = 16 * ct + (cl >> 4), p0 = cl & 15; const int t = b * 2048 + SL * c + j;
                    f32x4 v0 = acc[ai][bj][m][0], v1 = acc[ai][bj][m][1];
#pragma unroll
                    for (int e = 0; e < 4; ++e) { v0[e] = gelu_tanh(v0[e]); v1[e] = gelu_tanh(v1[e]); }
                    *(v4u*)(YG + (size_t)t * 1024 + 16 * g + p0) = pack8(v0, v1); } }
    }
};

struct EpiGlu {
    static constexpr bool PERM = true, CHAIN = false;
    const bf16* YG; unsigned char* YS; const float* bias;
    __device__ __forceinline__ void operator()(const f32x4 (&acc)[2][2][4][2], const Unit& u, int wr, int wc, int fr, int fq) const {
        const int row0 = u.pm * 256 + wr * 64 + fr, col0 = u.pn * 256 + wc * 32 + 8 * fq;
        f32x4 bv[2][2];
#pragma unroll
        for (int bj = 0; bj < 2; ++bj) { bv[bj][0] = *(const f32x4*)(bias + col0 + bj * 128); bv[bj][1] = *(const f32x4*)(bias + col0 + bj * 128 + 4); }
#pragma unroll
        for (int ai = 0; ai < 2; ++ai) { v4u ygv[4][2];
#pragma unroll
            for (int m = 0; m < 4; ++m)
#pragma unroll
                for (int bj = 0; bj < 2; ++bj) ygv[m][bj] = *(const v4u*)(YG + (size_t)(row0 + ai * 128 + m * 16) * 1024 + col0 + bj * 128);
#pragma unroll
            for (int m = 0; m < 4; ++m) { const size_t ro = (size_t)(row0 + ai * 128 + m * 16) * 1024;
#pragma unroll
                for (int bj = 0; bj < 2; ++bj) { const int col = col0 + bj * 128; const v4u yg = ygv[m][bj]; f32x4 z0 = acc[ai][bj][m][0] + bv[bj][0], z1 = acc[ai][bj][m][1] + bv[bj][1];
                    z0[0] = bflo(yg.x) * sigmoidf_(z0[0]); z0[1] = bfhi(yg.x) * sigmoidf_(z0[1]); z0[2] = bflo(yg.y) * sigmoidf_(z0[2]); z0[3] = bfhi(yg.y) * sigmoidf_(z0[3]);
                    z1[0] = bflo(yg.z) * sigmoidf_(z1[0]); z1[1] = bfhi(yg.z) * sigmoidf_(z1[1]); z1[2] = bflo(yg.w) * sigmoidf_(z1[2]); z1[3] = bfhi(yg.w) * sigmoidf_(z1[3]);
                    z0 = z0 * F8_MSCALE; z1 = z1 * F8_MSCALE; v2u w8; w8.x = pk4_fp8(z0[0], z0[1], z0[2], z0[3]); w8.y = pk4_fp8(z1[0], z1[1], z1[2], z1[3]); *(v2u*)(YS + 2 * ro + col) = w8; } } }
    }
};

struct EpiProjAB {
    static constexpr bool PERM = true, CHAIN = true; static constexpr int MID_T = 8;
    const unsigned char* GATES; unsigned char* MG;
    __device__ __forceinline__ void mid(f32x4 (&acc)[2][2][4][2], const Unit& u, int wr, int wc, int fr, int fq) const {
        int row0 = u.pm * 256 + wr * 64 + fr, col0 = u.pn * 256 + wc * 32 + 8 * fq; asm volatile("" : "+v"(row0), "+v"(col0));
#pragma unroll
        for (int ai = 0; ai < 2; ++ai)
#pragma unroll
            for (int m = 0; m < 4; ++m) { const size_t row = (size_t)(row0 + ai * 128 + m * 16);
#pragma unroll
                for (int bj = 0; bj < 2; ++bj) { const int col = col0 + bj * 128; const v2u ga = *(const v2u*)(GATES + row * 4096 + col), gs = *(const v2u*)(GATES + row * 4096 + 2048 + col);
                    f32x4& a0 = acc[ai][bj][m][0]; f32x4& a1 = acc[ai][bj][m][1];
#pragma unroll
                    for (int e = 0; e < 4; ++e) { a0[e] *= (float)((ga.x >> (8 * e)) & 0xffu) * __builtin_amdgcn_rcpf((float)((gs.x >> (8 * e)) & 0xffu));
                                                  a1[e] *= (float)((ga.y >> (8 * e)) & 0xffu) * __builtin_amdgcn_rcpf((float)((gs.y >> (8 * e)) & 0xffu)); } } }
    }
    __device__ __forceinline__ void operator()(const f32x4 (&acc)[2][2][4][2], const Unit& u, int wr, int wc, int fr, int fq) const {
        int row0 = u.pm * 256 + wr * 64 + fr, col0 = u.pn * 256 + wc * 32 + 8 * fq; asm volatile("" : "+v"(row0), "+v"(col0));
        constexpr float SC = F8_MDESCALE * F8_MSCALE * (1.0f / 255.0f);
        v2u gsv[2][4][2];
#pragma unroll
        for (int ai = 0; ai < 2; ++ai)
#pragma unroll
            for (int m = 0; m < 4; ++m)
#pragma unroll
                for (int bj = 0; bj < 2; ++bj) gsv[ai][m][bj] = *(const v2u*)(GATES + (size_t)(row0 + ai * 128 + m * 16) * 4096 + 2048 + col0 + bj * 128);
#pragma unroll
        for (int ai = 0; ai < 2; ++ai)
#pragma unroll
            for (int m = 0; m < 4; ++m) { const size_t row = (size_t)(row0 + ai * 128 + m * 16);
#pragma unroll
                for (int bj = 0; bj < 2; ++bj) { const int col = col0 + bj * 128; const v2u gs = gsv[ai][m][bj]; const f32x4 a0 = acc[ai][bj][m][0] * SC, a1 = acc[ai][bj][m][1] * SC;
                    v2u w8; w8.x = pk4_fp8(a0[0] * (float)(gs.x & 0xffu), a0[1] * (float)((gs.x >> 8) & 0xffu), a0[2] * (float)((gs.x >> 16) & 0xffu), a0[3] * (float)(gs.x >> 24));
                    w8.y = pk4_fp8(a1[0] * (float)(gs.y & 0xffu), a1[1] * (float)((gs.y >> 8) & 0xffu), a1[2] * (float)((gs.y >> 16) & 0xffu), a1[3] * (float)(gs.y >> 24));
                    *(v2u*)(MG + row * 2048 + col) = w8; } }
    }
};

struct EpiOut {
    static constexpr bool PERM = true, CHAIN = false;
    const float* X; const float* MOD; bf16* X1;
    __device__ __forceinline__ void operator()(const f32x4 (&acc)[2][2][4][2], const Unit& u, int wr, int wc, int fr, int fq) const {
        const int row0 = u.pm * 256 + wr * 64 + fr, col0 = u.pn * 256 + wc * 32 + 8 * fq;
        const float* gt1 = MOD + (size_t)(u.pm >> 3) * MODW + 2 * DM;
        f32x4 gv[2][2];
#pragma unroll
        for (int bj = 0; bj < 2; ++bj) { gv[bj][0] = *(const f32x4*)(gt1 + col0 + bj * 128); gv[bj][1] = *(const f32x4*)(gt1 + col0 + bj * 128 + 4); }
#pragma unroll
        for (int ai = 0; ai < 2; ++ai) { f32x4 xv[4][2][2];
#pragma unroll
            for (int m = 0; m < 4; ++m)
#pragma unroll
                for (int bj = 0; bj < 2; ++bj) { const float* xp = X + (size_t)(row0 + ai * 128 + m * 16) * 2048 + col0 + bj * 128; xv[m][bj][0] = *(const f32x4*)xp; xv[m][bj][1] = *(const f32x4*)(xp + 4); }
#pragma unroll
            for (int m = 0; m < 4; ++m) { const size_t ro = (size_t)(row0 + ai * 128 + m * 16) * 2048;
#pragma unroll
                for (int bj = 0; bj < 2; ++bj) { const int col = col0 + bj * 128;
                    const f32x4 o0 = xv[m][bj][0] + gv[bj][0] * (acc[ai][bj][m][0] * F8_MDESCALE), o1 = xv[m][bj][1] + gv[bj][1] * (acc[ai][bj][m][1] * F8_MDESCALE);
                    *(v4u*)(X1 + ro + col) = pack8(o0, o1); } } }
    }
};

struct EpiGateUp {
    static constexpr bool PERM = true, CHAIN = false;
    const float* bgu; unsigned char* ACT;
    __device__ __forceinline__ void operator()(const f32x4 (&acc)[2][2][4][2], const Unit& u, int wr, int wc, int fr, int fq) const {
        const int e = u.pn >> 4, ct = u.pn & 15, row0 = u.pm * 256 + wr * 64 + fr, col = ct * 128 + wc * 32 + 8 * fq;
        const float* bg = bgu + (size_t)e * 4096 + col; const f32x4 g0 = *(const f32x4*)bg, g1 = *(const f32x4*)(bg + 4);
        const f32x4 u0 = (*(const f32x4*)(bg + 2048) + 1.0f) * F8_ASCALE, u1 = (*(const f32x4*)(bg + 2052) + 1.0f) * F8_ASCALE;
        constexpr float D4 = F8_DESCALE * F8_ASCALE;
#pragma unroll
        for (int ai = 0; ai < 2; ++ai)
#pragma unroll
            for (int m = 0; m < 4; ++m) { f32x4 ga = acc[ai][0][m][0] * F8_DESCALE + g0, gb = acc[ai][0][m][1] * F8_DESCALE + g1, ua = acc[ai][1][m][0] * D4 + u0, ub = acc[ai][1][m][1] * D4 + u1;
#pragma unroll
                for (int q = 0; q < 4; ++q) { float gg = fminf(ga[q], 7.0f), uu = __builtin_amdgcn_fmed3f(ua[q], -6.0f * F8_ASCALE, 8.0f * F8_ASCALE); ga[q] = uu * (gg * sigmoid1702(gg));
                    gg = fminf(gb[q], 7.0f); uu = __builtin_amdgcn_fmed3f(ub[q], -6.0f * F8_ASCALE, 8.0f * F8_ASCALE); gb[q] = uu * (gg * sigmoid1702(gg)); }
                v2u w; w.x = pk4_fp8_nc(ga[0], ga[1], ga[2], ga[3]); w.y = pk4_fp8_nc(gb[0], gb[1], gb[2], gb[3]);
                *(v2u*)(ACT + (size_t)(row0 + ai * 128 + m * 16) * 2048 + col) = w; }
    }
};

struct EpiDown {
    static constexpr bool PERM = true, CHAIN = false;
    const float* bd; const float* GLIST; const LAS int* mt; unsigned char* YE;
    __device__ __forceinline__ void operator()(const f32x4 (&acc)[2][2][4][2], const Unit& u, int wr, int wc, int fr, int fq) const {
        const int e = (u.pn >> 3) & 31, ct = u.pn & 7, row0 = u.pm * 256 + wr * 64 + fr, col0 = ct * 256 + wc * 32 + 8 * fq, ne = mt[32 + e], i0 = row0 - mt[e];
        f32x4 bv[2][2]; float grv[2][4];
#pragma unroll
        for (int bj = 0; bj < 2; ++bj) { const float* bp = bd + (size_t)e * 2048 + col0 + bj * 128; bv[bj][0] = *(const f32x4*)bp; bv[bj][1] = *(const f32x4*)(bp + 4); }
#pragma unroll
        for (int ai = 0; ai < 2; ++ai)
#pragma unroll
            for (int m = 0; m < 4; ++m) { const int idx = i0 + ai * 128 + m * 16; const bool ok = idx >= 0 && idx < ne && idx < T; const float gl = GLIST[(size_t)e * T + (ok ? idx : 0)]; grv[ai][m] = ok ? gl * F8_YSCALE : 0.f; }
#pragma unroll
        for (int ai = 0; ai < 2; ++ai)
#pragma unroll
            for (int m = 0; m < 4; ++m) { const size_t row = (size_t)(row0 + ai * 128 + m * 16); const float gr = grv[ai][m];
#pragma unroll
                for (int bj = 0; bj < 2; ++bj) { const int col = col0 + bj * 128;
                    const f32x4 y0 = (acc[ai][bj][m][0] * F8_DESCALE + bv[bj][0]) * gr, y1 = (acc[ai][bj][m][1] * F8_DESCALE + bv[bj][1]) * gr;
                    v2u w8; w8.x = pk4_fp8(y0[0], y0[1], y0[2], y0[3]); w8.y = pk4_fp8(y1[0], y1[1], y1[2], y1[3]); *(v2u*)(YE + row * 2048 + col) = w8; } }
    }
};

struct SsmSOrder {
    int G, c;
    __device__ __forceinline__ bool next(int i, Unit& u) const { const int L = i * G + c; if (L >= 2 * SSMG) return false; u.pm = L; u.pn = L >> 1; return true; }
    __device__ __forceinline__ void a_ready(const Unit&) const {}
    __device__ __forceinline__ void done(const Unit&) const {}
};
struct SsmYOrder {
    int G, c;
    __device__ __forceinline__ bool next(int i, Unit& u) const { const int L = i * G + c; if (L >= 256) return false; const int g = L >> 2; u.pm = 2 * g + ((L >> 1) & 1); u.pn = 2 * g + (L & 1); return true; }
    __device__ __forceinline__ void a_ready(const Unit&) const {}
    __device__ __forceinline__ void done(const Unit&) const {}
};
struct MoeOrder {
    const LAS int* rbe; int nrb, sh, G, c;
    __device__ __forceinline__ bool next(int i, Unit& u) const {
        int rb, ct;
        if (G == 256) { const int x = c & 7, m = c >> 3, st = i * 8 + x, rbq = m >> 3, ctq = m & 7;
            if (sh == 4) { rb = 4 * (st >> 1) + rbq; ct = 8 * (st & 1) + ctq; } else { rb = 4 * st + rbq; ct = ctq; } }
        else { const int L = i * G + c; rb = L >> sh; ct = L & ((1 << sh) - 1); }
        if (rb >= nrb) return false;
        const int e = __builtin_amdgcn_readfirstlane(rbe[rb]);
        u.pm = rb; u.pn = (e << sh) + ct; return true; }
    __device__ __forceinline__ void a_ready(const Unit&) const {}
    __device__ __forceinline__ void done(const Unit&) const {}
};

struct Args { const float* in[28]; float* out; unsigned char* ws; int ph_lo, ph_hi; };
enum { I_X = 0, I_C, I_WADA, I_BADA, I_N1G, I_WIN, I_QG, I_KG, I_ARE, I_AIM, I_LDT, I_BRE, I_BIM, I_CRE, I_CIM, I_SD, I_WGLU, I_BGLU, I_WPA, I_WPB, I_WOUT, I_N2G, I_WR, I_BR, I_WGU, I_BGU, I_WD, I_BD };

__device__ __forceinline__ int crow(int r, int hi) { return (r & 3) + 8 * (r >> 2) + 4 * hi; }

__device__ __forceinline__ void ph0_adaln(const Args& a, LAS unsigned char* lds, int tid, int G, int bid) {
    LAS float* cond = (LAS float*)lds;
    LAS float* red = (LAS float*)(lds + 65536);
    const float* c = a.in[I_C]; const float* W = a.in[I_WADA]; const float* bada = a.in[I_BADA]; float* MOD = (float*)(a.ws + WS_MOD);
    bool have = false;
    for (int ub = bid; ub < MODW / 64; ub += G) {
        if (!have) { for (int i = tid; i < NB * DM; i += NTHR) { const int b = i >> 11, k = i & 2047; const float v = c[i]; cond[k * 8 + b] = v / (1.0f + expf(-v)); } __syncthreads(); have = true; }
        const int cc = tid & 63, col = ub * 64 + cc, kq = tid >> 6;
        float acc[8];
#pragma unroll
        for (int b = 0; b < 8; ++b) acc[b] = 0.f;
        const float* wp = W + (size_t)(kq * 256) * MODW + col;
        for (int k = 0; k < 256; k += 64) {
            float w[64];
#pragma unroll
            for (int q = 0; q < 64; ++q) w[q] = wp[(size_t)(k + q) * MODW];
#pragma unroll
            for (int q = 0; q < 64; ++q) { const f32x4 c0 = *(const LAS f32x4*)(cond + (kq * 256 + k + q) * 8), c1 = *(const LAS f32x4*)(cond + (kq * 256 + k + q) * 8 + 4);
                acc[0] += w[q] * c0[0]; acc[1] += w[q] * c0[1]; acc[2] += w[q] * c0[2]; acc[3] += w[q] * c0[3];
                acc[4] += w[q] * c1[0]; acc[5] += w[q] * c1[1]; acc[6] += w[q] * c1[2]; acc[7] += w[q] * c1[3]; }
        }
#pragma unroll
        for (int b = 0; b < 8; ++b) red[(kq * 8 + b) * 64 + cc] = acc[b];
        __syncthreads();
        { const int b = tid >> 6;
          float s = 0.f;
#pragma unroll
          for (int q = 0; q < 8; ++q) s += red[(q * 8 + b) * 64 + cc];
          MOD[(size_t)b * MODW + col] = s + bada[col]; }
        __syncthreads();
    }
    __syncthreads();
}
__device__ __forceinline__ void tr_item(const float* W, int ldw, int K, int srccol, int nvalid, bf16* WT, size_t dstrow0, int k0, LAS float* scr, int lane) {
    const int nn = lane & 31; const bool ok = nn < nvalid;
    float wv_[32];
#pragma unroll
    for (int i = 0; i < 32; ++i) { const int kk = 2 * i + (lane >> 5); wv_[i] = ok ? W[(size_t)(k0 + kk) * ldw + srccol + nn] : 0.f; }
#pragma unroll
    for (int i = 0; i < 32; ++i) { const int kk = 2 * i + (lane >> 5); scr[kk * 33 + nn] = wv_[i]; }
    LDS_WAIT(); asm volatile("" ::: "memory");
    const int c = lane & 7;
#pragma unroll
    for (int j = 0; j < 4; ++j) { const int n = (lane >> 3) + 8 * j; const LAS float* s = scr + (8 * c) * 33 + n;
        v4u o; o.x = pk2(s[0 * 33], s[1 * 33]); o.y = pk2(s[2 * 33], s[3 * 33]); o.z = pk2(s[4 * 33], s[5 * 33]); o.w = pk2(s[6 * 33], s[7 * 33]);
        *(v4u*)(WT + (dstrow0 + n) * K + k0 + 8 * c) = o; }
    LDS_WAIT(); asm volatile("" ::: "memory");
}
__device__ __forceinline__ void tr128_f8(const float* W, int ldw, int srccol, unsigned char* WT, size_t dstrow0, int K, int k0, LAS unsigned char* tile, int lane) {
    const float* src = W + (size_t)k0 * ldw + srccol + 2 * lane;
    f32x2 va[16], vb[16], vc[16], vd[16];
#define CV_LOAD(v, kb) do { _Pragma("unroll") for (int j = 0; j < 16; ++j) v[j] = __builtin_nontemporal_load((const f32x2*)(src + (size_t)((kb) * 16 + j) * ldw)); } while (0)
#define CV_PUT(v, kb) do { v4u a, b; \
        a.x = pk4_fp8(v[0][0] * F8_WSCALE, v[1][0] * F8_WSCALE, v[2][0] * F8_WSCALE, v[3][0] * F8_WSCALE); a.y = pk4_fp8(v[4][0] * F8_WSCALE, v[5][0] * F8_WSCALE, v[6][0] * F8_WSCALE, v[7][0] * F8_WSCALE); \
        a.z = pk4_fp8(v[8][0] * F8_WSCALE, v[9][0] * F8_WSCALE, v[10][0] * F8_WSCALE, v[11][0] * F8_WSCALE); a.w = pk4_fp8(v[12][0] * F8_WSCALE, v[13][0] * F8_WSCALE, v[14][0] * F8_WSCALE, v[15][0] * F8_WSCALE); \
        b.x = pk4_fp8(v[0][1] * F8_WSCALE, v[1][1] * F8_WSCALE, v[2][1] * F8_WSCALE, v[3][1] * F8_WSCALE); b.y = pk4_fp8(v[4][1] * F8_WSCALE, v[5][1] * F8_WSCALE, v[6][1] * F8_WSCALE, v[7][1] * F8_WSCALE); \
        b.z = pk4_fp8(v[8][1] * F8_WSCALE, v[9][1] * F8_WSCALE, v[10][1] * F8_WSCALE, v[11][1] * F8_WSCALE); b.w = pk4_fp8(v[12][1] * F8_WSCALE, v[13][1] * F8_WSCALE, v[14][1] * F8_WSCALE, v[15][1] * F8_WSCALE); \
        const int n0 = 2 * lane, n1 = 2 * lane + 1; \
        *(LAS v4u*)(tile + n0 * 128 + ((((kb)) ^ (n0 & 7)) << 4)) = a; *(LAS v4u*)(tile + n1 * 128 + ((((kb)) ^ (n1 & 7)) << 4)) = b; } while (0)
    CV_LOAD(va, 0); CV_LOAD(vb, 1); CV_LOAD(vc, 2);
    CV_LOAD(vd, 3); CV_PUT(va, 0); CV_LOAD(va, 4); CV_PUT(vb, 1); CV_LOAD(vb, 5); CV_PUT(vc, 2); CV_LOAD(vc, 6); CV_PUT(vd, 3); CV_LOAD(vd, 7);
    CV_PUT(va, 4); CV_PUT(vb, 5); CV_PUT(vc, 6); CV_PUT(vd, 7);
#undef CV_LOAD
#undef CV_PUT
    LDS_WAIT(); asm volatile("" ::: "memory");
    const int c = lane & 7;
#pragma unroll
    for (int j = 0; j < 16; ++j) { const int n = (lane >> 3) + 8 * j; const v4u o = *(const LAS v4u*)(tile + n * 128 + ((c ^ (n & 7)) << 4));
        *(v4u*)(WT + (dstrow0 + n) * K + k0 + 16 * c) = o; }
    LDS_WAIT(); asm volatile("" ::: "memory");
}
constexpr int CV_GU1 = 16 * 32, CV_GU = 32 * CV_GU1, CV_D1 = 16 * 16, CV_DN = 32 * CV_D1, CV_PA = 8 * 16, CV_PB = 8 * 16, CV_WO = 16 * 16, CV_ITEMS = CV_PA + CV_PB + CV_WO + CV_GU + CV_DN;
__device__ __forceinline__ void cv_item(const Args& a, int it, LAS unsigned char* tile, int lane) {
    if (it < CV_PA) { const int kt = it >> 4, nt = it & 15; tr128_f8(a.in[I_WPA], 2048, 128 * nt, (unsigned char*)(a.ws + WS_WA), (size_t)128 * nt, 2048, 128 * kt, tile, lane); return; } it -= CV_PA;
    if (it < CV_PB) { const int kt = it >> 4, nt = it & 15; tr128_f8(a.in[I_WPB], 2048, 128 * nt, (unsigned char*)(a.ws + WS_WA + 1024), (size_t)128 * nt, 2048, 128 * kt, tile, lane); return; } it -= CV_PB;
    if (it < CV_WO) { const int kt = it >> 4, nt = it & 15; tr128_f8(a.in[I_WOUT], 2048, 128 * nt, (unsigned char*)(a.ws + WS_WO), (size_t)128 * nt, 2048, 128 * kt, tile, lane); return; } it -= CV_WO;
    if (it < CV_GU) { const int e = it / CV_GU1, q = it % CV_GU1, kt = q >> 5, nt = q & 31, d0 = 128 * nt, ct = d0 >> 8; const int src = (d0 & 128) ? (2048 + 128 * ct) : (128 * ct);
        tr128_f8(a.in[I_WGU] + (size_t)e * 2048 * 4096, 4096, src, (unsigned char*)(a.ws + WS_WGU), (size_t)e * 4096 + d0, 2048, 128 * kt, tile, lane); }
    else { const int r = it - CV_GU, e = r / CV_D1, q = r % CV_D1, kt = q >> 4, nt = q & 15;
        tr128_f8(a.in[I_WD] + (size_t)e * 2048 * 2048, 2048, 128 * nt, (unsigned char*)(a.ws + WS_WD), (size_t)e * 2048 + 128 * nt, 2048, 128 * kt, tile, lane); }
}
__device__ __forceinline__ void ph0_transposes(const Args& a, LAS unsigned char* lds, int wave, int lane, int G, int bid) {
    LAS float* scr = (LAS float*)(lds + wave * 16384);
    const int gw = wave * G + bid, NGW = G * NWAVES;
    constexpr int I_IN = 32 * 80, I_GL = 16 * 32, I_IN8 = 16 * 42;
    constexpr int NITEMS = I_IN + I_GL + I_IN8;
    for (int it = gw; it < NITEMS; it += NGW) {
        int r = it;
        if (r < I_IN) { const int kb = r / 80, nb = r % 80, d0 = 32 * nb; int src, nv = 32;
            if (d0 < 1280) src = d0; else if (d0 < 2304) src = 1536 + (d0 - 1280); else if (d0 < 2368) src = 2560 + (d0 - 2304); else if (d0 == 2368) { src = 2624; nv = 16; } else { src = 0; nv = 0; }
            tr_item(a.in[I_WIN], INW, DM, src, nv, (bf16*)(a.ws + WS_WIN), (size_t)d0, 64 * kb, scr, lane); continue; } r -= I_IN;
        if (r < I_GL) { const int kb = r / 32, nb = r % 32; tr_item(a.in[I_WGLU], 1024, 1024, 32 * nb, 32, (bf16*)(a.ws + WS_WGLU), (size_t)32 * nb, 64 * kb, scr, lane); continue; } r -= I_GL;
        { const int kt = r / 42, nt = r % 42; const int src = nt < 2 ? 1280 + 128 * nt : (nt < 10 ? 2640 + 128 * (nt - 2) : 3664 + 128 * (nt - 10));
          tr128_f8(a.in[I_WIN], INW, src, (unsigned char*)(a.ws + WS_WIN8), (size_t)128 * nt, 2048, 128 * kt, lds + wave * 16384, lane); }
    }
}
__device__ __forceinline__ void cv_queue(const Args& a, LAS unsigned char* lds, int wave, int lane) {
    unsigned* ctr = (unsigned*)(a.ws + WS_CTL) + CW_CVQ;
    for (;;) { int it = 0; if (lane == 0) it = (int)__hip_atomic_fetch_add(ctr, 1u, RLX_AGENT); it = __builtin_amdgcn_readfirstlane(it); if (it >= CV_ITEMS) break; cv_item(a, it, lds + wave * 16384, lane); }
}
__device__ __forceinline__ void cexp_d(double zr, double zi, double& er, double& ei) {
    const double s = 1.0 / 1024.0; zr *= s; zi *= s;
    double wr = 1.0, wi = 0.0;
#pragma unroll
    for (int k = 10; k >= 1; --k) { const double tr = (zr * wr - zi * wi) / (double)k, ti = (zr * wi + zi * wr) / (double)k; wr = 1.0 + tr; wi = ti; }
#pragma unroll
    for (int q = 0; q < 10; ++q) { const double tr = wr * wr - wi * wi, ti = 2.0 * wr * wi; wr = tr; wi = ti; }
    er = wr; ei = wi;
}
__device__ __forceinline__ void ph0_ssm_consts(const Args& a, int tid, int G, int bid) {
    float* BBAR = (float*)(a.ws + WS_BBAR); float* POW = (float*)(a.ws + WS_POW);
    for (int idx = bid * NTHR + tid; idx < SSMG * SSMN; idx += G * NTHR) {
        const int g = idx >> 6, n = idx & 63;
        double st, dummy; cexp_d((double)a.in[I_LDT][g], 0.0, st, dummy);
        const double are = (double)a.in[I_ARE][idx], aim = (double)a.in[I_AIM][idx];
        double er, ei; cexp_d(st * are, st * aim, er, ei);
        const double den = are * are + aim * aim, nr = er - 1.0, ni = ei;
        const double cr = (nr * are + ni * aim) / den, ci = (ni * are - nr * aim) / den;
#pragma unroll 4
        for (int p = 0; p < 16; ++p) { const double br = (double)a.in[I_BRE][(size_t)idx * 16 + p], bi = (double)a.in[I_BIM][(size_t)idx * 16 + p];
            BBAR[((size_t)idx * 16 + p) * 2 + 0] = (float)(cr * br - ci * bi); BBAR[((size_t)idx * 16 + p) * 2 + 1] = (float)(cr * bi + ci * br); }
        double pr = 1.0, pi = 0.0;
        for (int t = 0; t <= 64; ++t) { POW[(((size_t)g * 65 + t) * 64 + n) * 2 + 0] = (float)pr; POW[(((size_t)g * 65 + t) * 64 + n) * 2 + 1] = (float)pi;
            const double tr = pr * er - pi * ei, ti = pr * ei + pi * er; pr = tr; pi = ti; }
    }
}

__device__ __forceinline__ void ph1_norm(const Args& a, int wave, int lane, int G, int bid) {
    const float* MOD = (const float*)(a.ws + WS_MOD);
    const int gw = bid * NWAVES + wave, NGW = G * NWAVES;
    {
        const float* X = a.in[I_X]; const float* g1 = a.in[I_N1G]; bf16* HN = (bf16*)(a.ws + WS_HN); unsigned char* HN8 = (unsigned char*)(a.ws + WS_HN8);
        const int RPW = (T + NGW - 1) / NGW, r0 = gw * RPW, r1 = min(T, r0 + RPW);
        f32x4 vn[8], pa[8], pb[8]; int curb = -1;
        if (r0 < r1) { const f32x4* xr = (const f32x4*)(X + (size_t)r0 * DM) + 2 * lane;
#pragma unroll
            for (int j = 0; j < 4; ++j) { vn[2 * j] = xr[128 * j]; vn[2 * j + 1] = xr[128 * j + 1]; } }
        for (int row = r0; row < r1; ++row) {
            const int b = row >> 11;
            f32x4 v[8]; float s = 0.f;
#pragma unroll
            for (int j = 0; j < 8; ++j) { v[j] = vn[j]; s += (v[j][0] * v[j][0] + v[j][1] * v[j][1]) + (v[j][2] * v[j][2] + v[j][3] * v[j][3]); }
            if (row + 1 < r1) { const f32x4* xr = (const f32x4*)(X + (size_t)(row + 1) * DM) + 2 * lane;
#pragma unroll
                for (int j = 0; j < 4; ++j) { vn[2 * j] = xr[128 * j]; vn[2 * j + 1] = xr[128 * j + 1]; } }
            if (b != curb) { curb = b; const f32x4* gp = (const f32x4*)g1 + 2 * lane; const f32x4* shp = (const f32x4*)(MOD + (size_t)b * MODW) + 2 * lane; const f32x4* scp = (const f32x4*)(MOD + (size_t)b * MODW + DM) + 2 * lane;
#pragma unroll
                for (int j = 0; j < 4; ++j) { pa[2 * j] = gp[128 * j] * (scp[128 * j] + 1.0f); pa[2 * j + 1] = gp[128 * j + 1] * (scp[128 * j + 1] + 1.0f); pb[2 * j] = shp[128 * j]; pb[2 * j + 1] = shp[128 * j + 1]; } }
            const float rstd = 1.0f / sqrtf(wave_sum(s) * (1.0f / DM) + RMS_EPS);
            v4u* o16 = (v4u*)(HN + (size_t)row * DM) + lane; v2u* o8 = (v2u*)(HN8 + (size_t)row * DM) + lane; v4u w[4]; v2u w8[4];
#pragma unroll
            for (int j = 0; j < 4; ++j) { const f32x4 y0 = (v[2 * j] * rstd) * pa[2 * j] + pb[2 * j], y1 = (v[2 * j + 1] * rstd) * pa[2 * j + 1] + pb[2 * j + 1];
                w[j].x = pk2(y0[0], y0[1]); w[j].y = pk2(y0[2], y0[3]); w[j].z = pk2(y1[0], y1[1]); w[j].w = pk2(y1[2], y1[3]);
                w8[j].x = pk4_fp8(y0[0] * F8_ASCALE, y0[1] * F8_ASCALE, y0[2] * F8_ASCALE, y0[3] * F8_ASCALE); w8[j].y = pk4_fp8(y1[0] * F8_ASCALE, y1[1] * F8_ASCALE, y1[2] * F8_ASCALE, y1[3] * F8_ASCALE); }
#pragma unroll
            for (int j = 0; j < 4; ++j) { o16[64 * j] = w[j]; o8[64 * j] = w8[j]; }
        }
    }
}
__device__ __forceinline__ void ph1_small(const Args& a, int tid, int wave, int lane, int G, int bid) {
    const float* MOD = (const float*)(a.ws + WS_MOD);
    const int gw = bid * NWAVES + wave, NGW = G * NWAVES;
    {
        const float* g2 = a.in[I_N2G]; const float* wr = a.in[I_WR]; const float* br = a.in[I_BR]; float* WRP = (float*)(a.ws + WS_WRP); float* BRP = (float*)(a.ws + WS_BRP);
        for (int base = bid * NTHR + tid; base < NB * DM * NEXP; base += 4 * G * NTHR) { float v[4];
#pragma unroll
            for (int u = 0; u < 4; ++u) { const int idx = base + u * G * NTHR, ic = idx < NB * DM * NEXP ? idx : 0, b = ic >> 16, k = (ic >> 5) & 2047; v[u] = g2[k] * (1.0f + MOD[(size_t)b * MODW + 4 * DM + k]) * wr[ic & 65535]; }
#pragma unroll
            for (int u = 0; u < 4; ++u) { const int idx = base + u * G * NTHR; if (idx < NB * DM * NEXP) WRP[idx] = v[u]; } }
        for (int o = (wave == 2 ? bid : NB * NEXP); o < NB * NEXP; o += G) { const int b = o >> 5, e = o & 31; float s = 0.f;
#pragma unroll 8
            for (int k = lane; k < DM; k += 64) s += MOD[(size_t)b * MODW + 3 * DM + k] * wr[k * 32 + e];
            s = wave_sum(s); if (lane == 0) BRP[o] = s + br[e]; }
    }
    {
        const float* cre = a.in[I_CRE]; const float* cim = a.in[I_CIM]; const float* BBAR = (const float*)(a.ws + WS_BBAR); const float* POW = (const float*)(a.ws + WS_POW); float* KT = (float*)(a.ws + WS_KT);
        for (int idx = (tid < 128 ? bid * 128 + tid : SSMG * SL * 16); idx < SSMG * SL * 16; idx += G * 128) {
            const int g = idx >> 9, tau = (idx >> 4) & 31, p = idx & 15; float s[16];
#pragma unroll
            for (int q = 0; q < 16; ++q) s[q] = 0.f;
#pragma unroll 8
            for (int n = 0; n < 64; ++n) { const float cr = cre[((size_t)g * 16 + p) * 64 + n], ci = cim[((size_t)g * 16 + p) * 64 + n];
                const float pr = POW[(((size_t)g * 65 + tau) * 64 + n) * 2], pi = POW[(((size_t)g * 65 + tau) * 64 + n) * 2 + 1];
                const float er = cr * pr - ci * pi, ei = cr * pi + ci * pr;
                const f32x4* bp = (const f32x4*)(BBAR + ((size_t)g * 64 + n) * 32);
#pragma unroll
                for (int q = 0; q < 8; ++q) { const f32x4 bb = bp[q]; s[2 * q] += er * bb[0] - ei * bb[1]; s[2 * q + 1] += er * bb[2] - ei * bb[3]; } }
            { const float dv = (tau == 0) ? a.in[I_SD][g * 16 + p] : 0.0f;
#pragma unroll
              for (int q = 0; q < 16; ++q) s[q] += (q == p) ? dv : 0.0f; }
            float* kp = KT + (((size_t)g * 64 + tau) * 16 + p) * 16;
#pragma unroll
            for (int q = 0; q < 4; ++q) *(f32x4*)(kp + 4 * q) = (f32x4){s[4 * q], s[4 * q + 1], s[4 * q + 2], s[4 * q + 3]}; }
    }
}

__device__ __forceinline__ void qknorm_body(const Args& a, int wave, int lane, int G, int bid) {
    const int gw = bid * NWAVES + wave, NGW = G * NWAVES;
    {   bf16* Q = (bf16*)(a.ws + WS_Q); bf16* K = (bf16*)(a.ws + WS_K); const float* qg = a.in[I_QG]; const float* kg = a.in[I_KG];
        const float qs = 0.08838834764831845f * 1.4426950408889634f;
        const int l32 = lane & 31; float qgv[16], kgv[8];
#pragma unroll
        for (int e = 0; e < 16; ++e) qgv[e] = qg[((16 * lane) & 127) + e];
#pragma unroll
        for (int e = 0; e < 8; ++e) kgv[e] = kg[((8 * l32) & 127) + e];
        for (int row0 = gw; row0 < T; row0 += 4 * NGW) {
            v4u qa[4], qb[4], ka[4];
#pragma unroll
            for (int u = 0; u < 4; ++u) { const int row = min(row0 + u * NGW, T - 1); const v4u* qp = (const v4u*)(Q + (size_t)row * 1024 + 16 * lane); qa[u] = qp[0]; qb[u] = qp[1]; ka[u] = *(const v4u*)(K + (size_t)row * 256 + 8 * l32); }
#pragma unroll
            for (int u = 0; u < 4; ++u) { const int row = row0 + u * NGW; if (row < T) {
                {   v4u* qp = (v4u*)(Q + (size_t)row * 1024 + 16 * lane); const v4u w0 = qa[u], w1 = qb[u]; float f[16];
                    f[0] = bflo(w0.x); f[1] = bfhi(w0.x); f[2] = bflo(w0.y); f[3] = bfhi(w0.y); f[4] = bflo(w0.z); f[5] = bfhi(w0.z); f[6] = bflo(w0.w); f[7] = bfhi(w0.w);
                    f[8] = bflo(w1.x); f[9] = bfhi(w1.x); f[10] = bflo(w1.y); f[11] = bfhi(w1.y); f[12] = bflo(w1.z); f[13] = bfhi(w1.z); f[14] = bflo(w1.w); f[15] = bfhi(w1.w);
                    float s = 0.f;
#pragma unroll
                    for (int e = 0; e < 16; ++e) s += f[e] * f[e];
                    s += __shfl_xor(s, 1); s += __shfl_xor(s, 2); s += __shfl_xor(s, 4);
                    const float rs = qs / sqrtf(s * (1.0f / 128.0f) + RMS_EPS);
#pragma unroll
                    for (int e = 0; e < 16; ++e) f[e] = f[e] * rs * qgv[e];
                    v4u o0, o1; o0.x = pk2(f[0], f[1]); o0.y = pk2(f[2], f[3]); o0.z = pk2(f[4], f[5]); o0.w = pk2(f[6], f[7]); o1.x = pk2(f[8], f[9]); o1.y = pk2(f[10], f[11]); o1.z = pk2(f[12], f[13]); o1.w = pk2(f[14], f[15]);
                    qp[0] = o0; qp[1] = o1; }
                {   v4u* kp = (v4u*)(K + (size_t)row * 256 + 8 * l32); const v4u w0 = ka[u]; float f[8];
                    f[0] = bflo(w0.x); f[1] = bfhi(w0.x); f[2] = bflo(w0.y); f[3] = bfhi(w0.y); f[4] = bflo(w0.z); f[5] = bfhi(w0.z); f[6] = bflo(w0.w); f[7] = bfhi(w0.w);
                    float s = 0.f;
#pragma unroll
                    for (int e = 0; e < 8; ++e) s += f[e] * f[e];
                    s += __shfl_xor(s, 1); s += __shfl_xor(s, 2); s += __shfl_xor(s, 4); s += __shfl_xor(s, 8);
                    const float rs = 1.0f / sqrtf(s * (1.0f / 128.0f) + RMS_EPS);
#pragma unroll
                    for (int e = 0; e < 8; ++e) f[e] = f[e] * rs * kgv[e];
                    v4u o0; o0.x = pk2(f[0], f[1]); o0.y = pk2(f[2], f[3]); o0.z = pk2(f[4], f[5]); o0.w = pk2(f[6], f[7]);
                    if (lane < 32) kp[0] = o0; } } }
        }
    }
}
__device__ __forceinline__ void bty_body(const Args& a, int tid, int G, int bid) {
    const float* KT = (const float*)(a.ws + WS_KT); const float* POW = (const float*)(a.ws + WS_POW); const float* cre = a.in[I_CRE]; const float* cim = a.in[I_CIM]; bf16* BTY = (bf16*)(a.ws + WS_BTY);
    constexpr int RPG = SL * 16; const int NA = SSMG * RPG * 64, NBC = SSMG * RPG * 16, ST = G * NTHR;
    for (int base = bid * NTHR + tid; base < NA; base += 4 * ST) {
        f32x4 lo[4], hi[4];
#pragma unroll
        for (int u = 0; u < 4; ++u) { const int idx = base + u * ST, ic = idx < NA ? idx : 0, cc = ic & 63, rr = (ic >> 6) & (RPG - 1), g = ic >> 15, j = rr >> 4, p = rr & 15, i = cc >> 1, d = j >= i ? j - i : 0;
            const float* kp = KT + (((size_t)g * 64 + d) * 16 + p) * 16 + (cc & 1) * 8; lo[u] = *(const f32x4*)kp; hi[u] = *(const f32x4*)(kp + 4); }
#pragma unroll
        for (int u = 0; u < 4; ++u) { const int idx = base + u * ST; if (idx < NA) { const int cc = idx & 63, rr = (idx >> 6) & (RPG - 1), g = idx >> 15, j = rr >> 4, i = cc >> 1; const bool ok = j >= i;
            v4u o; o.x = ok ? pk2(lo[u][0], lo[u][1]) : 0u; o.y = ok ? pk2(lo[u][2], lo[u][3]) : 0u; o.z = ok ? pk2(hi[u][0], hi[u][1]) : 0u; o.w = ok ? pk2(hi[u][2], hi[u][3]) : 0u;
            *(v4u*)(BTY + ((size_t)g * RPG + rr) * UA_LD + 8 * cc) = o; } }
    }
    for (int base = bid * NTHR + tid; base < NBC; base += 4 * ST) {
        f32x4 cr[4], ci[4], p0[4], p1[4];
#pragma unroll
        for (int u = 0; u < 4; ++u) { const int idx = base + u * ST, ic = idx < NBC ? idx : 0, cq = ic & 15, rr = (ic >> 4) & (RPG - 1), g = ic >> 13, j = rr >> 4, p = rr & 15;
            cr[u] = *(const f32x4*)(cre + ((size_t)g * 16 + p) * 64 + 4 * cq); ci[u] = *(const f32x4*)(cim + ((size_t)g * 16 + p) * 64 + 4 * cq);
            const float* pw = POW + (((size_t)g * 65 + (j + 1)) * 64 + 4 * cq) * 2; p0[u] = *(const f32x4*)pw; p1[u] = *(const f32x4*)(pw + 4); }
#pragma unroll
        for (int u = 0; u < 4; ++u) { const int idx = base + u * ST; if (idx < NBC) { const int cq = idx & 15, rr = (idx >> 4) & (RPG - 1), g = idx >> 13;
            v4u o; o.x = pk2(cr[u][0] * p0[u][0] - ci[u][0] * p0[u][1], -(cr[u][0] * p0[u][1] + ci[u][0] * p0[u][0])); o.y = pk2(cr[u][1] * p0[u][2] - ci[u][1] * p0[u][3], -(cr[u][1] * p0[u][3] + ci[u][1] * p0[u][2]));
            o.z = pk2(cr[u][2] * p1[u][0] - ci[u][2] * p1[u][1], -(cr[u][2] * p1[u][1] + ci[u][2] * p1[u][0])); o.w = pk2(cr[u][3] * p1[u][2] - ci[u][3] * p1[u][3], -(cr[u][3] * p1[u][3] + ci[u][3] * p1[u][2]));
            *(v4u*)(BTY + ((size_t)g * RPG + rr) * UA_LD + SL * 16 + 8 * cq) = o; } }
    }
}
__device__ __forceinline__ void bts_body(const Args& a, int tid, int G, int bid) {
    const float* BBAR = (const float*)(a.ws + WS_BBAR); const float* POW = (const float*)(a.ws + WS_POW); bf16* BTS = (bf16*)(a.ws + WS_BTS);
    constexpr int CPR = SL * 16 / 8; const int NCH = SSMG * 256 * CPR, ST = G * NTHR;
    for (int base = bid * NTHR + tid; base < NCH; base += 4 * ST) {
        f32x4 bb[4][4]; f32x2 pw[4];
#pragma unroll
        for (int u = 0; u < 4; ++u) { const int idx = base + u * ST, ic = idx < NCH ? idx : 0, cc = ic % CPR, rr = (ic / CPR) & 127, g = ic / (CPR * 256), col0 = 8 * cc, i = col0 >> 4, pp0 = col0 & 15, n = rr >> 1;
            pw[u] = *(const f32x2*)(POW + (((size_t)g * 65 + (SL - 1 - i)) * 64 + n) * 2); const f32x4* bp = (const f32x4*)(BBAR + (((size_t)g * 64 + n) * 16 + pp0) * 2);
#pragma unroll
            for (int q = 0; q < 4; ++q) bb[u][q] = bp[q]; }
#pragma unroll
        for (int u = 0; u < 4; ++u) { const int idx = base + u * ST; if (idx < NCH) { const int cc = idx % CPR, rr = (idx / CPR) & 255, g = idx / (CPR * 256); const bool live = rr < 128, part = rr & 1; const float pr = pw[u][0], pi = pw[u][1]; float f[8];
#pragma unroll
            for (int q = 0; q < 4; ++q) { f[2 * q] = part ? (pr * bb[u][q][1] + pi * bb[u][q][0]) : (pr * bb[u][q][0] - pi * bb[u][q][1]); f[2 * q + 1] = part ? (pr * bb[u][q][3] + pi * bb[u][q][2]) : (pr * bb[u][q][2] - pi * bb[u][q][3]); }
            v4u o; o.x = live ? pk2(f[0], f[1]) : 0u; o.y = live ? pk2(f[2], f[3]) : 0u; o.z = live ? pk2(f[4], f[5]) : 0u; o.w = live ? pk2(f[6], f[7]) : 0u;
            *(v4u*)(BTS + ((size_t)g * 256 + rr) * (SL * 16) + 8 * cc) = o; } }
    }
}

namespace att {
constexpr int D = 128, NW = 8, QBLK = 32, KVBLK = 64, LDK = 256;
constexpr float THR2 = 11.5415603f;
constexpr size_t SHM_V = KVBLK * D * 2, SHM_K = KVBLK * D * 2, SHM_ATTN = 2 * SHM_V + 2 * SHM_K + NW * 64 * 4;
using u32x4 = __attribute__((ext_vector_type(4))) unsigned;
#define KSWZ(row, colB) ((row) * 256 + ((colB) ^ (((row) & 7) << 4)))
#define SBAR() __builtin_amdgcn_sched_barrier(0)
__device__ __forceinline__ unsigned cvtpk(float lo, float hi) { unsigned r; asm volatile("v_cvt_pk_bf16_f32 %0, %1, %2" : "=v"(r) : "v"(lo), "v"(hi)); return r; }

__device__ __forceinline__ void amask(f32x16& p0, f32x16& p1, unsigned mw0, unsigned mw1, float dq, float nslope, int hi) {
  const unsigned s0 = mw0 >> (4 * hi), s1 = mw1 >> (4 * hi);
#pragma unroll
  for (int r = 0; r < 16; ++r) { const int c = (r & 3) + 8 * (r >> 2);
    const float v = fmaf(nslope, fabsf(dq - (float)c), p0[r]); p0[r] = (s0 & (1u << c)) ? v : -INFINITY;
    const float w = fmaf(nslope, fabsf(dq - (float)(c + 32)), p1[r]); p1[r] = (s1 & (1u << c)) ? w : -INFINITY; }
}
__device__ __forceinline__ void partialSM(f32x16& p0, f32x16& p1, float& m_reg, float& mn, float& alpha) {
  float pmax = p0[0];
#pragma unroll
  for (int r = 1; r < 16; ++r) pmax = fmaxf(pmax, p0[r]);
#pragma unroll
  for (int r = 0; r < 16; ++r) pmax = fmaxf(pmax, p1[r]);
  { auto rr = __builtin_amdgcn_permlane32_swap(__float_as_uint(pmax), __float_as_uint(pmax), false, false);
    pmax = fmaxf(__uint_as_float(rr[0]), __uint_as_float(rr[1])); }
  if (__builtin_expect(__all(pmax - m_reg <= THR2), 1)) { mn = m_reg; alpha = 1.f; }
  else { mn = fmaxf(m_reg, pmax); alpha = __builtin_amdgcn_exp2f(m_reg - mn); m_reg = mn; }
#pragma unroll
  for (int r = 0; r < 16; ++r) p0[r] = p0[r] - mn;
#pragma unroll
  for (int r = 0; r < 16; ++r) p1[r] = p1[r] - mn;
#pragma unroll
  for (int r = 0; r < 16; ++r) p0[r] = __builtin_amdgcn_exp2f(p0[r]);
}
__device__ __forceinline__ void finishSM(f32x16& p0, f32x16& p1, float alpha, float& l_reg, bf16x8& pa0, bf16x8& pa1, bf16x8& pa2, bf16x8& pa3) {
#pragma unroll
  for (int r = 0; r < 16; ++r) p1[r] = __builtin_amdgcn_exp2f(p1[r]);
  float ps = 0;
#pragma unroll
  for (int r = 0; r < 16; ++r) ps += p0[r];
#pragma unroll
  for (int r = 0; r < 16; ++r) ps += p1[r];
  { auto rr = __builtin_amdgcn_permlane32_swap(__float_as_uint(ps), __float_as_uint(ps), false, false);
    ps = __uint_as_float(rr[0]) + __uint_as_float(rr[1]); }
  l_reg = l_reg * alpha + ps;
#define PK4(P, BASE, OUT) do { unsigned a0 = cvtpk(P[BASE + 0], P[BASE + 1]), a1 = cvtpk(P[BASE + 2], P[BASE + 3]);   \
    unsigned b0 = cvtpk(P[BASE + 4], P[BASE + 5]), b1 = cvtpk(P[BASE + 6], P[BASE + 7]);                              \
    auto r0 = __builtin_amdgcn_permlane32_swap(a0, b0, false, false); auto r1 = __builtin_amdgcn_permlane32_swap(a1, b1, false, false); \
    u32x4 w = {r0[0], r1[0], r0[1], r1[1]}; OUT = *reinterpret_cast<bf16x8*>(&w); } while (0)
  PK4(p0, 0, pa0); PK4(p0, 8, pa1); PK4(p1, 0, pa2); PK4(p1, 8, pa3);
#undef PK4
}
__device__ __forceinline__ void qkt(f32x16& p0, f32x16& p1, const bf16* Ks, const bf16x8* qr, int r32, int hi) {
  p0 = f32x16{}; p1 = f32x16{};
#pragma unroll
  for (int d0 = 0; d0 < 8; ++d0) { int cb = (d0 * 16 + hi * 8) * 2;
    bf16x8 b0 = *reinterpret_cast<const bf16x8*>((const char*)Ks + KSWZ(r32, cb));
    bf16x8 b1 = *reinterpret_cast<const bf16x8*>((const char*)Ks + KSWZ(32 + r32, cb));
    p0 = __builtin_amdgcn_mfma_f32_32x32x16_bf16(b0, qr[d0], p0, 0, 0, 0);
    p1 = __builtin_amdgcn_mfma_f32_32x32x16_bf16(b1, qr[d0], p1, 0, 0, 0); }
}
__device__ __forceinline__ int v_st(int k, int c) { const int kk = (k & ~0xC) | ((k & 4) << 1) | ((k & 8) >> 1); return ((kk >> 3) * 4 + (c >> 5)) * 512 + ((kk & 7) * 32 + (c & 31)) * 2; }
__device__ __forceinline__ int v_rd_base(int lane) { return ((lane & 3) << 3) | (((lane >> 2) & 3) << 6) | (((lane >> 4) & 1) << 5) | (((lane >> 5) & 1) << 8); }
constexpr int v_rd_off(int d0, int ks, int half) { return d0 * 512 + ks * 4096 + half * 2048; }
template <int OFF> __device__ __forceinline__ s16x4 tr_read(int vb) {
  s16x4 r; asm volatile("ds_read_b64_tr_b16 %0, %1 offset:%2" : "=&v"(r) : "v"(vb), "i"(OFF) : "memory"); return r;
}
template <int D0> __device__ __forceinline__ void pv_one(f32x16& od, int vb, bf16x8 pa0, bf16x8 pa1, bf16x8 pa2, bf16x8 pa3) {
  const s16x4 l0 = tr_read<v_rd_off(D0, 0, 0)>(vb), h0 = tr_read<v_rd_off(D0, 0, 1)>(vb), l1 = tr_read<v_rd_off(D0, 1, 0)>(vb), h1 = tr_read<v_rd_off(D0, 1, 1)>(vb);
  const s16x4 l2 = tr_read<v_rd_off(D0, 2, 0)>(vb), h2 = tr_read<v_rd_off(D0, 2, 1)>(vb), l3 = tr_read<v_rd_off(D0, 3, 0)>(vb), h3 = tr_read<v_rd_off(D0, 3, 1)>(vb);
  asm volatile("s_waitcnt lgkmcnt(0)" ::: "memory"); SBAR();
#define PK(L, H) (bf16x8){L[0], L[1], L[2], L[3], H[0], H[1], H[2], H[3]}
  od = __builtin_amdgcn_mfma_f32_32x32x16_bf16(pa0, PK(l0, h0), od, 0, 0, 0);
  od = __builtin_amdgcn_mfma_f32_32x32x16_bf16(pa1, PK(l1, h1), od, 0, 0, 0);
  od = __builtin_amdgcn_mfma_f32_32x32x16_bf16(pa2, PK(l2, h2), od, 0, 0, 0);
  od = __builtin_amdgcn_mfma_f32_32x32x16_bf16(pa3, PK(l3, h3), od, 0, 0, 0);
#undef PK
}
__device__ __forceinline__ void pv_d0(f32x16* o, int vb, bf16x8 pa0, bf16x8 pa1, bf16x8 pa2, bf16x8 pa3) {
  pv_one<0>(o[0], vb, pa0, pa1, pa2, pa3); pv_one<1>(o[1], vb, pa0, pa1, pa2, pa3); pv_one<2>(o[2], vb, pa0, pa1, pa2, pa3); pv_one<3>(o[3], vb, pa0, pa1, pa2, pa3);
}

__device__ __forceinline__ void attn_unit(const bf16* __restrict__ Qlane, const bf16* __restrict__ Kh, const bf16* __restrict__ Vh, unsigned char* __restrict__ Ow, int ldo,
                                          const unsigned* __restrict__ selbase, unsigned selo, int qpos, float nslope, int NT, int NTreal, char* lds) {
  const int tid = threadIdx.x, wid = tid >> 6, lane = tid & 63, r32 = lane & 31, hi = lane >> 5;
  bf16* V_lds = (bf16*)lds; bf16* K_lds = (bf16*)(lds + 2 * SHM_V);
  float* ws = (float*)(lds + 2 * SHM_V + 2 * SHM_K) + wid * 64; float* li_l = ws; float* al_l = ws + 32;
  float m_reg = -1e30f, l_reg = 0; f32x16 o[4] = {}; bf16x8 qr[8];
#pragma unroll
  for (int d0 = 0; d0 < 8; ++d0) qr[d0] = *reinterpret_cast<const bf16x8*>(Qlane + d0 * 16);
  const int sr = tid >> 4, sc = (tid & 15) * 8, vst0 = v_st(sr, sc), vst1 = v_st(32 + sr, sc);
  const int vb0 = (int)(uintptr_t)V_lds + v_rd_base(lane);
  const int soffb = (sr * LDK + sc) * 2;
  const __amdgpu_buffer_rsrc_t rsK = __builtin_amdgcn_make_buffer_rsrc((void*)Kh, 0, 1 << 20, 0x00020000), rsV = __builtin_amdgcn_make_buffer_rsrc((void*)Vh, 0, 1 << 20, 0x00020000);
  const float dqb = (float)(qpos - 4 * hi);
  struct { bf16x8 vs0, vs1, ks0, ks1; } sr_[2];
#define SLOAD(i, k0) do { const int so_ = (k0) * (LDK * 2); \
    sr_[i].vs0 = __builtin_bit_cast(bf16x8, __builtin_amdgcn_raw_buffer_load_b128(rsV, soffb, so_, 0)); sr_[i].vs1 = __builtin_bit_cast(bf16x8, __builtin_amdgcn_raw_buffer_load_b128(rsV, soffb, so_ + 32 * LDK * 2, 0)); \
    sr_[i].ks0 = __builtin_bit_cast(bf16x8, __builtin_amdgcn_raw_buffer_load_b128(rsK, soffb, so_, 0)); sr_[i].ks1 = __builtin_bit_cast(bf16x8, __builtin_amdgcn_raw_buffer_load_b128(rsK, soffb, so_ + 32 * LDK * 2, 0)); } while (0)
#define SWRITE(b, i) do { *(bf16x8*)((char*)V_lds + (b) * SHM_V + vst0) = sr_[i].vs0;          \
    *(bf16x8*)((char*)V_lds + (b) * SHM_V + vst1) = sr_[i].vs1; int kc = sc * 2;               \
    *(bf16x8*)((char*)K_lds + (b) * SHM_K + KSWZ(sr, kc)) = sr_[i].ks0;                       \
    *(bf16x8*)((char*)K_lds + (b) * SHM_K + KSWZ(32 + sr, kc)) = sr_[i].ks1; } while (0)
#define SWAIT() asm volatile("s_waitcnt vmcnt(4)" ::: "memory")
#define RESC(a) do { if (__any((a) < 1.f)) { if (hi == 0) al_l[r32] = (a); asm volatile("s_waitcnt lgkmcnt(0)" ::: "memory"); \
    _Pragma("unroll") for (int d = 0; d < 4; ++d) _Pragma("unroll") for (int r = 0; r < 16; ++r) o[d][r] *= al_l[crow(r, hi)]; } } while (0)
#define MASKW(j, m0, m1) do { const v2u mm_ = *reinterpret_cast<const v2u*>(selbase + (selo + 2u * (unsigned)(j))); const bool in_ = (j) < NTreal; m0 = in_ ? mm_.x : 0u; m1 = in_ ? mm_.y : 0u; } while (0)
  f32x16 pA0, pA1, pB0, pB1; float mnA, mnB, alA, alB; bf16x8 pa0, pa1, pa2, pa3; unsigned ma0, ma1, mb0, mb1;
  constexpr int SE = 0, SO = 1;
  SLOAD(SE, 0); MASKW(0, ma0, ma1); MASKW(1, mb0, mb1); asm volatile("s_waitcnt vmcnt(0)" ::: "memory"); SWRITE(0, SE); __syncthreads();
  qkt(pA0, pA1, K_lds, qr, r32, hi); amask(pA0, pA1, ma0, ma1, dqb, nslope, hi); partialSM(pA0, pA1, m_reg, mnA, alA);
  SLOAD(SO, KVBLK); if (2 < NT) SLOAD(SE, 2 * KVBLK);
  SWAIT(); SWRITE(1, SO); __syncthreads();
  for (int j = 1; j + 1 < NT; j += 2) {
    SBAR(); qkt(pB0, pB1, (bf16*)((char*)K_lds + SHM_K), qr, r32, hi);
    finishSM(pA0, pA1, alA, l_reg, pa0, pa1, pa2, pa3); SBAR();
    MASKW(j + 1, ma0, ma1); SLOAD(SO, (j + 2) * KVBLK); SBAR();
    pv_d0(o, vb0, pa0, pa1, pa2, pa3); amask(pB0, pB1, mb0, mb1, dqb - (float)(64 * j), nslope, hi); partialSM(pB0, pB1, m_reg, mnB, alB);
    __syncthreads(); SWAIT(); SWRITE(0, SE);
    RESC(alB); __syncthreads();
    SBAR(); qkt(pA0, pA1, K_lds, qr, r32, hi);
    finishSM(pB0, pB1, alB, l_reg, pa0, pa1, pa2, pa3); SBAR();
    MASKW(j + 2, mb0, mb1); if (j + 3 < NT) SLOAD(SE, (j + 3) * KVBLK); SBAR();
    pv_d0(o, vb0 + (int)SHM_V, pa0, pa1, pa2, pa3); amask(pA0, pA1, ma0, ma1, dqb - (float)(64 * (j + 1)), nslope, hi); partialSM(pA0, pA1, m_reg, mnA, alA);
    __syncthreads(); SWAIT(); SWRITE(1, SO);
    RESC(alA); __syncthreads();
  }
  SBAR(); qkt(pB0, pB1, (bf16*)((char*)K_lds + SHM_K), qr, r32, hi);
  finishSM(pA0, pA1, alA, l_reg, pa0, pa1, pa2, pa3); SBAR();
  SBAR();
  pv_d0(o, vb0, pa0, pa1, pa2, pa3); amask(pB0, pB1, mb0, mb1, dqb - (float)(64 * (NT - 1)), nslope, hi); partialSM(pB0, pB1, m_reg, mnB, alB);
  __syncthreads(); RESC(alB);
  finishSM(pB0, pB1, alB, l_reg, pa0, pa1, pa2, pa3); SBAR();
  pv_d0(o, vb0 + (int)SHM_V, pa0, pa1, pa2, pa3);
  if (hi == 0) li_l[r32] = l_reg; asm volatile("s_waitcnt lgkmcnt(0)" ::: "memory");
  float rli[16];
#pragma unroll
  for (int r = 0; r < 16; ++r) rli[r] = __builtin_amdgcn_rcpf(li_l[crow(r, hi)]);
  unsigned ob = (unsigned)(4 * hi * ldo + r32); asm volatile("" : "+v"(ob));
#pragma unroll
  for (int r = 0; r < 16; ++r) { const int orow0 = crow(r, 0);
#pragma unroll
    for (int d0 = 0; d0 < 4; ++d0) Ow[ob + (unsigned)(orow0 * ldo + d0 * 32)] = (unsigned char)(__builtin_amdgcn_cvt_pk_fp8_f32(__builtin_amdgcn_fmed3f(o[d0][r] * rli[r] * F8_MSCALE, -448.f, 448.f), 0.f, 0, false) & 0xff); }
  __syncthreads();
#undef SLOAD
#undef SWRITE
#undef SWAIT
#undef RESC
#undef MASKW
}
#undef KSWZ
#undef SBAR
}

__device__ __forceinline__ void ph4a_unit(const Args& a, LAS unsigned char* lds, int tid, int wave, int lane, int b, int ci, int p0, int np) {
    const bf16* IQ = (const bf16*)(a.ws + WS_IQ); const bf16* IK = (const bf16*)(a.ws + WS_IK); const float* IW = (const float*)(a.ws + WS_IW); float* SC = (float*)(a.ws + WS_SC);
    const int tok0 = b * SEQ + ci * CHUNK;
    __syncthreads();
    for (int i = tid; i < 64 * 128; i += NTHR) { const int q = i >> 7, ch = i & 127, head = ch >> 3, c8 = ch & 7;
        const v4u v = *(const v4u*)(IQ + ((size_t)tok0 + q) * 1024 + ch * 8);
        *(LAS v4u*)(lds + q * 2048 + ((head ^ ((q >> 3) & 1)) * 128) + ((c8 ^ (q & 7)) * 16)) = v; }
    __syncthreads();
    const int qt = wave & 1, q = qt * 32 + (lane & 31), hh = lane >> 5; const size_t tokq = (size_t)tok0 + q;
    float wgt[16];
#pragma unroll
    for (int h4 = 0; h4 < 4; ++h4) { const f32x4 w4 = *(const f32x4*)(IW + tokq * 16 + 4 * h4); wgt[4 * h4] = w4[0]; wgt[4 * h4 + 1] = w4[1]; wgt[4 * h4 + 2] = w4[2]; wgt[4 * h4 + 3] = w4[3]; }
    const LAS unsigned char* qb = lds + q * 2048; const int hx = ((q >> 3) & 1) * 128; int offk[4];
#pragma unroll
    for (int kk = 0; kk < 4; ++kk) offk[kk] = ((2 * kk + hh) ^ (q & 7)) * 16;
    int it = wave >> 1;
    bf16x8 ak[2][4];
    if (it < np) { const bf16* kp = IK + ((size_t)b * SEQ + (p0 + it) * 64 + (lane & 31)) * 64 + hh * 8;
#pragma unroll
        for (int kk = 0; kk < 4; ++kk) { ak[0][kk] = *(const bf16x8*)(kp + kk * 16); ak[1][kk] = *(const bf16x8*)(kp + 32 * 64 + kk * 16); } }
    for (; it < np; it += 4) {
        bf16x8 an[2][4]; const bool more = it + 4 < np;
        { const int itn = more ? it + 4 : it; const bf16* kp = IK + ((size_t)b * SEQ + (p0 + itn) * 64 + (lane & 31)) * 64 + hh * 8;
#pragma unroll
          for (int kk = 0; kk < 4; ++kk) { an[0][kk] = *(const bf16x8*)(kp + kk * 16); an[1][kk] = *(const bf16x8*)(kp + 32 * 64 + kk * 16); } }
        float s0[16], s1[16];
#pragma unroll
        for (int i = 0; i < 16; ++i) { s0[i] = 0.f; s1[i] = 0.f; }
        bf16x8 bfc[4]; f32x16 a0, a1;
#pragma unroll
        for (int kk = 0; kk < 4; ++kk) bfc[kk] = *(const LAS bf16x8*)(qb + hx + offk[kk]);
#pragma unroll
        for (int i = 0; i < 16; ++i) { a0[i] = 0.f; a1[i] = 0.f; }
#pragma unroll
        for (int kk = 0; kk < 4; ++kk) { a0 = __builtin_amdgcn_mfma_f32_32x32x16_bf16(ak[0][kk], bfc[kk], a0, 0, 0, 0); a1 = __builtin_amdgcn_mfma_f32_32x32x16_bf16(ak[1][kk], bfc[kk], a1, 0, 0, 0); }
#pragma unroll
        for (int kk = 0; kk < 4; ++kk) bfc[kk] = *(const LAS bf16x8*)(qb + ((1 * 128) ^ hx) + offk[kk]);
#pragma unroll
        for (int h = 0; h < 16; ++h) { f32x16 b0, b1; bf16x8 bfn[4];
            if (h + 1 < 16) {
#pragma unroll
                for (int i = 0; i < 16; ++i) { b0[i] = 0.f; b1[i] = 0.f; }
#pragma unroll
                for (int kk = 0; kk < 4; ++kk) { b0 = __builtin_amdgcn_mfma_f32_32x32x16_bf16(ak[0][kk], bfc[kk], b0, 0, 0, 0); b1 = __builtin_amdgcn_mfma_f32_32x32x16_bf16(ak[1][kk], bfc[kk], b1, 0, 0, 0); }
                if (h + 2 < 16) { const int hb = ((h + 2) * 128) ^ hx;
#pragma unroll
                    for (int kk = 0; kk < 4; ++kk) bfn[kk] = *(const LAS bf16x8*)(qb + hb + offk[kk]); } }
            __builtin_amdgcn_sched_barrier(0);
            const float wh = wgt[h];
#pragma unroll
            for (int i = 0; i < 16; ++i) { s0[i] = fmaf(wh, fmaxf(a0[i], 0.f), s0[i]); asm volatile("" : "+v"(s0[i])); s1[i] = fmaf(wh, fmaxf(a1[i], 0.f), s1[i]); asm volatile("" : "+v"(s1[i])); }
            if (h + 1 < 16) { a0 = b0; a1 = b1; }
            if (h + 2 < 16) {
#pragma unroll
                for (int kk = 0; kk < 4; ++kk) bfc[kk] = bfn[kk]; }
            __builtin_amdgcn_sched_barrier(0); }
        float* op = SC + tokq * 2048 + (p0 + it) * 64 + 4 * hh;
#pragma unroll
        for (int i4 = 0; i4 < 4; ++i4) { *(f32x4*)(op + 8 * i4) = (f32x4){s0[4 * i4], s0[4 * i4 + 1], s0[4 * i4 + 2], s0[4 * i4 + 3]};
            *(f32x4*)(op + 32 + 8 * i4) = (f32x4){s1[4 * i4], s1[4 * i4 + 1], s1[4 * i4 + 2], s1[4 * i4 + 3]}; }
#pragma unroll
        for (int kk = 0; kk < 4; ++kk) { ak[0][kk] = an[0][kk]; ak[1][kk] = an[1][kk]; }
    }
}
__device__ __forceinline__ void ph4a_decode(int u, int& b, int& ci, int& p0, int& np) {
    if (u < 128) { b = u & 7; ci = 16 + (u >> 3); p0 = 0; np = 16; }
    else { const int v = 16 - ((u - 128) >> 4), w = (u - 128) & 15; b = w & 7; if (w >> 3) { ci = 15 + v; p0 = 16; np = v; } else { ci = v - 1; p0 = 0; np = v; } }
}
__device__ __forceinline__ void ph4a_body(const Args& a, LAS unsigned char* lds, int tid, int wave, int lane, int G, int bid) {
    int b, ci, p0, np;
    if (G == 256) { ph4a_decode(bid, b, ci, p0, np); ph4a_unit(a, lds, tid, wave, lane, b, ci, p0, np);
        if (bid >= 128) { ph4a_decode(511 - bid, b, ci, p0, np); ph4a_unit(a, lds, tid, wave, lane, b, ci, p0, np); } }
    else for (int u = bid; u < 384; u += G) { ph4a_decode(u, b, ci, p0, np); ph4a_unit(a, lds, tid, wave, lane, b, ci, p0, np); }
    __syncthreads();
}
template <int NVM> __device__ __forceinline__ int cnt_ge(const unsigned (&key)[32], unsigned cand) {
    unsigned c0 = 0, c1 = 0, c2 = 0, c3 = 0;
#pragma unroll
    for (int i = 0; i < NVM; i += 4) {
        asm("v_cmp_ge_u32 vcc, %1, %2\n\tv_addc_co_u32 %0, vcc, 0, %0, vcc" : "+v"(c0) : "v"(key[i]), "v"(cand) : "vcc");
        asm("v_cmp_ge_u32 vcc, %1, %2\n\tv_addc_co_u32 %0, vcc, 0, %0, vcc" : "+v"(c1) : "v"(key[i + 1]), "v"(cand) : "vcc");
        asm("v_cmp_ge_u32 vcc, %1, %2\n\tv_addc_co_u32 %0, vcc, 0, %0, vcc" : "+v"(c2) : "v"(key[i + 2]), "v"(cand) : "vcc");
        asm("v_cmp_ge_u32 vcc, %1, %2\n\tv_addc_co_u32 %0, vcc, 0, %0, vcc" : "+v"(c3) : "v"(key[i + 3]), "v"(cand) : "vcc"); }
    const unsigned c = (c0 + c1) + (c2 + c3);
    int tot = 0;
#pragma unroll
    for (int b = 0; b < 6; ++b) tot += __builtin_popcountll(__ballot((c >> b) & 1u)) << b;
    return tot;
}
template <int NVM> __device__ __forceinline__ unsigned sel_thr(const unsigned (&key)[32]) {
    unsigned Tt = 0u;
    for (int bit = 31; bit >= 0; --bit) { const unsigned cand = Tt | (1u << bit); const int cnt = cnt_ge<NVM>(key, cand);
        if (cnt >= TOPK) { Tt = cand; if (cnt == TOPK) break; } }
    return Tt;
}
__device__ __forceinline__ void ph4b_body(const Args& a, int wave, int lane, int G, int bid) {
    const float* SC = (const float*)(a.ws + WS_SC); unsigned long long* SEL = (unsigned long long*)(a.ws + WS_SEL);
    const int gw = bid * NWAVES + wave, NGW = G * NWAVES;
    float raw[32]; unsigned key[32];
#define SEL_ROW(idx, row, nv) const int bb_ = (idx) >> 11; int t_ = (idx) & 2047; if (bb_ & 1) t_ = 2047 - t_; const size_t row = (size_t)bb_ * SEQ + t_; const int nv = (t_ >> 6) + 1;
    int idx = gw;
    if (idx < T) { SEL_ROW(idx, row, nv) const float* sp = SC + row * 2048 + lane;
#pragma unroll
        for (int i = 0; i < 32; ++i) raw[i] = sp[64 * (i < nv ? i : nv - 1)]; }
    for (; idx < T; idx += NGW) {
        SEL_ROW(idx, row, nv)
#pragma unroll
        for (int i = 0; i < 32; ++i) { const unsigned uu = __float_as_uint(raw[i]); const unsigned kk = (uu & 0x80000000u) ? ~uu : (uu | 0x80000000u); key[i] = (i < nv) ? kk : 0u; }
        if (idx + NGW < T) { SEL_ROW(idx + NGW, rown, nvn) const float* sp = SC + rown * 2048 + lane;
#pragma unroll
            for (int i = 0; i < 32; ++i) raw[i] = sp[64 * (i < nvn ? i : nvn - 1)]; }
        unsigned Tt = 0u;
        if (nv > 4) { if (nv <= 8) Tt = sel_thr<8>(key); else if (nv <= 16) Tt = sel_thr<16>(key); else if (nv <= 24) Tt = sel_thr<24>(key); else Tt = sel_thr<32>(key); }
        unsigned long long myw = 0ull;
#pragma unroll
        for (int i = 0; i < 32; ++i) { const unsigned long long bm = __ballot(key[i] >= Tt); if (lane == i) myw = bm; }
        if (lane < nv) SEL[row * 32 + lane] = myw;
    }
#undef SEL_ROW
}

__device__ __forceinline__ void ph5_body(const Args& a, char* ldsg, int wave, int lane, int G, int bid) {
    const bf16* Q = (const bf16*)(a.ws + WS_Q); const bf16* K = (const bf16*)(a.ws + WS_K); const bf16* V = (const bf16*)(a.ws + WS_V);
    const unsigned* SELW = (const unsigned*)(a.ws + WS_SEL); unsigned char* YA = (unsigned char*)(a.ws + WS_YA);
    for (int L = bid; L < NB * NCHUNK * NKVH; L += G) {
        const int Lr = L & 255, ci = (L < 256) ? 31 - (Lr >> 4) : (Lr >> 4), b = (Lr >> 1) & 7, g = Lr & 1;
        const int head = g * 4 + (wave >> 1), qpos = ci * 64 + (wave & 1) * 32 + (lane & 31); const size_t tokq = (size_t)b * SEQ + qpos;
        const int NTreal = ci + 1, NT = NTreal + (NTreal & 1);
        const float nslope = -1.4426950408889634f * exp2f(-(float)(head + 1));
        att::attn_unit(Q + tokq * 1024 + head * 128 + (lane >> 5) * 8, K + (size_t)b * SEQ * 256 + g * 128, V + (size_t)b * SEQ * 256 + g * 128,
                       YA + ((size_t)b * SEQ + ci * 64 + (wave & 1) * 32) * 2048 + head * 128, 2048, SELW + ((size_t)b * SEQ + ci * 64) * 64, (unsigned)(((wave & 1) * 32 + (lane & 31)) * 64), qpos, nslope, NT, NTreal, ldsg);
    }
}

__device__ __forceinline__ void ph7_body(const Args& a, int tid, int G, int bid) {
    const float* POW = (const float*)(a.ws + WS_POW); const float* SBUF = (const float*)(a.ws + WS_SBUF); bf16* UA = (bf16*)(a.ws + WS_UA);
    for (int idx = (tid < 128 ? bid * 128 + tid : SSMG * NB * SSMN); idx < SSMG * NB * SSMN; idx += G * 128) {
        const int n = idx & 63, b = (idx >> 6) & 7, g = idx >> 9;
        const float ar = POW[(((size_t)g * 65 + SL) * 64 + n) * 2], ai = POW[(((size_t)g * 65 + SL) * 64 + n) * 2 + 1];
        float hr = 0.f, hi = 0.f;
#pragma unroll 1
        for (int c0 = 0; c0 < NSC; c0 += 64) {
            f32x2 sv[64];
#pragma unroll
            for (int c = 0; c < 64; ++c) sv[c] = *(const f32x2*)(SBUF + ((size_t)g * SROWS + b * NSC + c0 + c) * 128 + 2 * n);
#pragma unroll
            for (int c = 0; c < 64; ++c) { const size_t row = (size_t)g * SROWS + b * NSC + c0 + c;
                *(unsigned*)(UA + row * UA_LD + SL * 16 + 2 * n) = pk2(hr, hi);
                const float nr = ar * hr - ai * hi + sv[c][0], ni = ar * hi + ai * hr + sv[c][1]; hr = nr; hi = ni; }
        }
    }
}

__device__ __forceinline__ void ph12_body(const Args& a, LAS unsigned char* lds, int tid, int wave, int lane, int G, int bid, size_t alt) {
    const bf16* X1 = (const bf16*)(a.ws + WS_X1); const float* WRP = (const float*)(a.ws + WS_WRP); const float* BRP = (const float*)(a.ws + WS_BRP); float* RSTD = (float*)(a.ws + (alt ? WS_SC : WS_RSTD));
    unsigned* CNT = (unsigned*)(a.ws + WS_CTL) + CW_CNT + (alt ? 64 : 0); int* ASGE = (int*)(a.ws + (alt ? WS_SC + MiB : WS_ASGE)); int* ASGP = (int*)(a.ws + (alt ? WS_SC + 2 * MiB : WS_ASGP));
    int* LIST = (int*)(a.ws + (alt ? WS_SC + 4 * MiB : WS_LIST)); float* GLIST = (float*)(a.ws + (alt ? WS_SC + 8 * MiB : WS_GLIST)); unsigned char* XS = (unsigned char*)(a.ws + (alt ? WS_SC + 16 * MiB : WS_XS));
    const float* MOD = (const float*)(a.ws + WS_MOD); const float* g2 = a.in[I_N2G];
    LAS float* xs = (LAS float*)lds;
    LAS float* part = (LAS float*)(lds + 65792); LAS float* logit = (LAS float*)(lds + 65792 + 32768);
    LAS float* rstdL = (LAS float*)(lds + 65792 + 32768 + 4352); LAS unsigned* lcnt = (LAS unsigned*)(rstdL + 32); LAS unsigned* base = lcnt + 32;
    for (int tile = bid; tile < T / 32; tile += G) {
        const int t0 = tile * 32, b = t0 >> 11; const int lrow = tid >> 4, cg = tid & 15;
        f32x16 acc;
#pragma unroll
        for (int i = 0; i < 16; ++i) acc[i] = 0.f;
        float ss = 0.f;
        if (tid < 32) lcnt[tid] = 0u;
        for (int ch = 0; ch < 4; ++ch) {
            f32x4 v[8]; const v2u* xr = (const v2u*)(X1 + (size_t)(t0 + lrow) * DM + ch * 512) + cg;
#pragma unroll
            for (int j = 0; j < 8; ++j) { const v2u w = xr[16 * j]; v[j] = (f32x4){bflo(w.x), bfhi(w.x), bflo(w.y), bfhi(w.y)}; ss += (v[j][0] * v[j][0] + v[j][1] * v[j][1]) + (v[j][2] * v[j][2] + v[j][3] * v[j][3]); }
            float wv[32]; const float* wp = WRP + (size_t)b * (DM * NEXP) + (size_t)(ch * 512 + 64 * wave + (lane >> 5)) * NEXP + (lane & 31);
#pragma unroll
            for (int q = 0; q < 32; ++q) wv[q] = wp[2 * q * NEXP];
            __syncthreads();
#pragma unroll
            for (int j = 0; j < 8; ++j)
#pragma unroll
                for (int e = 0; e < 4; ++e) xs[lrow * 513 + cg * 4 + 64 * j + e] = v[j][e];
            __syncthreads();
            const LAS float* xq = xs + (lane & 31) * 513 + 64 * wave + (lane >> 5);
#pragma unroll
            for (int q = 0; q < 32; ++q) acc = __builtin_amdgcn_mfma_f32_32x32x2f32(xq[2 * q], wv[q], acc, 0, 0, 0);
        }
        ss += __shfl_xor(ss, 1); ss += __shfl_xor(ss, 2); ss += __shfl_xor(ss, 4); ss += __shfl_xor(ss, 8);
        if (cg == 0) { const float rstd = 1.0f / sqrtf(ss * (1.0f / DM) + RMS_EPS); rstdL[lrow] = rstd; RSTD[t0 + lrow] = rstd; }
#pragma unroll
        for (int i = 0; i < 16; ++i) part[(wave * 16 + i) * 64 + lane] = acc[i];
        __syncthreads();
#pragma unroll
        for (int z = 0; z < 2; ++z) { const int o = tid + 512 * z, tk = o >> 5, e = o & 31, hh = (tk >> 2) & 1, i = (tk & 3) + 4 * (tk >> 3), ln = e + 32 * hh; float s = 0.f;
#pragma unroll
            for (int w = 0; w < 8; ++w) s += part[(w * 16 + i) * 64 + ln];
            logit[tk * 33 + e] = rstdL[tk] * s + BRP[b * 32 + e]; }
        __syncthreads();
        LAS float* selv = (LAS float*)(base + 32);
        int rk[4]; float mv[4], gt[4]; unsigned rr[4];
        const int ex = lane & 31;
#pragma unroll
        for (int j = 0; j < 4; ++j) { const int tk = wave * 4 + j; const float v = logit[tk * 33 + ex]; int r = 0;
#pragma unroll
            for (int e2 = 0; e2 < 32; ++e2) { const float u = logit[tk * 33 + e2]; r += ((u > v) || (u == v && e2 < ex)) ? 1 : 0; }
            rk[j] = r; mv[j] = v; if (lane < 32 && r < 4) selv[tk * 4 + r] = v; }
        LDS_WAIT(); asm volatile("" ::: "memory");
#pragma unroll
        for (int j = 0; j < 4; ++j) { const int tk = wave * 4 + j; gt[j] = 0.f; rr[j] = 0u;
            if (lane < 32 && rk[j] < 4) { const float v0 = selv[tk * 4], v1 = selv[tk * 4 + 1], v2 = selv[tk * 4 + 2], v3 = selv[tk * 4 + 3];
                const float den = 1.0f + expf(v1 - v0) + expf(v2 - v0) + expf(v3 - v0); gt[j] = expf(mv[j] - v0) / den;
                rr[j] = __hip_atomic_fetch_add(lcnt + ex, 1u, __ATOMIC_RELAXED, __HIP_MEMORY_SCOPE_WORKGROUP); } }
        __syncthreads();
        if (tid < 32) base[tid] = __hip_atomic_fetch_add(CNT + tid, lcnt[tid], RLX_AGENT);
        __syncthreads();
#pragma unroll
        for (int j = 0; j < 4; ++j) if (lane < 32 && rk[j] < 4) { const int tk = t0 + wave * 4 + j, as = tk * 4 + rk[j], pos = (int)(base[ex] + rr[j]); ASGE[as] = ex; ASGP[as] = pos;
            if (pos < T) { LIST[ex * T + pos] = tk; GLIST[ex * T + pos] = gt[j]; } }
        { const f32x4* gp = (const f32x4*)g2 + 2 * lane; const f32x4* shp = (const f32x4*)(MOD + (size_t)b * MODW + 3 * DM) + 2 * lane; const f32x4* scp = (const f32x4*)(MOD + (size_t)b * MODW + 4 * DM) + 2 * lane;
          v4u xw[4][4]; f32x4 pa[8], pb[8];
#pragma unroll
          for (int j = 0; j < 4; ++j) { const v4u* xr = (const v4u*)(X1 + (size_t)(t0 + wave * 4 + j) * DM) + lane;
#pragma unroll
              for (int q = 0; q < 4; ++q) xw[j][q] = xr[64 * q]; }
#pragma unroll
          for (int q = 0; q < 4; ++q)
#pragma unroll
              for (int h = 0; h < 2; ++h) { pa[2 * q + h] = gp[128 * q + h] * (scp[128 * q + h] + 1.0f) * F8_ASCALE; pb[2 * q + h] = shp[128 * q + h] * F8_ASCALE; }
#pragma unroll
          for (int j = 0; j < 4; ++j) { const int tk = wave * 4 + j; const float rstd = rstdL[tk]; v2u o[4];
#pragma unroll
              for (int q = 0; q < 4; ++q) { const v4u w = xw[j][q]; const f32x4 x0 = {bflo(w.x), bfhi(w.x), bflo(w.y), bfhi(w.y)}, x1 = {bflo(w.z), bfhi(w.z), bflo(w.w), bfhi(w.w)};
                  const f32x4 y0 = (x0 * rstd) * pa[2 * q] + pb[2 * q], y1 = (x1 * rstd) * pa[2 * q + 1] + pb[2 * q + 1];
                  o[q].x = pk4_fp8(y0[0], y0[1], y0[2], y0[3]); o[q].y = pk4_fp8(y1[0], y1[1], y1[2], y1[3]); }
              v2u* dst = (v2u*)(XS + (size_t)(t0 + tk) * DM) + lane;
#pragma unroll
              for (int q = 0; q < 4; ++q) dst[64 * q] = o[q]; } }
        __syncthreads();
    }
}

constexpr int LDS_MOE = RING_BYTES + 1024;
__device__ __forceinline__ void moe_tables(const Args& a, LAS unsigned char* lds, int tid) {
    LAS int* off = (LAS int*)(lds + LDS_MOE); LAS int* cnt = off + 32; LAS int* nrbp = off + 64; LAS int* rbe = off + 96;
    if (tid == 0) { unsigned* CNT = (unsigned*)(a.ws + WS_CTL) + CW_CNT; int o = 0, rb = 0;
        for (int e = 0; e < NEXP; ++e) { const int c = (int)__hip_atomic_load(CNT + e, RLX_AGENT); cnt[e] = c; off[e] = o; const int nb = (c + 255) >> 8;
            for (int q = 0; q < nb; ++q) { if (rb < 320) rbe[rb] = e; ++rb; } o += nb * 256; }
        nrbp[0] = rb < 288 ? rb : 288; }
    __syncthreads();
}
constexpr int LDS_ROWS = RING_BYTES + 3072, ROWS_CAP = (LDS_BYTES - LDS_ROWS) / 512;
template <class Sched> __device__ __forceinline__ void moe_rows(const Args& a, LAS unsigned char* lds, int tid, const Sched& S) {
    const LAS int* off = (const LAS int*)(lds + LDS_MOE); const LAS int* cnt = off + 32; const int* LIST = (const int*)(a.ws + WS_LIST);
    LAS unsigned short* rows = (LAS unsigned short*)(lds + LDS_ROWS);
    pg8::Unit u;
    for (int i = 0; i < ROWS_CAP && S.next(i, u); ++i) { const int e = (u.pn >> 4) & 31, idx = (u.pm - (off[e] >> 8)) * 256 + (tid & 255);
        if (tid < 256) { int tok = (idx >= 0 && idx < cnt[e] && idx < T) ? LIST[e * T + idx] : 0; rows[i * 256 + tid] = (unsigned short)min(max(tok, 0), T - 1); } }
    __syncthreads();
}

typedef float f32x2v __attribute__((ext_vector_type(2)));
__device__ __forceinline__ void ph16_acc8(f32x4& a0, f32x4& a1, v2u w) {
    const f32x2v p0 = __builtin_amdgcn_cvt_pk_f32_fp8((int)w.x, false), p1 = __builtin_amdgcn_cvt_pk_f32_fp8((int)w.x, true), p2 = __builtin_amdgcn_cvt_pk_f32_fp8((int)w.y, false), p3 = __builtin_amdgcn_cvt_pk_f32_fp8((int)w.y, true);
    a0[0] += p0[0]; a0[1] += p0[1]; a0[2] += p1[0]; a0[3] += p1[1]; a1[0] += p2[0]; a1[1] += p2[1]; a1[2] += p3[0]; a1[3] += p3[1];
}
#define PH16_SLOT(k) min(max(off[ASGE[row * 4 + (k)] & 31] + ASGP[row * 4 + (k)], 0), MOE_ROWS - 1)
__device__ __forceinline__ void ph16_row(const LAS int* off, const int* ASGE, const int* ASGP, const unsigned char* YE, const bf16* X1, int row, int lane, f32x4 (&acc)[8], f32x4 (&xv)[8]) {
    const int s0 = PH16_SLOT(0), s1 = PH16_SLOT(1), s2 = PH16_SLOT(2), s3 = PH16_SLOT(3);
    const v2u* y0 = (const v2u*)(YE + (size_t)s0 * DM) + lane; const v2u* y1 = (const v2u*)(YE + (size_t)s1 * DM) + lane; const v2u* y2 = (const v2u*)(YE + (size_t)s2 * DM) + lane; const v2u* y3 = (const v2u*)(YE + (size_t)s3 * DM) + lane;
    const v4u* xi = (const v4u*)(X1 + (size_t)row * DM) + lane;
#pragma unroll
    for (int j = 0; j < 4; ++j) { const v2u w0 = y0[64 * j], w1 = y1[64 * j], w2 = y2[64 * j], w3 = y3[64 * j]; const v4u xw = xi[64 * j];
        acc[2 * j] = (f32x4){0.f, 0.f, 0.f, 0.f}; acc[2 * j + 1] = (f32x4){0.f, 0.f, 0.f, 0.f};
        ph16_acc8(acc[2 * j], acc[2 * j + 1], w0); ph16_acc8(acc[2 * j], acc[2 * j + 1], w1); ph16_acc8(acc[2 * j], acc[2 * j + 1], w2); ph16_acc8(acc[2 * j], acc[2 * j + 1], w3);
        acc[2 * j] = acc[2 * j] * (1.0f / F8_YSCALE); acc[2 * j + 1] = acc[2 * j + 1] * (1.0f / F8_YSCALE);
        xv[2 * j] = (f32x4){bflo(xw.x), bfhi(xw.x), bflo(xw.y), bfhi(xw.y)}; xv[2 * j + 1] = (f32x4){bflo(xw.z), bfhi(xw.z), bflo(xw.w), bfhi(xw.w)}; }
}
__device__ __forceinline__ void ph16_body(const Args& a, LAS unsigned char* lds, int tid, int wave, int lane, int G, int bid, float* OUT) {
    moe_tables(a, lds, tid); const LAS int* off = (const LAS int*)(lds + LDS_MOE);
    const float* MOD = (const float*)(a.ws + WS_MOD); const int* ASGE = (const int*)(a.ws + WS_ASGE); const int* ASGP = (const int*)(a.ws + WS_ASGP); const unsigned char* YE = (const unsigned char*)(a.ws + WS_YE); const bf16* X1 = (const bf16*)(a.ws + WS_X1);
    const int gw = bid * NWAVES + wave, NGW = G * NWAVES;
    for (int row = gw; row < T; row += 2 * NGW) {
        const int rowB = row + NGW; const bool hasB = rowB < T;
        f32x4 aA[8], xA[8], aB[8], xB[8];
        ph16_row(off, ASGE, ASGP, YE, X1, row, lane, aA, xA);
        if (hasB) ph16_row(off, ASGE, ASGP, YE, X1, rowB, lane, aB, xB);
        { const f32x4* gp = (const f32x4*)(MOD + (size_t)(row >> 11) * MODW + 5 * DM) + 2 * lane; f32x4* xo = (f32x4*)(OUT + (size_t)row * DM) + 2 * lane;
#pragma unroll
          for (int j = 0; j < 4; ++j) { xo[128 * j] = xA[2 * j] + gp[128 * j] * aA[2 * j]; xo[128 * j + 1] = xA[2 * j + 1] + gp[128 * j + 1] * aA[2 * j + 1]; } }
        if (hasB) { const f32x4* gp = (const f32x4*)(MOD + (size_t)(rowB >> 11) * MODW + 5 * DM) + 2 * lane; f32x4* xo = (f32x4*)(OUT + (size_t)rowB * DM) + 2 * lane;
#pragma unroll
          for (int j = 0; j < 4; ++j) { xo[128 * j] = xB[2 * j] + gp[128 * j] * aB[2 * j]; xo[128 * j + 1] = xB[2 * j + 1] + gp[128 * j + 1] * aB[2 * j + 1]; } }
    }
}

#ifndef PROBE_REP
#define PROBE_REP 0
#endif
#ifndef MK_ONE_LAUNCH
#define MK_ONE_LAUNCH 1
#endif
constexpr int NPH = 13;
__global__ void __launch_bounds__(NTHR, 2) fwd(Args args) {
    extern __shared__ __attribute__((aligned(16))) unsigned char lds_raw[];
    LAS unsigned char* lds = (LAS unsigned char*)lds_raw;
    const int tid = threadIdx.x, lane = tid & 63, wave = __builtin_amdgcn_readfirstlane(tid >> 6);
    const int G = gridDim.x, bid = blockIdx.x;
    volatile LAS unsigned* MISC = (volatile LAS unsigned*)(lds + MISC_OFF);
    for (int u = tid; u < (LDS_BYTES - LDSCTL_OFF) / 4; u += NTHR) ((LAS unsigned*)(lds + LDSCTL_OFF))[u] = 0u;
    __syncthreads();
    unsigned char* ws = args.ws;
    unsigned* ctl = (unsigned*)(ws + WS_CTL);
    const int lo = args.ph_lo, hi = args.ph_hi;
    XcdBarrier bar; bar.bar = ctl + CW_BAR; bar.x = 0; bar.st = nullptr;
    if (hi - lo > 1) bar = xcd_barrier_post(ctl + CW_BAR, MISC + 8);
#define IN(k) (lo <= (k) && (k) < hi)
#define REPS(k) _Pragma("unroll") for (int rep_ = 0; rep_ < 1 + ((PROBE_REP >> (k)) & 1); ++rep_)
#define SEAM(k) do { if (IN(k) && IN((k) + 1)) xcd_barrier(bar); } while (0)

    if (IN(0)) REPS(0) { ph0_ssm_consts(args, tid, G, (bid + 8) % G);
         ph0_adaln(args, lds, tid, G, bid); }
    SEAM(0);
    if (IN(1)) REPS(1) {
        if (bid & 1) { ph1_small(args, tid, wave, lane, G, bid); bts_body(args, tid, G, bid); ph0_transposes(args, lds, wave, lane, G, bid); ph1_norm(args, wave, lane, G, bid); }
        else { ph1_norm(args, wave, lane, G, bid); ph0_transposes(args, lds, wave, lane, G, bid); ph1_small(args, tid, wave, lane, G, bid); bts_body(args, tid, G, bid); } __syncthreads(); }
    SEAM(1);
    if (IN(2)) REPS(2) {
        const int Gg = (G > 2 * NCONV) ? G - NCONV : G;
        if (bid < Gg) {
            { pg8::Gemm g{(const bf16*)(ws + WS_HN), (const bf16*)(ws + WS_WIN), DM, DM, DM}; pg8::StaticOrder S; S.init(T, 2560, Gg, bid);
              EpiInProjA E{(bf16*)(ws + WS_Q), (bf16*)(ws + WS_K), (bf16*)(ws + WS_IQ), (bf16*)(ws + WS_IK), (float*)(ws + WS_IW)};
              pg8::gemm_phase<EpiInProjA, pg8::StaticOrder, true, true>(lds, g, S, E); }
            { pg8::Gemm g{(const bf16*)(ws + WS_HN8), (const bf16*)(ws + WS_WIN8), DM / 2, DM / 2, DM / 2}; pg8::StaticOrder S; S.init(T, 5376, Gg, bid);
              EpiInProjB E{(bf16*)(ws + WS_V), (bf16*)(ws + WS_UA), (unsigned char*)(ws + WS_GATES)};
              pg8::gemm_phase<EpiInProjB, pg8::StaticOrder, true, true, true>(lds, g, S, E); } }
        cv_queue(args, lds, wave, lane); }
    SEAM(2);
    if (IN(3)) REPS(3) {
        ph4a_body(args, lds, tid, wave, lane, G, bid);
        { pg8::Gemm g{(const bf16*)(ws + WS_UA), (const bf16*)(ws + WS_BTS), UA_LD, SL * 16, SL * 16}; SsmSOrder S{G, (G - 1) - bid}; EpiSsmS E{(float*)(ws + WS_SBUF)};
          pg8::gemm_phase<EpiSsmS, SsmSOrder, true, true>(lds, g, S, E); }
        qknorm_body(args, wave, lane, G, bid); bty_body(args, tid, G, bid); }
    SEAM(3);
    if (IN(4)) REPS(4) { ph4b_body(args, wave, lane, G, bid); ph7_body(args, tid, G, bid); }
    SEAM(4);
    if (IN(5)) REPS(5) {
        ph5_body(args, (char*)lds_raw, wave, lane, G, bid);
        { pg8::Gemm g{(const bf16*)(ws + WS_UA), (const bf16*)(ws + WS_BTY), UA_LD, UA_LD, UA_LD}; SsmYOrder S{G, bid}; EpiSsmY E{(bf16*)(ws + WS_YG)};
          pg8::gemm_phase<EpiSsmY, SsmYOrder, true, true>(lds, g, S, E); } }
    SEAM(5);
    if (IN(6)) REPS(6) {
        pg8::Gemm g{(const bf16*)(ws + WS_YG), (const bf16*)(ws + WS_WGLU), 1024, 1024, 1024}; pg8::StaticOrder S; S.init(T, 1024, G, bid);
        EpiGlu E{(const bf16*)(ws + WS_YG), (unsigned char*)(ws + WS_YA + 1024), args.in[I_BGLU]};
        pg8::gemm_phase<EpiGlu, pg8::StaticOrder, true, true>(lds, g, S, E); }
    SEAM(6);
    if (IN(7)) REPS(7) {
        pg8::StaticOrder S; S.init(T, DM, G, bid);
        pg8::Gemm g{(const bf16*)(ws + WS_YA), (const bf16*)(ws + WS_WA), 1024, 1024, 1024}; EpiProjAB E{(const unsigned char*)(ws + WS_GATES), (unsigned char*)(ws + WS_MG)};
        pg8::gemm_phase<EpiProjAB, pg8::StaticOrder, true, true, true>(lds, g, S, E); }
    SEAM(7);
    if (IN(8)) REPS(8) {
        pg8::Gemm g{(const bf16*)(ws + WS_MG), (const bf16*)(ws + WS_WO), DM / 2, DM / 2, DM / 2}; pg8::StaticOrder S; S.init(T, DM, G, bid);
        EpiOut E{args.in[I_X], (const float*)(ws + WS_MOD), (bf16*)(ws + WS_X1)};
        pg8::gemm_phase<EpiOut, pg8::StaticOrder, true, true, true>(lds, g, S, E); }
    SEAM(8);
    if (IN(9)) REPS(9) ph12_body(args, lds, tid, wave, lane, G, bid, (size_t)rep_);
    SEAM(9);
    if (IN(10)) REPS(10) {
        moe_tables(args, lds, tid);
        const LAS int* mt = (const LAS int*)(lds + LDS_MOE); MoeOrder S{mt + 96, mt[64], 4, G, bid};
        moe_rows(args, lds, tid, S);
        pg8::Gemm g{(const bf16*)(ws + WS_XS), (const bf16*)(ws + WS_WGU), DM / 2, DM / 2, DM / 2, (const LAS unsigned short*)(lds + LDS_ROWS)}; EpiGateUp E{args.in[I_BGU], (unsigned char*)(ws + WS_ACT)};
        pg8::gemm_phase<EpiGateUp, MoeOrder, true, true, true, true>(lds, g, S, E); }
    SEAM(10);
    if (IN(11)) REPS(11) {
        moe_tables(args, lds, tid);
        const LAS int* mt = (const LAS int*)(lds + LDS_MOE); MoeOrder S{mt + 96, mt[64], 3, G, bid};
        pg8::Gemm g{(const bf16*)(ws + WS_ACT), (const bf16*)(ws + WS_WD), DM / 2, DM / 2, DM / 2}; EpiDown E{args.in[I_BD], (const float*)(ws + WS_GLIST), mt, (unsigned char*)(ws + WS_YE)};
        pg8::gemm_phase<EpiDown, MoeOrder, true, true, true>(lds, g, S, E); }
    SEAM(11);
    if (IN(12)) REPS(12) ph16_body(args, lds, tid, wave, lane, G, bid, rep_ ? (float*)(ws + WS_SC) : args.out);
#if defined(PROBE_BAR)
    if (hi - lo > 1) { _Pragma("unroll 1") for (int q = 0; q < PROBE_BAR; ++q) xcd_barrier(bar); }
#endif
#undef IN
#undef SEAM
}

extern "C" void kernel_launch(void* const* d_in, const int* in_sizes, int n_in, void* d_out, int out_size, void* d_ws, size_t ws_size, hipStream_t stream) {
    static int grid = 0;
    if (grid == 0) {
        if (n_in != 28 || out_size != T * DM || ws_size < WS_END) { fprintf(stderr, "kernel_launch: unexpected shapes (n_in %d out %d ws %zu)\n", n_in, out_size, ws_size); grid = -1; return; }
        int dev = 0, cus = 0, per_cu = 0;
        if (hipGetDevice(&dev) != hipSuccess || hipDeviceGetAttribute(&cus, hipDeviceAttributeMultiprocessorCount, dev) != hipSuccess) { grid = -1; return; }
        if (hipFuncSetAttribute((const void*)fwd, hipFuncAttributeMaxDynamicSharedMemorySize, LDS_BYTES) != hipSuccess) { fprintf(stderr, "kernel_launch: hipFuncSetAttribute failed\n"); grid = -1; return; }
        if (hipOccupancyMaxActiveBlocksPerMultiprocessor(&per_cu, (const void*)fwd, NTHR, LDS_BYTES) != hipSuccess || per_cu < 1) { fprintf(stderr, "kernel_launch: occupancy query says %d\n", per_cu); (void)hipGetLastError(); grid = -1; return; }
        if (cus * ROWS_CAP < 288 * 16) { fprintf(stderr, "kernel_launch: too few CUs (%d) for the gather lists\n", cus); grid = -1; return; }
        grid = cus;
    }
    if (grid < 0) return;
    (void)hipMemsetAsync((char*)d_ws + WS_CTL, 0, CTL_ZERO_BYTES, stream);
    Args a{};
    for (int i = 0; i < 28; ++i) a.in[i] = (const float*)d_in[i];
    a.out = (float*)d_out; a.ws = (unsigned char*)d_ws;
#if MK_ONE_LAUNCH
    a.ph_lo = 0; a.ph_hi = NPH;
    hipLaunchKernelGGL(fwd, dim3(grid), dim3(NTHR), LDS_BYTES, stream, a);
#else
    for (int p = 0; p < NPH; ++p) { a.ph_lo = p; a.ph_hi = p + 1; hipLaunchKernelGGL(fwd, dim3(grid), dim3(NTHR), LDS_BYTES, stream, a); }
#endif
}
```

```cpp
#include <hip/hip_runtime.h>
#include <cstdio>
#include <cstdint>

#define GAS __attribute__((address_space(1)))
#define LAS __attribute__((address_space(3)))
typedef unsigned short bf16;
typedef unsigned v4u __attribute__((ext_vector_type(4)));
typedef unsigned v2u __attribute__((ext_vector_type(2)));
typedef float f32x2 __attribute__((ext_vector_type(2)));
typedef float f32x4 __attribute__((ext_vector_type(4)));
typedef float f32x16 __attribute__((ext_vector_type(16)));
typedef short bf16x8 __attribute__((ext_vector_type(8)));
typedef short s16x4 __attribute__((ext_vector_type(4)));
typedef __bf16 bf16x2_t __attribute__((ext_vector_type(2)));

constexpr int DM = 2048, NB = 8, SEQ = 2048, T = NB * SEQ;
constexpr int CHUNK = 64, NCHUNK = SEQ / CHUNK;
constexpr int HD = 128, NQH = 8, NKVH = 2, ATTW = 1024, KVW = 256;
constexpr int IDXH = 16, IDXD = 64, TOPK = 256;
constexpr int SSMW = 1024, SSMG = 64, SSMP = 16, SSMN = 64;
constexpr int NEXP = 32, MOEK = 4, DFF = 2048;
constexpr int INW = 7760, INW_PAD = 7936;
constexpr int MODW = 6 * DM;
constexpr float RMS_EPS = 1e-6f;
constexpr int SL = 32, NSC = SEQ / SL, SROWS = NB * NSC;
constexpr int UA_LD = SL * 16 + 128;
constexpr int MOE_ROWS = T * MOEK + NEXP * 256;
constexpr int NWAVES = 8, NTHR = 512;

constexpr size_t MiB = 1u << 20;
constexpr size_t WS_CTL = 0, CTL_ZERO_BYTES = 1 * MiB;
constexpr size_t WS_MOD = 1 * MiB;
constexpr size_t WS_WRP = 2 * MiB;
constexpr size_t WS_BRP = 4 * MiB;
constexpr size_t WS_BBAR = 5 * MiB;
constexpr size_t WS_POW = 6 * MiB;
constexpr size_t WS_KT = 9 * MiB;
constexpr size_t WS_ASGE = 14 * MiB;
constexpr size_t WS_ASGP = WS_ASGE + 256 * 1024;
constexpr size_t WS_ASGG = WS_ASGP + 256 * 1024;
constexpr size_t WS_SLOT = WS_ASGG + 256 * 1024;
constexpr size_t WS_ROWG = 15 * MiB;
constexpr size_t WS_RSTD = 15 * MiB + 512 * 1024;
constexpr size_t WS_WIN = 16 * MiB;
constexpr size_t WS_WIN8 = 27 * MiB;
constexpr size_t WS_WGLU = 47 * MiB;
constexpr size_t WS_WA = 49 * MiB;
constexpr size_t WS_WB = 53 * MiB;
constexpr size_t WS_WO = 57 * MiB;
constexpr size_t WS_BTS = 65 * MiB;
constexpr size_t WS_BTY = 97 * MiB;
constexpr size_t WS_HN = 241 * MiB;
constexpr size_t WS_X1 = 241 * MiB;
constexpr size_t WS_HN8 = 980 * MiB;
constexpr size_t WS_Q = 305 * MiB;
constexpr size_t WS_K = 337 * MiB;
constexpr size_t WS_V = 345 * MiB;
constexpr size_t WS_IQ = 353 * MiB;
constexpr size_t WS_IK = 385 * MiB;
constexpr size_t WS_IW = 387 * MiB;
constexpr size_t WS_UA = 788 * MiB;
constexpr size_t WS_GATES = 424 * MiB;
constexpr size_t WS_SC = 552 * MiB;
constexpr size_t WS_SEL = 680 * MiB;
constexpr size_t WS_YA = 684 * MiB;
constexpr size_t WS_SBUF = 852 * MiB;
constexpr size_t WS_YG = 724 * MiB;
constexpr size_t WS_YS = 756 * MiB;
constexpr size_t WS_MRG = 788 * MiB;
constexpr size_t WS_MG = 916 * MiB;
constexpr size_t WS_H2 = 980 * MiB;
constexpr size_t WS_XS = 1044 * MiB;
constexpr size_t WS_LIST = WS_XS + 64 * MiB;
constexpr size_t WS_GLIST = WS_XS + 66 * MiB;
constexpr size_t WS_ACT = 1332 * MiB;
constexpr size_t WS_YE = 1620 * MiB;
constexpr size_t WS_WGU = 1908 * MiB;
constexpr size_t WS_WD = 2420 * MiB;
constexpr size_t WS_END = 2676 * MiB;
constexpr int CW_CNT = 1024;
constexpr int CW_CVQ = 2048;
constexpr int NCONV = 112;
constexpr int CW_BAR = 4096;
constexpr int RING_BYTES = 131072;
constexpr int LDSCTL_OFF = RING_BYTES, MISC_OFF = LDSCTL_OFF + 320;
constexpr int LDS_BYTES = 147456;

#define LDS_WAIT() asm volatile("s_waitcnt lgkmcnt(0)" ::: "memory")
#define VM_WAIT() asm volatile("s_waitcnt vmcnt(0)" ::: "memory")
#define RLX_AGENT __ATOMIC_RELAXED, __HIP_MEMORY_SCOPE_AGENT

__device__ __forceinline__ unsigned pk2(float lo, float hi) { f32x2 v = {lo, hi}; bf16x2_t b = __builtin_convertvector(v, bf16x2_t); return __builtin_bit_cast(unsigned, b); }
__device__ __forceinline__ float bf2f(unsigned h) { return __builtin_bit_cast(float, h << 16); }
__device__ __forceinline__ float bflo(unsigned w) { return __builtin_bit_cast(float, w << 16); }
__device__ __forceinline__ float bfhi(unsigned w) { return __builtin_bit_cast(float, w & 0xffff0000u); }
__device__ __forceinline__ float wave_sum(float v) {
#pragma unroll
    for (int o = 1; o < 64; o <<= 1) v += __shfl_xor(v, o);
    return v;
}
constexpr float F8_WSCALE = 256.0f, F8_ASCALE = 4.0f, F8_DESCALE = 1.0f / (256.0f * 4.0f);
constexpr float F8_YSCALE = 8.0f;
constexpr float F8_MSCALE = 16.0f, F8_MDESCALE = 1.0f / (256.0f * 16.0f);
__device__ __forceinline__ unsigned pk4_fp8(float a, float b, float c, float d) { int w = 0; a = __builtin_amdgcn_fmed3f(a, -448.f, 448.f); b = __builtin_amdgcn_fmed3f(b, -448.f, 448.f); c = __builtin_amdgcn_fmed3f(c, -448.f, 448.f); d = __builtin_amdgcn_fmed3f(d, -448.f, 448.f);
    w = __builtin_amdgcn_cvt_pk_fp8_f32(a, b, w, false); w = __builtin_amdgcn_cvt_pk_fp8_f32(c, d, w, true); return (unsigned)w; }
__device__ __forceinline__ unsigned pk4_fp8_nc(float a, float b, float c, float d) { int w = 0; w = __builtin_amdgcn_cvt_pk_fp8_f32(a, b, w, false); w = __builtin_amdgcn_cvt_pk_fp8_f32(c, d, w, true); return (unsigned)w; }
__device__ __forceinline__ float sigmoidf_(float x) { return __builtin_amdgcn_rcpf(1.0f + __builtin_amdgcn_exp2f(x * -1.4426950408889634f)); }
__device__ __forceinline__ float sigmoid1702(float x) { return __builtin_amdgcn_rcpf(1.0f + __builtin_amdgcn_exp2f(x * (-1.702f * 1.4426950408889634f))); }

namespace pg8 {
#define PG8_LAS __attribute__((address_space(3)))
typedef unsigned short bf16_t;
typedef short bf16x8 __attribute__((ext_vector_type(8)));
typedef float f32x4 __attribute__((ext_vector_type(4)));
typedef unsigned u32x4 __attribute__((ext_vector_type(4)));
constexpr int BM = 256, BK = 64, HALF = 128, HTB = HALF * BK * 2, STAGE_BYTES = 8 * HTB, NXCD = 8, WGM = 8;

__host__ __device__ __forceinline__ int lds_byte(int r, int c) { const int st = (r >> 4) * 2 + (c >> 5), rr = r & 15, cc = c & 31, ob = rr * 64 + cc * 2; return st * 1024 + (ob ^ (((ob >> 9) & 1) << 5)); }
__host__ __device__ __forceinline__ void stage_rc(int b, int& R, int& C) { const int st = b / 1024, sb = b % 1024, swz = sb ^ (((sb >> 9) & 1) << 5); R = (st >> 1) * 16 + swz / 64; C = (st & 1) * 32 + (swz % 64) / 2; }
__host__ __device__ __forceinline__ int perm32(int rho) { const int n = rho >> 4, i = rho & 15; return 8 * (i >> 2) + 4 * n + (i & 3); }

struct Unit { int pm, pn; };
struct Gemm { const bf16_t* A; const bf16_t* Bt; int lda, ldb, K; const PG8_LAS unsigned short* rows; };

struct StaticOrder {
    int nM, nN, nwg, G, c;
    __host__ __device__ void init(int M, int N, int G_, int c_) { nM = M / BM; nN = N / BM; nwg = nM * nN; G = G_; c = c_; }
    __host__ __device__ bool next(int i, Unit& u) const {
        const long L = (long)i * G + c; if (L >= nwg) return false;
        int wgid = (int)L; { const int q = nwg / NXCD, r = nwg % NXCD, xcd = wgid % NXCD, off = wgid / NXCD; wgid = (xcd < r ? xcd * (q + 1) : r * (q + 1) + (xcd - r) * q) + off; }
        const int nig = WGM * nN, gid = wgid / nig, fm = gid * WGM, gsz = (nM - fm) < WGM ? (nM - fm) : WGM;
        u.pm = fm + ((wgid % nig) % gsz); u.pn = (wgid % nig) / gsz; return true;
    }
    __device__ __forceinline__ void a_ready(const Unit&) const {}
    __device__ __forceinline__ void done(const Unit&) const {}
};

typedef int i32x4 __attribute__((ext_vector_type(4)));
typedef int i32x8 __attribute__((ext_vector_type(8)));
template <bool F8> struct FragT;
template <> struct FragT<false> { bf16x8 k0, k1; };
template <> struct FragT<true> { i32x8 v; };
template <bool F8> __device__ __forceinline__ FragT<F8> ldfrag(const PG8_LAS unsigned char* p) {
    if constexpr (F8) { const i32x4 lo = *(const PG8_LAS i32x4*)p, hi = *(const PG8_LAS i32x4*)(p + 1024); FragT<true> f; f.v = __builtin_shufflevector(lo, hi, 0, 1, 2, 3, 4, 5, 6, 7); return f; }
    else { FragT<false> f; f.k0 = *(const PG8_LAS bf16x8*)p; f.k1 = *(const PG8_LAS bf16x8*)(p + 1024); return f; }
}
template <bool F8> __device__ __forceinline__ f32x4 mma1(const FragT<F8>& b, const FragT<F8>& a, f32x4 c) {
#if defined(__HIP_DEVICE_COMPILE__)
    if constexpr (F8) { asm volatile("v_mfma_f32_16x16x128_f8f6f4 %0, %1, %2, %0" : "+v"(c) : "v"(b.v), "v"(a.v)); return c; }
#else
    if constexpr (F8) { return c; }
#endif
    else { c = __builtin_amdgcn_mfma_f32_16x16x32_bf16(b.k0, a.k0, c, 0, 0, 0); return __builtin_amdgcn_mfma_f32_16x16x32_bf16(b.k1, a.k1, c, 0, 0, 0); }
}
template <class Epi, class Sched, bool ALIGN_EPI = false, bool SP2 = false, bool F8 = false, bool GATHER = false>
__device__ __forceinline__ void gemm_phase(PG8_LAS unsigned char* lds, const Gemm g, const Sched& S, const Epi& E) {
    const int tid = threadIdx.x, wid = __builtin_amdgcn_readfirstlane(tid >> 6), lane = tid & 63, wr = wid >> 2, wc = wid & 3, fr = lane & 15, fq = lane >> 4;
    const int K = g.K, nt = K / BK;
    unsigned voffA[2], voffB[2];
#pragma unroll
    for (int i = 0; i < 2; ++i) { int R, C; stage_rc(tid * 16 + i * 8192, R, C); const int Rb = Epi::PERM ? ((R & ~31) + perm32(R & 31)) : R;
        voffA[i] = (unsigned)(R * g.lda + C) * 2u; voffB[i] = (unsigned)(Rb * g.ldb + C) * 2u; }
    unsigned gC0[2] = {0u, 0u}, gC1[2] = {0u, 0u}, gN0[2] = {0u, 0u}, gN1[2] = {0u, 0u}; int gR[2] = {0, 0}; unsigned gCb[2] = {0u, 0u};
    if constexpr (GATHER) {
#pragma unroll
        for (int i = 0; i < 2; ++i) { int R, C; stage_rc(tid * 16 + i * 8192, R, C); gR[i] = R; gCb[i] = (unsigned)C * 2u; } }
#define PG8_GROWS(d0, d1, slot) do { _Pragma("unroll") for (int _i = 0; _i < 2; ++_i) { \
        d0[_i] = (unsigned)g.rows[(slot) * 256 + gR[_i]] * (unsigned)(g.lda * 2) + gCb[_i]; d1[_i] = (unsigned)g.rows[(slot) * 256 + 128 + gR[_i]] * (unsigned)(g.lda * 2) + gCb[_i]; } } while (0)
    const size_t kstep = (size_t)(BK * 2);
    const size_t hstepA = (size_t)HALF * g.lda * 2, hstepB = (size_t)HALF * g.ldb * 2;
    const size_t tstepA = 2 * hstepA, tstepB = 2 * hstepB;
    const unsigned ldsw = (unsigned)wid * 1024u;
    const int aoff = lds_byte(wr * 64 + fr, fq * 8), boff = lds_byte(wc * 32 + fr, fq * 8);
#define PG8_SA(b, h) (((b) * 2 + (h)) * HTB)
#define PG8_SB(b, h) ((4 + (b) * 2 + (h)) * HTB)
#define PG8_STAGE(bufoff, gbase, voff) do { _Pragma("unroll") for (int _i = 0; _i < 2; ++_i) \
        __builtin_amdgcn_global_load_lds((const unsigned*)((const char*)(gbase) + (voff)[_i]), (PG8_LAS unsigned*)(lds + (bufoff) + ldsw + _i * 8192), 16, 0, 0); } while (0)
#define PG8_STAGE2(bufoff, gbase, o0, o1) do { \
        __builtin_amdgcn_global_load_lds((const unsigned*)((const char*)(gbase) + (o0)), (PG8_LAS unsigned*)(lds + (bufoff) + ldsw), 16, 0, 0); \
        __builtin_amdgcn_global_load_lds((const unsigned*)((const char*)(gbase) + (o1)), (PG8_LAS unsigned*)(lds + (bufoff) + ldsw + 8192), 16, 0, 0); } while (0)
#define PG8_STAGE_A(bufoff, kb, h, nx) do { if constexpr (GATHER) { \
        if ((h) == 0) PG8_STAGE2(bufoff, kb, ((nx) ? gN0[0] : gC0[0]), ((nx) ? gN0[1] : gC0[1])); else PG8_STAGE2(bufoff, kb, ((nx) ? gN1[0] : gC1[0]), ((nx) ? gN1[1] : gC1[1])); \
        } else { PG8_STAGE(bufoff, (kb) + ((h) ? hstepA : (size_t)0), voffA); } } while (0)
#define PG8_LDA(dst, b, h) do { _Pragma("unroll") for (int m = 0; m < 4; ++m) dst[m] = ldfrag<F8>(lds + PG8_SA(b, h) + aoff + m * 2048); } while (0)
#define PG8_LDB(dst, b, h) do { _Pragma("unroll") for (int n = 0; n < 2; ++n) dst[n] = ldfrag<F8>(lds + PG8_SB(b, h) + boff + n * 2048); } while (0)
#define PG8_MMA(ai, bj, At, Bt) do { __builtin_amdgcn_s_setprio(1); _Pragma("unroll") for (int m = 0; m < 4; ++m) _Pragma("unroll") for (int n = 0; n < 2; ++n) \
        acc[ai][bj][m][n] = mma1<F8>(Bt[n], At[m], acc[ai][bj][m][n]); __builtin_amdgcn_s_setprio(0); } while (0)
#define PG8_WAIT_V(n) asm volatile("s_waitcnt vmcnt(" #n ")" ::: "memory")
#define PG8_WAIT_L(n) asm volatile("s_waitcnt lgkmcnt(" #n ")" ::: "memory")
#define PG8_BAR __builtin_amdgcn_s_barrier()
#define PG8_SCHED __builtin_amdgcn_sched_barrier(0)
    Unit cur, nxt; int ui = 0;
    if (!S.next(0, cur)) return;
    f32x4 acc[2][2][4][2];
#pragma unroll
    for (int a = 0; a < 2; ++a)
#pragma unroll
        for (int b = 0; b < 2; ++b)
#pragma unroll
            for (int m = 0; m < 4; ++m)
#pragma unroll
                for (int n = 0; n < 2; ++n) acc[a][b][m][n] = (f32x4){0.f, 0.f, 0.f, 0.f};
    FragT<F8> At[4], B0[2], B1[2];
    const char* cA = (const char*)g.A + (GATHER ? (size_t)0 : (size_t)cur.pm * tstepA); const char* cB = (const char*)g.Bt + (size_t)cur.pn * tstepB;
    if constexpr (GATHER) { PG8_GROWS(gC0, gC1, 0); }
    S.a_ready(cur);
    if constexpr (SP2) {
        PG8_STAGE(PG8_SB(0, 0), cB, voffB); PG8_STAGE(PG8_SB(0, 1), cB + hstepB, voffB); PG8_STAGE_A(PG8_SA(0, 0), cA, 0, false); PG8_STAGE_A(PG8_SA(0, 1), cA, 1, false);
        if (wr == 1) PG8_BAR;
        PG8_WAIT_V(2); PG8_BAR;
        PG8_STAGE(PG8_SB(1, 0), cB + kstep, voffB); PG8_STAGE_A(PG8_SA(1, 0), cA + kstep, 0, false); PG8_STAGE(PG8_SB(1, 1), cB + hstepB + kstep, voffB);
        PG8_WAIT_V(6); PG8_BAR;
    } else {
        PG8_STAGE(PG8_SB(0, 0), cB, voffB); PG8_STAGE_A(PG8_SA(0, 0), cA, 0, false); PG8_STAGE(PG8_SB(0, 1), cB + hstepB, voffB); PG8_STAGE_A(PG8_SA(0, 1), cA, 1, false);
        if (wr == 1) PG8_BAR;
        PG8_WAIT_V(4); PG8_BAR;
        PG8_STAGE(PG8_SB(1, 0), cB + kstep, voffB); PG8_STAGE_A(PG8_SA(1, 0), cA + kstep, 0, false); PG8_STAGE(PG8_SB(1, 1), cB + hstepB + kstep, voffB);
        PG8_WAIT_V(6); PG8_BAR;
    }
    for (;;) {
        const bool has_next = S.next(ui + 1, nxt);
        const char* nA = (has_next && !GATHER) ? (const char*)g.A + (size_t)nxt.pm * tstepA : cA; const char* nB = has_next ? (const char*)g.Bt + (size_t)nxt.pn * tstepB : cB;
        if constexpr (GATHER) { if (has_next) { PG8_GROWS(gN0, gN1, ui + 1); } else { gN0[0] = gC0[0]; gN0[1] = gC0[1]; gN1[0] = gC1[0]; gN1[1] = gC1[1]; } }
        for (int t = 0; t < nt; t += 2) {
            const bool last = (t == nt - 2);
            const char* a1 = cA + (size_t)(t + 1) * kstep;
            const char* a2 = last ? nA : cA + (size_t)(t + 2) * kstep; const char* b2 = last ? nB : cB + (size_t)(t + 2) * kstep;
            const char* a3 = a2 + kstep; const char* b3 = b2 + kstep;
            if (last && has_next) S.a_ready(nxt);
            if constexpr (Epi::CHAIN) { if (t == Epi::MID_T) {
                if constexpr (F8) asm volatile("s_nop 15\n\ts_nop 15" ::: "memory");
                int fr_ = fr, fq_ = fq; asm volatile("" : "+v"(fr_), "+v"(fq_)); E.mid(acc, cur, wr, wc, fr_, fq_); } }
            if constexpr (SP2) {
            PG8_LDB(B0, 0, 0); PG8_LDB(B1, 0, 1); PG8_SCHED; PG8_LDA(At, 0, 0); PG8_STAGE_A(PG8_SA(1, 1), a1, 1, false);
            PG8_WAIT_V(8); PG8_WAIT_L(0); PG8_BAR; PG8_MMA(0, 0, At, B0); PG8_MMA(0, 1, At, B1); PG8_BAR; PG8_SCHED;
            PG8_LDA(At, 0, 1); PG8_STAGE(PG8_SB(0, 0), b2, voffB); PG8_STAGE(PG8_SB(0, 1), b2 + hstepB, voffB); PG8_STAGE_A(PG8_SA(0, 0), a2, 0, last);
            PG8_WAIT_V(8); PG8_WAIT_L(0); PG8_BAR; PG8_MMA(1, 0, At, B0); PG8_MMA(1, 1, At, B1); PG8_BAR; PG8_SCHED;
            PG8_LDB(B0, 1, 0); PG8_LDB(B1, 1, 1); PG8_SCHED; PG8_LDA(At, 1, 0); PG8_STAGE_A(PG8_SA(0, 1), a2, 1, last);
            PG8_WAIT_V(8); PG8_WAIT_L(0); PG8_BAR; PG8_MMA(0, 0, At, B0); PG8_MMA(0, 1, At, B1); PG8_BAR; PG8_SCHED;
            PG8_LDA(At, 1, 1); PG8_STAGE(PG8_SB(1, 0), b3, voffB); PG8_STAGE(PG8_SB(1, 1), b3 + hstepB, voffB); PG8_STAGE_A(PG8_SA(1, 0), a3, 0, last);
            PG8_WAIT_V(8); PG8_WAIT_L(0); PG8_BAR; PG8_MMA(1, 0, At, B0); PG8_MMA(1, 1, At, B1); PG8_BAR; PG8_SCHED;
            } else {
            PG8_LDB(B0, 0, 0); PG8_SCHED; PG8_LDA(At, 0, 0); PG8_STAGE_A(PG8_SA(1, 1), a1, 1, false);
            PG8_WAIT_L(8); PG8_BAR; PG8_WAIT_L(0); PG8_MMA(0, 0, At, B0); PG8_BAR; PG8_SCHED;
            PG8_LDB(B1, 0, 1); PG8_STAGE(PG8_SB(0, 0), b2, voffB);
            PG8_BAR; PG8_WAIT_L(0); PG8_MMA(0, 1, At, B1); PG8_BAR;
            PG8_LDA(At, 0, 1); PG8_STAGE_A(PG8_SA(0, 0), a2, 0, last);
            PG8_BAR; PG8_WAIT_L(0); PG8_MMA(1, 0, At, B0); PG8_BAR; PG8_SCHED;
            PG8_STAGE(PG8_SB(0, 1), b2 + hstepB, voffB);
            PG8_WAIT_V(6); PG8_BAR; PG8_MMA(1, 1, At, B1); PG8_BAR;
            PG8_LDB(B0, 1, 0); PG8_SCHED; PG8_LDA(At, 1, 0); PG8_STAGE_A(PG8_SA(0, 1), a2, 1, last);
            PG8_WAIT_L(8); PG8_BAR; PG8_WAIT_L(0); PG8_MMA(0, 0, At, B0); PG8_BAR; PG8_SCHED;
            PG8_LDB(B1, 1, 1); PG8_STAGE(PG8_SB(1, 0), b3, voffB);
            PG8_BAR; PG8_WAIT_L(0); PG8_MMA(0, 1, At, B1); PG8_BAR;
            PG8_LDA(At, 1, 1); PG8_STAGE_A(PG8_SA(1, 0), a3, 0, last);
            PG8_BAR; PG8_WAIT_L(0); PG8_MMA(1, 0, At, B0); PG8_BAR; PG8_SCHED;
            PG8_STAGE(PG8_SB(1, 1), b3 + hstepB, voffB);
            PG8_WAIT_V(6); PG8_BAR; PG8_MMA(1, 1, At, B1); PG8_BAR;
            }
        }
        if constexpr (ALIGN_EPI) { if (wr == 0) PG8_BAR; }
        if constexpr (F8) asm volatile("s_nop 15\n\ts_nop 15" ::: "memory");
        { int fr_ = fr, fq_ = fq; asm volatile("" : "+v"(fr_), "+v"(fq_));
          E(acc, cur, wr, wc, fr_, fq_); } S.done(cur);
        if (!has_next) break;
#pragma unroll
        for (int a = 0; a < 2; ++a)
#pragma unroll
            for (int b = 0; b < 2; ++b)
#pragma unroll
                for (int m = 0; m < 4; ++m)
#pragma unroll
                    for (int n = 0; n < 2; ++n) acc[a][b][m][n] = (f32x4){0.f, 0.f, 0.f, 0.f};
        cur = nxt; cA = nA; cB = nB; ++ui;
        if constexpr (GATHER) { gC0[0] = gN0[0]; gC0[1] = gN0[1]; gC1[0] = gN1[0]; gC1[1] = gN1[1]; }
        if constexpr (ALIGN_EPI) { if (wr == 1) PG8_BAR; }
    }
    PG8_WAIT_V(0);
    if constexpr (!ALIGN_EPI) { if (wr == 0) PG8_BAR; }
    PG8_BAR;
#undef PG8_SA
#undef PG8_SB
#undef PG8_STAGE
#undef PG8_STAGE2
#undef PG8_STAGE_A
#undef PG8_GROWS
#undef PG8_LDA
#undef PG8_LDB
#undef PG8_MMA
#undef PG8_WAIT_V
#undef PG8_WAIT_L
#undef PG8_BAR
#undef PG8_SCHED
}
}

#define XB_TMO      128
#define XB_XCNT(j)  (256  + 64 * (j))
#define XB_XSUB(j)  (1280 + 64 * (j))
#define XB_XGEN(j)  (2304 + 64 * (j))
#define XB_TOP      3328
#define XB_TOPGEN   3392
#define XCD_BAR_WORDS 3456
#define XB_SPIN_CAP (1u << 18)

__device__ __forceinline__ unsigned xb_ld(unsigned* p)              { return __hip_atomic_load(p, __ATOMIC_RELAXED, __HIP_MEMORY_SCOPE_AGENT); }
__device__ __forceinline__ unsigned xb_add(unsigned* p, unsigned v) { return __hip_atomic_fetch_add(p, v, __ATOMIC_RELAXED, __HIP_MEMORY_SCOPE_AGENT); }
__device__ __forceinline__ unsigned xb_xcc_id() { return (unsigned)__builtin_amdgcn_s_getreg((3 << 11) | 20) & 0xFu; }
#define XB_SPIN(cond, bar) do { unsigned _sp = 0; while (cond) { __builtin_amdgcn_s_sleep(1); \
    if ((++_sp & 255u) == 0u) { if (xb_ld(&(bar)[XB_TMO])) break; if (_sp > XB_SPIN_CAP) { atomicAdd(&(bar)[XB_TMO], 1u); break; } } } } while (0)

struct XcdBarrier { unsigned* bar; unsigned x; volatile LAS unsigned* st; };

__device__ __forceinline__ XcdBarrier xcd_barrier_post(unsigned* bar, volatile LAS unsigned* st) {
    XcdBarrier b; b.bar = bar; b.x = xb_xcc_id(); b.st = st;
    if (threadIdx.x == 0) (void)xb_add(&bar[XB_XCNT(b.x)], 1u);
    return b;
}
__device__ __forceinline__ void xcd_barrier_complete(unsigned* bar, unsigned x, unsigned& nloc, unsigned& nx) {
    const unsigned G = gridDim.x * gridDim.y * gridDim.z;
    unsigned sum, cnt, mine, sp = 0u;
    for (;;) {
        sum = 0u; cnt = 0u; mine = 0u;
#pragma unroll
        for (unsigned j = 0; j < 16; ++j) { const unsigned c = xb_ld(&bar[XB_XCNT(j)]); sum += c; cnt += (c > 0u) ? 1u : 0u; mine = (j == x) ? c : mine; }
        if (sum == G) break;
        __builtin_amdgcn_s_sleep(1);
        if ((++sp & 255u) == 0u) { if (xb_ld(&bar[XB_TMO])) break; if (sp > XB_SPIN_CAP) { atomicAdd(&bar[XB_TMO], 1u); break; } }
    }
    nloc = mine > 0u ? mine : 1u; nx = cnt > 0u ? cnt : 1u;
}
__device__ __forceinline__ void xcd_barrier(const XcdBarrier& b) {
    asm volatile("s_waitcnt vmcnt(0)" ::: "memory");
    __syncthreads();
    if (threadIdx.x == 0) {
        unsigned* bar = b.bar;
        __builtin_amdgcn_s_waitcnt(0);
        unsigned nloc = b.st[0], nx = b.st[1];
        if (nloc == 0u) { xcd_barrier_complete(bar, b.x, nloc, nx); b.st[0] = nloc; b.st[1] = nx; }
        const unsigned old = xb_add(&bar[XB_XSUB(b.x)], 1u);
        const unsigned gen = old / nloc;
        if (old + 1u == (gen + 1u) * nloc) {
            __builtin_amdgcn_fence(__ATOMIC_RELEASE, "agent");
            asm volatile("s_waitcnt vmcnt(0)" ::: "memory");
            const unsigned og = xb_add(&bar[XB_TOP], 1u);
            const unsigned tg = og / nx;
            if (og + 1u == (tg + 1u) * nx) xb_add(&bar[XB_TOPGEN], 1u);
            else XB_SPIN(xb_ld(&bar[XB_TOPGEN]) == tg, bar);
            __builtin_amdgcn_fence(__ATOMIC_ACQUIRE, "agent");
            xb_add(&bar[XB_XGEN(b.x)], 1u);
            asm volatile("s_waitcnt vmcnt(0)" ::: "memory");
        } else {
            XB_SPIN(xb_ld(&bar[XB_XGEN(b.x)]) == gen, bar);
            __builtin_amdgcn_fence(__ATOMIC_ACQUIRE, "agent");
            asm volatile("s_waitcnt vmcnt(0)" ::: "memory");
        }
    }
    __syncthreads();
}

using pg8::Unit;
__device__ __forceinline__ v4u pack8(const f32x4& a, const f32x4& b) { v4u w; w.x = pk2(a[0], a[1]); w.y = pk2(a[2], a[3]); w.z = pk2(b[0], b[1]); w.w = pk2(b[2], b[3]); return w; }
__device__ __forceinline__ float gelu_tanh(float y) { const float u2 = 1.5957691216f * (y + 0.044715f * y * y * y); return y * __builtin_amdgcn_rcpf(1.0f + __builtin_amdgcn_exp2f(u2 * -1.4426950408889634f)); }

struct EpiInProjA {
    static constexpr bool PERM = true, CHAIN = false;
    bf16 *Q, *K, *IQ, *IK; float* IW;
    __device__ __forceinline__ void operator()(const f32x4 (&acc)[2][2][4][2], const Unit& u, int wr, int wc, int fr, int fq) const {
        const int pn = u.pn, row0 = u.pm * 256 + wr * 64 + fr, cl0 = wc * 32 + 8 * fq;
        if (pn < 9) {
            bf16* dst; int ld, coff; float sc = 1.f;
            if (pn < 4) { dst = Q; ld = 1024; coff = pn * 256; } else if (pn == 4) { dst = K; ld = 256; coff = 0; } else { dst = IQ; ld = 1024; coff = (pn - 5) * 256; sc = 0.125f; }
#pragma unroll
            for (int ai = 0; ai < 2; ++ai)
#pragma unroll
                for (int m = 0; m < 4; ++m) { bf16* rowp = dst + (size_t)(row0 + ai * 128 + m * 16) * ld + coff + cl0;
#pragma unroll
                    for (int bj = 0; bj < 2; ++bj) *(v4u*)(rowp + bj * 128) = pack8(acc[ai][bj][m][0] * sc, acc[ai][bj][m][1] * sc); }
        } else {
#pragma unroll
            for (int ai = 0; ai < 2; ++ai)
#pragma unroll
                for (int m = 0; m < 4; ++m) { const int row = row0 + ai * 128 + m * 16;
                    if (cl0 < 64) *(v4u*)(IK + (size_t)row * 64 + cl0) = pack8(acc[ai][0][m][0], acc[ai][0][m][1]);
                    else if (cl0 < 80) { float* p = IW + (size_t)row * 16 + (cl0 - 64); *(f32x4*)p = acc[ai][0][m][0] * 0.25f; *(f32x4*)(p + 4) = acc[ai][0][m][1] * 0.25f; } }
        }
    }
};
struct EpiInProjB {
    static constexpr bool PERM = true, CHAIN = false;
    bf16 *V, *UA; unsigned char* GATES;
    __device__ __forceinline__ void operator()(const f32x4 (&acc)[2][2][4][2], const Unit& u, int wr, int wc, int fr, int fq) const {
        const int pn = u.pn, row0 = u.pm * 256 + wr * 64 + fr, cl0 = wc * 32 + 8 * fq;
        if (pn >= 5) {
            const int coff = (pn - 5) * 256 + cl0;
#pragma unroll
            for (int ai = 0; ai < 2; ++ai)
#pragma unroll
                for (int m = 0; m < 4; ++m) { unsigned char* rowp = GATES + (size_t)(row0 + ai * 128 + m * 16) * 4096 + coff;
#pragma unroll
                    for (int bj = 0; bj < 2; ++bj) { const f32x4 v0 = acc[ai][bj][m][0] * F8_DESCALE, v1 = acc[ai][bj][m][1] * F8_DESCALE; unsigned c[8];
#pragma unroll
                        for (int e = 0; e < 4; ++e) { c[e] = (unsigned)fminf(fmaxf(sigmoidf_(v0[e]) * 255.0f + 0.5f, 1.0f), 255.0f); c[4 + e] = (unsigned)fminf(fmaxf(sigmoidf_(v1[e]) * 255.0f + 0.5f, 1.0f), 255.0f); }
                        v2u w; w.x = c[0] | (c[1] << 8) | (c[2] << 16) | (c[3] << 24); w.y = c[4] | (c[5] << 8) | (c[6] << 16) | (c[7] << 24);
                        *(v2u*)(rowp + bj * 128) = w; } }
        } else if (pn == 0) {
#pragma unroll
            for (int ai = 0; ai < 2; ++ai)
#pragma unroll
                for (int m = 0; m < 4; ++m) { bf16* rowp = V + (size_t)(row0 + ai * 128 + m * 16) * 256 + cl0;
#pragma unroll
                    for (int bj = 0; bj < 2; ++bj) *(v4u*)(rowp + bj * 128) = pack8(acc[ai][bj][m][0] * F8_DESCALE, acc[ai][bj][m][1] * F8_DESCALE); }
        } else {
#pragma unroll
            for (int ai = 0; ai < 2; ++ai)
#pragma unroll
                for (int m = 0; m < 4; ++m) { const int row = row0 + ai * 128 + m * 16, b = row >> 11, t = row & 2047, c = t >> 5, i = t & 31;
#pragma unroll
                    for (int bj = 0; bj < 2; ++bj) { const int ch0 = (pn - 1) * 256 + bj * 128 + cl0, g = ch0 >> 4, p0 = ch0 & 15;
                        *(v4u*)(UA + ((size_t)(g * SROWS + b * NSC + c)) * UA_LD + i * 16 + p0) = pack8(acc[ai][bj][m][0] * F8_DESCALE, acc[ai][bj][m][1] * F8_DESCALE); } }
        }
    }
};

struct EpiSsmS {
    static constexpr bool PERM = false, CHAIN = false;
    float* SBUF;
    __device__ __forceinline__ void operator()(const f32x4 (&acc)[2][2][4][2], const Unit& u, int wr, int wc, int fr, int fq) const {
#pragma unroll
        for (int ai = 0; ai < 2; ++ai)
#pragma unroll
            for (int m = 0; m < 4; ++m) { const int rl = ai * 128 + wr * 64 + m * 16 + fr;
#pragma unroll
                for (int n = 0; n < 2; ++n) *(f32x4*)(SBUF + ((size_t)(u.pm * 256 + rl)) * 128 + wc * 32 + 16 * n + 4 * fq) = acc[ai][0][m][n]; }
    }
};

struct EpiSsmY {
    static constexpr bool PERM = true, CHAIN = false;
    bf16* YG;
    __device__ __forceinline__ void operator()(const f32x4 (&acc)[2][2][4][2], const Unit& u, int wr, int wc, int fr, int fq) const {
        const int g = u.pm >> 1, rt = u.pm & 1, ct = u.pn & 1;
#pragma unroll
        for (int ai = 0; ai < 2; ++ai)
#pragma unroll
            for (int m = 0; m < 4; ++m) { const int r = rt * 256 + ai * 128 + wr * 64 + m * 16 + fr, b = r >> 6, c = r & 63;
#pragma unroll
                for (int bj = 0; bj < 2; ++bj) { const int cl = bj * 128 + wc * 32 + 8 * fq, j = 16 * ct + (cl >> 4), p0 = cl & 15; const int t = b * 2048 + SL * c + j;
                    f32x4 v0 = acc[ai][bj][m][0], v1 = acc[ai][bj][m][1];
#pragma unroll
                    for (int e = 0; e < 4; ++e) { v0[e] = gelu_tanh(v0[e]); v1[e] = gelu_tanh(v1[e]); }
                    *(v4u*)(YG + (size_t)t * 1024 + 16 * g + p0) = pack8(v0, v1); } }
    }
};

struct EpiGlu {
    static constexpr bool PERM = true, CHAIN = false;
    const bf16* YG; unsigned char* YS; const float* bias;
    __device__ __forceinline__ void operator()(const f32x4 (&acc)[2][2][4][2], const Unit& u, int wr, int wc, int fr, int fq) const {
        const int row0 = u.pm * 256 + wr * 64 + fr, col0 = u.pn * 256 + wc * 32 + 8 * fq;
        f32x4 bv[2][2];
#pragma unroll
        for (int bj = 0; bj < 2; ++bj) { bv[bj][0] = *(const f32x4*)(bias + col0 + bj * 128); bv[bj][1] = *(const f32x4*)(bias + col0 + bj * 128 + 4); }
#pragma unroll
        for (int ai = 0; ai < 2; ++ai) { v4u ygv[4][2];
#pragma unroll
            for (int m = 0; m < 4; ++m)
#pragma unroll
                for (int bj = 0; bj < 2; ++bj) ygv[m][bj] = *(const v4u*)(YG + (size_t)(row0 + ai * 128 + m * 16) * 1024 + col0 + bj * 128);
#pragma unroll
            for (int m = 0; m < 4; ++m) { const size_t ro = (size_t)(row0 + ai * 128 + m * 16) * 1024;
#pragma unroll
                for (int bj = 0; bj < 2; ++bj) { const int col = col0 + bj * 128; const v4u yg = ygv[m][bj]; f32x4 z0 = acc[ai][bj][m][0] + bv[bj][0], z1 = acc[ai][bj][m][1] + bv[bj][1];
                    z0[0] = bflo(yg.x) * sigmoidf_(z0[0]); z0[1] = bfhi(yg.x) * sigmoidf_(z0[1]); z0[2] = bflo(yg.y) * sigmoidf_(z0[2]); z0[3] = bfhi(yg.y) * sigmoidf_(z0[3]);
                    z1[0] = bflo(yg.z) * sigmoidf_(z1[0]); z1[1] = bfhi(yg.z) * sigmoidf_(z1[1]); z1[2] = bflo(yg.w) * sigmoidf_(z1[2]); z1[3] = bfhi(yg.w) * sigmoidf_(z1[3]);
                    z0 = z0 * F8_MSCALE; z1 = z1 * F8_MSCALE; v2u w8; w8.x = pk4_fp8(z0[0], z0[1], z0[2], z0[3]); w8.y = pk4_fp8(z1[0], z1[1], z1[2], z1[3]); *(v2u*)(YS + 2 * ro + col) = w8; } } }
    }
};

struct EpiProjAB {
    static constexpr bool PERM = true, CHAIN = true; static constexpr int MID_T = 8;
    const unsigned char* GATES; unsigned char* MG;
    __device__ __forceinline__ void mid(f32x4 (&acc)[2][2][4][2], const Unit& u, int wr, int wc, int fr, int fq) const {
        int row0 = u.pm * 256 + wr * 64 + fr, col0 = u.pn * 256 + wc * 32 + 8 * fq; asm volatile("" : "+v"(row0), "+v"(col0));
#pragma unroll
        for (int ai = 0; ai < 2; ++ai)
#pragma unroll
            for (int m = 0; m < 4; ++m) { const size_t row = (size_t)(row0 + ai * 128 + m * 16);
#pragma unroll
                for (int bj = 0; bj < 2; ++bj) { const int col = col0 + bj * 128; const v2u ga = *(const v2u*)(GATES + row * 4096 + col), gs = *(const v2u*)(GATES + row * 4096 + 2048 + col);
                    f32x4& a0 = acc[ai][bj][m][0]; f32x4& a1 = acc[ai][bj][m][1];
#pragma unroll
                    for (int e = 0; e < 4; ++e) { a0[e] *= (float)((ga.x >> (8 * e)) & 0xffu) * __builtin_amdgcn_rcpf((float)((gs.x >> (8 * e)) & 0xffu));
                                                  a1[e] *= (float)((ga.y >> (8 * e)) & 0xffu) * __builtin_amdgcn_rcpf((float)((gs.y >> (8 * e)) & 0xffu)); } } }
    }
    __device__ __forceinline__ void operator()(const f32x4 (&acc)[2][2][4][2], const Unit& u, int wr, int wc, int fr, int fq) const {
        int row0 = u.pm * 256 + wr * 64 + fr, col0 = u.pn * 256 + wc * 32 + 8 * fq; asm volatile("" : "+v"(row0), "+v"(col0));
        constexpr float SC = F8_MDESCALE * F8_MSCALE * (1.0f / 255.0f);
        v2u gsv[2][4][2];
#pragma unroll
        for (int ai = 0; ai < 2; ++ai)
#pragma unroll
            for (int m = 0; m < 4; ++m)
#pragma unroll
                for (int bj = 0; bj < 2; ++bj) gsv[ai][m][bj] = *(const v2u*)(GATES + (size_t)(row0 + ai * 128 + m * 16) * 4096 + 2048 + col0 + bj * 128);
#pragma unroll
        for (int ai = 0; ai < 2; ++ai)
#pragma unroll
            for (int m = 0; m < 4; ++m) { const size_t row = (size_t)(row0 + ai * 128 + m * 16);
#pragma unroll
                for (int bj = 0; bj < 2; ++bj) { const int col = col0 + bj * 128; const v2u gs = gsv[ai][m][bj]; const f32x4 a0 = acc[ai][bj][m][0] * SC, a1 = acc[ai][bj][m][1] * SC;
                    v2u w8; w8.x = pk4_fp8(a0[0] * (float)(gs.x & 0xffu), a0[1] * (float)((gs.x >> 8) & 0xffu), a0[2] * (float)((gs.x >> 16) & 0xffu), a0[3] * (float)(gs.x >> 24));
                    w8.y = pk4_fp8(a1[0] * (float)(gs.y & 0xffu), a1[1] * (float)((gs.y >> 8) & 0xffu), a1[2] * (float)((gs.y >> 16) & 0xffu), a1[3] * (float)(gs.y >> 24));
                    *(v2u*)(MG + row * 2048 + col) = w8; } }
    }
};

struct EpiOut {
    static constexpr bool PERM = true, CHAIN = false;
    const float* X; const float* MOD; bf16* X1;
    __device__ __forceinline__ void operator()(const f32x4 (&acc)[2][2][4][2], const Unit& u, int wr, int wc, int fr, int fq) const {
        const int row0 = u.pm * 256 + wr * 64 + fr, col0 = u.pn * 256 + wc * 32 + 8 * fq;
        const float* gt1 = MOD + (size_t)(u.pm >> 3) * MODW + 2 * DM;
        f32x4 gv[2][2];
#pragma unroll
        for (int bj = 0; bj < 2; ++bj) { gv[bj][0] = *(const f32x4*)(gt1 + col0 + bj * 128); gv[bj][1] = *(const f32x4*)(gt1 + col0 + bj * 128 + 4); }
#pragma unroll
        for (int ai = 0; ai < 2; ++ai) { f32x4 xv[4][2][2];
#pragma unroll
            for (int m = 0; m < 4; ++m)
#pragma unroll
                for (int bj = 0; bj < 2; ++bj) { const float* xp = X + (size_t)(row0 + ai * 128 + m * 16) * 2048 + col0 + bj * 128; xv[m][bj][0] = *(const f32x4*)xp; xv[m][bj][1] = *(const f32x4*)(xp + 4); }
#pragma unroll
            for (int m = 0; m < 4; ++m) { const size_t ro = (size_t)(row0 + ai * 128 + m * 16) * 2048;
#pragma unroll
                for (int bj = 0; bj < 2; ++bj) { const int col = col0 + bj * 128;
                    const f32x4 o0 = xv[m][bj][0] + gv[bj][0] * (acc[ai][bj][m][0] * F8_MDESCALE), o1 = xv[m][bj][1] + gv[bj][1] * (acc[ai][bj][m][1] * F8_MDESCALE);
                    *(v4u*)(X1 + ro + col) = pack8(o0, o1); } } }
    }
};

struct EpiGateUp {
    static constexpr bool PERM = true, CHAIN = false;
    const float* bgu; unsigned char* ACT;
    __device__ __forceinline__ void operator()(const f32x4 (&acc)[2][2][4][2], const Unit& u, int wr, int wc, int fr, int fq) const {
        const int e = u.pn >> 4, ct = u.pn & 15, row0 = u.pm * 256 + wr * 64 + fr, col = ct * 128 + wc * 32 + 8 * fq;
        const float* bg = bgu + (size_t)e * 4096 + col; const f32x4 g0 = *(const f32x4*)bg, g1 = *(const f32x4*)(bg + 4);
        const f32x4 u0 = (*(const f32x4*)(bg + 2048) + 1.0f) * F8_ASCALE, u1 = (*(const f32x4*)(bg + 2052) + 1.0f) * F8_ASCALE;
        constexpr float D4 = F8_DESCALE * F8_ASCALE;
#pragma unroll
        for (int ai = 0; ai < 2; ++ai)
#pragma unroll
            for (int m = 0; m < 4; ++m) { f32x4 ga = acc[ai][0][m][0] * F8_DESCALE + g0, gb = acc[ai][0][m][1] * F8_DESCALE + g1, ua = acc[ai][1][m][0] * D4 + u0, ub = acc[ai][1][m][1] * D4 + u1;
#pragma unroll
                for (int q = 0; q < 4; ++q) { float gg = fminf(ga[q], 7.0f), uu = __builtin_amdgcn_fmed3f(ua[q], -6.0f * F8_ASCALE, 8.0f * F8_ASCALE); ga[q] = uu * (gg * sigmoid1702(gg));
                    gg = fminf(gb[q], 7.0f); uu = __builtin_amdgcn_fmed3f(ub[q], -6.0f * F8_ASCALE, 8.0f * F8_ASCALE); gb[q] = uu * (gg * sigmoid1702(gg)); }
                v2u w; w.x = pk4_fp8_nc(ga[0], ga[1], ga[2], ga[3]); w.y = pk4_fp8_nc(gb[0], gb[1], gb[2], gb[3]);
                *(v2u*)(ACT + (size_t)(row0 + ai * 128 + m * 16) * 2048 + col) = w; }
    }
};

struct EpiDown {
    static constexpr bool PERM = true, CHAIN = false;
    const float* bd; const float* GLIST; const LAS int* mt; unsigned char* YE;
    __device__ __forceinline__ void operator()(const f32x4 (&acc)[2][2][4][2], const Unit& u, int wr, int wc, int fr, int fq) const {
        const int e = (u.pn >> 3) & 31, ct = u.pn & 7, row0 = u.pm * 256 + wr * 64 + fr, col0 = ct * 256 + wc * 32 + 8 * fq, ne = mt[32 + e], i0 = row0 - mt[e];
        f32x4 bv[2][2]; float grv[2][4];
#pragma unroll
        for (int bj = 0; bj < 2; ++bj) { const float* bp = bd + (size_t)e * 2048 + col0 + bj * 128; bv[bj][0] = *(const f32x4*)bp; bv[bj][1] = *(const f32x4*)(bp + 4); }
#pragma unroll
        for (int ai = 0; ai < 2; ++ai)
#pragma unroll
            for (int m = 0; m < 4; ++m) { const int idx = i0 + ai * 128 + m * 16; const bool ok = idx >= 0 && idx < ne && idx < T; const float gl = GLIST[(size_t)e * T + (ok ? idx : 0)]; grv[ai][m] = ok ? gl * F8_YSCALE : 0.f; }
#pragma unroll
        for (int ai = 0; ai < 2; ++ai)
#pragma unroll
            for (int m = 0; m < 4; ++m) { const size_t row = (size_t)(row0 + ai * 128 + m * 16); const float gr = grv[ai][m];
#pragma unroll
                for (int bj = 0; bj < 2; ++bj) { const int col = col0 + bj * 128;
                    const f32x4 y0 = (acc[ai][bj][m][0] * F8_DESCALE + bv[bj][0]) * gr, y1 = (acc[ai][bj][m][1] * F8_DESCALE + bv[bj][1]) * gr;
                    v2u w8; w8.x = pk4_fp8(y0[0], y0[1], y0[2], y0[3]); w8.y = pk4_fp8(y1[0], y1[1], y1[2], y1[3]); *(v2u*)(YE + row * 2048 + col) = w8; } }
    }
};

struct SsmSOrder {
    int G, c;
    __device__ __forceinline__ bool next(int i, Unit& u) const { const int L = i * G + c; if (L >= 2 * SSMG) return false; u.pm = L; u.pn = L >> 1; return true; }
    __device__ __forceinline__ void a_ready(const Unit&) const {}
    __device__ __forceinline__ void done(const Unit&) const {}
};
struct SsmYOrder {
    int G, c;
    __device__ __forceinline__ bool next(int i, Unit& u) const { const int L = i * G + c; if (L >= 256) return false; const int g = L >> 2; u.pm = 2 * g + ((L >> 1) & 1); u.pn = 2 * g + (L & 1); return true; }
    __device__ __forceinline__ void a_ready(const Unit&) const {}
    __device__ __forceinline__ void done(const Unit&) const {}
};
struct MoeOrder {
    const LAS int* rbe; int nrb, sh, G, c;
    __device__ __forceinline__ bool next(int i, Unit& u) const {
        int rb, ct;
        if (G == 256) { const int x = c & 7, m = c >> 3, st = i * 8 + x, rbq = m >> 3, ctq = m & 7;
            if (sh == 4) { rb = 4 * (st >> 1) + rbq; ct = 8 * (st & 1) + ctq; } else { rb = 4 * st + rbq; ct = ctq; } }
        else { const int L = i * G + c; rb = L >> sh; ct = L & ((1 << sh) - 1); }
        if (rb >= nrb) return false;
        const int e = __builtin_amdgcn_readfirstlane(rbe[rb]);
        u.pm = rb; u.pn = (e << sh) + ct; return true; }
    __device__ __forceinline__ void a_ready(const Unit&) const {}
    __device__ __forceinline__ void done(const Unit&) const {}
};

struct Args { const float* in[28]; float* out; unsigned char* ws; int ph_lo, ph_hi; };
enum { I_X = 0, I_C, I_WADA, I_BADA, I_N1G, I_WIN, I_QG, I_KG, I_ARE, I_AIM, I_LDT, I_BRE, I_BIM, I_CRE, I_CIM, I_SD, I_WGLU, I_BGLU, I_WPA, I_WPB, I_WOUT, I_N2G, I_WR, I_BR, I_WGU, I_BGU, I_WD, I_BD };

__device__ __forceinline__ int crow(int r, int hi) { return (r & 3) + 8 * (r >> 2) + 4 * hi; }

__device__ __forceinline__ void ph0_adaln(const Args& a, LAS unsigned char* lds, int tid, int G, int bid) {
    LAS float* cond = (LAS float*)lds;
    LAS float* red = (LAS float*)(lds + 65536);
    const float* c = a.in[I_C]; const float* W = a.in[I_WADA]; const float* bada = a.in[I_BADA]; float* MOD = (float*)(a.ws + WS_MOD);
    bool have = false;
    for (int ub = bid; ub < MODW / 64; ub += G) {
        if (!have) { for (int i = tid; i < NB * DM; i += NTHR) { const int b = i >> 11, k = i & 2047; const float v = c[i]; cond[k * 8 + b] = v / (1.0f + expf(-v)); } __syncthreads(); have = true; }
        const int cc = tid & 63, col = ub * 64 + cc, kq = tid >> 6;
        float acc[8];
#pragma unroll
        for (int b = 0; b < 8; ++b) acc[b] = 0.f;
        const float* wp = W + (size_t)(kq * 256) * MODW + col;
        for (int k = 0; k < 256; k += 64) {
            float w[64];
#pragma unroll
            for (int q = 0; q < 64; ++q) w[q] = wp[(size_t)(k + q) * MODW];
#pragma unroll
            for (int q = 0; q < 64; ++q) { const f32x4 c0 = *(const LAS f32x4*)(cond + (kq * 256 + k + q) * 8), c1 = *(const LAS f32x4*)(cond + (kq * 256 + k + q) * 8 + 4);
                acc[0] += w[q] * c0[0]; acc[1] += w[q] * c0[1]; acc[2] += w[q] * c0[2]; acc[3] += w[q] * c0[3];
                acc[4] += w[q] * c1[0]; acc[5] += w[q] * c1[1]; acc[6] += w[q] * c1[2]; acc[7] += w[q] * c1[3]; }
        }
#pragma unroll
        for (int b = 0; b < 8; ++b) red[(kq * 8 + b) * 64 + cc] = acc[b];
        __syncthreads();
        { const int b = tid >> 6;
          float s = 0.f;
#pragma unroll
          for (int q = 0; q < 8; ++q) s += red[(q * 8 + b) * 64 + cc];
          MOD[(size_t)b * MODW + col] = s + bada[col]; }
        __syncthreads();
    }
    __syncthreads();
}
__device__ __forceinline__ void tr_item(const float* W, int ldw, int K, int srccol, int nvalid, bf16* WT, size_t dstrow0, int k0, LAS float* scr, int lane) {
    const int nn = lane & 31; const bool ok = nn < nvalid;
    float wv_[32];
#pragma unroll
    for (int i = 0; i < 32; ++i) { const int kk = 2 * i + (lane >> 5); wv_[i] = ok ? W[(size_t)(k0 + kk) * ldw + srccol + nn] : 0.f; }
#pragma unroll
    for (int i = 0; i < 32; ++i) { const int kk = 2 * i + (lane >> 5); scr[kk * 33 + nn] = wv_[i]; }
    LDS_WAIT(); asm volatile("" ::: "memory");
    const int c = lane & 7;
#pragma unroll
    for (int j = 0; j < 4; ++j) { const int n = (lane >> 3) + 8 * j; const LAS float* s = scr + (8 * c) * 33 + n;
        v4u o; o.x = pk2(s[0 * 33], s[1 * 33]); o.y = pk2(s[2 * 33], s[3 * 33]); o.z = pk2(s[4 * 33], s[5 * 33]); o.w = pk2(s[6 * 33], s[7 * 33]);
        *(v4u*)(WT + (dstrow0 + n) * K + k0 + 8 * c) = o; }
    LDS_WAIT(); asm volatile("" ::: "memory");
}
__device__ __forceinline__ void tr128_f8(const float* W, int ldw, int srccol, unsigned char* WT, size_t dstrow0, int K, int k0, LAS unsigned char* tile, int lane) {
    const float* src = W + (size_t)k0 * ldw + srccol + 2 * lane;
    f32x2 va[16], vb[16], vc[16], vd[16];
#define CV_LOAD(v, kb) do { _Pragma("unroll") for (int j = 0; j < 16; ++j) v[j] = __builtin_nontemporal_load((const f32x2*)(src + (size_t)((kb) * 16 + j) * ldw)); } while (0)
#define CV_PUT(v, kb) do { v4u a, b; \
        a.x = pk4_fp8(v[0][0] * F8_WSCALE, v[1][0] * F8_WSCALE, v[2][0] * F8_WSCALE, v[3][0] * F8_WSCALE); a.y = pk4_fp8(v[4][0] * F8_WSCALE, v[5][0] * F8_WSCALE, v[6][0] * F8_WSCALE, v[7][0] * F8_WSCALE); \
        a.z = pk4_fp8(v[8][0] * F8_WSCALE, v[9][0] * F8_WSCALE, v[10][0] * F8_WSCALE, v[11][0] * F8_WSCALE); a.w = pk4_fp8(v[12][0] * F8_WSCALE, v[13][0] * F8_WSCALE, v[14][0] * F8_WSCALE, v[15][0] * F8_WSCALE); \
        b.x = pk4_fp8(v[0][1] * F8_WSCALE, v[1][1] * F8_WSCALE, v[2][1] * F8_WSCALE, v[3][1] * F8_WSCALE); b.y = pk4_fp8(v[4][1] * F8_WSCALE, v[5][1] * F8_WSCALE, v[6][1] * F8_WSCALE, v[7][1] * F8_WSCALE); \
        b.z = pk4_fp8(v[8][1] * F8_WSCALE, v[9][1] * F8_WSCALE, v[10][1] * F8_WSCALE, v[11][1] * F8_WSCALE); b.w = pk4_fp8(v[12][1] * F8_WSCALE, v[13][1] * F8_WSCALE, v[14][1] * F8_WSCALE, v[15][1] * F8_WSCALE); \
        const int n0 = 2 * lane, n1 = 2 * lane + 1; \
        *(LAS v4u*)(tile + n0 * 128 + ((((kb)) ^ (n0 & 7)) << 4)) = a; *(LAS v4u*)(tile + n1 * 128 + ((((kb)) ^ (n1 & 7)) << 4)) = b; } while (0)
    CV_LOAD(va, 0); CV_LOAD(vb, 1); CV_LOAD(vc, 2);
    CV_LOAD(vd, 3); CV_PUT(va, 0); CV_LOAD(va, 4); CV_PUT(vb, 1); CV_LOAD(vb, 5); CV_PUT(vc, 2); CV_LOAD(vc, 6); CV_PUT(vd, 3); CV_LOAD(vd, 7);
    CV_PUT(va, 4); CV_PUT(vb, 5); CV_PUT(vc, 6); CV_PUT(vd, 7);
#undef CV_LOAD
#undef CV_PUT
    LDS_WAIT(); asm volatile("" ::: "memory");
    const int c = lane & 7;
#pragma unroll
    for (int j = 0; j < 16; ++j) { const int n = (lane >> 3) + 8 * j; const v4u o = *(const LAS v4u*)(tile + n * 128 + ((c ^ (n & 7)) << 4));
        *(v4u*)(WT + (dstrow0 + n) * K + k0 + 16 * c) = o; }
    LDS_WAIT(); asm volatile("" ::: "memory");
}
constexpr int CV_GU1 = 16 * 32, CV_GU = 32 * CV_GU1, CV_D1 = 16 * 16, CV_DN = 32 * CV_D1, CV_PA = 8 * 16, CV_PB = 8 * 16, CV_WO = 16 * 16, CV_ITEMS = CV_PA + CV_PB + CV_WO + CV_GU + CV_DN;
__device__ __forceinline__ void cv_item(const Args& a, int it, LAS unsigned char* tile, int lane) {
    if (it < CV_PA) { const int kt = it >> 4, nt = it & 15; tr128_f8(a.in[I_WPA], 2048, 128 * nt, (unsigned char*)(a.ws + WS_WA), (size_t)128 * nt, 2048, 128 * kt, tile, lane); return; } it -= CV_PA;
    if (it < CV_PB) { const int kt = it >> 4, nt = it & 15; tr128_f8(a.in[I_WPB], 2048, 128 * nt, (unsigned char*)(a.ws + WS_WA + 1024), (size_t)128 * nt, 2048, 128 * kt, tile, lane); return; } it -= CV_PB;
    if (it < CV_WO) { const int kt = it >> 4, nt = it & 15; tr128_f8(a.in[I_WOUT], 2048, 128 * nt, (unsigned char*)(a.ws + WS_WO), (size_t)128 * nt, 2048, 128 * kt, tile, lane); return; } it -= CV_WO;
    if (it < CV_GU) { const int e = it / CV_GU1, q = it % CV_GU1, kt = q >> 5, nt = q & 31, d0 = 128 * nt, ct = d0 >> 8; const int src = (d0 & 128) ? (2048 + 128 * ct) : (128 * ct);
        tr128_f8(a.in[I_WGU] + (size_t)e * 2048 * 4096, 4096, src, (unsigned char*)(a.ws + WS_WGU), (size_t)e * 4096 + d0, 2048, 128 * kt, tile, lane); }
    else { const int r = it - CV_GU, e = r / CV_D1, q = r % CV_D1, kt = q >> 4, nt = q & 15;
        tr128_f8(a.in[I_WD] + (size_t)e * 2048 * 2048, 2048, 128 * nt, (unsigned char*)(a.ws + WS_WD), (size_t)e * 2048 + 128 * nt, 2048, 128 * kt, tile, lane); }
}
__device__ __forceinline__ void ph0_transposes(const Args& a, LAS unsigned char* lds, int wave, int lane, int G, int bid) {
    LAS float* scr = (LAS float*)(lds + wave * 16384);
    const int gw = wave * G + bid, NGW = G * NWAVES;
    constexpr int I_IN = 32 * 80, I_GL = 16 * 32, I_IN8 = 16 * 42;
    constexpr int NITEMS = I_IN + I_GL + I_IN8;
    for (int it = gw; it < NITEMS; it += NGW) {
        int r = it;
        if (r < I_IN) { const int kb = r / 80, nb = r % 80, d0 = 32 * nb; int src, nv = 32;
            if (d0 < 1280) src = d0; else if (d0 < 2304) src = 1536 + (d0 - 1280); else if (d0 < 2368) src = 2560 + (d0 - 2304); else if (d0 == 2368) { src = 2624; nv = 16; } else { src = 0; nv = 0; }
            tr_item(a.in[I_WIN], INW, DM, src, nv, (bf16*)(a.ws + WS_WIN), (size_t)d0, 64 * kb, scr, lane); continue; } r -= I_IN;
        if (r < I_GL) { const int kb = r / 32, nb = r % 32; tr_item(a.in[I_WGLU], 1024, 1024, 32 * nb, 32, (bf16*)(a.ws + WS_WGLU), (size_t)32 * nb, 64 * kb, scr, lane); continue; } r -= I_GL;
        { const int kt = r / 42, nt = r % 42; const int src = nt < 2 ? 1280 + 128 * nt : (nt < 10 ? 2640 + 128 * (nt - 2) : 3664 + 128 * (nt - 10));
          tr128_f8(a.in[I_WIN], INW, src, (unsigned char*)(a.ws + WS_WIN8), (size_t)128 * nt, 2048, 128 * kt, lds + wave * 16384, lane); }
    }
}
__device__ __forceinline__ void cv_queue(const Args& a, LAS unsigned char* lds, int wave, int lane) {
    unsigned* ctr = (unsigned*)(a.ws + WS_CTL) + CW_CVQ;
    for (;;) { int it = 0; if (lane == 0) it = (int)__hip_atomic_fetch_add(ctr, 1u, RLX_AGENT); it = __builtin_amdgcn_readfirstlane(it); if (it >= CV_ITEMS) break; cv_item(a, it, lds + wave * 16384, lane); }
}
__device__ __forceinline__ void cexp_d(double zr, double zi, double& er, double& ei) {
    const double s = 1.0 / 1024.0; zr *= s; zi *= s;
    double wr = 1.0, wi = 0.0;
#pragma unroll
    for (int k = 10; k >= 1; --k) { const double tr = (zr * wr - zi * wi) / (double)k, ti = (zr * wi + zi * wr) / (double)k; wr = 1.0 + tr; wi = ti; }
#pragma unroll
    for (int q = 0; q < 10; ++q) { const double tr = wr * wr - wi * wi, ti = 2.0 * wr * wi; wr = tr; wi = ti; }
    er = wr; ei = wi;
}
__device__ __forceinline__ void ph0_ssm_consts(const Args& a, int tid, int G, int bid) {
    float* BBAR = (float*)(a.ws + WS_BBAR); float* POW = (float*)(a.ws + WS_POW);
    for (int idx = bid * NTHR + tid; idx < SSMG * SSMN; idx += G * NTHR) {
        const int g = idx >> 6, n = idx & 63;
        double st, dummy; cexp_d((double)a.in[I_LDT][g], 0.0, st, dummy);
        const double are = (double)a.in[I_ARE][idx], aim = (double)a.in[I_AIM][idx];
        double er, ei; cexp_d(st * are, st * aim, er, ei);
        const double den = are * are + aim * aim, nr = er - 1.0, ni = ei;
        const double cr = (nr * are + ni * aim) / den, ci = (ni * are - nr * aim) / den;
#pragma unroll 4
        for (int p = 0; p < 16; ++p) { const double br = (double)a.in[I_BRE][(size_t)idx * 16 + p], bi = (double)a.in[I_BIM][(size_t)idx * 16 + p];
            BBAR[((size_t)idx * 16 + p) * 2 + 0] = (float)(cr * br - ci * bi); BBAR[((size_t)idx * 16 + p) * 2 + 1] = (float)(cr * bi + ci * br); }
        double pr = 1.0, pi = 0.0;
        for (int t = 0; t <= 64; ++t) { POW[(((size_t)g * 65 + t) * 64 + n) * 2 + 0] = (float)pr; POW[(((size_t)g * 65 + t) * 64 + n) * 2 + 1] = (float)pi;
            const double tr = pr * er - pi * ei, ti = pr * ei + pi * er; pr = tr; pi = ti; }
    }
}

__device__ __forceinline__ void ph1_norm(const Args& a, int wave, int lane, int G, int bid) {
    const float* MOD = (const float*)(a.ws + WS_MOD);
    const int gw = bid * NWAVES + wave, NGW = G * NWAVES;
    {
        const float* X = a.in[I_X]; const float* g1 = a.in[I_N1G]; bf16* HN = (bf16*)(a.ws + WS_HN); unsigned char* HN8 = (unsigned char*)(a.ws + WS_HN8);
        const int RPW = (T + NGW - 1) / NGW, r0 = gw * RPW, r1 = min(T, r0 + RPW);
        f32x4 vn[8], pa[8], pb[8]; int curb = -1;
        if (r0 < r1) { const f32x4* xr = (const f32x4*)(X + (size_t)r0 * DM) + 2 * lane;
#pragma unroll
            for (int j = 0; j < 4; ++j) { vn[2 * j] = xr[128 * j]; vn[2 * j + 1] = xr[128 * j + 1]; } }
        for (int row = r0; row < r1; ++row) {
            const int b = row >> 11;
            f32x4 v[8]; float s = 0.f;
#pragma unroll
            for (int j = 0; j < 8; ++j) { v[j] = vn[j]; s += (v[j][0] * v[j][0] + v[j][1] * v[j][1]) + (v[j][2] * v[j][2] + v[j][3] * v[j][3]); }
            if (row + 1 < r1) { const f32x4* xr = (const f32x4*)(X + (size_t)(row + 1) * DM) + 2 * lane;
#pragma unroll
                for (int j = 0; j < 4; ++j) { vn[2 * j] = xr[128 * j]; vn[2 * j + 1] = xr[128 * j + 1]; } }
            if (b != curb) { curb = b; const f32x4* gp = (const f32x4*)g1 + 2 * lane; const f32x4* shp = (const f32x4*)(MOD + (size_t)b * MODW) + 2 * lane; const f32x4* scp = (const f32x4*)(MOD + (size_t)b * MODW + DM) + 2 * lane;
#pragma unroll
                for (int j = 0; j < 4; ++j) { pa[2 * j] = gp[128 * j] * (scp[128 * j] + 1.0f); pa[2 * j + 1] = gp[128 * j + 1] * (scp[128 * j + 1] + 1.0f); pb[2 * j] = shp[128 * j]; pb[2 * j + 1] = shp[128 * j + 1]; } }
            const float rstd = 1.0f / sqrtf(wave_sum(s) * (1.0f / DM) + RMS_EPS);
            v4u* o16 = (v4u*)(HN + (size_t)row * DM) + lane; v2u* o8 = (v2u*)(HN8 + (size_t)row * DM) + lane; v4u w[4]; v2u w8[4];
#pragma unroll
            for (int j = 0; j < 4; ++j) { const f32x4 y0 = (v[2 * j] * rstd) * pa[2 * j] + pb[2 * j], y1 = (v[2 * j + 1] * rstd) * pa[2 * j + 1] + pb[2 * j + 1];
                w[j].x = pk2(y0[0], y0[1]); w[j].y = pk2(y0[2], y0[3]); w[j].z = pk2(y1[0], y1[1]); w[j].w = pk2(y1[2], y1[3]);
                w8[j].x = pk4_fp8(y0[0] * F8_ASCALE, y0[1] * F8_ASCALE, y0[2] * F8_ASCALE, y0[3] * F8_ASCALE); w8[j].y = pk4_fp8(y1[0] * F8_ASCALE, y1[1] * F8_ASCALE, y1[2] * F8_ASCALE, y1[3] * F8_ASCALE); }
#pragma unroll
            for (int j = 0; j < 4; ++j) { o16[64 * j] = w[j]; o8[64 * j] = w8[j]; }
        }
    }
}
__device__ __forceinline__ void ph1_small(const Args& a, int tid, int wave, int lane, int G, int bid) {
    const float* MOD = (const float*)(a.ws + WS_MOD);
    const int gw = bid * NWAVES + wave, NGW = G * NWAVES;
    {
        const float* g2 = a.in[I_N2G]; const float* wr = a.in[I_WR]; const float* br = a.in[I_BR]; float* WRP = (float*)(a.ws + WS_WRP); float* BRP = (float*)(a.ws + WS_BRP);
        for (int base = bid * NTHR + tid; base < NB * DM * NEXP; base += 4 * G * NTHR) { float v[4];
#pragma unroll
            for (int u = 0; u < 4; ++u) { const int idx = base + u * G * NTHR, ic = idx < NB * DM * NEXP ? idx : 0, b = ic >> 16, k = (ic >> 5) & 2047; v[u] = g2[k] * (1.0f + MOD[(size_t)b * MODW + 4 * DM + k]) * wr[ic & 65535]; }
#pragma unroll
            for (int u = 0; u < 4; ++u) { const int idx = base + u * G * NTHR; if (idx < NB * DM * NEXP) WRP[idx] = v[u]; } }
        for (int o = (wave == 2 ? bid : NB * NEXP); o < NB * NEXP; o += G) { const int b = o >> 5, e = o & 31; float s = 0.f;
#pragma unroll 8
            for (int k = lane; k < DM; k += 64) s += MOD[(size_t)b * MODW + 3 * DM + k] * wr[k * 32 + e];
            s = wave_sum(s); if (lane == 0) BRP[o] = s + br[e]; }
    }
    {
        const float* cre = a.in[I_CRE]; const float* cim = a.in[I_CIM]; const float* BBAR = (const float*)(a.ws + WS_BBAR); const float* POW = (const float*)(a.ws + WS_POW); float* KT = (float*)(a.ws + WS_KT);
        for (int idx = (tid < 128 ? bid * 128 + tid : SSMG * SL * 16); idx < SSMG * SL * 16; idx += G * 128) {
            const int g = idx >> 9, tau = (idx >> 4) & 31, p = idx & 15; float s[16];
#pragma unroll
            for (int q = 0; q < 16; ++q) s[q] = 0.f;
#pragma unroll 8
            for (int n = 0; n < 64; ++n) { const float cr = cre[((size_t)g * 16 + p) * 64 + n], ci = cim[((size_t)g * 16 + p) * 64 + n];
                const float pr = POW[(((size_t)g * 65 + tau) * 64 + n) * 2], pi = POW[(((size_t)g * 65 + tau) * 64 + n) * 2 + 1];
                const float er = cr * pr - ci * pi, ei = cr * pi + ci * pr;
                const f32x4* bp = (const f32x4*)(BBAR + ((size_t)g * 64 + n) * 32);
#pragma unroll
                for (int q = 0; q < 8; ++q) { const f32x4 bb = bp[q]; s[2 * q] += er * bb[0] - ei * bb[1]; s[2 * q + 1] += er * bb[2] - ei * bb[3]; } }
            { const float dv = (tau == 0) ? a.in[I_SD][g * 16 + p] : 0.0f;
#pragma unroll
              for (int q = 0; q < 16; ++q) s[q] += (q == p) ? dv : 0.0f; }
            float* kp = KT + (((size_t)g * 64 + tau) * 16 + p) * 16;
#pragma unroll
            for (int q = 0; q < 4; ++q) *(f32x4*)(kp + 4 * q) = (f32x4){s[4 * q], s[4 * q + 1], s[4 * q + 2], s[4 * q + 3]}; }
    }
}

__device__ __forceinline__ void qknorm_body(const Args& a, int wave, int lane, int G, int bid) {
    const int gw = bid * NWAVES + wave, NGW = G * NWAVES;
    {   bf16* Q = (bf16*)(a.ws + WS_Q); bf16* K = (bf16*)(a.ws + WS_K); const float* qg = a.in[I_QG]; const float* kg = a.in[I_KG];
        const float qs = 0.08838834764831845f * 1.4426950408889634f;
        const int l32 = lane & 31; float qgv[16], kgv[8];
#pragma unroll
        for (int e = 0; e < 16; ++e) qgv[e] = qg[((16 * lane) & 127) + e];
#pragma unroll
        for (int e = 0; e < 8; ++e) kgv[e] = kg[((8 * l32) & 127) + e];
        for (int row0 = gw; row0 < T; row0 += 4 * NGW) {
            v4u qa[4], qb[4], ka[4];
#pragma unroll
            for (int u = 0; u < 4; ++u) { const int row = min(row0 + u * NGW, T - 1); const v4u* qp = (const v4u*)(Q + (size_t)row * 1024 + 16 * lane); qa[u] = qp[0]; qb[u] = qp[1]; ka[u] = *(const v4u*)(K + (size_t)row * 256 + 8 * l32); }
#pragma unroll
            for (int u = 0; u < 4; ++u) { const int row = row0 + u * NGW; if (row < T) {
                {   v4u* qp = (v4u*)(Q + (size_t)row * 1024 + 16 * lane); const v4u w0 = qa[u], w1 = qb[u]; float f[16];
                    f[0] = bflo(w0.x); f[1] = bfhi(w0.x); f[2] = bflo(w0.y); f[3] = bfhi(w0.y); f[4] = bflo(w0.z); f[5] = bfhi(w0.z); f[6] = bflo(w0.w); f[7] = bfhi(w0.w);
                    f[8] = bflo(w1.x); f[9] = bfhi(w1.x); f[10] = bflo(w1.y); f[11] = bfhi(w1.y); f[12] = bflo(w1.z); f[13] = bfhi(w1.z); f[14] = bflo(w1.w); f[15] = bfhi(w1.w);
                    float s = 0.f;
#pragma unroll
                    for (int e = 0; e < 16; ++e) s += f[e] * f[e];
                    s += __shfl_xor(s, 1); s += __shfl_xor(s, 2); s += __shfl_xor(s, 4);
                    const float rs = qs / sqrtf(s * (1.0f / 128.0f) + RMS_EPS);
#pragma unroll
                    for (int e = 0; e < 16; ++e) f[e] = f[e] * rs * qgv[e];
                    v4u o0, o1; o0.x = pk2(f[0], f[1]); o0.y = pk2(f[2], f[3]); o0.z = pk2(f[4], f[5]); o0.w = pk2(f[6], f[7]); o1.x = pk2(f[8], f[9]); o1.y = pk2(f[10], f[11]); o1.z = pk2(f[12], f[13]); o1.w = pk2(f[14], f[15]);
                    qp[0] = o0; qp[1] = o1; }
                {   v4u* kp = (v4u*)(K + (size_t)row * 256 + 8 * l32); const v4u w0 = ka[u]; float f[8];
                    f[0] = bflo(w0.x); f[1] = bfhi(w0.x); f[2] = bflo(w0.y); f[3] = bfhi(w0.y); f[4] = bflo(w0.z); f[5] = bfhi(w0.z); f[6] = bflo(w0.w); f[7] = bfhi(w0.w);
                    float s = 0.f;
#pragma unroll
                    for (int e = 0; e < 8; ++e) s += f[e] * f[e];
                    s += __shfl_xor(s, 1); s += __shfl_xor(s, 2); s += __shfl_xor(s, 4); s += __shfl_xor(s, 8);
                    const float rs = 1.0f / sqrtf(s * (1.0f / 128.0f) + RMS_EPS);
#pragma unroll
                    for (int e = 0; e < 8; ++e) f[e] = f[e] * rs * kgv[e];
                    v4u o0; o0.x = pk2(f[0], f[1]); o0.y = pk2(f[2], f[3]); o0.z = pk2(f[4], f[5]); o0.w = pk2(f[6], f[7]);
                    if (lane < 32) kp[0] = o0; } } }
        }
    }
}
__device__ __forceinline__ void bty_body(const Args& a, int tid, int G, int bid) {
    const float* KT = (const float*)(a.ws + WS_KT); const float* POW = (const float*)(a.ws + WS_POW); const float* cre = a.in[I_CRE]; const float* cim = a.in[I_CIM]; bf16* BTY = (bf16*)(a.ws + WS_BTY);
    constexpr int RPG = SL * 16; const int NA = SSMG * RPG * 64, NBC = SSMG * RPG * 16, ST = G * NTHR;
    for (int base = bid * NTHR + tid; base < NA; base += 4 * ST) {
        f32x4 lo[4], hi[4];
#pragma unroll
        for (int u = 0; u < 4; ++u) { const int idx = base + u * ST, ic = idx < NA ? idx : 0, cc = ic & 63, rr = (ic >> 6) & (RPG - 1), g = ic >> 15, j = rr >> 4, p = rr & 15, i = cc >> 1, d = j >= i ? j - i : 0;
            const float* kp = KT + (((size_t)g * 64 + d) * 16 + p) * 16 + (cc & 1) * 8; lo[u] = *(const f32x4*)kp; hi[u] = *(const f32x4*)(kp + 4); }
#pragma unroll
        for (int u = 0; u < 4; ++u) { const int idx = base + u * ST; if (idx < NA) { const int cc = idx & 63, rr = (idx >> 6) & (RPG - 1), g = idx >> 15, j = rr >> 4, i = cc >> 1; const bool ok = j >= i;
            v4u o; o.x = ok ? pk2(lo[u][0], lo[u][1]) : 0u; o.y = ok ? pk2(lo[u][2], lo[u][3]) : 0u; o.z = ok ? pk2(hi[u][0], hi[u][1]) : 0u; o.w = ok ? pk2(hi[u][2], hi[u][3]) : 0u;
            *(v4u*)(BTY + ((size_t)g * RPG + rr) * UA_LD + 8 * cc) = o; } }
    }
    for (int base = bid * NTHR + tid; base < NBC; base += 4 * ST) {
        f32x4 cr[4], ci[4], p0[4], p1[4];
#pragma unroll
        for (int u = 0; u < 4; ++u) { const int idx = base + u * ST, ic = idx < NBC ? idx : 0, cq = ic & 15, rr = (ic >> 4) & (RPG - 1), g = ic >> 13, j = rr >> 4, p = rr & 15;
            cr[u] = *(const f32x4*)(cre + ((size_t)g * 16 + p) * 64 + 4 * cq); ci[u] = *(const f32x4*)(cim + ((size_t)g * 16 + p) * 64 + 4 * cq);
            const float* pw = POW + (((size_t)g * 65 + (j + 1)) * 64 + 4 * cq) * 2; p0[u] = *(const f32x4*)pw; p1[u] = *(const f32x4*)(pw + 4); }
#pragma unroll
        for (int u = 0; u < 4; ++u) { const int idx = base + u * ST; if (idx < NBC) { const int cq = idx & 15, rr = (idx >> 4) & (RPG - 1), g = idx >> 13;
            v4u o; o.x = pk2(cr[u][0] * p0[u][0] - ci[u][0] * p0[u][1], -(cr[u][0] * p0[u][1] + ci[u][0] * p0[u][0])); o.y = pk2(cr[u][1] * p0[u][2] - ci[u][1] * p0[u][3], -(cr[u][1] * p0[u][3] + ci[u][1] * p0[u][2]));
            o.z = pk2(cr[u][2] * p1[u][0] - ci[u][2] * p1[u][1], -(cr[u][2] * p1[u][1] + ci[u][2] * p1[u][0])); o.w = pk2(cr[u][3] * p1[u][2] - ci[u][3] * p1[u][3], -(cr[u][3] * p1[u][3] + ci[u][3] * p1[u][2]));
            *(v4u*)(BTY + ((size_t)g * RPG + rr) * UA_LD + SL * 16 + 8 * cq) = o; } }
    }
}
__device__ __forceinline__ void bts_body(const Args& a, int tid, int G, int bid) {
    const float* BBAR = (const float*)(a.ws + WS_BBAR); const float* POW = (const float*)(a.ws + WS_POW); bf16* BTS = (bf16*)(a.ws + WS_BTS);
    constexpr int CPR = SL * 16 / 8; const int NCH = SSMG * 256 * CPR, ST = G * NTHR;
    for (int base = bid * NTHR + tid; base < NCH; base += 4 * ST) {
        f32x4 bb[4][4]; f32x2 pw[4];
#pragma unroll
        for (int u = 0; u < 4; ++u) { const int idx = base + u * ST, ic = idx < NCH ? idx : 0, cc = ic % CPR, rr = (ic / CPR) & 127, g = ic / (CPR * 256), col0 = 8 * cc, i = col0 >> 4, pp0 = col0 & 15, n = rr >> 1;
            pw[u] = *(const f32x2*)(POW + (((size_t)g * 65 + (SL - 1 - i)) * 64 + n) * 2); const f32x4* bp = (const f32x4*)(BBAR + (((size_t)g * 64 + n) * 16 + pp0) * 2);
#pragma unroll
            for (int q = 0; q < 4; ++q) bb[u][q] = bp[q]; }
#pragma unroll
        for (int u = 0; u < 4; ++u) { const int idx = base + u * ST; if (idx < NCH) { const int cc = idx % CPR, rr = (idx / CPR) & 255, g = idx / (CPR * 256); const bool live = rr < 128, part = rr & 1; const float pr = pw[u][0], pi = pw[u][1]; float f[8];
#pragma unroll
            for (int q = 0; q < 4; ++q) { f[2 * q] = part ? (pr * bb[u][q][1] + pi * bb[u][q][0]) : (pr * bb[u][q][0] - pi * bb[u][q][1]); f[2 * q + 1] = part ? (pr * bb[u][q][3] + pi * bb[u][q][2]) : (pr * bb[u][q][2] - pi * bb[u][q][3]); }
            v4u o; o.x = live ? pk2(f[0], f[1]) : 0u; o.y = live ? pk2(f[2], f[3]) : 0u; o.z = live ? pk2(f[4], f[5]) : 0u; o.w = live ? pk2(f[6], f[7]) : 0u;
            *(v4u*)(BTS + ((size_t)g * 256 + rr) * (SL * 16) + 8 * cc) = o; } }
    }
}

namespace att {
constexpr int D = 128, NW = 8, QBLK = 32, KVBLK = 64, LDK = 256;
constexpr float THR2 = 11.5415603f;
constexpr size_t SHM_V = KVBLK * D * 2, SHM_K = KVBLK * D * 2, SHM_ATTN = 2 * SHM_V + 2 * SHM_K + NW * 64 * 4;
using u32x4 = __attribute__((ext_vector_type(4))) unsigned;
#define KSWZ(row, colB) ((row) * 256 + ((colB) ^ (((row) & 7) << 4)))
#define SBAR() __builtin_amdgcn_sched_barrier(0)
__device__ __forceinline__ unsigned cvtpk(float lo, float hi) { unsigned r; asm volatile("v_cvt_pk_bf16_f32 %0, %1, %2" : "=v"(r) : "v"(lo), "v"(hi)); return r; }

__device__ __forceinline__ void amask(f32x16& p0, f32x16& p1, unsigned mw0, unsigned mw1, float dq, float nslope, int hi) {
  const unsigned s0 = mw0 >> (4 * hi), s1 = mw1 >> (4 * hi);
#pragma unroll
  for (int r = 0; r < 16; ++r) { const int c = (r & 3) + 8 * (r >> 2);
    const float v = fmaf(nslope, fabsf(dq - (float)c), p0[r]); p0[r] = (s0 & (1u << c)) ? v : -INFINITY;
    const float w = fmaf(nslope, fabsf(dq - (float)(c + 32)), p1[r]); p1[r] = (s1 & (1u << c)) ? w : -INFINITY; }
}
__device__ __forceinline__ void partialSM(f32x16& p0, f32x16& p1, float& m_reg, float& mn, float& alpha) {
  float pmax = p0[0];
#pragma unroll
  for (int r = 1; r < 16; ++r) pmax = fmaxf(pmax, p0[r]);
#pragma unroll
  for (int r = 0; r < 16; ++r) pmax = fmaxf(pmax, p1[r]);
  { auto rr = __builtin_amdgcn_permlane32_swap(__float_as_uint(pmax), __float_as_uint(pmax), false, false);
    pmax = fmaxf(__uint_as_float(rr[0]), __uint_as_float(rr[1])); }
  if (__builtin_expect(__all(pmax - m_reg <= THR2), 1)) { mn = m_reg; alpha = 1.f; }
  else { mn = fmaxf(m_reg, pmax); alpha = __builtin_amdgcn_exp2f(m_reg - mn); m_reg = mn; }
#pragma unroll
  for (int r = 0; r < 16; ++r) p0[r] = p0[r] - mn;
#pragma unroll
  for (int r = 0; r < 16; ++r) p1[r] = p1[r] - mn;
#pragma unroll
  for (int r = 0; r < 16; ++r) p0[r] = __builtin_amdgcn_exp2f(p0[r]);
}
__device__ __forceinline__ void finishSM(f32x16& p0, f32x16& p1, float alpha, float& l_reg, bf16x8& pa0, bf16x8& pa1, bf16x8& pa2, bf16x8& pa3) {
#pragma unroll
  for (int r = 0; r < 16; ++r) p1[r] = __builtin_amdgcn_exp2f(p1[r]);
  float ps = 0;
#pragma unroll
  for (int r = 0; r < 16; ++r) ps += p0[r];
#pragma unroll
  for (int r = 0; r < 16; ++r) ps += p1[r];
  { auto rr = __builtin_amdgcn_permlane32_swap(__float_as_uint(ps), __float_as_uint(ps), false, false);
    ps = __uint_as_float(rr[0]) + __uint_as_float(rr[1]); }
  l_reg = l_reg * alpha + ps;
#define PK4(P, BASE, OUT) do { unsigned a0 = cvtpk(P[BASE + 0], P[BASE + 1]), a1 = cvtpk(P[BASE + 2], P[BASE + 3]);   \
    unsigned b0 = cvtpk(P[BASE + 4], P[BASE + 5]), b1 = cvtpk(P[BASE + 6], P[BASE + 7]);                              \
    auto r0 = __builtin_amdgcn_permlane32_swap(a0, b0, false, false); auto r1 = __builtin_amdgcn_permlane32_swap(a1, b1, false, false); \
    u32x4 w = {r0[0], r1[0], r0[1], r1[1]}; OUT = *reinterpret_cast<bf16x8*>(&w); } while (0)
  PK4(p0, 0, pa0); PK4(p0, 8, pa1); PK4(p1, 0, pa2); PK4(p1, 8, pa3);
#undef PK4
}
__device__ __forceinline__ void qkt(f32x16& p0, f32x16& p1, const bf16* Ks, const bf16x8* qr, int r32, int hi) {
  p0 = f32x16{}; p1 = f32x16{};
#pragma unroll
  for (int d0 = 0; d0 < 8; ++d0) { int cb = (d0 * 16 + hi * 8) * 2;
    bf16x8 b0 = *reinterpret_cast<const bf16x8*>((const char*)Ks + KSWZ(r32, cb));
    bf16x8 b1 = *reinterpret_cast<const bf16x8*>((const char*)Ks + KSWZ(32 + r32, cb));
    p0 = __builtin_amdgcn_mfma_f32_32x32x16_bf16(b0, qr[d0], p0, 0, 0, 0);
    p1 = __builtin_amdgcn_mfma_f32_32x32x16_bf16(b1, qr[d0], p1, 0, 0, 0); }
}
__device__ __forceinline__ int v_st(int k, int c) { const int kk = (k & ~0xC) | ((k & 4) << 1) | ((k & 8) >> 1); return ((kk >> 3) * 4 + (c >> 5)) * 512 + ((kk & 7) * 32 + (c & 31)) * 2; }
__device__ __forceinline__ int v_rd_base(int lane) { return ((lane & 3) << 3) | (((lane >> 2) & 3) << 6) | (((lane >> 4) & 1) << 5) | (((lane >> 5) & 1) << 8); }
constexpr int v_rd_off(int d0, int ks, int half) { return d0 * 512 + ks * 4096 + half * 2048; }
template <int OFF> __device__ __forceinline__ s16x4 tr_read(int vb) {
  s16x4 r; asm volatile("ds_read_b64_tr_b16 %0, %1 offset:%2" : "=&v"(r) : "v"(vb), "i"(OFF) : "memory"); return r;
}
template <int D0> __device__ __forceinline__ void pv_one(f32x16& od, int vb, bf16x8 pa0, bf16x8 pa1, bf16x8 pa2, bf16x8 pa3) {
  const s16x4 l0 = tr_read<v_rd_off(D0, 0, 0)>(vb), h0 = tr_read<v_rd_off(D0, 0, 1)>(vb), l1 = tr_read<v_rd_off(D0, 1, 0)>(vb), h1 = tr_read<v_rd_off(D0, 1, 1)>(vb);
  const s16x4 l2 = tr_read<v_rd_off(D0, 2, 0)>(vb), h2 = tr_read<v_rd_off(D0, 2, 1)>(vb), l3 = tr_read<v_rd_off(D0, 3, 0)>(vb), h3 = tr_read<v_rd_off(D0, 3, 1)>(vb);
  asm volatile("s_waitcnt lgkmcnt(0)" ::: "memory"); SBAR();
#define PK(L, H) (bf16x8){L[0], L[1], L[2], L[3], H[0], H[1], H[2], H[3]}
  od = __builtin_amdgcn_mfma_f32_32x32x16_bf16(pa0, PK(l0, h0), od, 0, 0, 0);
  od = __builtin_amdgcn_mfma_f32_32x32x16_bf16(pa1, PK(l1, h1), od, 0, 0, 0);
  od = __builtin_amdgcn_mfma_f32_32x32x16_bf16(pa2, PK(l2, h2), od, 0, 0, 0);
  od = __builtin_amdgcn_mfma_f32_32x32x16_bf16(pa3, PK(l3, h3), od, 0, 0, 0);
#undef PK
}
__device__ __forceinline__ void pv_d0(f32x16* o, int vb, bf16x8 pa0, bf16x8 pa1, bf16x8 pa2, bf16x8 pa3) {
  pv_one<0>(o[0], vb, pa0, pa1, pa2, pa3); pv_one<1>(o[1], vb, pa0, pa1, pa2, pa3); pv_one<2>(o[2], vb, pa0, pa1, pa2, pa3); pv_one<3>(o[3], vb, pa0, pa1, pa2, pa3);
}

__device__ __forceinline__ void attn_unit(const bf16* __restrict__ Qlane, const bf16* __restrict__ Kh, const bf16* __restrict__ Vh, unsigned char* __restrict__ Ow, int ldo,
                                          const unsigned* __restrict__ selbase, unsigned selo, int qpos, float nslope, int NT, int NTreal, char* lds) {
  const int tid = threadIdx.x, wid = tid >> 6, lane = tid & 63, r32 = lane & 31, hi = lane >> 5;
  bf16* V_lds = (bf16*)lds; bf16* K_lds = (bf16*)(lds + 2 * SHM_V);
  float* ws = (float*)(lds + 2 * SHM_V + 2 * SHM_K) + wid * 64; float* li_l = ws; float* al_l = ws + 32;
  float m_reg = -1e30f, l_reg = 0; f32x16 o[4] = {}; bf16x8 qr[8];
#pragma unroll
  for (int d0 = 0; d0 < 8; ++d0) qr[d0] = *reinterpret_cast<const bf16x8*>(Qlane + d0 * 16);
  const int sr = tid >> 4, sc = (tid & 15) * 8, vst0 = v_st(sr, sc), vst1 = v_st(32 + sr, sc);
  const int vb0 = (int)(uintptr_t)V_lds + v_rd_base(lane);
  const int soffb = (sr * LDK + sc) * 2;
  const __amdgpu_buffer_rsrc_t rsK = __builtin_amdgcn_make_buffer_rsrc((void*)Kh, 0, 1 << 20, 0x00020000), rsV = __builtin_amdgcn_make_buffer_rsrc((void*)Vh, 0, 1 << 20, 0x00020000);
  const float dqb = (float)(qpos - 4 * hi);
  struct { bf16x8 vs0, vs1, ks0, ks1; } sr_[2];
#define SLOAD(i, k0) do { const int so_ = (k0) * (LDK * 2); \
    sr_[i].vs0 = __builtin_bit_cast(bf16x8, __builtin_amdgcn_raw_buffer_load_b128(rsV, soffb, so_, 0)); sr_[i].vs1 = __builtin_bit_cast(bf16x8, __builtin_amdgcn_raw_buffer_load_b128(rsV, soffb, so_ + 32 * LDK * 2, 0)); \
    sr_[i].ks0 = __builtin_bit_cast(bf16x8, __builtin_amdgcn_raw_buffer_load_b128(rsK, soffb, so_, 0)); sr_[i].ks1 = __builtin_bit_cast(bf16x8, __builtin_amdgcn_raw_buffer_load_b128(rsK, soffb, so_ + 32 * LDK * 2, 0)); } while (0)
#define SWRITE(b, i) do { *(bf16x8*)((char*)V_lds + (b) * SHM_V + vst0) = sr_[i].vs0;          \
    *(bf16x8*)((char*)V_lds + (b) * SHM_V + vst1) = sr_[i].vs1; int kc = sc * 2;               \
    *(bf16x8*)((char*)K_lds + (b) * SHM_K + KSWZ(sr, kc)) = sr_[i].ks0;                       \
    *(bf16x8*)((char*)K_lds + (b) * SHM_K + KSWZ(32 + sr, kc)) = sr_[i].ks1; } while (0)
#define SWAIT() asm volatile("s_waitcnt vmcnt(4)" ::: "memory")
#define RESC(a) do { if (__any((a) < 1.f)) { if (hi == 0) al_l[r32] = (a); asm volatile("s_waitcnt lgkmcnt(0)" ::: "memory"); \
    _Pragma("unroll") for (int d = 0; d < 4; ++d) _Pragma("unroll") for (int r = 0; r < 16; ++r) o[d][r] *= al_l[crow(r, hi)]; } } while (0)
#define MASKW(j, m0, m1) do { const v2u mm_ = *reinterpret_cast<const v2u*>(selbase + (selo + 2u * (unsigned)(j))); const bool in_ = (j) < NTreal; m0 = in_ ? mm_.x : 0u; m1 = in_ ? mm_.y : 0u; } while (0)
  f32x16 pA0, pA1, pB0, pB1; float mnA, mnB, alA, alB; bf16x8 pa0, pa1, pa2, pa3; unsigned ma0, ma1, mb0, mb1;
  constexpr int SE = 0, SO = 1;
  SLOAD(SE, 0); MASKW(0, ma0, ma1); MASKW(1, mb0, mb1); asm volatile("s_waitcnt vmcnt(0)" ::: "memory"); SWRITE(0, SE); __syncthreads();
  qkt(pA0, pA1, K_lds, qr, r32, hi); amask(pA0, pA1, ma0, ma1, dqb, nslope, hi); partialSM(pA0, pA1, m_reg, mnA, alA);
  SLOAD(SO, KVBLK); if (2 < NT) SLOAD(SE, 2 * KVBLK);
  SWAIT(); SWRITE(1, SO); __syncthreads();
  for (int j = 1; j + 1 < NT; j += 2) {
    SBAR(); qkt(pB0, pB1, (bf16*)((char*)K_lds + SHM_K), qr, r32, hi);
    finishSM(pA0, pA1, alA, l_reg, pa0, pa1, pa2, pa3); SBAR();
    MASKW(j + 1, ma0, ma1); SLOAD(SO, (j + 2) * KVBLK); SBAR();
    pv_d0(o, vb0, pa0, pa1, pa2, pa3); amask(pB0, pB1, mb0, mb1, dqb - (float)(64 * j), nslope, hi); partialSM(pB0, pB1, m_reg, mnB, alB);
    __syncthreads(); SWAIT(); SWRITE(0, SE);
    RESC(alB); __syncthreads();
    SBAR(); qkt(pA0, pA1, K_lds, qr, r32, hi);
    finishSM(pB0, pB1, alB, l_reg, pa0, pa1, pa2, pa3); SBAR();
    MASKW(j + 2, mb0, mb1); if (j + 3 < NT) SLOAD(SE, (j + 3) * KVBLK); SBAR();
    pv_d0(o, vb0 + (int)SHM_V, pa0, pa1, pa2, pa3); amask(pA0, pA1, ma0, ma1, dqb - (float)(64 * (j + 1)), nslope, hi); partialSM(pA0, pA1, m_reg, mnA, alA);
    __syncthreads(); SWAIT(); SWRITE(1, SO);
    RESC(alA); __syncthreads();
  }
  SBAR(); qkt(pB0, pB1, (bf16*)((char*)K_lds + SHM_K), qr, r32, hi);
  finishSM(pA0, pA1, alA, l_reg, pa0, pa1, pa2, pa3); SBAR();
  SBAR();
  pv_d0(o, vb0, pa0, pa1, pa2, pa3); amask(pB0, pB1, mb0, mb1, dqb - (float)(64 * (NT - 1)), nslope, hi); partialSM(pB0, pB1, m_reg, mnB, alB);
  __syncthreads(); RESC(alB);
  finishSM(pB0, pB1, alB, l_reg, pa0, pa1, pa2, pa3); SBAR();
  pv_d0(o, vb0 + (int)SHM_V, pa0, pa1, pa2, pa3);
  if (hi == 0) li_l[r32] = l_reg; asm volatile("s_waitcnt lgkmcnt(0)" ::: "memory");
  float rli[16];
#pragma unroll
  for (int r = 0; r < 16; ++r) rli[r] = __builtin_amdgcn_rcpf(li_l[crow(r, hi)]);
  unsigned ob = (unsigned)(4 * hi * ldo + r32); asm volatile("" : "+v"(ob));
#pragma unroll
  for (int r = 0; r < 16; ++r) { const int orow0 = crow(r, 0);
#pragma unroll
    for (int d0 = 0; d0 < 4; ++d0) Ow[ob + (unsigned)(orow0 * ldo + d0 * 32)] = (unsigned char)(__builtin_amdgcn_cvt_pk_fp8_f32(__builtin_amdgcn_fmed3f(o[d0][r] * rli[r] * F8_MSCALE, -448.f, 448.f), 0.f, 0, false) & 0xff); }
  __syncthreads();
#undef SLOAD
#undef SWRITE
#undef SWAIT
#undef RESC
#undef MASKW
}
#undef KSWZ
#undef SBAR
}

__device__ __forceinline__ void ph4a_unit(const Args& a, LAS unsigned char* lds, int tid, int wave, int lane, int b, int ci, int p0, int np) {
    const bf16* IQ = (const bf16*)(a.ws + WS_IQ); const bf16* IK = (const bf16*)(a.ws + WS_IK); const float* IW = (const float*)(a.ws + WS_IW); float* SC = (float*)(a.ws + WS_SC);
    const int tok0 = b * SEQ + ci * CHUNK;
    __syncthreads();
    for (int i = tid; i < 64 * 128; i += NTHR) { const int q = i >> 7, ch = i & 127, head = ch >> 3, c8 = ch & 7;
        const v4u v = *(const v4u*)(IQ + ((size_t)tok0 + q) * 1024 + ch * 8);
        *(LAS v4u*)(lds + q * 2048 + ((head ^ ((q >> 3) & 1)) * 128) + ((c8 ^ (q & 7)) * 16)) = v; }
    __syncthreads();
    const int qt = wave & 1, q = qt * 32 + (lane & 31), hh = lane >> 5; const size_t tokq = (size_t)tok0 + q;
    float wgt[16];
#pragma unroll
    for (int h4 = 0; h4 < 4; ++h4) { const f32x4 w4 = *(const f32x4*)(IW + tokq * 16 + 4 * h4); wgt[4 * h4] = w4[0]; wgt[4 * h4 + 1] = w4[1]; wgt[4 * h4 + 2] = w4[2]; wgt[4 * h4 + 3] = w4[3]; }
    const LAS unsigned char* qb = lds + q * 2048; const int hx = ((q >> 3) & 1) * 128; int offk[4];
#pragma unroll
    for (int kk = 0; kk < 4; ++kk) offk[kk] = ((2 * kk + hh) ^ (q & 7)) * 16;
    int it = wave >> 1;
    bf16x8 ak[2][4];
    if (it < np) { const bf16* kp = IK + ((size_t)b * SEQ + (p0 + it) * 64 + (lane & 31)) * 64 + hh * 8;
#pragma unroll
        for (int kk = 0; kk < 4; ++kk) { ak[0][kk] = *(const bf16x8*)(kp + kk * 16); ak[1][kk] = *(const bf16x8*)(kp + 32 * 64 + kk * 16); } }
    for (; it < np; it += 4) {
        bf16x8 an[2][4]; const bool more = it + 4 < np;
        { const int itn = more ? it + 4 : it; const bf16* kp = IK + ((size_t)b * SEQ + (p0 + itn) * 64 + (lane & 31)) * 64 + hh * 8;
#pragma unroll
          for (int kk = 0; kk < 4; ++kk) { an[0][kk] = *(const bf16x8*)(kp + kk * 16); an[1][kk] = *(const bf16x8*)(kp + 32 * 64 + kk * 16); } }
        float s0[16], s1[16];
#pragma unroll
        for (int i = 0; i < 16; ++i) { s0[i] = 0.f; s1[i] = 0.f; }
        bf16x8 bfc[4]; f32x16 a0, a1;
#pragma unroll
        for (int kk = 0; kk < 4; ++kk) bfc[kk] = *(const LAS bf16x8*)(qb + hx + offk[kk]);
#pragma unroll
        for (int i = 0; i < 16; ++i) { a0[i] = 0.f; a1[i] = 0.f; }
#pragma unroll
        for (int kk = 0; kk < 4; ++kk) { a0 = __builtin_amdgcn_mfma_f32_32x32x16_bf16(ak[0][kk], bfc[kk], a0, 0, 0, 0); a1 = __builtin_amdgcn_mfma_f32_32x32x16_bf16(ak[1][kk], bfc[kk], a1, 0, 0, 0); }
#pragma unroll
        for (int kk = 0; kk < 4; ++kk) bfc[kk] = *(const LAS bf16x8*)(qb + ((1 * 128) ^ hx) + offk[kk]);
#pragma unroll
        for (int h = 0; h < 16; ++h) { f32x16 b0, b1; bf16x8 bfn[4];
            if (h + 1 < 16) {
#pragma unroll
                for (int i = 0; i < 16; ++i) { b0[i] = 0.f; b1[i] = 0.f; }
#pragma unroll
                for (int kk = 0; kk < 4; ++kk) { b0 = __builtin_amdgcn_mfma_f32_32x32x16_bf16(ak[0][kk], bfc[kk], b0, 0, 0, 0); b1 = __builtin_amdgcn_mfma_f32_32x32x16_bf16(ak[1][kk], bfc[kk], b1, 0, 0, 0); }
                if (h + 2 < 16) { const int hb = ((h + 2) * 128) ^ hx;
#pragma unroll
                    for (int kk = 0; kk < 4; ++kk) bfn[kk] = *(const LAS bf16x8*)(qb + hb + offk[kk]); } }
            __builtin_amdgcn_sched_barrier(0);
            const float wh = wgt[h];
#pragma unroll
            for (int i = 0; i < 16; ++i) { s0[i] = fmaf(wh, fmaxf(a0[i], 0.f), s0[i]); asm volatile("" : "+v"(s0[i])); s1[i] = fmaf(wh, fmaxf(a1[i], 0.f), s1[i]); asm volatile("" : "+v"(s1[i])); }
            if (h + 1 < 16) { a0 = b0; a1 = b1; }
            if (h + 2 < 16) {
#pragma unroll
                for (int kk = 0; kk < 4; ++kk) bfc[kk] = bfn[kk]; }
            __builtin_amdgcn_sched_barrier(0); }
        float* op = SC + tokq * 2048 + (p0 + it) * 64 + 4 * hh;
#pragma unroll
        for (int i4 = 0; i4 < 4; ++i4) { *(f32x4*)(op + 8 * i4) = (f32x4){s0[4 * i4], s0[4 * i4 + 1], s0[4 * i4 + 2], s0[4 * i4 + 3]};
            *(f32x4*)(op + 32 + 8 * i4) = (f32x4){s1[4 * i4], s1[4 * i4 + 1], s1[4 * i4 + 2], s1[4 * i4 + 3]}; }
#pragma unroll
        for (int kk = 0; kk < 4; ++kk) { ak[0][kk] = an[0][kk]; ak[1][kk] = an[1][kk]; }
    }
}
__device__ __forceinline__ void ph4a_decode(int u, int& b, int& ci, int& p0, int& np) {
    if (u < 128) { b = u & 7; ci = 16 + (u >> 3); p0 = 0; np = 16; }
    else { const int v = 16 - ((u - 128) >> 4), w = (u - 128) & 15; b = w & 7; if (w >> 3) { ci = 15 + v; p0 = 16; np = v; } else { ci = v - 1; p0 = 0; np = v; } }
}
__device__ __forceinline__ void ph4a_body(const Args& a, LAS unsigned char* lds, int tid, int wave, int lane, int G, int bid) {
    int b, ci, p0, np;
    if (G == 256) { ph4a_decode(bid, b, ci, p0, np); ph4a_unit(a, lds, tid, wave, lane, b, ci, p0, np);
        if (bid >= 128) { ph4a_decode(511 - bid, b, ci, p0, np); ph4a_unit(a, lds, tid, wave, lane, b, ci, p0, np); } }
    else for (int u = bid; u < 384; u += G) { ph4a_decode(u, b, ci, p0, np); ph4a_unit(a, lds, tid, wave, lane, b, ci, p0, np); }
    __syncthreads();
}
template <int NVM> __device__ __forceinline__ int cnt_ge(const unsigned (&key)[32], unsigned cand) {
    unsigned c0 = 0, c1 = 0, c2 = 0, c3 = 0;
#pragma unroll
    for (int i = 0; i < NVM; i += 4) {
        asm("v_cmp_ge_u32 vcc, %1, %2\n\tv_addc_co_u32 %0, vcc, 0, %0, vcc" : "+v"(c0) : "v"(key[i]), "v"(cand) : "vcc");
        asm("v_cmp_ge_u32 vcc, %1, %2\n\tv_addc_co_u32 %0, vcc, 0, %0, vcc" : "+v"(c1) : "v"(key[i + 1]), "v"(cand) : "vcc");
        asm("v_cmp_ge_u32 vcc, %1, %2\n\tv_addc_co_u32 %0, vcc, 0, %0, vcc" : "+v"(c2) : "v"(key[i + 2]), "v"(cand) : "vcc");
        asm("v_cmp_ge_u32 vcc, %1, %2\n\tv_addc_co_u32 %0, vcc, 0, %0, vcc" : "+v"(c3) : "v"(key[i + 3]), "v"(cand) : "vcc"); }
    const unsigned c = (c0 + c1) + (c2 + c3);
    int tot = 0;
#pragma unroll
    for (int b = 0; b < 6; ++b) tot += __builtin_popcountll(__ballot((c >> b) & 1u)) << b;
    return tot;
}
template <int NVM> __device__ __forceinline__ unsigned sel_thr(const unsigned (&key)[32]) {
    unsigned Tt = 0u;
    for (int bit = 31; bit >= 0; --bit) { const unsigned cand = Tt | (1u << bit); const int cnt = cnt_ge<NVM>(key, cand);
        if (cnt >= TOPK) { Tt = cand; if (cnt == TOPK) break; } }
    return Tt;
}
__device__ __forceinline__ void ph4b_body(const Args& a, int wave, int lane, int G, int bid) {
    const float* SC = (const float*)(a.ws + WS_SC); unsigned long long* SEL = (unsigned long long*)(a.ws + WS_SEL);
    const int gw = bid * NWAVES + wave, NGW = G * NWAVES;
    float raw[32]; unsigned key[32];
#define SEL_ROW(idx, row, nv) const int bb_ = (idx) >> 11; int t_ = (idx) & 2047; if (bb_ & 1) t_ = 2047 - t_; const size_t row = (size_t)bb_ * SEQ + t_; const int nv = (t_ >> 6) + 1;
    int idx = gw;
    if (idx < T) { SEL_ROW(idx, row, nv) const float* sp = SC + row * 2048 + lane;
#pragma unroll
        for (int i = 0; i < 32; ++i) raw[i] = sp[64 * (i < nv ? i : nv - 1)]; }
    for (; idx < T; idx += NGW) {
        SEL_ROW(idx, row, nv)
#pragma unroll
        for (int i = 0; i < 32; ++i) { const unsigned uu = __float_as_uint(raw[i]); const unsigned kk = (uu & 0x80000000u) ? ~uu : (uu | 0x80000000u); key[i] = (i < nv) ? kk : 0u; }
        if (idx + NGW < T) { SEL_ROW(idx + NGW, rown, nvn) const float* sp = SC + rown * 2048 + lane;
#pragma unroll
            for (int i = 0; i < 32; ++i) raw[i] = sp[64 * (i < nvn ? i : nvn - 1)]; }
        unsigned Tt = 0u;
        if (nv > 4) { if (nv <= 8) Tt = sel_thr<8>(key); else if (nv <= 16) Tt = sel_thr<16>(key); else if (nv <= 24) Tt = sel_thr<24>(key); else Tt = sel_thr<32>(key); }
        unsigned long long myw = 0ull;
#pragma unroll
        for (int i = 0; i < 32; ++i) { const unsigned long long bm = __ballot(key[i] >= Tt); if (lane == i) myw = bm; }
        if (lane < nv) SEL[row * 32 + lane] = myw;
    }
#undef SEL_ROW
}

__device__ __forceinline__ void ph5_body(const Args& a, char* ldsg, int wave, int lane, int G, int bid) {
    const bf16* Q = (const bf16*)(a.ws + WS_Q); const bf16* K = (const bf16*)(a.ws + WS_K); const bf16* V = (const bf16*)(a.ws + WS_V);
    const unsigned* SELW = (const unsigned*)(a.ws + WS_SEL); unsigned char* YA = (unsigned char*)(a.ws + WS_YA);
    for (int L = bid; L < NB * NCHUNK * NKVH; L += G) {
        const int Lr = L & 255, ci = (L < 256) ? 31 - (Lr >> 4) : (Lr >> 4), b = (Lr >> 1) & 7, g = Lr & 1;
        const int head = g * 4 + (wave >> 1), qpos = ci * 64 + (wave & 1) * 32 + (lane & 31); const size_t tokq = (size_t)b * SEQ + qpos;
        const int NTreal = ci + 1, NT = NTreal + (NTreal & 1);
        const float nslope = -1.4426950408889634f * exp2f(-(float)(head + 1));
        att::attn_unit(Q + tokq * 1024 + head * 128 + (lane >> 5) * 8, K + (size_t)b * SEQ * 256 + g * 128, V + (size_t)b * SEQ * 256 + g * 128,
                       YA + ((size_t)b * SEQ + ci * 64 + (wave & 1) * 32) * 2048 + head * 128, 2048, SELW + ((size_t)b * SEQ + ci * 64) * 64, (unsigned)(((wave & 1) * 32 + (lane & 31)) * 64), qpos, nslope, NT, NTreal, ldsg);
    }
}

__device__ __forceinline__ void ph7_body(const Args& a, int tid, int G, int bid) {
    const float* POW = (const float*)(a.ws + WS_POW); const float* SBUF = (const float*)(a.ws + WS_SBUF); bf16* UA = (bf16*)(a.ws + WS_UA);
    for (int idx = (tid < 128 ? bid * 128 + tid : SSMG * NB * SSMN); idx < SSMG * NB * SSMN; idx += G * 128) {
        const int n = idx & 63, b = (idx >> 6) & 7, g = idx >> 9;
        const float ar = POW[(((size_t)g * 65 + SL) * 64 + n) * 2], ai = POW[(((size_t)g * 65 + SL) * 64 + n) * 2 + 1];
        float hr = 0.f, hi = 0.f;
#pragma unroll 1
        for (int c0 = 0; c0 < NSC; c0 += 64) {
            f32x2 sv[64];
#pragma unroll
            for (int c = 0; c < 64; ++c) sv[c] = *(const f32x2*)(SBUF + ((size_t)g * SROWS + b * NSC + c0 + c) * 128 + 2 * n);
#pragma unroll
            for (int c = 0; c < 64; ++c) { const size_t row = (size_t)g * SROWS + b * NSC + c0 + c;
                *(unsigned*)(UA + row * UA_LD + SL * 16 + 2 * n) = pk2(hr, hi);
                const float nr = ar * hr - ai * hi + sv[c][0], ni = ar * hi + ai * hr + sv[c][1]; hr = nr; hi = ni; }
        }
    }
}

__device__ __forceinline__ void ph12_body(const Args& a, LAS unsigned char* lds, int tid, int wave, int lane, int G, int bid, size_t alt) {
    const bf16* X1 = (const bf16*)(a.ws + WS_X1); const float* WRP = (const float*)(a.ws + WS_WRP); const float* BRP = (const float*)(a.ws + WS_BRP); float* RSTD = (float*)(a.ws + (alt ? WS_SC : WS_RSTD));
    unsigned* CNT = (unsigned*)(a.ws + WS_CTL) + CW_CNT + (alt ? 64 : 0); int* ASGE = (int*)(a.ws + (alt ? WS_SC + MiB : WS_ASGE)); int* ASGP = (int*)(a.ws + (alt ? WS_SC + 2 * MiB : WS_ASGP));
    int* LIST = (int*)(a.ws + (alt ? WS_SC + 4 * MiB : WS_LIST)); float* GLIST = (float*)(a.ws + (alt ? WS_SC + 8 * MiB : WS_GLIST)); unsigned char* XS = (unsigned char*)(a.ws + (alt ? WS_SC + 16 * MiB : WS_XS));
    const float* MOD = (const float*)(a.ws + WS_MOD); const float* g2 = a.in[I_N2G];
    LAS float* xs = (LAS float*)lds;
    LAS float* part = (LAS float*)(lds + 65792); LAS float* logit = (LAS float*)(lds + 65792 + 32768);
    LAS float* rstdL = (LAS float*)(lds + 65792 + 32768 + 4352); LAS unsigned* lcnt = (LAS unsigned*)(rstdL + 32); LAS unsigned* base = lcnt + 32;
    for (int tile = bid; tile < T / 32; tile += G) {
        const int t0 = tile * 32, b = t0 >> 11; const int lrow = tid >> 4, cg = tid & 15;
        f32x16 acc;
#pragma unroll
        for (int i = 0; i < 16; ++i) acc[i] = 0.f;
        float ss = 0.f;
        if (tid < 32) lcnt[tid] = 0u;
        for (int ch = 0; ch < 4; ++ch) {
            f32x4 v[8]; const v2u* xr = (const v2u*)(X1 + (size_t)(t0 + lrow) * DM + ch * 512) + cg;
#pragma unroll
            for (int j = 0; j < 8; ++j) { const v2u w = xr[16 * j]; v[j] = (f32x4){bflo(w.x), bfhi(w.x), bflo(w.y), bfhi(w.y)}; ss += (v[j][0] * v[j][0] + v[j][1] * v[j][1]) + (v[j][2] * v[j][2] + v[j][3] * v[j][3]); }
            float wv[32]; const float* wp = WRP + (size_t)b * (DM * NEXP) + (size_t)(ch * 512 + 64 * wave + (lane >> 5)) * NEXP + (lane & 31);
#pragma unroll
            for (int q = 0; q < 32; ++q) wv[q] = wp[2 * q * NEXP];
            __syncthreads();
#pragma unroll
            for (int j = 0; j < 8; ++j)
#pragma unroll
                for (int e = 0; e < 4; ++e) xs[lrow * 513 + cg * 4 + 64 * j + e] = v[j][e];
            __syncthreads();
            const LAS float* xq = xs + (lane & 31) * 513 + 64 * wave + (lane >> 5);
#pragma unroll
            for (int q = 0; q < 32; ++q) acc = __builtin_amdgcn_mfma_f32_32x32x2f32(xq[2 * q], wv[q], acc, 0, 0, 0);
        }
        ss += __shfl_xor(ss, 1); ss += __shfl_xor(ss, 2); ss += __shfl_xor(ss, 4); ss += __shfl_xor(ss, 8);
        if (cg == 0) { const float rstd = 1.0f / sqrtf(ss * (1.0f / DM) + RMS_EPS); rstdL[lrow] = rstd; RSTD[t0 + lrow] = rstd; }
#pragma unroll
        for (int i = 0; i < 16; ++i) part[(wave * 16 + i) * 64 + lane] = acc[i];
        __syncthreads();
#pragma unroll
        for (int z = 0; z < 2; ++z) { const int o = tid + 512 * z, tk = o >> 5, e = o & 31, hh = (tk >> 2) & 1, i = (tk & 3) + 4 * (tk >> 3), ln = e + 32 * hh; float s = 0.f;
#pragma unroll
            for (int w = 0; w < 8; ++w) s += part[(w * 16 + i) * 64 + ln];
            logit[tk * 33 + e] = rstdL[tk] * s + BRP[b * 32 + e]; }
        __syncthreads();
        LAS float* selv = (LAS float*)(base + 32);
        int rk[4]; float mv[4], gt[4]; unsigned rr[4];
        const int ex = lane & 31;
#pragma unroll
        for (int j = 0; j < 4; ++j) { const int tk = wave * 4 + j; const float v = logit[tk * 33 + ex]; int r = 0;
#pragma unroll
            for (int e2 = 0; e2 < 32; ++e2) { const float u = logit[tk * 33 + e2]; r += ((u > v) || (u == v && e2 < ex)) ? 1 : 0; }
            rk[j] = r; mv[j] = v; if (lane < 32 && r < 4) selv[tk * 4 + r] = v; }
        LDS_WAIT(); asm volatile("" ::: "memory");
#pragma unroll
        for (int j = 0; j < 4; ++j) { const int tk = wave * 4 + j; gt[j] = 0.f; rr[j] = 0u;
            if (lane < 32 && rk[j] < 4) { const float v0 = selv[tk * 4], v1 = selv[tk * 4 + 1], v2 = selv[tk * 4 + 2], v3 = selv[tk * 4 + 3];
                const float den = 1.0f + expf(v1 - v0) + expf(v2 - v0) + expf(v3 - v0); gt[j] = expf(mv[j] - v0) / den;
                rr[j] = __hip_atomic_fetch_add(lcnt + ex, 1u, __ATOMIC_RELAXED, __HIP_MEMORY_SCOPE_WORKGROUP); } }
        __syncthreads();
        if (tid < 32) base[tid] = __hip_atomic_fetch_add(CNT + tid, lcnt[tid], RLX_AGENT);
        __syncthreads();
#pragma unroll
        for (int j = 0; j < 4; ++j) if (lane < 32 && rk[j] < 4) { const int tk = t0 + wave * 4 + j, as = tk * 4 + rk[j], pos = (int)(base[ex] + rr[j]); ASGE[as] = ex; ASGP[as] = pos;
            if (pos < T) { LIST[ex * T + pos] = tk; GLIST[ex * T + pos] = gt[j]; } }
        { const f32x4* gp = (const f32x4*)g2 + 2 * lane; const f32x4* shp = (const f32x4*)(MOD + (size_t)b * MODW + 3 * DM) + 2 * lane; const f32x4* scp = (const f32x4*)(MOD + (size_t)b * MODW + 4 * DM) + 2 * lane;
          v4u xw[4][4]; f32x4 pa[8], pb[8];
#pragma unroll
          for (int j = 0; j < 4; ++j) { const v4u* xr = (const v4u*)(X1 + (size_t)(t0 + wave * 4 + j) * DM) + lane;
#pragma unroll
              for (int q = 0; q < 4; ++q) xw[j][q] = xr[64 * q]; }
#pragma unroll
          for (int q = 0; q < 4; ++q)
#pragma unroll
              for (int h = 0; h < 2; ++h) { pa[2 * q + h] = gp[128 * q + h] * (scp[128 * q + h] + 1.0f) * F8_ASCALE; pb[2 * q + h] = shp[128 * q + h] * F8_ASCALE; }
#pragma unroll
          for (int j = 0; j < 4; ++j) { const int tk = wave * 4 + j; const float rstd = rstdL[tk]; v2u o[4];
#pragma unroll
              for (int q = 0; q < 4; ++q) { const v4u w = xw[j][q]; const f32x4 x0 = {bflo(w.x), bfhi(w.x), bflo(w.y), bfhi(w.y)}, x1 = {bflo(w.z), bfhi(w.z), bflo(w.w), bfhi(w.w)};
                  const f32x4 y0 = (x0 * rstd) * pa[2 * q] + pb[2 * q], y1 = (x1 * rstd) * pa[2 * q + 1] + pb[2 * q + 1];
                  o[q].x = pk4_fp8(y0[0], y0[1], y0[2], y0[3]); o[q].y = pk4_fp8(y1[0], y1[1], y1[2], y1[3]); }
              v2u* dst = (v2u*)(XS + (size_t)(t0 + tk) * DM) + lane;
#pragma unroll
              for (int q = 0; q < 4; ++q) dst[64 * q] = o[q]; } }
        __syncthreads();
    }
}

constexpr int LDS_MOE = RING_BYTES + 1024;
__device__ __forceinline__ void moe_tables(const Args& a, LAS unsigned char* lds, int tid) {
    LAS int* off = (LAS int*)(lds + LDS_MOE); LAS int* cnt = off + 32; LAS int* nrbp = off + 64; LAS int* rbe = off + 96;
    if (tid < 32) {
        unsigned* CNT = (unsigned*)(a.ws + WS_CTL) + CW_CNT; const int c = (int)__hip_atomic_load(CNT + tid, RLX_AGENT), nb = (c + 255) >> 8; int inc = nb;
#pragma unroll
        for (int d = 1; d < 32; d <<= 1) { const int t = __shfl_up(inc, d); if (tid >= d) inc += t; }
        const int ex = inc - nb; cnt[tid] = c; off[tid] = ex * 256;
        for (int q = 0; q < nb; ++q) if (ex + q < 320) rbe[ex + q] = tid;
        if (tid == 31) nrbp[0] = inc < 288 ? inc : 288; }
    __syncthreads();
}
constexpr int LDS_ROWS = RING_BYTES + 3072, ROWS_CAP = (LDS_BYTES - LDS_ROWS) / 512;
template <class Sched> __device__ __forceinline__ void moe_rows(const Args& a, LAS unsigned char* lds, int tid, const Sched& S) {
    const LAS int* off = (const LAS int*)(lds + LDS_MOE); const LAS int* cnt = off + 32; const int* LIST = (const int*)(a.ws + WS_LIST);
    LAS unsigned short* rows = (LAS unsigned short*)(lds + LDS_ROWS);
    pg8::Unit u;
    for (int i = 0; i < ROWS_CAP && S.next(i, u); ++i) { const int e = (u.pn >> 4) & 31, idx = (u.pm - (off[e] >> 8)) * 256 + (tid & 255);
        if (tid < 256) { int tok = (idx >= 0 && idx < cnt[e] && idx < T) ? LIST[e * T + idx] : 0; rows[i * 256 + tid] = (unsigned short)min(max(tok, 0), T - 1); } }
    __syncthreads();
}

typedef float f32x2v __attribute__((ext_vector_type(2)));
__device__ __forceinline__ void ph16_acc8(f32x4& a0, f32x4& a1, v2u w) {
    const f32x2v p0 = __builtin_amdgcn_cvt_pk_f32_fp8((int)w.x, false), p1 = __builtin_amdgcn_cvt_pk_f32_fp8((int)w.x, true), p2 = __builtin_amdgcn_cvt_pk_f32_fp8((int)w.y, false), p3 = __builtin_amdgcn_cvt_pk_f32_fp8((int)w.y, true);
    a0[0] += p0[0]; a0[1] += p0[1]; a0[2] += p1[0]; a0[3] += p1[1]; a1[0] += p2[0]; a1[1] += p2[1]; a1[2] += p3[0]; a1[3] += p3[1];
}
#define PH16_SLOT(k) min(max(off[ASGE[row * 4 + (k)] & 31] + ASGP[row * 4 + (k)], 0), MOE_ROWS - 1)
__device__ __forceinline__ void ph16_row(const LAS int* off, const int* ASGE, const int* ASGP, const unsigned char* YE, const bf16* X1, int row, int lane, f32x4 (&acc)[8], f32x4 (&xv)[8]) {
    const int s0 = PH16_SLOT(0), s1 = PH16_SLOT(1), s2 = PH16_SLOT(2), s3 = PH16_SLOT(3);
    const v2u* y0 = (const v2u*)(YE + (size_t)s0 * DM) + lane; const v2u* y1 = (const v2u*)(YE + (size_t)s1 * DM) + lane; const v2u* y2 = (const v2u*)(YE + (size_t)s2 * DM) + lane; const v2u* y3 = (const v2u*)(YE + (size_t)s3 * DM) + lane;
    const v4u* xi = (const v4u*)(X1 + (size_t)row * DM) + lane;
#pragma unroll
    for (int j = 0; j < 4; ++j) { const v2u w0 = y0[64 * j], w1 = y1[64 * j], w2 = y2[64 * j], w3 = y3[64 * j]; const v4u xw = xi[64 * j];
        acc[2 * j] = (f32x4){0.f, 0.f, 0.f, 0.f}; acc[2 * j + 1] = (f32x4){0.f, 0.f, 0.f, 0.f};
        ph16_acc8(acc[2 * j], acc[2 * j + 1], w0); ph16_acc8(acc[2 * j], acc[2 * j + 1], w1); ph16_acc8(acc[2 * j], acc[2 * j + 1], w2); ph16_acc8(acc[2 * j], acc[2 * j + 1], w3);
        acc[2 * j] = acc[2 * j] * (1.0f / F8_YSCALE); acc[2 * j + 1] = acc[2 * j + 1] * (1.0f / F8_YSCALE);
        xv[2 * j] = (f32x4){bflo(xw.x), bfhi(xw.x), bflo(xw.y), bfhi(xw.y)}; xv[2 * j + 1] = (f32x4){bflo(xw.z), bfhi(xw.z), bflo(xw.w), bfhi(xw.w)}; }
}
__device__ __forceinline__ void ph16_body(const Args& a, LAS unsigned char* lds, int tid, int wave, int lane, int G, int bid, float* OUT) {
    moe_tables(a, lds, tid); const LAS int* off = (const LAS int*)(lds + LDS_MOE);
    const float* MOD = (const float*)(a.ws + WS_MOD); const int* ASGE = (const int*)(a.ws + WS_ASGE); const int* ASGP = (const int*)(a.ws + WS_ASGP); const unsigned char* YE = (const unsigned char*)(a.ws + WS_YE); const bf16* X1 = (const bf16*)(a.ws + WS_X1);
    const int gw = bid * NWAVES + wave, NGW = G * NWAVES;
    for (int row = gw; row < T; row += 2 * NGW) {
        const int rowB = row + NGW; const bool hasB = rowB < T;
        f32x4 aA[8], xA[8], aB[8], xB[8];
        ph16_row(off, ASGE, ASGP, YE, X1, row, lane, aA, xA);
        if (hasB) ph16_row(off, ASGE, ASGP, YE, X1, rowB, lane, aB, xB);
        { const f32x4* gp = (const f32x4*)(MOD + (size_t)(row >> 11) * MODW + 5 * DM) + 2 * lane; f32x4* xo = (f32x4*)(OUT + (size_t)row * DM) + 2 * lane;
#pragma unroll
          for (int j = 0; j < 4; ++j) { xo[128 * j] = xA[2 * j] + gp[128 * j] * aA[2 * j]; xo[128 * j + 1] = xA[2 * j + 1] + gp[128 * j + 1] * aA[2 * j + 1]; } }
        if (hasB) { const f32x4* gp = (const f32x4*)(MOD + (size_t)(rowB >> 11) * MODW + 5 * DM) + 2 * lane; f32x4* xo = (f32x4*)(OUT + (size_t)rowB * DM) + 2 * lane;
#pragma unroll
          for (int j = 0; j < 4; ++j) { xo[128 * j] = xB[2 * j] + gp[128 * j] * aB[2 * j]; xo[128 * j + 1] = xB[2 * j + 1] + gp[128 * j + 1] * aB[2 * j + 1]; } }
    }
}

#ifndef PROBE_REP
#define PROBE_REP 0
#endif
#ifndef MK_ONE_LAUNCH
#define MK_ONE_LAUNCH 1
#endif
constexpr int NPH = 13;
__global__ void __launch_bounds__(NTHR, 2) fwd(Args args) {
    extern __shared__ __attribute__((aligned(16))) unsigned char lds_raw[];
    LAS unsigned char* lds = (LAS unsigned char*)lds_raw;
    const int tid = threadIdx.x, lane = tid & 63, wave = __builtin_amdgcn_readfirstlane(tid >> 6);
    const int G = gridDim.x, bid = blockIdx.x;
    volatile LAS unsigned* MISC = (volatile LAS unsigned*)(lds + MISC_OFF);
    for (int u = tid; u < (LDS_BYTES - LDSCTL_OFF) / 4; u += NTHR) ((LAS unsigned*)(lds + LDSCTL_OFF))[u] = 0u;
    __syncthreads();
    unsigned char* ws = args.ws;
    unsigned* ctl = (unsigned*)(ws + WS_CTL);
    const int lo = args.ph_lo, hi = args.ph_hi;
    XcdBarrier bar; bar.bar = ctl + CW_BAR; bar.x = 0; bar.st = nullptr;
    if (hi - lo > 1) bar = xcd_barrier_post(ctl + CW_BAR, MISC + 8);
#define IN(k) (lo <= (k) && (k) < hi)
#define REPS(k) _Pragma("unroll") for (int rep_ = 0; rep_ < 1 + ((PROBE_REP >> (k)) & 1); ++rep_)
#define SEAM(k) do { if (IN(k) && IN((k) + 1)) xcd_barrier(bar); } while (0)

    if (IN(0)) REPS(0) { ph0_ssm_consts(args, tid, G, (bid + 8) % G);
         ph0_adaln(args, lds, tid, G, bid); }
    SEAM(0);
    if (IN(1)) REPS(1) {
        if (bid & 1) { ph1_small(args, tid, wave, lane, G, bid); bts_body(args, tid, G, bid); ph0_transposes(args, lds, wave, lane, G, bid); ph1_norm(args, wave, lane, G, bid); }
        else { ph1_norm(args, wave, lane, G, bid); ph0_transposes(args, lds, wave, lane, G, bid); ph1_small(args, tid, wave, lane, G, bid); bts_body(args, tid, G, bid); } __syncthreads(); }
    SEAM(1);
    if (IN(2)) REPS(2) {
        const int Gg = (G > 2 * NCONV) ? G - NCONV : G;
        if (bid < Gg) {
            { pg8::Gemm g{(const bf16*)(ws + WS_HN), (const bf16*)(ws + WS_WIN), DM, DM, DM}; pg8::StaticOrder S; S.init(T, 2560, Gg, bid);
              EpiInProjA E{(bf16*)(ws + WS_Q), (bf16*)(ws + WS_K), (bf16*)(ws + WS_IQ), (bf16*)(ws + WS_IK), (float*)(ws + WS_IW)};
              pg8::gemm_phase<EpiInProjA, pg8::StaticOrder, true, true>(lds, g, S, E); }
            { pg8::Gemm g{(const bf16*)(ws + WS_HN8), (const bf16*)(ws + WS_WIN8), DM / 2, DM / 2, DM / 2}; pg8::StaticOrder S; S.init(T, 5376, Gg, bid);
              EpiInProjB E{(bf16*)(ws + WS_V), (bf16*)(ws + WS_UA), (unsigned char*)(ws + WS_GATES)};
              pg8::gemm_phase<EpiInProjB, pg8::StaticOrder, true, true, true>(lds, g, S, E); } }
        cv_queue(args, lds, wave, lane); }
    SEAM(2);
    if (IN(3)) REPS(3) {
        ph4a_body(args, lds, tid, wave, lane, G, bid);
        { pg8::Gemm g{(const bf16*)(ws + WS_UA), (const bf16*)(ws + WS_BTS), UA_LD, SL * 16, SL * 16}; SsmSOrder S{G, (G - 1) - bid}; EpiSsmS E{(float*)(ws + WS_SBUF)};
          pg8::gemm_phase<EpiSsmS, SsmSOrder, true, true>(lds, g, S, E); }
        qknorm_body(args, wave, lane, G, bid); bty_body(args, tid, G, bid); }
    SEAM(3);
    if (IN(4)) REPS(4) { ph4b_body(args, wave, lane, G, bid); ph7_body(args, tid, G, bid); }
    SEAM(4);
    if (IN(5)) REPS(5) {
        ph5_body(args, (char*)lds_raw, wave, lane, G, bid);
        { pg8::Gemm g{(const bf16*)(ws + WS_UA), (const bf16*)(ws + WS_BTY), UA_LD, UA_LD, UA_LD}; SsmYOrder S{G, bid}; EpiSsmY E{(bf16*)(ws + WS_YG)};
          pg8::gemm_phase<EpiSsmY, SsmYOrder, true, true>(lds, g, S, E); } }
    SEAM(5);
    if (IN(6)) REPS(6) {
        pg8::Gemm g{(const bf16*)(ws + WS_YG), (const bf16*)(ws + WS_WGLU), 1024, 1024, 1024}; pg8::StaticOrder S; S.init(T, 1024, G, bid);
        EpiGlu E{(const bf16*)(ws + WS_YG), (unsigned char*)(ws + WS_YA + 1024), args.in[I_BGLU]};
        pg8::gemm_phase<EpiGlu, pg8::StaticOrder, true, true>(lds, g, S, E); }
    SEAM(6);
    if (IN(7)) REPS(7) {
        pg8::StaticOrder S; S.init(T, DM, G, bid);
        pg8::Gemm g{(const bf16*)(ws + WS_YA), (const bf16*)(ws + WS_WA), 1024, 1024, 1024}; EpiProjAB E{(const unsigned char*)(ws + WS_GATES), (unsigned char*)(ws + WS_MG)};
        pg8::gemm_phase<EpiProjAB, pg8::StaticOrder, true, true, true>(lds, g, S, E); }
    SEAM(7);
    if (IN(8)) REPS(8) {
        pg8::Gemm g{(const bf16*)(ws + WS_MG), (const bf16*)(ws + WS_WO), DM / 2, DM / 2, DM / 2}; pg8::StaticOrder S; S.init(T, DM, G, bid);
        EpiOut E{args.in[I_X], (const float*)(ws + WS_MOD), (bf16*)(ws + WS_X1)};
        pg8::gemm_phase<EpiOut, pg8::StaticOrder, true, true, true>(lds, g, S, E); }
    SEAM(8);
    if (IN(9)) REPS(9) ph12_body(args, lds, tid, wave, lane, G, bid, (size_t)rep_);
    SEAM(9);
    if (IN(10)) REPS(10) {
        moe_tables(args, lds, tid);
        const LAS int* mt = (const LAS int*)(lds + LDS_MOE); MoeOrder S{mt + 96, mt[64], 4, G, bid};
        moe_rows(args, lds, tid, S);
        pg8::Gemm g{(const bf16*)(ws + WS_XS), (const bf16*)(ws + WS_WGU), DM / 2, DM / 2, DM / 2, (const LAS unsigned short*)(lds + LDS_ROWS)}; EpiGateUp E{args.in[I_BGU], (unsigned char*)(ws + WS_ACT)};
        pg8::gemm_phase<EpiGateUp, MoeOrder, true, true, true, true>(lds, g, S, E); }
    SEAM(10);
    if (IN(11)) REPS(11) {
        moe_tables(args, lds, tid);
        const LAS int* mt = (const LAS int*)(lds + LDS_MOE); MoeOrder S{mt + 96, mt[64], 3, G, bid};
        pg8::Gemm g{(const bf16*)(ws + WS_ACT), (const bf16*)(ws + WS_WD), DM / 2, DM / 2, DM / 2}; EpiDown E{args.in[I_BD], (const float*)(ws + WS_GLIST), mt, (unsigned char*)(ws + WS_YE)};
        pg8::gemm_phase<EpiDown, MoeOrder, true, true, true>(lds, g, S, E); }
    SEAM(11);
    if (IN(12)) REPS(12) ph16_body(args, lds, tid, wave, lane, G, bid, rep_ ? (float*)(ws + WS_SC) : args.out);
#if defined(PROBE_BAR)
    if (hi - lo > 1) { _Pragma("unroll 1") for (int q = 0; q < PROBE_BAR; ++q) xcd_barrier(bar); }
#endif
#undef IN
#undef SEAM
}

extern "C" void kernel_launch(void* const* d_in, const int* in_sizes, int n_in, void* d_out, int out_size, void* d_ws, size_t ws_size, hipStream_t stream) {
    static int grid = 0;
    if (grid == 0) {
        if (n_in != 28 || out_size != T * DM || ws_size < WS_END) { fprintf(stderr, "kernel_launch: unexpected shapes (n_in %d out %d ws %zu)\n", n_in, out_size, ws_size); grid = -1; return; }
        int dev = 0, cus = 0, per_cu = 0;
        if (hipGetDevice(&dev) != hipSuccess || hipDeviceGetAttribute(&cus, hipDeviceAttributeMultiprocessorCount, dev) != hipSuccess) { grid = -1; return; }
        if (hipFuncSetAttribute((const void*)fwd, hipFuncAttributeMaxDynamicSharedMemorySize, LDS_BYTES) != hipSuccess) { fprintf(stderr, "kernel_launch: hipFuncSetAttribute failed\n"); grid = -1; return; }
        if (hipOccupancyMaxActiveBlocksPerMultiprocessor(&per_cu, (const void*)fwd, NTHR, LDS_BYTES) != hipSuccess || per_cu < 1) { fprintf(stderr, "kernel_launch: occupancy query says %d\n", per_cu); (void)hipGetLastError(); grid = -1; return; }
        if (cus * ROWS_CAP < 288 * 16) { fprintf(stderr, "kernel_launch: too few CUs (%d) for the gather lists\n", cus); grid = -1; return; }
        grid = cus;
    }
    if (grid < 0) return;
    (void)hipMemsetAsync((char*)d_ws + WS_CTL, 0, CTL_ZERO_BYTES, stream);
    Args a{};
    for (int i = 0; i < 28; ++i) a.in[i] = (const float*)d_in[i];
    a.out = (float*)d_out; a.ws = (unsigned char*)d_ws;
#if MK_ONE_LAUNCH
    a.ph_lo = 0; a.ph_hi = NPH;
    hipLaunchKernelGGL(fwd, dim3(grid), dim3(NTHR), LDS_BYTES, stream, a);
#else
    for (int p = 0; p < NPH; ++p) { a.ph_lo = p; a.ph_hi = p + 1; hipLaunchKernelGGL(fwd, dim3(grid), dim3(NTHR), LDS_BYTES, stream, a); }
#endif
}
```

```cpp
#include <hip/hip_runtime.h>
#include <cstdio>
#include <cstdint>

#define GAS __attribute__((address_space(1)))
#define LAS __attribute__((address_space(3)))
typedef unsigned short bf16;
typedef unsigned v4u __attribute__((ext_vector_type(4)));
typedef unsigned v2u __attribute__((ext_vector_type(2)));
typedef float f32x2 __attribute__((ext_vector_type(2)));
typedef float f32x4 __attribute__((ext_vector_type(4)));
typedef float f32x16 __attribute__((ext_vector_type(16)));
typedef short bf16x8 __attribute__((ext_vector_type(8)));
typedef short s16x4 __attribute__((ext_vector_type(4)));
typedef __bf16 bf16x2_t __attribute__((ext_vector_type(2)));

constexpr int DM = 2048, NB = 8, SEQ = 2048, T = NB * SEQ;
constexpr int CHUNK = 64, NCHUNK = SEQ / CHUNK;
constexpr int HD = 128, NQH = 8, NKVH = 2, ATTW = 1024, KVW = 256;
constexpr int IDXH = 16, IDXD = 64, TOPK = 256;
constexpr int SSMW = 1024, SSMG = 64, SSMP = 16, SSMN = 64;
constexpr int NEXP = 32, MOEK = 4, DFF = 2048;
constexpr int INW = 7760, INW_PAD = 7936;
constexpr int MODW = 6 * DM;
constexpr float RMS_EPS = 1e-6f;
constexpr int SL = 32, NSC = SEQ / SL, SROWS = NB * NSC;
constexpr int UA_LD = SL * 16 + 128;
constexpr int MOE_ROWS = T * MOEK + NEXP * 256;
constexpr int NWAVES = 8, NTHR = 512;

constexpr size_t MiB = 1u << 20;
constexpr size_t WS_CTL = 0, CTL_ZERO_BYTES = 1 * MiB;
constexpr size_t WS_MOD = 1 * MiB;
constexpr size_t WS_WRP = 2 * MiB;
constexpr size_t WS_BRP = 4 * MiB;
constexpr size_t WS_BBAR = 5 * MiB;
constexpr size_t WS_POW = 6 * MiB;
constexpr size_t WS_KT = 9 * MiB;
constexpr size_t WS_ASGE = 14 * MiB;
constexpr size_t WS_ASGP = WS_ASGE + 256 * 1024;
constexpr size_t WS_ASGG = WS_ASGP + 256 * 1024;
constexpr size_t WS_SLOT = WS_ASGG + 256 * 1024;
constexpr size_t WS_ROWG = 15 * MiB;
constexpr size_t WS_RSTD = 15 * MiB + 512 * 1024;
constexpr size_t WS_WIN = 16 * MiB;
constexpr size_t WS_WIN8 = 27 * MiB;
constexpr size_t WS_WGLU = 47 * MiB;
constexpr size_t WS_WA = 49 * MiB;
constexpr size_t WS_WB = 53 * MiB;
constexpr size_t WS_WO = 57 * MiB;
constexpr size_t WS_BTS = 65 * MiB;
constexpr size_t WS_BTY = 97 * MiB;
constexpr size_t WS_HN = 241 * MiB;
constexpr size_t WS_X1 = 241 * MiB;
constexpr size_t WS_HN8 = 980 * MiB;
constexpr size_t WS_Q = 305 * MiB;
constexpr size_t WS_K = 337 * MiB;
constexpr size_t WS_V = 345 * MiB;
constexpr size_t WS_IQ = 353 * MiB;
constexpr size_t WS_IK = 385 * MiB;
constexpr size_t WS_IW = 387 * MiB;
constexpr size_t WS_UA = 788 * MiB;
constexpr size_t WS_GATES = 424 * MiB;
constexpr size_t WS_SC = 552 * MiB;
constexpr size_t WS_SEL = 680 * MiB;
constexpr size_t WS_YA = 684 * MiB;
constexpr size_t WS_SBUF = 852 * MiB;
constexpr size_t WS_YG = 724 * MiB;
constexpr size_t WS_YS = 756 * MiB;
constexpr size_t WS_MRG = 788 * MiB;
constexpr size_t WS_MG = 916 * MiB;
constexpr size_t WS_H2 = 980 * MiB;
constexpr size_t WS_XS = 1044 * MiB;
constexpr size_t WS_LIST = WS_XS + 64 * MiB;
constexpr size_t WS_GLIST = WS_XS + 66 * MiB;
constexpr size_t WS_ACT = 1332 * MiB;
constexpr size_t WS_YE = 1620 * MiB;
constexpr size_t WS_WGU = 1908 * MiB;
constexpr size_t WS_WD = 2420 * MiB;
constexpr size_t WS_END = 2676 * MiB;
constexpr int CW_CNT = 1024;
constexpr int CW_CVQ = 2048;
constexpr int NCONV = 112;
constexpr int CW_BAR = 4096;
constexpr int RING_BYTES = 131072;
constexpr int LDSCTL_OFF = RING_BYTES, MISC_OFF = LDSCTL_OFF + 320;
constexpr int LDS_BYTES = 147456;

#define LDS_WAIT() asm volatile("s_waitcnt lgkmcnt(0)" ::: "memory")
#define VM_WAIT() asm volatile("s_waitcnt vmcnt(0)" ::: "memory")
#define RLX_AGENT __ATOMIC_RELAXED, __HIP_MEMORY_SCOPE_AGENT

__device__ __forceinline__ unsigned pk2(float lo, float hi) { f32x2 v = {lo, hi}; bf16x2_t b = __builtin_convertvector(v, bf16x2_t); return __builtin_bit_cast(unsigned, b); }
__device__ __forceinline__ float bf2f(unsigned h) { return __builtin_bit_cast(float, h << 16); }
__device__ __forceinline__ float bflo(unsigned w) { return __builtin_bit_cast(float, w << 16); }
__device__ __forceinline__ float bfhi(unsigned w) { return __builtin_bit_cast(float, w & 0xffff0000u); }
__device__ __forceinline__ float wave_sum(float v) {
#pragma unroll
    for (int o = 1; o < 64; o <<= 1) v += __shfl_xor(v, o);
    return v;
}
constexpr float F8_WSCALE = 256.0f, F8_ASCALE = 4.0f, F8_DESCALE = 1.0f / (256.0f * 4.0f);
constexpr float F8_YSCALE = 8.0f;
constexpr float F8_MSCALE = 16.0f, F8_MDESCALE = 1.0f / (256.0f * 16.0f);
__device__ __forceinline__ unsigned pk4_fp8(float a, float b, float c, float d) { int w = 0; a = __builtin_amdgcn_fmed3f(a, -448.f, 448.f); b = __builtin_amdgcn_fmed3f(b, -448.f, 448.f); c = __builtin_amdgcn_fmed3f(c, -448.f, 448.f); d = __builtin_amdgcn_fmed3f(d, -448.f, 448.f);
    w = __builtin_amdgcn_cvt_pk_fp8_f32(a, b, w, false); w = __builtin_amdgcn_cvt_pk_fp8_f32(c, d, w, true); return (unsigned)w; }
__device__ __forceinline__ unsigned pk4_fp8_nc(float a, float b, float c, float d) { int w = 0; w = __builtin_amdgcn_cvt_pk_fp8_f32(a, b, w, false); w = __builtin_amdgcn_cvt_pk_fp8_f32(c, d, w, true); return (unsigned)w; }
__device__ __forceinline__ float sigmoidf_(float x) { return __builtin_amdgcn_rcpf(1.0f + __builtin_amdgcn_exp2f(x * -1.4426950408889634f)); }
__device__ __forceinline__ float sigmoid1702(float x) { return __builtin_amdgcn_rcpf(1.0f + __builtin_amdgcn_exp2f(x * (-1.702f * 1.4426950408889634f))); }

namespace pg8 {
#define PG8_LAS __attribute__((address_space(3)))
typedef unsigned short bf16_t;
typedef short bf16x8 __attribute__((ext_vector_type(8)));
typedef float f32x4 __attribute__((ext_vector_type(4)));
typedef unsigned u32x4 __attribute__((ext_vector_type(4)));
constexpr int BM = 256, BK = 64, HALF = 128, HTB = HALF * BK * 2, STAGE_BYTES = 8 * HTB, NXCD = 8, WGM = 8;

__host__ __device__ __forceinline__ int lds_byte(int r, int c) { const int st = (r >> 4) * 2 + (c >> 5), rr = r & 15, cc = c & 31, ob = rr * 64 + cc * 2; return st * 1024 + (ob ^ (((ob >> 9) & 1) << 5)); }
__host__ __device__ __forceinline__ void stage_rc(int b, int& R, int& C) { const int st = b / 1024, sb = b % 1024, swz = sb ^ (((sb >> 9) & 1) << 5); R = (st >> 1) * 16 + swz / 64; C = (st & 1) * 32 + (swz % 64) / 2; }
__host__ __device__ __forceinline__ int perm32(int rho) { const int n = rho >> 4, i = rho & 15; return 8 * (i >> 2) + 4 * n + (i & 3); }

struct Unit { int pm, pn; };
struct Gemm { const bf16_t* A; const bf16_t* Bt; int lda, ldb, K; const PG8_LAS unsigned short* rows; };

struct StaticOrder {
    int nM, nN, nwg, G, c;
    __host__ __device__ void init(int M, int N, int G_, int c_) { nM = M / BM; nN = N / BM; nwg = nM * nN; G = G_; c = c_; }
    __host__ __device__ bool next(int i, Unit& u) const {
        const long L = (long)i * G + c; if (L >= nwg) return false;
        int wgid = (int)L; { const int q = nwg / NXCD, r = nwg % NXCD, xcd = wgid % NXCD, off = wgid / NXCD; wgid = (xcd < r ? xcd * (q + 1) : r * (q + 1) + (xcd - r) * q) + off; }
        const int nig = WGM * nN, gid = wgid / nig, fm = gid * WGM, gsz = (nM - fm) < WGM ? (nM - fm) : WGM;
        u.pm = fm + ((wgid % nig) % gsz); u.pn = (wgid % nig) / gsz; return true;
    }
    __device__ __forceinline__ void a_ready(const Unit&) const {}
    __device__ __forceinline__ void done(const Unit&) const {}
};

typedef int i32x4 __attribute__((ext_vector_type(4)));
typedef int i32x8 __attribute__((ext_vector_type(8)));
template <bool F8> struct FragT;
template <> struct FragT<false> { bf16x8 k0, k1; };
template <> struct FragT<true> { i32x8 v; };
template <bool F8> __device__ __forceinline__ FragT<F8> ldfrag(const PG8_LAS unsigned char* p) {
    if constexpr (F8) { const i32x4 lo = *(const PG8_LAS i32x4*)p, hi = *(const PG8_LAS i32x4*)(p + 1024); FragT<true> f; f.v = __builtin_shufflevector(lo, hi, 0, 1, 2, 3, 4, 5, 6, 7); return f; }
    else { FragT<false> f; f.k0 = *(const PG8_LAS bf16x8*)p; f.k1 = *(const PG8_LAS bf16x8*)(p + 1024); return f; }
}
template <bool F8> __device__ __forceinline__ f32x4 mma1(const FragT<F8>& b, const FragT<F8>& a, f32x4 c) {
#if defined(__HIP_DEVICE_COMPILE__)
    if constexpr (F8) { asm volatile("v_mfma_f32_16x16x128_f8f6f4 %0, %1, %2, %0" : "+v"(c) : "v"(b.v), "v"(a.v)); return c; }
#else
    if constexpr (F8) { return c; }
#endif
    else { c = __builtin_amdgcn_mfma_f32_16x16x32_bf16(b.k0, a.k0, c, 0, 0, 0); return __builtin_amdgcn_mfma_f32_16x16x32_bf16(b.k1, a.k1, c, 0, 0, 0); }
}
template <class Epi, class Sched, bool ALIGN_EPI = false, bool SP2 = false, bool F8 = false, bool GATHER = false>
__device__ __forceinline__ void gemm_phase(PG8_LAS unsigned char* lds, const Gemm g, const Sched& S, const Epi& E) {
    const int tid = threadIdx.x, wid = __builtin_amdgcn_readfirstlane(tid >> 6), lane = tid & 63, wr = wid >> 2, wc = wid & 3, fr = lane & 15, fq = lane >> 4;
    const int K = g.K, nt = K / BK;
    unsigned voffA[2], voffB[2];
#pragma unroll
    for (int i = 0; i < 2; ++i) { int R, C; stage_rc(tid * 16 + i * 8192, R, C); const int Rb = Epi::PERM ? ((R & ~31) + perm32(R & 31)) : R;
        voffA[i] = (unsigned)(R * g.lda + C) * 2u; voffB[i] = (unsigned)(Rb * g.ldb + C) * 2u; }
    unsigned gC0[2] = {0u, 0u}, gC1[2] = {0u, 0u}, gN0[2] = {0u, 0u}, gN1[2] = {0u, 0u}; int gR[2] = {0, 0}; unsigned gCb[2] = {0u, 0u};
    if constexpr (GATHER) {
#pragma unroll
        for (int i = 0; i < 2; ++i) { int R, C; stage_rc(tid * 16 + i * 8192, R, C); gR[i] = R; gCb[i] = (unsigned)C * 2u; } }
#define PG8_GROWS(d0, d1, slot) do { _Pragma("unroll") for (int _i = 0; _i < 2; ++_i) { \
        d0[_i] = (unsigned)g.rows[(slot) * 256 + gR[_i]] * (unsigned)(g.lda * 2) + gCb[_i]; d1[_i] = (unsigned)g.rows[(slot) * 256 + 128 + gR[_i]] * (unsigned)(g.lda * 2) + gCb[_i]; } } while (0)
    const size_t kstep = (size_t)(BK * 2);
    const size_t hstepA = (size_t)HALF * g.lda * 2, hstepB = (size_t)HALF * g.ldb * 2;
    const size_t tstepA = 2 * hstepA, tstepB = 2 * hstepB;
    const unsigned ldsw = (unsigned)wid * 1024u;
    const int aoff = lds_byte(wr * 64 + fr, fq * 8), boff = lds_byte(wc * 32 + fr, fq * 8);
#define PG8_SA(b, h) (((b) * 2 + (h)) * HTB)
#define PG8_SB(b, h) ((4 + (b) * 2 + (h)) * HTB)
#define PG8_STAGE(bufoff, gbase, voff) do { _Pragma("unroll") for (int _i = 0; _i < 2; ++_i) \
        __builtin_amdgcn_global_load_lds((const unsigned*)((const char*)(gbase) + (voff)[_i]), (PG8_LAS unsigned*)(lds + (bufoff) + ldsw + _i * 8192), 16, 0, 0); } while (0)
#define PG8_STAGE2(bufoff, gbase, o0, o1) do { \
        __builtin_amdgcn_global_load_lds((const unsigned*)((const char*)(gbase) + (o0)), (PG8_LAS unsigned*)(lds + (bufoff) + ldsw), 16, 0, 0); \
        __builtin_amdgcn_global_load_lds((const unsigned*)((const char*)(gbase) + (o1)), (PG8_LAS unsigned*)(lds + (bufoff) + ldsw + 8192), 16, 0, 0); } while (0)
#define PG8_STAGE_A(bufoff, kb, h, nx) do { if constexpr (GATHER) { \
        if ((h) == 0) PG8_STAGE2(bufoff, kb, ((nx) ? gN0[0] : gC0[0]), ((nx) ? gN0[1] : gC0[1])); else PG8_STAGE2(bufoff, kb, ((nx) ? gN1[0] : gC1[0]), ((nx) ? gN1[1] : gC1[1])); \
        } else { PG8_STAGE(bufoff, (kb) + ((h) ? hstepA : (size_t)0), voffA); } } while (0)
#define PG8_LDA(dst, b, h) do { _Pragma("unroll") for (int m = 0; m < 4; ++m) dst[m] = ldfrag<F8>(lds + PG8_SA(b, h) + aoff + m * 2048); } while (0)
#define PG8_LDB(dst, b, h) do { _Pragma("unroll") for (int n = 0; n < 2; ++n) dst[n] = ldfrag<F8>(lds + PG8_SB(b, h) + boff + n * 2048); } while (0)
#define PG8_MMA(ai, bj, At, Bt) do { __builtin_amdgcn_s_setprio(1); _Pragma("unroll") for (int m = 0; m < 4; ++m) _Pragma("unroll") for (int n = 0; n < 2; ++n) \
        acc[ai][bj][m][n] = mma1<F8>(Bt[n], At[m], acc[ai][bj][m][n]); __builtin_amdgcn_s_setprio(0); } while (0)
#define PG8_WAIT_V(n) asm volatile("s_waitcnt vmcnt(" #n ")" ::: "memory")
#define PG8_WAIT_L(n) asm volatile("s_waitcnt lgkmcnt(" #n ")" ::: "memory")
#define PG8_BAR __builtin_amdgcn_s_barrier()
#define PG8_SCHED __builtin_amdgcn_sched_barrier(0)
    Unit cur, nxt; int ui = 0;
    if (!S.next(0, cur)) return;
    f32x4 acc[2][2][4][2];
#pragma unroll
    for (int a = 0; a < 2; ++a)
#pragma unroll
        for (int b = 0; b < 2; ++b)
#pragma unroll
            for (int m = 0; m < 4; ++m)
#pragma unroll
                for (int n = 0; n < 2; ++n) acc[a][b][m][n] = (f32x4){0.f, 0.f, 0.f, 0.f};
    FragT<F8> At[4], B0[2], B1[2];
    const char* cA = (const char*)g.A + (GATHER ? (size_t)0 : (size_t)cur.pm * tstepA); const char* cB = (const char*)g.Bt + (size_t)cur.pn * tstepB;
    if constexpr (GATHER) { PG8_GROWS(gC0, gC1, 0); }
    S.a_ready(cur);
    if constexpr (SP2) {
        PG8_STAGE(PG8_SB(0, 0), cB, voffB); PG8_STAGE(PG8_SB(0, 1), cB + hstepB, voffB); PG8_STAGE_A(PG8_SA(0, 0), cA, 0, false); PG8_STAGE_A(PG8_SA(0, 1), cA, 1, false);
        if (wr == 1) PG8_BAR;
        PG8_WAIT_V(2); PG8_BAR;
        PG8_STAGE(PG8_SB(1, 0), cB + kstep, voffB); PG8_STAGE_A(PG8_SA(1, 0), cA + kstep, 0, false); PG8_STAGE(PG8_SB(1, 1), cB + hstepB + kstep, voffB);
        PG8_WAIT_V(6); PG8_BAR;
    } else {
        PG8_STAGE(PG8_SB(0, 0), cB, voffB); PG8_STAGE_A(PG8_SA(0, 0), cA, 0, false); PG8_STAGE(PG8_SB(0, 1), cB + hstepB, voffB); PG8_STAGE_A(PG8_SA(0, 1), cA, 1, false);
        if (wr == 1) PG8_BAR;
        PG8_WAIT_V(4); PG8_BAR;
        PG8_STAGE(PG8_SB(1, 0), cB + kstep, voffB); PG8_STAGE_A(PG8_SA(1, 0), cA + kstep, 0, false); PG8_STAGE(PG8_SB(1, 1), cB + hstepB + kstep, voffB);
        PG8_WAIT_V(6); PG8_BAR;
    }
    for (;;) {
        const bool has_next = S.next(ui + 1, nxt);
        const char* nA = (has_next && !GATHER) ? (const char*)g.A + (size_t)nxt.pm * tstepA : cA; const char* nB = has_next ? (const char*)g.Bt + (size_t)nxt.pn * tstepB : cB;
        if constexpr (GATHER) { if (has_next) { PG8_GROWS(gN0, gN1, ui + 1); } else { gN0[0] = gC0[0]; gN0[1] = gC0[1]; gN1[0] = gC1[0]; gN1[1] = gC1[1]; } }
        for (int t = 0; t < nt; t += 2) {
            const bool last = (t == nt - 2);
            const char* a1 = cA + (size_t)(t + 1) * kstep;
            const char* a2 = last ? nA : cA + (size_t)(t + 2) * kstep; const char* b2 = last ? nB : cB + (size_t)(t + 2) * kstep;
            const char* a3 = a2 + kstep; const char* b3 = b2 + kstep;
            if (last && has_next) S.a_ready(nxt);
            if constexpr (Epi::CHAIN) { if (t == Epi::MID_T) {
                if constexpr (F8) asm volatile("s_nop 15\n\ts_nop 15" ::: "memory");
                int fr_ = fr, fq_ = fq; asm volatile("" : "+v"(fr_), "+v"(fq_)); E.mid(acc, cur, wr, wc, fr_, fq_); } }
            if constexpr (SP2) {
            PG8_LDB(B0, 0, 0); PG8_LDB(B1, 0, 1); PG8_SCHED; PG8_LDA(At, 0, 0); PG8_STAGE_A(PG8_SA(1, 1), a1, 1, false);
            PG8_WAIT_V(8); PG8_WAIT_L(0); PG8_BAR; PG8_MMA(0, 0, At, B0); PG8_MMA(0, 1, At, B1); PG8_BAR; PG8_SCHED;
            PG8_LDA(At, 0, 1); PG8_STAGE(PG8_SB(0, 0), b2, voffB); PG8_STAGE(PG8_SB(0, 1), b2 + hstepB, voffB); PG8_STAGE_A(PG8_SA(0, 0), a2, 0, last);
            PG8_WAIT_V(8); PG8_WAIT_L(0); PG8_BAR; PG8_MMA(1, 0, At, B0); PG8_MMA(1, 1, At, B1); PG8_BAR; PG8_SCHED;
            PG8_LDB(B0, 1, 0); PG8_LDB(B1, 1, 1); PG8_SCHED; PG8_LDA(At, 1, 0); PG8_STAGE_A(PG8_SA(0, 1), a2, 1, last);
            PG8_WAIT_V(8); PG8_WAIT_L(0); PG8_BAR; PG8_MMA(0, 0, At, B0); PG8_MMA(0, 1, At, B1); PG8_BAR; PG8_SCHED;
            PG8_LDA(At, 1, 1); PG8_STAGE(PG8_SB(1, 0), b3, voffB); PG8_STAGE(PG8_SB(1, 1), b3 + hstepB, voffB); PG8_STAGE_A(PG8_SA(1, 0), a3, 0, last);
            PG8_WAIT_V(8); PG8_WAIT_L(0); PG8_BAR; PG8_MMA(1, 0, At, B0); PG8_MMA(1, 1, At, B1); PG8_BAR; PG8_SCHED;
            } else {
            PG8_LDB(B0, 0, 0); PG8_SCHED; PG8_LDA(At, 0, 0); PG8_STAGE_A(PG8_SA(1, 1), a1, 1, false);
            PG8_WAIT_L(8); PG8_BAR; PG8_WAIT_L(0); PG8_MMA(0, 0, At, B0); PG8_BAR; PG8_SCHED;
            PG8_LDB(B1, 0, 1); PG8_STAGE(PG8_SB(0, 0), b2, voffB);
            PG8_BAR; PG8_WAIT_L(0); PG8_MMA(0, 1, At, B1); PG8_BAR;
            PG8_LDA(At, 0, 1); PG8_STAGE_A(PG8_SA(0, 0), a2, 0, last);
            PG8_BAR; PG8_WAIT_L(0); PG8_MMA(1, 0, At, B0); PG8_BAR; PG8_SCHED;
            PG8_STAGE(PG8_SB(0, 1), b2 + hstepB, voffB);
            PG8_WAIT_V(6); PG8_BAR; PG8_MMA(1, 1, At, B1); PG8_BAR;
            PG8_LDB(B0, 1, 0); PG8_SCHED; PG8_LDA(At, 1, 0); PG8_STAGE_A(PG8_SA(0, 1), a2, 1, last);
            PG8_WAIT_L(8); PG8_BAR; PG8_WAIT_L(0); PG8_MMA(0, 0, At, B0); PG8_BAR; PG8_SCHED;
            PG8_LDB(B1, 1, 1); PG8_STAGE(PG8_SB(1, 0), b3, voffB);
            PG8_BAR; PG8_WAIT_L(0); PG8_MMA(0, 1, At, B1); PG8_BAR;
            PG8_LDA(At, 1, 1); PG8_STAGE_A(PG8_SA(1, 0), a3, 0, last);
            PG8_BAR; PG8_WAIT_L(0); PG8_MMA(1, 0, At, B0); PG8_BAR; PG8_SCHED;
            PG8_STAGE(PG8_SB(1, 1), b3 + hstepB, voffB);
            PG8_WAIT_V(6); PG8_BAR; PG8_MMA(1, 1, At, B1); PG8_BAR;
            }
        }
        if constexpr (ALIGN_EPI) { if (wr == 0) PG8_BAR; }
        if constexpr (F8) asm volatile("s_nop 15\n\ts_nop 15" ::: "memory");
        { int fr_ = fr, fq_ = fq; asm volatile("" : "+v"(fr_), "+v"(fq_));
          E(acc, cur, wr, wc, fr_, fq_); } S.done(cur);
        if (!has_next) break;
#pragma unroll
        for (int a = 0; a < 2; ++a)
#pragma unroll
            for (int b = 0; b < 2; ++b)
#pragma unroll
                for (int m = 0; m < 4; ++m)
#pragma unroll
                    for (int n = 0; n < 2; ++n) acc[a][b][m][n] = (f32x4){0.f, 0.f, 0.f, 0.f};
        cur = nxt; cA = nA; cB = nB; ++ui;
        if constexpr (GATHER) { gC0[0] = gN0[0]; gC0[1] = gN0[1]; gC1[0] = gN1[0]; gC1[1] = gN1[1]; }
        if constexpr (ALIGN_EPI) { if (wr == 1) PG8_BAR; }
    }
    PG8_WAIT_V(0);
    if constexpr (!ALIGN_EPI) { if (wr == 0) PG8_BAR; }
    PG8_BAR;
#undef PG8_SA
#undef PG8_SB
#undef PG8_STAGE
#undef PG8_STAGE2
#undef PG8_STAGE_A
#undef PG8_GROWS
#undef PG8_LDA
#undef PG8_LDB
#undef PG8_MMA
#undef PG8_WAIT_V
#undef PG8_WAIT_L
#undef PG8_BAR
#undef PG8_SCHED
}
}

#define XB_TMO      128
#define XB_XCNT(j)  (256  + 64 * (j))
#define XB_XSUB(j)  (1280 + 64 * (j))
#define XB_XGEN(j)  (2304 + 64 * (j))
#define XB_TOP      3328
#define XB_TOPGEN   3392
#define XCD_BAR_WORDS 3456
#define XB_SPIN_CAP (1u << 18)

__device__ __forceinline__ unsigned xb_ld(unsigned* p)              { return __hip_atomic_load(p, __ATOMIC_RELAXED, __HIP_MEMORY_SCOPE_AGENT); }
__device__ __forceinline__ unsigned xb_add(unsigned* p, unsigned v) { return __hip_atomic_fetch_add(p, v, __ATOMIC_RELAXED, __HIP_MEMORY_SCOPE_AGENT); }
__device__ __forceinline__ unsigned xb_xcc_id() { return (unsigned)__builtin_amdgcn_s_getreg((3 << 11) | 20) & 0xFu; }
#define XB_SPIN(cond, bar) do { unsigned _sp = 0; while (cond) { __builtin_amdgcn_s_sleep(1); \
    if ((++_sp & 255u) == 0u) { if (xb_ld(&(bar)[XB_TMO])) break; if (_sp > XB_SPIN_CAP) { atomicAdd(&(bar)[XB_TMO], 1u); break; } } } } while (0)

struct XcdBarrier { unsigned* bar; unsigned x; volatile LAS unsigned* st; };

__device__ __forceinline__ XcdBarrier xcd_barrier_post(unsigned* bar, volatile LAS unsigned* st) {
    XcdBarrier b; b.bar = bar; b.x = xb_xcc_id(); b.st = st;
    if (threadIdx.x == 0) (void)xb_add(&bar[XB_XCNT(b.x)], 1u);
    return b;
}
__device__ __forceinline__ void xcd_barrier_complete(unsigned* bar, unsigned x, unsigned& nloc, unsigned& nx) {
    const unsigned G = gridDim.x * gridDim.y * gridDim.z;
    unsigned sum, cnt, mine, sp = 0u;
    for (;;) {
        sum = 0u; cnt = 0u; mine = 0u;
#pragma unroll
        for (unsigned j = 0; j < 16; ++j) { const unsigned c = xb_ld(&bar[XB_XCNT(j)]); sum += c; cnt += (c > 0u) ? 1u : 0u; mine = (j == x) ? c : mine; }
        if (sum == G) break;
        __builtin_amdgcn_s_sleep(1);
        if ((++sp & 255u) == 0u) { if (xb_ld(&bar[XB_TMO])) break; if (sp > XB_SPIN_CAP) { atomicAdd(&bar[XB_TMO], 1u); break; } }
    }
    nloc = mine > 0u ? mine : 1u; nx = cnt > 0u ? cnt : 1u;
}
__device__ __forceinline__ void xcd_barrier(const XcdBarrier& b) {
    asm volatile("s_waitcnt vmcnt(0)" ::: "memory");
    __syncthreads();
    if (threadIdx.x == 0) {
        unsigned* bar = b.bar;
        __builtin_amdgcn_s_waitcnt(0);
        unsigned nloc = b.st[0], nx = b.st[1];
        if (nloc == 0u) { xcd_barrier_complete(bar, b.x, nloc, nx); b.st[0] = nloc; b.st[1] = nx; }
        const unsigned old = xb_add(&bar[XB_XSUB(b.x)], 1u);
        const unsigned gen = old / nloc;
        if (old + 1u == (gen + 1u) * nloc) {
            __builtin_amdgcn_fence(__ATOMIC_RELEASE, "agent");
            asm volatile("s_waitcnt vmcnt(0)" ::: "memory");
            const unsigned og = xb_add(&bar[XB_TOP], 1u);
            const unsigned tg = og / nx;
            if (og + 1u == (tg + 1u) * nx) xb_add(&bar[XB_TOPGEN], 1u);
            else XB_SPIN(xb_ld(&bar[XB_TOPGEN]) == tg, bar);
            __builtin_amdgcn_fence(__ATOMIC_ACQUIRE, "agent");
            xb_add(&bar[XB_XGEN(b.x)], 1u);
            asm volatile("s_waitcnt vmcnt(0)" ::: "memory");
        } else {
            XB_SPIN(xb_ld(&bar[XB_XGEN(b.x)]) == gen, bar);
            __builtin_amdgcn_fence(__ATOMIC_ACQUIRE, "agent");
            asm volatile("s_waitcnt vmcnt(0)" ::: "memory");
        }
    }
    __syncthreads();
}

using pg8::Unit;
__device__ __forceinline__ v4u pack8(const f32x4& a, const f32x4& b) { v4u w; w.x = pk2(a[0], a[1]); w.y = pk2(a[2], a[3]); w.z = pk2(b[0], b[1]); w.w = pk2(b[2], b[3]); return w; }
__device__ __forceinline__ float gelu_tanh(float y) { const float u2 = 1.5957691216f * (y + 0.044715f * y * y * y); return y * __builtin_amdgcn_rcpf(1.0f + __builtin_amdgcn_exp2f(u2 * -1.4426950408889634f)); }

struct EpiInProjA {
    static constexpr bool PERM = true, CHAIN = false;
    bf16 *Q, *K, *IQ, *IK; float* IW;
    __device__ __forceinline__ void operator()(const f32x4 (&acc)[2][2][4][2], const Unit& u, int wr, int wc, int fr, int fq) const {
        const int pn = u.pn, row0 = u.pm * 256 + wr * 64 + fr, cl0 = wc * 32 + 8 * fq;
        if (pn < 9) {
            bf16* dst; int ld, coff; float sc = 1.f;
            if (pn < 4) { dst = Q; ld = 1024; coff = pn * 256; } else if (pn == 4) { dst = K; ld = 256; coff = 0; } else { dst = IQ; ld = 1024; coff = (pn - 5) * 256; sc = 0.125f; }
#pragma unroll
            for (int ai = 0; ai < 2; ++ai)
#pragma unroll
                for (int m = 0; m < 4; ++m) { bf16* rowp = dst + (size_t)(row0 + ai * 128 + m * 16) * ld + coff + cl0;
#pragma unroll
                    for (int bj = 0; bj < 2; ++bj) *(v4u*)(rowp + bj * 128) = pack8(acc[ai][bj][m][0] * sc, acc[ai][bj][m][1] * sc); }
        } else {
#pragma unroll
            for (int ai = 0; ai < 2; ++ai)
#pragma unroll
                for (int m = 0; m < 4; ++m) { const int row = row0 + ai * 128 + m * 16;
                    if (cl0 < 64) *(v4u*)(IK + (size_t)row * 64 + cl0) = pack8(acc[ai][0][m][0], acc[ai][0][m][1]);
                    else if (cl0 < 80) { float* p = IW + (size_t)row * 16 + (cl0 - 64); *(f32x4*)p = acc[ai][0][m][0] * 0.25f; *(f32x4*)(p + 4) = acc[ai][0][m][1] * 0.25f; } }
        }
    }
};
struct EpiInProjB {
    static constexpr bool PERM = true, CHAIN = false;
    bf16 *V, *UA; unsigned char* GATES;
    __device__ __forceinline__ void operator()(const f32x4 (&acc)[2][2][4][2], const Unit& u, int wr, int wc, int fr, int fq) const {
        const int pn = u.pn, row0 = u.pm * 256 + wr * 64 + fr, cl0 = wc * 32 + 8 * fq;
        if (pn >= 5) {
            const int coff = (pn - 5) * 256 + cl0;
#pragma unroll
            for (int ai = 0; ai < 2; ++ai)
#pragma unroll
                for (int m = 0; m < 4; ++m) { unsigned char* rowp = GATES + (size_t)(row0 + ai * 128 + m * 16) * 4096 + coff;
#pragma unroll
                    for (int bj = 0; bj < 2; ++bj) { const f32x4 v0 = acc[ai][bj][m][0] * F8_DESCALE, v1 = acc[ai][bj][m][1] * F8_DESCALE; unsigned c[8];
#pragma unroll
                        for (int e = 0; e < 4; ++e) { c[e] = (unsigned)fminf(fmaxf(sigmoidf_(v0[e]) * 255.0f + 0.5f, 1.0f), 255.0f); c[4 + e] = (unsigned)fminf(fmaxf(sigmoidf_(v1[e]) * 255.0f + 0.5f, 1.0f), 255.0f); }
                        v2u w; w.x = c[0] | (c[1] << 8) | (c[2] << 16) | (c[3] << 24); w.y = c[4] | (c[5] << 8) | (c[6] << 16) | (c[7] << 24);
                        *(v2u*)(rowp + bj * 128) = w; } }
        } else if (pn == 0) {
#pragma unroll
            for (int ai = 0; ai < 2; ++ai)
#pragma unroll
                for (int m = 0; m < 4; ++m) { bf16* rowp = V + (size_t)(row0 + ai * 128 + m * 16) * 256 + cl0;
#pragma unroll
                    for (int bj = 0; bj < 2; ++bj) *(v4u*)(rowp + bj * 128) = pack8(acc[ai][bj][m][0] * F8_DESCALE, acc[ai][bj][m][1] * F8_DESCALE); }
        } else {
#pragma unroll
            for (int ai = 0; ai < 2; ++ai)
#pragma unroll
                for (int m = 0; m < 4; ++m) { const int row = row0 + ai * 128 + m * 16, b = row >> 11, t = row & 2047, c = t >> 5, i = t & 31;
#pragma unroll
                    for (int bj = 0; bj < 2; ++bj) { const int ch0 = (pn - 1) * 256 + bj * 128 + cl0, g = ch0 >> 4, p0 = ch0 & 15;
                        *(v4u*)(UA + ((size_t)(g * SROWS + b * NSC + c)) * UA_LD + i * 16 + p0) = pack8(acc[ai][bj][m][0] * F8_DESCALE, acc[ai][bj][m][1] * F8_DESCALE); } }
        }
    }
};

struct EpiSsmS {
    static constexpr bool PERM = false, CHAIN = false;
    float* SBUF;
    __device__ __forceinline__ void operator()(const f32x4 (&acc)[2][2][4][2], const Unit& u, int wr, int wc, int fr, int fq) const {
#pragma unroll
        for (int ai = 0; ai < 2; ++ai)
#pragma unroll
            for (int m = 0; m < 4; ++m) { const int rl = ai * 128 + wr * 64 + m * 16 + fr;
#pragma unroll
                for (int n = 0; n < 2; ++n) *(f32x4*)(SBUF + ((size_t)(u.pm * 256 + rl)) * 128 + wc * 32 + 16 * n + 4 * fq) = acc[ai][0][m][n]; }
    }
};

struct EpiSsmY {
    static constexpr bool PERM = true, CHAIN = false;
    bf16* YG;
    __device__ __forceinline__ void operator()(const f32x4 (&acc)[2][2][4][2], const Unit& u, int wr, int wc, int fr, int fq) const {
        const int g = u.pm >> 1, rt = u.pm & 1, ct = u.pn & 1;
#pragma unroll
        for (int ai = 0; ai < 2; ++ai)
#pragma unroll
            for (int m = 0; m < 4; ++m) { const int r = rt * 256 + ai * 128 + wr * 64 + m * 16 + fr, b = r >> 6, c = r & 63;
#pragma unroll
                for (int bj = 0; bj < 2; ++bj) { const int cl = bj * 128 + wc * 32 + 8 * fq, j = 16 * ct + (cl >> 4), p0 = cl & 15; const int t = b * 2048 + SL * c + j;
                    f32x4 v0 = acc[ai][bj][m][0], v1 = acc[ai][bj][m][1];
#pragma unroll
                    for (int e = 0; e < 4; ++e) { v0[e] = gelu_tanh(v0[e]); v1[e] = gelu_tanh(v1[e]); }
                    *(v4u*)(YG + (size_t)t * 1024 + 16 * g + p0) = pack8(v0, v1); } }
    }
};

struct EpiGlu {
    static constexpr bool PERM = true, CHAIN = false;
    const bf16* YG; unsigned char* YS; const float* bias;
    __device__ __forceinline__ void operator()(const f32x4 (&acc)[2][2][4][2], const Unit& u, int wr, int wc, int fr, int fq) const {
        const int row0 = u.pm * 256 + wr * 64 + fr, col0 = u.pn * 256 + wc * 32 + 8 * fq;
        f32x4 bv[2][2];
#pragma unroll
        for (int bj = 0; bj < 2; ++bj) { bv[bj][0] = *(const f32x4*)(bias + col0 + bj * 128); bv[bj][1] = *(const f32x4*)(bias + col0 + bj * 128 + 4); }
#pragma unroll
        for (int ai = 0; ai < 2; ++ai) { v4u ygv[4][2];
#pragma unroll
            for (int m = 0; m < 4; ++m)
#pragma unroll
                for (int bj = 0; bj < 2; ++bj) ygv[m][bj] = *(const v4u*)(YG + (size_t)(row0 + ai * 128 + m * 16) * 1024 + col0 + bj * 128);
#pragma unroll
            for (int m = 0; m < 4; ++m) { const size_t ro = (size_t)(row0 + ai * 128 + m * 16) * 1024;
#pragma unroll
                for (int bj = 0; bj < 2; ++bj) { const int col = col0 + bj * 128; const v4u yg = ygv[m][bj]; f32x4 z0 = acc[ai][bj][m][0] + bv[bj][0], z1 = acc[ai][bj][m][1] + bv[bj][1];
                    z0[0] = bflo(yg.x) * sigmoidf_(z0[0]); z0[1] = bfhi(yg.x) * sigmoidf_(z0[1]); z0[2] = bflo(yg.y) * sigmoidf_(z0[2]); z0[3] = bfhi(yg.y) * sigmoidf_(z0[3]);
                    z1[0] = bflo(yg.z) * sigmoidf_(z1[0]); z1[1] = bfhi(yg.z) * sigmoidf_(z1[1]); z1[2] = bflo(yg.w) * sigmoidf_(z1[2]); z1[3] = bfhi(yg.w) * sigmoidf_(z1[3]);
                    z0 = z0 * F8_MSCALE; z1 = z1 * F8_MSCALE; v2u w8; w8.x = pk4_fp8(z0[0], z0[1], z0[2], z0[3]); w8.y = pk4_fp8(z1[0], z1[1], z1[2], z1[3]); *(v2u*)(YS + 2 * ro + col) = w8; } } }
    }
};

struct EpiProjAB {
    static constexpr bool PERM = true, CHAIN = true; static constexpr int MID_T = 8;
    const unsigned char* GATES; unsigned char* MG;
    __device__ __forceinline__ void mid(f32x4 (&acc)[2][2][4][2], const Unit& u, int wr, int wc, int fr, int fq) const {
        int row0 = u.pm * 256 + wr * 64 + fr, col0 = u.pn * 256 + wc * 32 + 8 * fq; asm volatile("" : "+v"(row0), "+v"(col0));
#pragma unroll
        for (int ai = 0; ai < 2; ++ai)
#pragma unroll
            for (int m = 0; m < 4; ++m) { const size_t row = (size_t)(row0 + ai * 128 + m * 16);
#pragma unroll
                for (int bj = 0; bj < 2; ++bj) { const int col = col0 + bj * 128; const v2u ga = *(const v2u*)(GATES + row * 4096 + col), gs = *(const v2u*)(GATES + row * 4096 + 2048 + col);
                    f32x4& a0 = acc[ai][bj][m][0]; f32x4& a1 = acc[ai][bj][m][1];
#pragma unroll
                    for (int e = 0; e < 4; ++e) { a0[e] *= (float)((ga.x >> (8 * e)) & 0xffu) * __builtin_amdgcn_rcpf((float)((gs.x >> (8 * e)) & 0xffu));
                                                  a1[e] *= (float)((ga.y >> (8 * e)) & 0xffu) * __builtin_amdgcn_rcpf((float)((gs.y >> (8 * e)) & 0xffu)); } } }
    }
    __device__ __forceinline__ void operator()(const f32x4 (&acc)[2][2][4][2], const Unit& u, int wr, int wc, int fr, int fq) const {
        int row0 = u.pm * 256 + wr * 64 + fr, col0 = u.pn * 256 + wc * 32 + 8 * fq; asm volatile("" : "+v"(row0), "+v"(col0));
        constexpr float SC = F8_MDESCALE * F8_MSCALE * (1.0f / 255.0f);
        v2u gsv[2][4][2];
#pragma unroll
        for (int ai = 0; ai < 2; ++ai)
#pragma unroll
            for (int m = 0; m < 4; ++m)
#pragma unroll
                for (int bj = 0; bj < 2; ++bj) gsv[ai][m][bj] = *(const v2u*)(GATES + (size_t)(row0 + ai * 128 + m * 16) * 4096 + 2048 + col0 + bj * 128);
#pragma unroll
        for (int ai = 0; ai < 2; ++ai)
#pragma unroll
            for (int m = 0; m < 4; ++m) { const size_t row = (size_t)(row0 + ai * 128 + m * 16);
#pragma unroll
                for (int bj = 0; bj < 2; ++bj) { const int col = col0 + bj * 128; const v2u gs = gsv[ai][m][bj]; const f32x4 a0 = acc[ai][bj][m][0] * SC, a1 = acc[ai][bj][m][1] * SC;
                    v2u w8; w8.x = pk4_fp8(a0[0] * (float)(gs.x & 0xffu), a0[1] * (float)((gs.x >> 8) & 0xffu), a0[2] * (float)((gs.x >> 16) & 0xffu), a0[3] * (float)(gs.x >> 24));
                    w8.y = pk4_fp8(a1[0] * (float)(gs.y & 0xffu), a1[1] * (float)((gs.y >> 8) & 0xffu), a1[2] * (float)((gs.y >> 16) & 0xffu), a1[3] * (float)(gs.y >> 24));
                    *(v2u*)(MG + row * 2048 + col) = w8; } }
    }
};

struct EpiOut {
    static constexpr bool PERM = true, CHAIN = false;
    const float* X; const float* MOD; bf16* X1;
    __device__ __forceinline__ void operator()(const f32x4 (&acc)[2][2][4][2], const Unit& u, int wr, int wc, int fr, int fq) const {
        const int row0 = u.pm * 256 + wr * 64 + fr, col0 = u.pn * 256 + wc * 32 + 8 * fq;
        const float* gt1 = MOD + (size_t)(u.pm >> 3) * MODW + 2 * DM;
        f32x4 gv[2][2];
#pragma unroll
        for (int bj = 0; bj < 2; ++bj) { gv[bj][0] = *(const f32x4*)(gt1 + col0 + bj * 128); gv[bj][1] = *(const f32x4*)(gt1 + col0 + bj * 128 + 4); }
#pragma unroll
        for (int ai = 0; ai < 2; ++ai) { f32x4 xv[4][2][2];
#pragma unroll
            for (int m = 0; m < 4; ++m)
#pragma unroll
                for (int bj = 0; bj < 2; ++bj) { const float* xp = X + (size_t)(row0 + ai * 128 + m * 16) * 2048 + col0 + bj * 128; xv[m][bj][0] = *(const f32x4*)xp; xv[m][bj][1] = *(const f32x4*)(xp + 4); }
#pragma unroll
            for (int m = 0; m < 4; ++m) { const size_t ro = (size_t)(row0 + ai * 128 + m * 16) * 2048;
#pragma unroll
                for (int bj = 0; bj < 2; ++bj) { const int col = col0 + bj * 128;
                    const f32x4 o0 = xv[m][bj][0] + gv[bj][0] * (acc[ai][bj][m][0] * F8_MDESCALE), o1 = xv[m][bj][1] + gv[bj][1] * (acc[ai][bj][m][1] * F8_MDESCALE);
                    *(v4u*)(X1 + ro + col) = pack8(o0, o1); } } }
    }
};

struct EpiGateUp {
    static constexpr bool PERM = true, CHAIN = false;
    const float* bgu; unsigned char* ACT;
    __device__ __forceinline__ void operator()(const f32x4 (&acc)[2][2][4][2], const Unit& u, int wr, int wc, int fr, int fq) const {
        const int e = u.pn >> 4, ct = u.pn & 15, row0 = u.pm * 256 + wr * 64 + fr, col = ct * 128 + wc * 32 + 8 * fq;
        const float* bg = bgu + (size_t)e * 4096 + col; const f32x4 g0 = *(const f32x4*)bg, g1 = *(const f32x4*)(bg + 4);
        const f32x4 u0 = (*(const f32x4*)(bg + 2048) + 1.0f) * F8_ASCALE, u1 = (*(const f32x4*)(bg + 2052) + 1.0f) * F8_ASCALE;
        constexpr float D4 = F8_DESCALE * F8_ASCALE;
#pragma unroll
        for (int ai = 0; ai < 2; ++ai)
#pragma unroll
            for (int m = 0; m < 4; ++m) { f32x4 ga = acc[ai][0][m][0] * F8_DESCALE + g0, gb = acc[ai][0][m][1] * F8_DESCALE + g1, ua = acc[ai][1][m][0] * D4 + u0, ub = acc[ai][1][m][1] * D4 + u1;
#pragma unroll
                for (int q = 0; q < 4; ++q) { float gg = fminf(ga[q], 7.0f), uu = __builtin_amdgcn_fmed3f(ua[q], -6.0f * F8_ASCALE, 8.0f * F8_ASCALE); ga[q] = uu * (gg * sigmoid1702(gg));
                    gg = fminf(gb[q], 7.0f); uu = __builtin_amdgcn_fmed3f(ub[q], -6.0f * F8_ASCALE, 8.0f * F8_ASCALE); gb[q] = uu * (gg * sigmoid1702(gg)); }
                v2u w; w.x = pk4_fp8_nc(ga[0], ga[1], ga[2], ga[3]); w.y = pk4_fp8_nc(gb[0], gb[1], gb[2], gb[3]);
                *(v2u*)(ACT + (size_t)(row0 + ai * 128 + m * 16) * 2048 + col) = w; }
    }
};

struct EpiDown {
    static constexpr bool PERM = true, CHAIN = false;
    const float* bd; const float* GLIST; const LAS int* mt; unsigned char* YE;
    __device__ __forceinline__ void operator()(const f32x4 (&acc)[2][2][4][2], const Unit& u, int wr, int wc, int fr, int fq) const {
        const int e = (u.pn >> 3) & 31, ct = u.pn & 7, row0 = u.pm * 256 + wr * 64 + fr, col0 = ct * 256 + wc * 32 + 8 * fq, ne = mt[32 + e], i0 = row0 - mt[e];
        f32x4 bv[2][2]; float grv[2][4];
#pragma unroll
        for (int bj = 0; bj < 2; ++bj) { const float* bp = bd + (size_t)e * 2048 + col0 + bj * 128; bv[bj][0] = *(const f32x4*)bp; bv[bj][1] = *(const f32x4*)(bp + 4); }
#pragma unroll
        for (int ai = 0; ai < 2; ++ai)
#pragma unroll
            for (int m = 0; m < 4; ++m) { const int idx = i0 + ai * 128 + m * 16; const bool ok = idx >= 0 && idx < ne && idx < T; const float gl = GLIST[(size_t)e * T + (ok ? idx : 0)]; grv[ai][m] = ok ? gl * F8_YSCALE : 0.f; }
#pragma unroll
        for (int ai = 0; ai < 2; ++ai)
#pragma unroll
            for (int m = 0; m < 4; ++m) { const size_t row = (size_t)(row0 + ai * 128 + m * 16); const float gr = grv[ai][m];
#pragma unroll
                for (int bj = 0; bj < 2; ++bj) { const int col = col0 + bj * 128;
                    const f32x4 y0 = (acc[ai][bj][m][0] * F8_DESCALE + bv[bj][0]) * gr, y1 = (acc[ai][bj][m][1] * F8_DESCALE + bv[bj][1]) * gr;
                    v2u w8; w8.x = pk4_fp8(y0[0], y0[1], y0[2], y0[3]); w8.y = pk4_fp8(y1[0], y1[1], y1[2], y1[3]); *(v2u*)(YE + row * 2048 + col) = w8; } }
    }
};

struct SsmSOrder {
    int G, c;
    __device__ __forceinline__ bool next(int i, Unit& u) const { const int L = i * G + c; if (L >= 2 * SSMG) return false; u.pm = L; u.pn = L >> 1; return true; }
    __device__ __forceinline__ void a_ready(const Unit&) const {}
    __device__ __forceinline__ void done(const Unit&) const {}
};
struct SsmYOrder {
    int G, c;
    __device__ __forceinline__ bool next(int i, Unit& u) const { const int L = i * G + c; if (L >= 256) return false; const int g = L >> 2; u.pm = 2 * g + ((L >> 1) & 1); u.pn = 2 * g + (L & 1); return true; }
    __device__ __forceinline__ void a_ready(const Unit&) const {}
    __device__ __forceinline__ void done(const Unit&) const {}
};
struct MoeOrder {
    const LAS int* rbe; int nrb, sh, G, c;
    __device__ __forceinline__ bool next(int i, Unit& u) const {
        int rb, ct;
        if (G == 256) { const int x = c & 7, m = c >> 3, st = i * 8 + x, rbq = m >> 3, ctq = m & 7;
            if (sh == 4) { rb = 4 * (st >> 1) + rbq; ct = 8 * (st & 1) + ctq; } else { rb = 4 * st + rbq; ct = ctq; } }
        else { const int L = i * G + c; rb = L >> sh; ct = L & ((1 << sh) - 1); }
        if (rb >= nrb) return false;
        const int e = __builtin_amdgcn_readfirstlane(rbe[rb]);
        u.pm = rb; u.pn = (e << sh) + ct; return true; }
    __device__ __forceinline__ void a_ready(const Unit&) const {}
    __device__ __forceinline__ void done(const Unit&) const {}
};

struct Args { const float* in[28]; float* out; unsigned char* ws; int ph_lo, ph_hi; };
enum { I_X = 0, I_C, I_WADA, I_BADA, I_N1G, I_WIN, I_QG, I_KG, I_ARE, I_AIM, I_LDT, I_BRE, I_BIM, I_CRE, I_CIM, I_SD, I_WGLU, I_BGLU, I_WPA, I_WPB, I_WOUT, I_N2G, I_WR, I_BR, I_WGU, I_BGU, I_WD, I_BD };

__device__ __forceinline__ int crow(int r, int hi) { return (r & 3) + 8 * (r >> 2) + 4 * hi; }

__device__ __forceinline__ void ph0_adaln(const Args& a, LAS unsigned char* lds, int tid, int G, int bid) {
    LAS float* cond = (LAS float*)lds;
    LAS float* red = (LAS float*)(lds + 65536);
    const float* c = a.in[I_C]; const float* W = a.in[I_WADA]; const float* bada = a.in[I_BADA]; float* MOD = (float*)(a.ws + WS_MOD);
    bool have = false;
    for (int ub = bid; ub < MODW / 64; ub += G) {
        if (!have) { for (int i = tid; i < NB * DM; i += NTHR) { const int b = i >> 11, k = i & 2047; const float v = c[i]; cond[k * 8 + b] = v / (1.0f + expf(-v)); } __syncthreads(); have = true; }
        const int cc = tid & 63, col = ub * 64 + cc, kq = tid >> 6;
        float acc[8];
#pragma unroll
        for (int b = 0; b < 8; ++b) acc[b] = 0.f;
        const float* wp = W + (size_t)(kq * 256) * MODW + col;
        for (int k = 0; k < 256; k += 64) {
            float w[64];
#pragma unroll
            for (int q = 0; q < 64; ++q) w[q] = wp[(size_t)(k + q) * MODW];
#pragma unroll
            for (int q = 0; q < 64; ++q) { const f32x4 c0 = *(const LAS f32x4*)(cond + (kq * 256 + k + q) * 8), c1 = *(const LAS f32x4*)(cond + (kq * 256 + k + q) * 8 + 4);
                acc[0] += w[q] * c0[0]; acc[1] += w[q] * c0[1]; acc[2] += w[q] * c0[2]; acc[3] += w[q] * c0[3];
                acc[4] += w[q] * c1[0]; acc[5] += w[q] * c1[1]; acc[6] += w[q] * c1[2]; acc[7] += w[q] * c1[3]; }
        }
#pragma unroll
        for (int b = 0; b < 8; ++b) red[(kq * 8 + b) * 64 + cc] = acc[b];
        __syncthreads();
        { const int b = tid >> 6;
          float s = 0.f;
#pragma unroll
          for (int q = 0; q < 8; ++q) s += red[(q * 8 + b) * 64 + cc];
          MOD[(size_t)b * MODW + col] = s + bada[col]; }
        __syncthreads();
    }
    __syncthreads();
}
__device__ __forceinline__ void tr_item(const float* W, int ldw, int K, int srccol, int nvalid, bf16* WT, size_t dstrow0, int k0, LAS float* scr, int lane) {
    const int nn = lane & 31; const bool ok = nn < nvalid;
    float wv_[32];
#pragma unroll
    for (int i = 0; i < 32; ++i) { const int kk = 2 * i + (lane >> 5); wv_[i] = ok ? W[(size_t)(k0 + kk) * ldw + srccol + nn] : 0.f; }
#pragma unroll
    for (int i = 0; i < 32; ++i) { const int kk = 2 * i + (lane >> 5); scr[kk * 33 + nn] = wv_[i]; }
    LDS_WAIT(); asm volatile("" ::: "memory");
    const int c = lane & 7;
#pragma unroll
    for (int j = 0; j < 4; ++j) { const int n = (lane >> 3) + 8 * j; const LAS float* s = scr + (8 * c) * 33 + n;
        v4u o; o.x = pk2(s[0 * 33], s[1 * 33]); o.y = pk2(s[2 * 33], s[3 * 33]); o.z = pk2(s[4 * 33], s[5 * 33]); o.w = pk2(s[6 * 33], s[7 * 33]);
        *(v4u*)(WT + (dstrow0 + n) * K + k0 + 8 * c) = o; }
    LDS_WAIT(); asm volatile("" ::: "memory");
}
__device__ __forceinline__ void tr128_f8(const float* W, int ldw, int srccol, unsigned char* WT, size_t dstrow0, int K, int k0, LAS unsigned char* tile, int lane) {
    const float* src = W + (size_t)k0 * ldw + srccol + 2 * lane;
    f32x2 va[16], vb[16], vc[16], vd[16];
#define CV_LOAD(v, kb) do { _Pragma("unroll") for (int j = 0; j < 16; ++j) v[j] = __builtin_nontemporal_load((const f32x2*)(src + (size_t)((kb) * 16 + j) * ldw)); } while (0)
#define CV_PUT(v, kb) do { v4u a, b; \
        a.x = pk4_fp8(v[0][0] * F8_WSCALE, v[1][0] * F8_WSCALE, v[2][0] * F8_WSCALE, v[3][0] * F8_WSCALE); a.y = pk4_fp8(v[4][0] * F8_WSCALE, v[5][0] * F8_WSCALE, v[6][0] * F8_WSCALE, v[7][0] * F8_WSCALE); \
        a.z = pk4_fp8(v[8][0] * F8_WSCALE, v[9][0] * F8_WSCALE, v[10][0] * F8_WSCALE, v[11][0] * F8_WSCALE); a.w = pk4_fp8(v[12][0] * F8_WSCALE, v[13][0] * F8_WSCALE, v[14][0] * F8_WSCALE, v[15][0] * F8_WSCALE); \
        b.x = pk4_fp8(v[0][1] * F8_WSCALE, v[1][1] * F8_WSCALE, v[2][1] * F8_WSCALE, v[3][1] * F8_WSCALE); b.y = pk4_fp8(v[4][1] * F8_WSCALE, v[5][1] * F8_WSCALE, v[6][1] * F8_WSCALE, v[7][1] * F8_WSCALE); \
        b.z = pk4_fp8(v[8][1] * F8_WSCALE, v[9][1] * F8_WSCALE, v[10][1] * F8_WSCALE, v[11][1] * F8_WSCALE); b.w = pk4_fp8(v[12][1] * F8_WSCALE, v[13][1] * F8_WSCALE, v[14][1] * F8_WSCALE, v[15][1] * F8_WSCALE); \
        const int n0 = 2 * lane, n1 = 2 * lane + 1; \
        *(LAS v4u*)(tile + n0 * 128 + ((((kb)) ^ (n0 & 7)) << 4)) = a; *(LAS v4u*)(tile + n1 * 128 + ((((kb)) ^ (n1 & 7)) << 4)) = b; } while (0)
    CV_LOAD(va, 0); CV_LOAD(vb, 1); CV_LOAD(vc, 2);
    CV_LOAD(vd, 3); CV_PUT(va, 0); CV_LOAD(va, 4); CV_PUT(vb, 1); CV_LOAD(vb, 5); CV_PUT(vc, 2); CV_LOAD(vc, 6); CV_PUT(vd, 3); CV_LOAD(vd, 7);
    CV_PUT(va, 4); CV_PUT(vb, 5); CV_PUT(vc, 6); CV_PUT(vd, 7);
#undef CV_LOAD
#undef CV_PUT
    LDS_WAIT(); asm volatile("" ::: "memory");
    const int c = lane & 7;
#pragma unroll
    for (int j = 0; j < 16; ++j) { const int n = (lane >> 3) + 8 * j; const v4u o = *(const LAS v4u*)(tile + n * 128 + ((c ^ (n & 7)) << 4));
        *(v4u*)(WT + (dstrow0 + n) * K + k0 + 16 * c) = o; }
    LDS_WAIT(); asm volatile("" ::: "memory");
}
constexpr int CV_GU1 = 16 * 32, CV_GU = 32 * CV_GU1, CV_D1 = 16 * 16, CV_DN = 32 * CV_D1, CV_PA = 8 * 16, CV_PB = 8 * 16, CV_WO = 16 * 16, CV_ITEMS = CV_PA + CV_PB + CV_WO + CV_GU + CV_DN;
__device__ __forceinline__ void cv_item(const Args& a, int it, LAS unsigned char* tile, int lane) {
    if (it < CV_PA) { const int kt = it >> 4, nt = it & 15; tr128_f8(a.in[I_WPA], 2048, 128 * nt, (unsigned char*)(a.ws + WS_WA), (size_t)128 * nt, 2048, 128 * kt, tile, lane); return; } it -= CV_PA;
    if (it < CV_PB) { const int kt = it >> 4, nt = it & 15; tr128_f8(a.in[I_WPB], 2048, 128 * nt, (unsigned char*)(a.ws + WS_WA + 1024), (size_t)128 * nt, 2048, 128 * kt, tile, lane); return; } it -= CV_PB;
    if (it < CV_WO) { const int kt = it >> 4, nt = it & 15; tr128_f8(a.in[I_WOUT], 2048, 128 * nt, (unsigned char*)(a.ws + WS_WO), (size_t)128 * nt, 2048, 128 * kt, tile, lane); return; } it -= CV_WO;
    if (it < CV_GU) { const int e = it / CV_GU1, q = it % CV_GU1, kt = q >> 5, nt = q & 31, d0 = 128 * nt, ct = d0 >> 8; const int src = (d0 & 128) ? (2048 + 128 * ct) : (128 * ct);
        tr128_f8(a.in[I_WGU] + (size_t)e * 2048 * 4096, 4096, src, (unsigned char*)(a.ws + WS_WGU), (size_t)e * 4096 + d0, 2048, 128 * kt, tile, lane); }
    else { const int r = it - CV_GU, e = r / CV_D1, q = r % CV_D1, kt = q >> 4, nt = q & 15;
        tr128_f8(a.in[I_WD] + (size_t)e * 2048 * 2048, 2048, 128 * nt, (unsigned char*)(a.ws + WS_WD), (size_t)e * 2048 + 128 * nt, 2048, 128 * kt, tile, lane); }
}
__device__ __forceinline__ void ph0_transposes(const Args& a, LAS unsigned char* lds, int wave, int lane, int G, int bid) {
    LAS float* scr = (LAS float*)(lds + wave * 16384);
    const int gw = wave * G + bid, NGW = G * NWAVES;
    constexpr int I_IN = 32 * 80, I_GL = 16 * 32, I_IN8 = 16 * 42;
    constexpr int NITEMS = I_IN + I_GL + I_IN8;
    for (int it = gw; it < NITEMS; it += NGW) {
        int r = it;
        if (r < I_IN) { const int kb = r / 80, nb = r % 80, d0 = 32 * nb; int src, nv = 32;
            if (d0 < 1280) src = d0; else if (d0 < 2304) src = 1536 + (d0 - 1280); else if (d0 < 2368) src = 2560 + (d0 - 2304); else if (d0 == 2368) { src = 2624; nv = 16; } else { src = 0; nv = 0; }
            tr_item(a.in[I_WIN], INW, DM, src, nv, (bf16*)(a.ws + WS_WIN), (size_t)d0, 64 * kb, scr, lane); continue; } r -= I_IN;
        if (r < I_GL) { const int kb = r / 32, nb = r % 32; tr_item(a.in[I_WGLU], 1024, 1024, 32 * nb, 32, (bf16*)(a.ws + WS_WGLU), (size_t)32 * nb, 64 * kb, scr, lane); continue; } r -= I_GL;
        { const int kt = r / 42, nt = r % 42; const int src = nt < 2 ? 1280 + 128 * nt : (nt < 10 ? 2640 + 128 * (nt - 2) : 3664 + 128 * (nt - 10));
          tr128_f8(a.in[I_WIN], INW, src, (unsigned char*)(a.ws + WS_WIN8), (size_t)128 * nt, 2048, 128 * kt, lds + wave * 16384, lane); }
    }
}
__device__ __forceinline__ void cv_queue(const Args& a, LAS unsigned char* lds, int wave, int lane) {
    unsigned* ctr = (unsigned*)(a.ws + WS_CTL) + CW_CVQ;
    for (;;) { int it = 0; if (lane == 0) it = (int)__hip_atomic_fetch_add(ctr, 1u, RLX_AGENT); it = __builtin_amdgcn_readfirstlane(it); if (it >= CV_ITEMS) break; cv_item(a, it, lds + wave * 16384, lane); }
}
__device__ __forceinline__ void cexp_d(double zr, double zi, double& er, double& ei) {
    const double s = 1.0 / 1024.0; zr *= s; zi *= s;
    double wr = 1.0, wi = 0.0;
#pragma unroll
    for (int k = 10; k >= 1; --k) { const double tr = (zr * wr - zi * wi) / (double)k, ti = (zr * wi + zi * wr) / (double)k; wr = 1.0 + tr; wi = ti; }
#pragma unroll
    for (int q = 0; q < 10; ++q) { const double tr = wr * wr - wi * wi, ti = 2.0 * wr * wi; wr = tr; wi = ti; }
    er = wr; ei = wi;
}
__device__ __forceinline__ void ph0_ssm_consts(const Args& a, int tid, int G, int bid) {
    float* BBAR = (float*)(a.ws + WS_BBAR); float* POW = (float*)(a.ws + WS_POW);
    for (int idx = bid * NTHR + tid; idx < SSMG * SSMN; idx += G * NTHR) {
        const int g = idx >> 6, n = idx & 63;
        double st, dummy; cexp_d((double)a.in[I_LDT][g], 0.0, st, dummy);
        const double are = (double)a.in[I_ARE][idx], aim = (double)a.in[I_AIM][idx];
        double er, ei; cexp_d(st * are, st * aim, er, ei);
        const double den = are * are + aim * aim, nr = er - 1.0, ni = ei;
        const double cr = (nr * are + ni * aim) / den, ci = (ni * are - nr * aim) / den;
#pragma unroll 4
        for (int p = 0; p < 16; ++p) { const double br = (double)a.in[I_BRE][(size_t)idx * 16 + p], bi = (double)a.in[I_BIM][(size_t)idx * 16 + p];
            BBAR[((size_t)idx * 16 + p) * 2 + 0] = (float)(cr * br - ci * bi); BBAR[((size_t)idx * 16 + p) * 2 + 1] = (float)(cr * bi + ci * br); }
        double pr = 1.0, pi = 0.0;
        for (int t = 0; t <= 64; ++t) { POW[(((size_t)g * 65 + t) * 64 + n) * 2 + 0] = (float)pr; POW[(((size_t)g * 65 + t) * 64 + n) * 2 + 1] = (float)pi;
            const double tr = pr * er - pi * ei, ti = pr * ei + pi * er; pr = tr; pi = ti; }
    }
}

__device__ __forceinline__ void ph1_norm(const Args& a, int wave, int lane, int G, int bid) {
    const float* MOD = (const float*)(a.ws + WS_MOD);
    const int gw = bid * NWAVES + wave, NGW = G * NWAVES;
    {
        const float* X = a.in[I_X]; const float* g1 = a.in[I_N1G]; bf16* HN = (bf16*)(a.ws + WS_HN); unsigned char* HN8 = (unsigned char*)(a.ws + WS_HN8);
        const int RPW = (T + NGW - 1) / NGW, r0 = gw * RPW, r1 = min(T, r0 + RPW);
        f32x4 vn[8], pa[8], pb[8]; int curb = -1;
        if (r0 < r1) { const f32x4* xr = (const f32x4*)(X + (size_t)r0 * DM) + 2 * lane;
#pragma unroll
            for (int j = 0; j < 4; ++j) { vn[2 * j] = xr[128 * j]; vn[2 * j + 1] = xr[128 * j + 1]; } }
        for (int row = r0; row < r1; ++row) {
            const int b = row >> 11;
            f32x4 v[8]; float s = 0.f;
#pragma unroll
            for (int j = 0; j < 8; ++j) { v[j] = vn[j]; s += (v[j][0] * v[j][0] + v[j][1] * v[j][1]) + (v[j][2] * v[j][2] + v[j][3] * v[j][3]); }
            if (row + 1 < r1) { const f32x4* xr = (const f32x4*)(X + (size_t)(row + 1) * DM) + 2 * lane;
#pragma unroll
                for (int j = 0; j < 4; ++j) { vn[2 * j] = xr[128 * j]; vn[2 * j + 1] = xr[128 * j + 1]; } }
            if (b != curb) { curb = b; const f32x4* gp = (const f32x4*)g1 + 2 * lane; const f32x4* shp = (const f32x4*)(MOD + (size_t)b * MODW) + 2 * lane; const f32x4* scp = (const f32x4*)(MOD + (size_t)b * MODW + DM) + 2 * lane;
#pragma unroll
                for (int j = 0; j < 4; ++j) { pa[2 * j] = gp[128 * j] * (scp[128 * j] + 1.0f); pa[2 * j + 1] = gp[128 * j + 1] * (scp[128 * j + 1] + 1.0f); pb[2 * j] = shp[128 * j]; pb[2 * j + 1] = shp[128 * j + 1]; } }
            const float rstd = 1.0f / sqrtf(wave_sum(s) * (1.0f / DM) + RMS_EPS);
            v4u* o16 = (v4u*)(HN + (size_t)row * DM) + lane; v2u* o8 = (v2u*)(HN8 + (size_t)row * DM) + lane; v4u w[4]; v2u w8[4];
#pragma unroll
            for (int j = 0; j < 4; ++j) { const f32x4 y0 = (v[2 * j] * rstd) * pa[2 * j] + pb[2 * j], y1 = (v[2 * j + 1] * rstd) * pa[2 * j + 1] + pb[2 * j + 1];
                w[j].x = pk2(y0[0], y0[1]); w[j].y = pk2(y0[2], y0[3]); w[j].z = pk2(y1[0], y1[1]); w[j].w = pk2(y1[2], y1[3]);
                w8[j].x = pk4_fp8(y0[0] * F8_ASCALE, y0[1] * F8_ASCALE, y0[2] * F8_ASCALE, y0[3] * F8_ASCALE); w8[j].y = pk4_fp8(y1[0] * F8_ASCALE, y1[1] * F8_ASCALE, y1[2] * F8_ASCALE, y1[3] * F8_ASCALE); }
#pragma unroll
            for (int j = 0; j < 4; ++j) { o16[64 * j] = w[j]; o8[64 * j] = w8[j]; }
        }
    }
}
__device__ __forceinline__ void ph1_small(const Args& a, int tid, int wave, int lane, int G, int bid) {
    const float* MOD = (const float*)(a.ws + WS_MOD);
    const int gw = bid * NWAVES + wave, NGW = G * NWAVES;
    {
        const float* g2 = a.in[I_N2G]; const float* wr = a.in[I_WR]; const float* br = a.in[I_BR]; float* WRP = (float*)(a.ws + WS_WRP); float* BRP = (float*)(a.ws + WS_BRP);
        for (int base = bid * NTHR + tid; base < NB * DM * NEXP; base += 4 * G * NTHR) { float v[4];
#pragma unroll
            for (int u = 0; u < 4; ++u) { const int idx = base + u * G * NTHR, ic = idx < NB * DM * NEXP ? idx : 0, b = ic >> 16, k = (ic >> 5) & 2047; v[u] = g2[k] * (1.0f + MOD[(size_t)b * MODW + 4 * DM + k]) * wr[ic & 65535]; }
#pragma unroll
            for (int u = 0; u < 4; ++u) { const int idx = base + u * G * NTHR; if (idx < NB * DM * NEXP) WRP[idx] = v[u]; } }
        for (int o = (wave == 2 ? bid : NB * NEXP); o < NB * NEXP; o += G) { const int b = o >> 5, e = o & 31; float s = 0.f;
#pragma unroll 8
            for (int k = lane; k < DM; k += 64) s += MOD[(size_t)b * MODW + 3 * DM + k] * wr[k * 32 + e];
            s = wave_sum(s); if (lane == 0) BRP[o] = s + br[e]; }
    }
    {
        const float* cre = a.in[I_CRE]; const float* cim = a.in[I_CIM]; const float* BBAR = (const float*)(a.ws + WS_BBAR); const float* POW = (const float*)(a.ws + WS_POW); float* KT = (float*)(a.ws + WS_KT);
        for (int idx = (tid < 128 ? bid * 128 + tid : SSMG * SL * 16); idx < SSMG * SL * 16; idx += G * 128) {
            const int g = idx >> 9, tau = (idx >> 4) & 31, p = idx & 15; float s[16];
#pragma unroll
            for (int q = 0; q < 16; ++q) s[q] = 0.f;
#pragma unroll 8
            for (int n = 0; n < 64; ++n) { const float cr = cre[((size_t)g * 16 + p) * 64 + n], ci = cim[((size_t)g * 16 + p) * 64 + n];
                const float pr = POW[(((size_t)g * 65 + tau) * 64 + n) * 2], pi = POW[(((size_t)g * 65 + tau) * 64 + n) * 2 + 1];
                const float er = cr * pr - ci * pi, ei = cr * pi + ci * pr;
                const f32x4* bp = (const f32x4*)(BBAR + ((size_t)g * 64 + n) * 32);
#pragma unroll
                for (int q = 0; q < 8; ++q) { const f32x4 bb = bp[q]; s[2 * q] += er * bb[0] - ei * bb[1]; s[2 * q + 1] += er * bb[2] - ei * bb[3]; } }
            { const float dv = (tau == 0) ? a.in[I_SD][g * 16 + p] : 0.0f;
#pragma unroll
              for (int q = 0; q < 16; ++q) s[q] += (q == p) ? dv : 0.0f; }
            float* kp = KT + (((size_t)g * 64 + tau) * 16 + p) * 16;
#pragma unroll
            for (int q = 0; q < 4; ++q) *(f32x4*)(kp + 4 * q) = (f32x4){s[4 * q], s[4 * q + 1], s[4 * q + 2], s[4 * q + 3]}; }
    }
}

__device__ __forceinline__ void qknorm_body(const Args& a, int wave, int lane, int G, int bid) {
    const int gw = bid * NWAVES + wave, NGW = G * NWAVES;
    {   bf16* Q = (bf16*)(a.ws + WS_Q); bf16* K = (bf16*)(a.ws + WS_K); const float* qg = a.in[I_QG]; const float* kg = a.in[I_KG];
        const float qs = 0.08838834764831845f * 1.4426950408889634f;
        const int l32 = lane & 31; float qgv[16], kgv[8];
#pragma unroll
        for (int e = 0; e < 16; ++e) qgv[e] = qg[((16 * lane) & 127) + e];
#pragma unroll
        for (int e = 0; e < 8; ++e) kgv[e] = kg[((8 * l32) & 127) + e];
        for (int row0 = gw; row0 < T; row0 += 4 * NGW) {
            v4u qa[4], qb[4], ka[4];
#pragma unroll
            for (int u = 0; u < 4; ++u) { const int row = min(row0 + u * NGW, T - 1); const v4u* qp = (const v4u*)(Q + (size_t)row * 1024 + 16 * lane); qa[u] = qp[0]; qb[u] = qp[1]; ka[u] = *(const v4u*)(K + (size_t)row * 256 + 8 * l32); }
#pragma unroll
            for (int u = 0; u < 4; ++u) { const int row = row0 + u * NGW; if (row < T) {
                {   v4u* qp = (v4u*)(Q + (size_t)row * 1024 + 16 * lane); const v4u w0 = qa[u], w1 = qb[u]; float f[16];
                    f[0] = bflo(w0.x); f[1] = bfhi(w0.x); f[2] = bflo(w0.y); f[3] = bfhi(w0.y); f[4] = bflo(w0.z); f[5] = bfhi(w0.z); f[6] = bflo(w0.w); f[7] = bfhi(w0.w);
                    f[8] = bflo(w1.x); f[9] = bfhi(w1.x); f[10] = bflo(w1.y); f[11] = bfhi(w1.y); f[12] = bflo(w1.z); f[13] = bfhi(w1.z); f[14] = bflo(w1.w); f[15] = bfhi(w1.w);
                    float s = 0.f;
#pragma unroll
                    for (int e = 0; e < 16; ++e) s += f[e] * f[e];
                    s += __shfl_xor(s, 1); s += __shfl_xor(s, 2); s += __shfl_xor(s, 4);
                    const float rs = qs / sqrtf(s * (1.0f / 128.0f) + RMS_EPS);
#pragma unroll
                    for (int e = 0; e < 16; ++e) f[e] = f[e] * rs * qgv[e];
                    v4u o0, o1; o0.x = pk2(f[0], f[1]); o0.y = pk2(f[2], f[3]); o0.z = pk2(f[4], f[5]); o0.w = pk2(f[6], f[7]); o1.x = pk2(f[8], f[9]); o1.y = pk2(f[10], f[11]); o1.z = pk2(f[12], f[13]); o1.w = pk2(f[14], f[15]);
                    qp[0] = o0; qp[1] = o1; }
                {   v4u* kp = (v4u*)(K + (size_t)row * 256 + 8 * l32); const v4u w0 = ka[u]; float f[8];
                    f[0] = bflo(w0.x); f[1] = bfhi(w0.x); f[2] = bflo(w0.y); f[3] = bfhi(w0.y); f[4] = bflo(w0.z); f[5] = bfhi(w0.z); f[6] = bflo(w0.w); f[7] = bfhi(w0.w);
                    float s = 0.f;
#pragma unroll
                    for (int e = 0; e < 8; ++e) s += f[e] * f[e];
                    s += __shfl_xor(s, 1); s += __shfl_xor(s, 2); s += __shfl_xor(s, 4); s += __shfl_xor(s, 8);
                    const float rs = 1.0f / sqrtf(s * (1.0f / 128.0f) + RMS_EPS);
#pragma unroll
                    for (int e = 0; e < 8; ++e) f[e] = f[e] * rs * kgv[e];
                    v4u o0; o0.x = pk2(f[0], f[1]); o0.y = pk2(f[2], f[3]); o0.z = pk2(f[4], f[5]); o0.w = pk2(f[6], f[7]);
                    if (lane < 32) kp[0] = o0; } } }
        }
    }
}
__device__ __forceinline__ void bty_body(const Args& a, int tid, int G, int bid) {
    const float* KT = (const float*)(a.ws + WS_KT); const float* POW = (const float*)(a.ws + WS_POW); const float* cre = a.in[I_CRE]; const float* cim = a.in[I_CIM]; bf16* BTY = (bf16*)(a.ws + WS_BTY);
    constexpr int RPG = SL * 16; const int NA = SSMG * RPG * 64, NBC = SSMG * RPG * 16, ST = G * NTHR;
    for (int base = bid * NTHR + tid; base < NA; base += 4 * ST) {
        f32x4 lo[4], hi[4];
#pragma unroll
        for (int u = 0; u < 4; ++u) { const int idx = base + u * ST, ic = idx < NA ? idx : 0, cc = ic & 63, rr = (ic >> 6) & (RPG - 1), g = ic >> 15, j = rr >> 4, p = rr & 15, i = cc >> 1, d = j >= i ? j - i : 0;
            const float* kp = KT + (((size_t)g * 64 + d) * 16 + p) * 16 + (cc & 1) * 8; lo[u] = *(const f32x4*)kp; hi[u] = *(const f32x4*)(kp + 4); }
#pragma unroll
        for (int u = 0; u < 4; ++u) { const int idx = base + u * ST; if (idx < NA) { const int cc = idx & 63, rr = (idx >> 6) & (RPG - 1), g = idx >> 15, j = rr >> 4, i = cc >> 1; const bool ok = j >= i;
            v4u o; o.x = ok ? pk2(lo[u][0], lo[u][1]) : 0u; o.y = ok ? pk2(lo[u][2], lo[u][3]) : 0u; o.z = ok ? pk2(hi[u][0], hi[u][1]) : 0u; o.w = ok ? pk2(hi[u][2], hi[u][3]) : 0u;
            *(v4u*)(BTY + ((size_t)g * RPG + rr) * UA_LD + 8 * cc) = o; } }
    }
    for (int base = bid * NTHR + tid; base < NBC; base += 4 * ST) {
        f32x4 cr[4], ci[4], p0[4], p1[4];
#pragma unroll
        for (int u = 0; u < 4; ++u) { const int idx = base + u * ST, ic = idx < NBC ? idx : 0, cq = ic & 15, rr = (ic >> 4) & (RPG - 1), g = ic >> 13, j = rr >> 4, p = rr & 15;
            cr[u] = *(const f32x4*)(cre + ((size_t)g * 16 + p) * 64 + 4 * cq); ci[u] = *(const f32x4*)(cim + ((size_t)g * 16 + p) * 64 + 4 * cq);
            const float* pw = POW + (((size_t)g * 65 + (j + 1)) * 64 + 4 * cq) * 2; p0[u] = *(const f32x4*)pw; p1[u] = *(const f32x4*)(pw + 4); }
#pragma unroll
        for (int u = 0; u < 4; ++u) { const int idx = base + u * ST; if (idx < NBC) { const int cq = idx & 15, rr = (idx >> 4) & (RPG - 1), g = idx >> 13;
            v4u o; o.x = pk2(cr[u][0] * p0[u][0] - ci[u][0] * p0[u][1], -(cr[u][0] * p0[u][1] + ci[u][0] * p0[u][0])); o.y = pk2(cr[u][1] * p0[u][2] - ci[u][1] * p0[u][3], -(cr[u][1] * p0[u][3] + ci[u][1] * p0[u][2]));
            o.z = pk2(cr[u][2] * p1[u][0] - ci[u][2] * p1[u][1], -(cr[u][2] * p1[u][1] + ci[u][2] * p1[u][0])); o.w = pk2(cr[u][3] * p1[u][2] - ci[u][3] * p1[u][3], -(cr[u][3] * p1[u][3] + ci[u][3] * p1[u][2]));
            *(v4u*)(BTY + ((size_t)g * RPG + rr) * UA_LD + SL * 16 + 8 * cq) = o; } }
    }
}
__device__ __forceinline__ void bts_body(const Args& a, int tid, int G, int bid) {
    const float* BBAR = (const float*)(a.ws + WS_BBAR); const float* POW = (const float*)(a.ws + WS_POW); bf16* BTS = (bf16*)(a.ws + WS_BTS);
    constexpr int CPR = SL * 16 / 8; const int NCH = SSMG * 256 * CPR, ST = G * NTHR;
    for (int base = bid * NTHR + tid; base < NCH; base += 4 * ST) {
        f32x4 bb[4][4]; f32x2 pw[4];
#pragma unroll
        for (int u = 0; u < 4; ++u) { const int idx = base + u * ST, ic = idx < NCH ? idx : 0, cc = ic % CPR, rr = (ic / CPR) & 127, g = ic / (CPR * 256), col0 = 8 * cc, i = col0 >> 4, pp0 = col0 & 15, n = rr >> 1;
            pw[u] = *(const f32x2*)(POW + (((size_t)g * 65 + (SL - 1 - i)) * 64 + n) * 2); const f32x4* bp = (const f32x4*)(BBAR + (((size_t)g * 64 + n) * 16 + pp0) * 2);
#pragma unroll
            for (int q = 0; q < 4; ++q) bb[u][q] = bp[q]; }
#pragma unroll
        for (int u = 0; u < 4; ++u) { const int idx = base + u * ST; if (idx < NCH) { const int cc = idx % CPR, rr = (idx / CPR) & 255, g = idx / (CPR * 256); const bool live = rr < 128, part = rr & 1; const float pr = pw[u][0], pi = pw[u][1]; float f[8];
#pragma unroll
            for (int q = 0; q < 4; ++q) { f[2 * q] = part ? (pr * bb[u][q][1] + pi * bb[u][q][0]) : (pr * bb[u][q][0] - pi * bb[u][q][1]); f[2 * q + 1] = part ? (pr * bb[u][q][3] + pi * bb[u][q][2]) : (pr * bb[u][q][2] - pi * bb[u][q][3]); }
            v4u o; o.x = live ? pk2(f[0], f[1]) : 0u; o.y = live ? pk2(f[2], f[3]) : 0u; o.z = live ? pk2(f[4], f[5]) : 0u; o.w = live ? pk2(f[6], f[7]) : 0u;
            *(v4u*)(BTS + ((size_t)g * 256 + rr) * (SL * 16) + 8 * cc) = o; } }
    }
}

namespace att {
constexpr int D = 128, NW = 8, QBLK = 32, KVBLK = 64, LDK = 256;
constexpr float THR2 = 11.5415603f;
constexpr size_t SHM_V = KVBLK * D * 2, SHM_K = KVBLK * D * 2, SHM_ATTN = 2 * SHM_V + 2 * SHM_K + NW * 64 * 4;
using u32x4 = __attribute__((ext_vector_type(4))) unsigned;
#define KSWZ(row, colB) ((row) * 256 + ((colB) ^ (((row) & 7) << 4)))
#define SBAR() __builtin_amdgcn_sched_barrier(0)
__device__ __forceinline__ unsigned cvtpk(float lo, float hi) { unsigned r; asm volatile("v_cvt_pk_bf16_f32 %0, %1, %2" : "=v"(r) : "v"(lo), "v"(hi)); return r; }

__device__ __forceinline__ void amask(f32x16& p0, f32x16& p1, unsigned mw0, unsigned mw1, float dq, float nslope, int hi) {
  const unsigned s0 = mw0 >> (4 * hi), s1 = mw1 >> (4 * hi);
#pragma unroll
  for (int r = 0; r < 16; ++r) { const int c = (r & 3) + 8 * (r >> 2);
    const float v = fmaf(nslope, fabsf(dq - (float)c), p0[r]); p0[r] = (s0 & (1u << c)) ? v : -INFINITY;
    const float w = fmaf(nslope, fabsf(dq - (float)(c + 32)), p1[r]); p1[r] = (s1 & (1u << c)) ? w : -INFINITY; }
}
__device__ __forceinline__ void partialSM(f32x16& p0, f32x16& p1, float& m_reg, float& mn, float& alpha) {
  float pmax = p0[0];
#pragma unroll
  for (int r = 1; r < 16; ++r) pmax = fmaxf(pmax, p0[r]);
#pragma unroll
  for (int r = 0; r < 16; ++r) pmax = fmaxf(pmax, p1[r]);
  { auto rr = __builtin_amdgcn_permlane32_swap(__float_as_uint(pmax), __float_as_uint(pmax), false, false);
    pmax = fmaxf(__uint_as_float(rr[0]), __uint_as_float(rr[1])); }
  if (__builtin_expect(__all(pmax - m_reg <= THR2), 1)) { mn = m_reg; alpha = 1.f; }
  else { mn = fmaxf(m_reg, pmax); alpha = __builtin_amdgcn_exp2f(m_reg - mn); m_reg = mn; }
#pragma unroll
  for (int r = 0; r < 16; ++r) p0[r] = p0[r] - mn;
#pragma unroll
  for (int r = 0; r < 16; ++r) p1[r] = p1[r] - mn;
#pragma unroll
  for (int r = 0; r < 16; ++r) p0[r] = __builtin_amdgcn_exp2f(p0[r]);
}
__device__ __forceinline__ void finishSM(f32x16& p0, f32x16& p1, float alpha, float& l_reg, bf16x8& pa0, bf16x8& pa1, bf16x8& pa2, bf16x8& pa3) {
#pragma unroll
  for (int r = 0; r < 16; ++r) p1[r] = __builtin_amdgcn_exp2f(p1[r]);
  float ps = 0;
#pragma unroll
  for (int r = 0; r < 16; ++r) ps += p0[r];
#pragma unroll
  for (int r = 0; r < 16; ++r) ps += p1[r];
  { auto rr = __builtin_amdgcn_permlane32_swap(__float_as_uint(ps), __float_as_uint(ps), false, false);
    ps = __uint_as_float(rr[0]) + __uint_as_float(rr[1]); }
  l_reg = l_reg * alpha + ps;
#define PK4(P, BASE, OUT) do { unsigned a0 = cvtpk(P[BASE + 0], P[BASE + 1]), a1 = cvtpk(P[BASE + 2], P[BASE + 3]);   \
    unsigned b0 = cvtpk(P[BASE + 4], P[BASE + 5]), b1 = cvtpk(P[BASE + 6], P[BASE + 7]);                              \
    auto r0 = __builtin_amdgcn_permlane32_swap(a0, b0, false, false); auto r1 = __builtin_amdgcn_permlane32_swap(a1, b1, false, false); \
    u32x4 w = {r0[0], r1[0], r0[1], r1[1]}; OUT = *reinterpret_cast<bf16x8*>(&w); } while (0)
  PK4(p0, 0, pa0); PK4(p0, 8, pa1); PK4(p1, 0, pa2); PK4(p1, 8, pa3);
#undef PK4
}
__device__ __forceinline__ void qkt(f32x16& p0, f32x16& p1, const bf16* Ks, const bf16x8* qr, int r32, int hi) {
  p0 = f32x16{}; p1 = f32x16{};
#pragma unroll
  for (int d0 = 0; d0 < 8; ++d0) { int cb = (d0 * 16 + hi * 8) * 2;
    bf16x8 b0 = *reinterpret_cast<const bf16x8*>((const char*)Ks + KSWZ(r32, cb));
    bf16x8 b1 = *reinterpret_cast<const bf16x8*>((const char*)Ks + KSWZ(32 + r32, cb));
    p0 = __builtin_amdgcn_mfma_f32_32x32x16_bf16(b0, qr[d0], p0, 0, 0, 0);
    p1 = __builtin_amdgcn_mfma_f32_32x32x16_bf16(b1, qr[d0], p1, 0, 0, 0); }
}
__device__ __forceinline__ int v_st(int k, int c) { const int kk = (k & ~0xC) | ((k & 4) << 1) | ((k & 8) >> 1); return ((kk >> 3) * 4 + (c >> 5)) * 512 + ((kk & 7) * 32 + (c & 31)) * 2; }
__device__ __forceinline__ int v_rd_base(int lane) { return ((lane & 3) << 3) | (((lane >> 2) & 3) << 6) | (((lane >> 4) & 1) << 5) | (((lane >> 5) & 1) << 8); }
constexpr int v_rd_off(int d0, int ks, int half) { return d0 * 512 + ks * 4096 + half * 2048; }
template <int OFF> __device__ __forceinline__ s16x4 tr_read(int vb) {
  s16x4 r; asm volatile("ds_read_b64_tr_b16 %0, %1 offset:%2" : "=&v"(r) : "v"(vb), "i"(OFF) : "memory"); return r;
}
template <int D0> __device__ __forceinline__ void pv_one(f32x16& od, int vb, bf16x8 pa0, bf16x8 pa1, bf16x8 pa2, bf16x8 pa3) {
  const s16x4 l0 = tr_read<v_rd_off(D0, 0, 0)>(vb), h0 = tr_read<v_rd_off(D0, 0, 1)>(vb), l1 = tr_read<v_rd_off(D0, 1, 0)>(vb), h1 = tr_read<v_rd_off(D0, 1, 1)>(vb);
  const s16x4 l2 = tr_read<v_rd_off(D0, 2, 0)>(vb), h2 = tr_read<v_rd_off(D0, 2, 1)>(vb), l3 = tr_read<v_rd_off(D0, 3, 0)>(vb), h3 = tr_read<v_rd_off(D0, 3, 1)>(vb);
  asm volatile("s_waitcnt lgkmcnt(0)" ::: "memory"); SBAR();
#define PK(L, H) (bf16x8){L[0], L[1], L[2], L[3], H[0], H[1], H[2], H[3]}
  od = __builtin_amdgcn_mfma_f32_32x32x16_bf16(pa0, PK(l0, h0), od, 0, 0, 0);
  od = __builtin_amdgcn_mfma_f32_32x32x16_bf16(pa1, PK(l1, h1), od, 0, 0, 0);
  od = __builtin_amdgcn_mfma_f32_32x32x16_bf16(pa2, PK(l2, h2), od, 0, 0, 0);
  od = __builtin_amdgcn_mfma_f32_32x32x16_bf16(pa3, PK(l3, h3), od, 0, 0, 0);
#undef PK
}
__device__ __forceinline__ void pv_d0(f32x16* o, int vb, bf16x8 pa0, bf16x8 pa1, bf16x8 pa2, bf16x8 pa3) {
  pv_one<0>(o[0], vb, pa0, pa1, pa2, pa3); pv_one<1>(o[1], vb, pa0, pa1, pa2, pa3); pv_one<2>(o[2], vb, pa0, pa1, pa2, pa3); pv_one<3>(o[3], vb, pa0, pa1, pa2, pa3);
}

__device__ __forceinline__ void attn_unit(const bf16* __restrict__ Qlane, const bf16* __restrict__ Kh, const bf16* __restrict__ Vh, unsigned char* __restrict__ Ow, int ldo,
                                          const unsigned* __restrict__ selbase, unsigned selo, int qpos, float nslope, int NT, int NTreal, char* lds) {
  const int tid = threadIdx.x, wid = tid >> 6, lane = tid & 63, r32 = lane & 31, hi = lane >> 5;
  bf16* V_lds = (bf16*)lds; bf16* K_lds = (bf16*)(lds + 2 * SHM_V);
  float* ws = (float*)(lds + 2 * SHM_V + 2 * SHM_K) + wid * 64; float* li_l = ws; float* al_l = ws + 32;
  float m_reg = -1e30f, l_reg = 0; f32x16 o[4] = {}; bf16x8 qr[8];
#pragma unroll
  for (int d0 = 0; d0 < 8; ++d0) qr[d0] = *reinterpret_cast<const bf16x8*>(Qlane + d0 * 16);
  const int sr = tid >> 4, sc = (tid & 15) * 8, vst0 = v_st(sr, sc), vst1 = v_st(32 + sr, sc);
  const int vb0 = (int)(uintptr_t)V_lds + v_rd_base(lane);
  const int soffb = (sr * LDK + sc) * 2;
  const __amdgpu_buffer_rsrc_t rsK = __builtin_amdgcn_make_buffer_rsrc((void*)Kh, 0, 1 << 20, 0x00020000), rsV = __builtin_amdgcn_make_buffer_rsrc((void*)Vh, 0, 1 << 20, 0x00020000);
  const float dqb = (float)(qpos - 4 * hi);
  struct { bf16x8 vs0, vs1, ks0, ks1; } sr_[2];
#define SLOAD(i, k0) do { const int so_ = (k0) * (LDK * 2); \
    sr_[i].vs0 = __builtin_bit_cast(bf16x8, __builtin_amdgcn_raw_buffer_load_b128(rsV, soffb, so_, 0)); sr_[i].vs1 = __builtin_bit_cast(bf16x8, __builtin_amdgcn_raw_buffer_load_b128(rsV, soffb, so_ + 32 * LDK * 2, 0)); \
    sr_[i].ks0 = __builtin_bit_cast(bf16x8, __builtin_amdgcn_raw_buffer_load_b128(rsK, soffb, so_, 0)); sr_[i].ks1 = __builtin_bit_cast(bf16x8, __builtin_amdgcn_raw_buffer_load_b128(rsK, soffb, so_ + 32 * LDK * 2, 0)); } while (0)
#define SWRITE(b, i) do { *(bf16x8*)((char*)V_lds + (b) * SHM_V + vst0) = sr_[i].vs0;          \
    *(bf16x8*)((char*)V_lds + (b) * SHM_V + vst1) = sr_[i].vs1; int kc = sc * 2;               \
    *(bf16x8*)((char*)K_lds + (b) * SHM_K + KSWZ(sr, kc)) = sr_[i].ks0;                       \
    *(bf16x8*)((char*)K_lds + (b) * SHM_K + KSWZ(32 + sr, kc)) = sr_[i].ks1; } while (0)
#define SWAIT() asm volatile("s_waitcnt vmcnt(4)" ::: "memory")
#define RESC(a) do { if (__any((a) < 1.f)) { if (hi == 0) al_l[r32] = (a); asm volatile("s_waitcnt lgkmcnt(0)" ::: "memory"); \
    _Pragma("unroll") for (int d = 0; d < 4; ++d) _Pragma("unroll") for (int r = 0; r < 16; ++r) o[d][r] *= al_l[crow(r, hi)]; } } while (0)
#define MASKW(j, m0, m1) do { const v2u mm_ = *reinterpret_cast<const v2u*>(selbase + (selo + 2u * (unsigned)(j))); const bool in_ = (j) < NTreal; m0 = in_ ? mm_.x : 0u; m1 = in_ ? mm_.y : 0u; } while (0)
  f32x16 pA0, pA1, pB0, pB1; float mnA, mnB, alA, alB; bf16x8 pa0, pa1, pa2, pa3; unsigned ma0, ma1, mb0, mb1;
  constexpr int SE = 0, SO = 1;
  SLOAD(SE, 0); MASKW(0, ma0, ma1); MASKW(1, mb0, mb1); asm volatile("s_waitcnt vmcnt(0)" ::: "memory"); SWRITE(0, SE); __syncthreads();
  qkt(pA0, pA1, K_lds, qr, r32, hi); amask(pA0, pA1, ma0, ma1, dqb, nslope, hi); partialSM(pA0, pA1, m_reg, mnA, alA);
  SLOAD(SO, KVBLK); if (2 < NT) SLOAD(SE, 2 * KVBLK);
  SWAIT(); SWRITE(1, SO); __syncthreads();
  for (int j = 1; j + 1 < NT; j += 2) {
    SBAR(); qkt(pB0, pB1, (bf16*)((char*)K_lds + SHM_K), qr, r32, hi);
    finishSM(pA0, pA1, alA, l_reg, pa0, pa1, pa2, pa3); SBAR();
    MASKW(j + 1, ma0, ma1); SLOAD(SO, (j + 2) * KVBLK); SBAR();
    pv_d0(o, vb0, pa0, pa1, pa2, pa3); amask(pB0, pB1, mb0, mb1, dqb - (float)(64 * j), nslope, hi); partialSM(pB0, pB1, m_reg, mnB, alB);
    __syncthreads(); SWAIT(); SWRITE(0, SE);
    RESC(alB); __syncthreads();
    SBAR(); qkt(pA0, pA1, K_lds, qr, r32, hi);
    finishSM(pB0, pB1, alB, l_reg, pa0, pa1, pa2, pa3); SBAR();
    MASKW(j + 2, mb0, mb1); if (j + 3 < NT) SLOAD(SE, (j + 3) * KVBLK); SBAR();
    pv_d0(o, vb0 + (int)SHM_V, pa0, pa1, pa2, pa3); amask(pA0, pA1, ma0, ma1, dqb - (float)(64 * (j + 1)), nslope, hi); partialSM(pA0, pA1, m_reg, mnA, alA);
    __syncthreads(); SWAIT(); SWRITE(1, SO);
    RESC(alA); __syncthreads();
  }
  SBAR(); qkt(pB0, pB1, (bf16*)((char*)K_lds + SHM_K), qr, r32, hi);
  finishSM(pA0, pA1, alA, l_reg, pa0, pa1, pa2, pa3); SBAR();
  SBAR();
  pv_d0(o, vb0, pa0, pa1, pa2, pa3); amask(pB0, pB1, mb0, mb1, dqb - (float)(64 * (NT - 1)), nslope, hi); partialSM(pB0, pB1, m_reg, mnB, alB);
  __syncthreads(); RESC(alB);
  finishSM(pB0, pB1, alB, l_reg, pa0, pa1, pa2, pa3); SBAR();
  pv_d0(o, vb0 + (int)SHM_V, pa0, pa1, pa2, pa3);
  if (hi == 0) li_l[r32] = l_reg; asm volatile("s_waitcnt lgkmcnt(0)" ::: "memory");
  float rli[16];
#pragma unroll
  for (int r = 0; r < 16; ++r) rli[r] = __builtin_amdgcn_rcpf(li_l[crow(r, hi)]);
  unsigned ob = (unsigned)(4 * hi * ldo + r32); asm volatile("" : "+v"(ob));
#pragma unroll
  for (int r = 0; r < 16; ++r) { const int orow0 = crow(r, 0);
#pragma unroll
    for (int d0 = 0; d0 < 4; ++d0) Ow[ob + (unsigned)(orow0 * ldo + d0 * 32)] = (unsigned char)(__builtin_amdgcn_cvt_pk_fp8_f32(__builtin_amdgcn_fmed3f(o[d0][r] * rli[r] * F8_MSCALE, -448.f, 448.f), 0.f, 0, false) & 0xff); }
  __syncthreads();
#undef SLOAD
#undef SWRITE
#undef SWAIT
#undef RESC
#undef MASKW
}
#undef KSWZ
#undef SBAR
}

__device__ __forceinline__ void ph4a_unit(const Args& a, LAS unsigned char* lds, int tid, int wave, int lane, int b, int ci, int p0, int np) {
    const bf16* IQ = (const bf16*)(a.ws + WS_IQ); const bf16* IK = (const bf16*)(a.ws + WS_IK); const float* IW = (const float*)(a.ws + WS_IW); float* SC = (float*)(a.ws + WS_SC);
    const int tok0 = b * SEQ + ci * CHUNK;
    __syncthreads();
    for (int i = tid; i < 64 * 128; i += NTHR) { const int q = i >> 7, ch = i & 127, head = ch >> 3, c8 = ch & 7;
        const v4u v = *(const v4u*)(IQ + ((size_t)tok0 + q) * 1024 + ch * 8);
        *(LAS v4u*)(lds + q * 2048 + ((head ^ ((q >> 3) & 1)) * 128) + ((c8 ^ (q & 7)) * 16)) = v; }
    __syncthreads();
    const int qt = wave & 1, q = qt * 32 + (lane & 31), hh = lane >> 5; const size_t tokq = (size_t)tok0 + q;
    float wgt[16];
#pragma unroll
    for (int h4 = 0; h4 < 4; ++h4) { const f32x4 w4 = *(const f32x4*)(IW + tokq * 16 + 4 * h4); wgt[4 * h4] = w4[0]; wgt[4 * h4 + 1] = w4[1]; wgt[4 * h4 + 2] = w4[2]; wgt[4 * h4 + 3] = w4[3]; }
    const LAS unsigned char* qb = lds + q * 2048; const int hx = ((q >> 3) & 1) * 128; int offk[4];
#pragma unroll
    for (int kk = 0; kk < 4; ++kk) offk[kk] = ((2 * kk + hh) ^ (q & 7)) * 16;
    int it = wave >> 1;
    bf16x8 ak[2][4];
    if (it < np) { const bf16* kp = IK + ((size_t)b * SEQ + (p0 + it) * 64 + (lane & 31)) * 64 + hh * 8;
#pragma unroll
        for (int kk = 0; kk < 4; ++kk) { ak[0][kk] = *(const bf16x8*)(kp + kk * 16); ak[1][kk] = *(const bf16x8*)(kp + 32 * 64 + kk * 16); } }
    for (; it < np; it += 4) {
        bf16x8 an[2][4]; const bool more = it + 4 < np;
        { const int itn = more ? it + 4 : it; const bf16* kp = IK + ((size_t)b * SEQ + (p0 + itn) * 64 + (lane & 31)) * 64 + hh * 8;
#pragma unroll
          for (int kk = 0; kk < 4; ++kk) { an[0][kk] = *(const bf16x8*)(kp + kk * 16); an[1][kk] = *(const bf16x8*)(kp + 32 * 64 + kk * 16); } }
        float s0[16], s1[16];
#pragma unroll
        for (int i = 0; i < 16; ++i) { s0[i] = 0.f; s1[i] = 0.f; }
        bf16x8 bfc[4]; f32x16 a0, a1;
#pragma unroll
        for (int kk = 0; kk < 4; ++kk) bfc[kk] = *(const LAS bf16x8*)(qb + hx + offk[kk]);
#pragma unroll
        for (int i = 0; i < 16; ++i) { a0[i] = 0.f; a1[i] = 0.f; }
#pragma unroll
        for (int kk = 0; kk < 4; ++kk) { a0 = __builtin_amdgcn_mfma_f32_32x32x16_bf16(ak[0][kk], bfc[kk], a0, 0, 0, 0); a1 = __builtin_amdgcn_mfma_f32_32x32x16_bf16(ak[1][kk], bfc[kk], a1, 0, 0, 0); }
#pragma unroll
        for (int kk = 0; kk < 4; ++kk) bfc[kk] = *(const LAS bf16x8*)(qb + ((1 * 128) ^ hx) + offk[kk]);
#pragma unroll
        for (int h = 0; h < 16; ++h) { f32x16 b0, b1; bf16x8 bfn[4];
            if (h + 1 < 16) {
#pragma unroll
                for (int i = 0; i < 16; ++i) { b0[i] = 0.f; b1[i] = 0.f; }
#pragma unroll
                for (int kk = 0; kk < 4; ++kk) { b0 = __builtin_amdgcn_mfma_f32_32x32x16_bf16(ak[0][kk], bfc[kk], b0, 0, 0, 0); b1 = __builtin_amdgcn_mfma_f32_32x32x16_bf16(ak[1][kk], bfc[kk], b1, 0, 0, 0); }
                if (h + 2 < 16) { const int hb = ((h + 2) * 128) ^ hx;
#pragma unroll
                    for (int kk = 0; kk < 4; ++kk) bfn[kk] = *(const LAS bf16x8*)(qb + hb + offk[kk]); } }
            __builtin_amdgcn_sched_barrier(0);
            const float wh = wgt[h];
#pragma unroll
            for (int i = 0; i < 16; ++i) { s0[i] = fmaf(wh, fmaxf(a0[i], 0.f), s0[i]); asm volatile("" : "+v"(s0[i])); s1[i] = fmaf(wh, fmaxf(a1[i], 0.f), s1[i]); asm volatile("" : "+v"(s1[i])); }
            if (h + 1 < 16) { a0 = b0; a1 = b1; }
            if (h + 2 < 16) {
#pragma unroll
                for (int kk = 0; kk < 4; ++kk) bfc[kk] = bfn[kk]; }
            __builtin_amdgcn_sched_barrier(0); }
        float* op = SC + tokq * 2048 + (p0 + it) * 64 + 4 * hh;
#pragma unroll
        for (int i4 = 0; i4 < 4; ++i4) { *(f32x4*)(op + 8 * i4) = (f32x4){s0[4 * i4], s0[4 * i4 + 1], s0[4 * i4 + 2], s0[4 * i4 + 3]};
            *(f32x4*)(op + 32 + 8 * i4) = (f32x4){s1[4 * i4], s1[4 * i4 + 1], s1[4 * i4 + 2], s1[4 * i4 + 3]}; }
#pragma unroll
        for (int kk = 0; kk < 4; ++kk) { ak[0][kk] = an[0][kk]; ak[1][kk] = an[1][kk]; }
    }
}
__device__ __forceinline__ void ph4a_decode(int u, int& b, int& ci, int& p0, int& np) {
    if (u < 128) { b = u & 7; ci = 16 + (u >> 3); p0 = 0; np = 16; }
    else { const int v = 16 - ((u - 128) >> 4), w = (u - 128) & 15; b = w & 7; if (w >> 3) { ci = 15 + v; p0 = 16; np = v; } else { ci = v - 1; p0 = 0; np = v; } }
}
__device__ __forceinline__ void ph4a_body(const Args& a, LAS unsigned char* lds, int tid, int wave, int lane, int G, int bid) {
    int b, ci, p0, np;
    if (G == 256) { ph4a_decode(bid, b, ci, p0, np); ph4a_unit(a, lds, tid, wave, lane, b, ci, p0, np);
        if (bid >= 128) { ph4a_decode(511 - bid, b, ci, p0, np); ph4a_unit(a, lds, tid, wave, lane, b, ci, p0, np); } }
    else for (int u = bid; u < 384; u += G) { ph4a_decode(u, b, ci, p0, np); ph4a_unit(a, lds, tid, wave, lane, b, ci, p0, np); }
    __syncthreads();
}
template <int NVM> __device__ __forceinline__ int cnt_ge(const unsigned (&key)[32], unsigned cand) {
    unsigned c0 = 0, c1 = 0, c2 = 0, c3 = 0;
#pragma unroll
    for (int i = 0; i < NVM; i += 4) {
        asm("v_cmp_ge_u32 vcc, %1, %2\n\tv_addc_co_u32 %0, vcc, 0, %0, vcc" : "+v"(c0) : "v"(key[i]), "v"(cand) : "vcc");
        asm("v_cmp_ge_u32 vcc, %1, %2\n\tv_addc_co_u32 %0, vcc, 0, %0, vcc" : "+v"(c1) : "v"(key[i + 1]), "v"(cand) : "vcc");
        asm("v_cmp_ge_u32 vcc, %1, %2\n\tv_addc_co_u32 %0, vcc, 0, %0, vcc" : "+v"(c2) : "v"(key[i + 2]), "v"(cand) : "vcc");
        asm("v_cmp_ge_u32 vcc, %1, %2\n\tv_addc_co_u32 %0, vcc, 0, %0, vcc" : "+v"(c3) : "v"(key[i + 3]), "v"(cand) : "vcc"); }
    const unsigned c = (c0 + c1) + (c2 + c3);
    int tot = 0;
#pragma unroll
    for (int b = 0; b < 6; ++b) tot += __builtin_popcountll(__ballot((c >> b) & 1u)) << b;
    return tot;
}
template <int NVM> __device__ __forceinline__ unsigned sel_thr(const unsigned (&key)[32]) {
    unsigned Tt = 0u;
    for (int bit = 31; bit >= 0; --bit) { const unsigned cand = Tt | (1u << bit); const int cnt = cnt_ge<NVM>(key, cand);
        if (cnt >= TOPK) { Tt = cand; if (cnt == TOPK) break; } }
    return Tt;
}
__device__ __forceinline__ void ph4b_body(const Args& a, int wave, int lane, int G, int bid) {
    const float* SC = (const float*)(a.ws + WS_SC); unsigned long long* SEL = (unsigned long long*)(a.ws + WS_SEL);
    const int gw = bid * NWAVES + wave, NGW = G * NWAVES;
    float raw[32]; unsigned key[32];
#define SEL_ROW(idx, row, nv) const int bb_ = (idx) >> 11; int t_ = (idx) & 2047; if (bb_ & 1) t_ = 2047 - t_; const size_t row = (size_t)bb_ * SEQ + t_; const int nv = (t_ >> 6) + 1;
    int idx = gw;
    if (idx < T) { SEL_ROW(idx, row, nv) const float* sp = SC + row * 2048 + lane;
#pragma unroll
        for (int i = 0; i < 32; ++i) raw[i] = sp[64 * (i < nv ? i : nv - 1)]; }
    for (; idx < T; idx += NGW) {
        SEL_ROW(idx, row, nv)
#pragma unroll
        for (int i = 0; i < 32; ++i) { const unsigned uu = __float_as_uint(raw[i]); const unsigned kk = (uu & 0x80000000u) ? ~uu : (uu | 0x80000000u); key[i] = (i < nv) ? kk : 0u; }
        if (idx + NGW < T) { SEL_ROW(idx + NGW, rown, nvn) const float* sp = SC + rown * 2048 + lane;
#pragma unroll
            for (int i = 0; i < 32; ++i) raw[i] = sp[64 * (i < nvn ? i : nvn - 1)]; }
        unsigned Tt = 0u;
        if (nv > 4) { if (nv <= 8) Tt = sel_thr<8>(key); else if (nv <= 16) Tt = sel_thr<16>(key); else if (nv <= 24) Tt = sel_thr<24>(key); else Tt = sel_thr<32>(key); }
        unsigned long long myw = 0ull;
#pragma unroll
        for (int i = 0; i < 32; ++i) { const unsigned long long bm = __ballot(key[i] >= Tt); if (lane == i) myw = bm; }
        if (lane < nv) SEL[row * 32 + lane] = myw;
    }
#undef SEL_ROW
}

__device__ __forceinline__ void ph5_body(const Args& a, char* ldsg, int wave, int lane, int G, int bid) {
    const bf16* Q = (const bf16*)(a.ws + WS_Q); const bf16* K = (const bf16*)(a.ws + WS_K); const bf16* V = (const bf16*)(a.ws + WS_V);
    const unsigned* SELW = (const unsigned*)(a.ws + WS_SEL); unsigned char* YA = (unsigned char*)(a.ws + WS_YA);
    for (int L = bid; L < NB * NCHUNK * NKVH; L += G) {
        const int Lr = L & 255, ci = (L < 256) ? 31 - (Lr >> 4) : (Lr >> 4), b = (Lr >> 1) & 7, g = Lr & 1;
        const int head = g * 4 + (wave >> 1), qpos = ci * 64 + (wave & 1) * 32 + (lane & 31); const size_t tokq = (size_t)b * SEQ + qpos;
        const int NTreal = ci + 1, NT = NTreal + (NTreal & 1);
        const float nslope = -1.4426950408889634f * exp2f(-(float)(head + 1));
        att::attn_unit(Q + tokq * 1024 + head * 128 + (lane >> 5) * 8, K + (size_t)b * SEQ * 256 + g * 128, V + (size_t)b * SEQ * 256 + g * 128,
                       YA + ((size_t)b * SEQ + ci * 64 + (wave & 1) * 32) * 2048 + head * 128, 2048, SELW + ((size_t)b * SEQ + ci * 64) * 64, (unsigned)(((wave & 1) * 32 + (lane & 31)) * 64), qpos, nslope, NT, NTreal, ldsg);
    }
}

__device__ __forceinline__ void ph7_body(const Args& a, int tid, int G, int bid) {
    const float* POW = (const float*)(a.ws + WS_POW); const float* SBUF = (const float*)(a.ws + WS_SBUF); bf16* UA = (bf16*)(a.ws + WS_UA);
    for (int idx = (tid < 128 ? bid * 128 + tid : SSMG * NB * SSMN); idx < SSMG * NB * SSMN; idx += G * 128) {
        const int n = idx & 63, b = (idx >> 6) & 7, g = idx >> 9;
        const float ar = POW[(((size_t)g * 65 + SL) * 64 + n) * 2], ai = POW[(((size_t)g * 65 + SL) * 64 + n) * 2 + 1];
        float hr = 0.f, hi = 0.f;
#pragma unroll 1
        for (int c0 = 0; c0 < NSC; c0 += 64) {
            f32x2 sv[64];
#pragma unroll
            for (int c = 0; c < 64; ++c) sv[c] = *(const f32x2*)(SBUF + ((size_t)g * SROWS + b * NSC + c0 + c) * 128 + 2 * n);
#pragma unroll
            for (int c = 0; c < 64; ++c) { const size_t row = (size_t)g * SROWS + b * NSC + c0 + c;
                *(unsigned*)(UA + row * UA_LD + SL * 16 + 2 * n) = pk2(hr, hi);
                const float nr = ar * hr - ai * hi + sv[c][0], ni = ar * hi + ai * hr + sv[c][1]; hr = nr; hi = ni; }
        }
    }
}

__device__ __forceinline__ void ph12_body(const Args& a, LAS unsigned char* lds, int tid, int wave, int lane, int G, int bid, size_t alt) {
    const bf16* X1 = (const bf16*)(a.ws + WS_X1); const float* WRP = (const float*)(a.ws + WS_WRP); const float* BRP = (const float*)(a.ws + WS_BRP); float* RSTD = (float*)(a.ws + (alt ? WS_SC : WS_RSTD));
    unsigned* CNT = (unsigned*)(a.ws + WS_CTL) + CW_CNT + (alt ? 64 : 0); int* ASGE = (int*)(a.ws + (alt ? WS_SC + MiB : WS_ASGE)); int* ASGP = (int*)(a.ws + (alt ? WS_SC + 2 * MiB : WS_ASGP));
    int* LIST = (int*)(a.ws + (alt ? WS_SC + 4 * MiB : WS_LIST)); float* GLIST = (float*)(a.ws + (alt ? WS_SC + 8 * MiB : WS_GLIST)); unsigned char* XS = (unsigned char*)(a.ws + (alt ? WS_SC + 16 * MiB : WS_XS));
    const float* MOD = (const float*)(a.ws + WS_MOD); const float* g2 = a.in[I_N2G];
    LAS float* xs = (LAS float*)lds;
    LAS float* part = (LAS float*)(lds + 65792); LAS float* logit = (LAS float*)(lds + 65792 + 32768);
    LAS float* rstdL = (LAS float*)(lds + 65792 + 32768 + 4352); LAS unsigned* lcnt = (LAS unsigned*)(rstdL + 32); LAS unsigned* base = lcnt + 32;
    for (int tile = bid; tile < T / 32; tile += G) {
        const int t0 = tile * 32, b = t0 >> 11; const int lrow = tid >> 4, cg = tid & 15;
        f32x16 acc;
#pragma unroll
        for (int i = 0; i < 16; ++i) acc[i] = 0.f;
        float ss = 0.f;
        if (tid < 32) lcnt[tid] = 0u;
        for (int ch = 0; ch < 4; ++ch) {
            f32x4 v[8]; const v2u* xr = (const v2u*)(X1 + (size_t)(t0 + lrow) * DM + ch * 512) + cg;
#pragma unroll
            for (int j = 0; j < 8; ++j) { const v2u w = xr[16 * j]; v[j] = (f32x4){bflo(w.x), bfhi(w.x), bflo(w.y), bfhi(w.y)}; ss += (v[j][0] * v[j][0] + v[j][1] * v[j][1]) + (v[j][2] * v[j][2] + v[j][3] * v[j][3]); }
            float wv[32]; const float* wp = WRP + (size_t)b * (DM * NEXP) + (size_t)(ch * 512 + 64 * wave + (lane >> 5)) * NEXP + (lane & 31);
#pragma unroll
            for (int q = 0; q < 32; ++q) wv[q] = wp[2 * q * NEXP];
            __syncthreads();
#pragma unroll
            for (int j = 0; j < 8; ++j)
#pragma unroll
                for (int e = 0; e < 4; ++e) xs[lrow * 513 + cg * 4 + 64 * j + e] = v[j][e];
            __syncthreads();
            const LAS float* xq = xs + (lane & 31) * 513 + 64 * wave + (lane >> 5);
#pragma unroll
            for (int q = 0; q < 32; ++q) acc = __builtin_amdgcn_mfma_f32_32x32x2f32(xq[2 * q], wv[q], acc, 0, 0, 0);
        }
        ss += __shfl_xor(ss, 1); ss += __shfl_xor(ss, 2); ss += __shfl_xor(ss, 4); ss += __shfl_xor(ss, 8);
        if (cg == 0) { const float rstd = 1.0f / sqrtf(ss * (1.0f / DM) + RMS_EPS); rstdL[lrow] = rstd; RSTD[t0 + lrow] = rstd; }
#pragma unroll
        for (int i = 0; i < 16; ++i) part[(wave * 16 + i) * 64 + lane] = acc[i];
        __syncthreads();
#pragma unroll
        for (int z = 0; z < 2; ++z) { const int o = tid + 512 * z, tk = o >> 5, e = o & 31, hh = (tk >> 2) & 1, i = (tk & 3) + 4 * (tk >> 3), ln = e + 32 * hh; float s = 0.f;
#pragma unroll
            for (int w = 0; w < 8; ++w) s += part[(w * 16 + i) * 64 + ln];
            logit[tk * 33 + e] = rstdL[tk] * s + BRP[b * 32 + e]; }
        __syncthreads();
        LAS float* selv = (LAS float*)(base + 32);
        int rk[4]; float mv[4], gt[4]; unsigned rr[4];
        const int ex = lane & 31;
#pragma unroll
        for (int j = 0; j < 4; ++j) { const int tk = wave * 4 + j; const float v = logit[tk * 33 + ex]; int r = 0;
#pragma unroll
            for (int e2 = 0; e2 < 32; ++e2) { const float u = logit[tk * 33 + e2]; r += ((u > v) || (u == v && e2 < ex)) ? 1 : 0; }
            rk[j] = r; mv[j] = v; if (lane < 32 && r < 4) selv[tk * 4 + r] = v; }
        LDS_WAIT(); asm volatile("" ::: "memory");
#pragma unroll
        for (int j = 0; j < 4; ++j) { const int tk = wave * 4 + j; gt[j] = 0.f; rr[j] = 0u;
            if (lane < 32 && rk[j] < 4) { const float v0 = selv[tk * 4], v1 = selv[tk * 4 + 1], v2 = selv[tk * 4 + 2], v3 = selv[tk * 4 + 3];
                const float den = 1.0f + expf(v1 - v0) + expf(v2 - v0) + expf(v3 - v0); gt[j] = expf(mv[j] - v0) / den;
                rr[j] = __hip_atomic_fetch_add(lcnt + ex, 1u, __ATOMIC_RELAXED, __HIP_MEMORY_SCOPE_WORKGROUP); } }
        __syncthreads();
        if (tid < 32) base[tid] = __hip_atomic_fetch_add(CNT + tid, lcnt[tid], RLX_AGENT);
        __syncthreads();
#pragma unroll
        for (int j = 0; j < 4; ++j) if (lane < 32 && rk[j] < 4) { const int tk = t0 + wave * 4 + j, as = tk * 4 + rk[j], pos = (int)(base[ex] + rr[j]); ASGE[as] = ex; ASGP[as] = pos;
            if (pos < T) { LIST[ex * T + pos] = tk; GLIST[ex * T + pos] = gt[j]; } }
        { const f32x4* gp = (const f32x4*)g2 + 2 * lane; const f32x4* shp = (const f32x4*)(MOD + (size_t)b * MODW + 3 * DM) + 2 * lane; const f32x4* scp = (const f32x4*)(MOD + (size_t)b * MODW + 4 * DM) + 2 * lane;
          v4u xw[4][4]; f32x4 pa[8], pb[8];
#pragma unroll
          for (int j = 0; j < 4; ++j) { const v4u* xr = (const v4u*)(X1 + (size_t)(t0 + wave * 4 + j) * DM) + lane;
#pragma unroll
              for (int q = 0; q < 4; ++q) xw[j][q] = xr[64 * q]; }
#pragma unroll
          for (int q = 0; q < 4; ++q)
#pragma unroll
              for (int h = 0; h < 2; ++h) { pa[2 * q + h] = gp[128 * q + h] * (scp[128 * q + h] + 1.0f) * F8_ASCALE; pb[2 * q + h] = shp[128 * q + h] * F8_ASCALE; }
#pragma unroll
          for (int j = 0; j < 4; ++j) { const int tk = wave * 4 + j; const float rstd = rstdL[tk]; v2u o[4];
#pragma unroll
              for (int q = 0; q < 4; ++q) { const v4u w = xw[j][q]; const f32x4 x0 = {bflo(w.x), bfhi(w.x), bflo(w.y), bfhi(w.y)}, x1 = {bflo(w.z), bfhi(w.z), bflo(w.w), bfhi(w.w)};
                  const f32x4 y0 = (x0 * rstd) * pa[2 * q] + pb[2 * q], y1 = (x1 * rstd) * pa[2 * q + 1] + pb[2 * q + 1];
                  o[q].x = pk4_fp8(y0[0], y0[1], y0[2], y0[3]); o[q].y = pk4_fp8(y1[0], y1[1], y1[2], y1[3]); }
              v2u* dst = (v2u*)(XS + (size_t)(t0 + tk) * DM) + lane;
#pragma unroll
              for (int q = 0; q < 4; ++q) dst[64 * q] = o[q]; } }
        __syncthreads();
    }
}

constexpr int LDS_MOE = RING_BYTES + 1024;
__device__ __forceinline__ void moe_tables(const Args& a, LAS unsigned char* lds, int tid) {
    LAS int* off = (LAS int*)(lds + LDS_MOE); LAS int* cnt = off + 32; LAS int* nrbp = off + 64; LAS int* rbe = off + 96;
    if (tid < 32) {
        unsigned* CNT = (unsigned*)(a.ws + WS_CTL) + CW_CNT; const int c = (int)__hip_atomic_load(CNT + tid, RLX_AGENT), nb = (c + 255) >> 8; int inc = nb;
#pragma unroll
        for (int d = 1; d < 32; d <<= 1) { const int t = __shfl_up(inc, d); if (tid >= d) inc += t; }
        const int ex = inc - nb; cnt[tid] = c; off[tid] = ex * 256;
        for (int q = 0; q < nb; ++q) if (ex + q < 320) rbe[ex + q] = tid;
        if (tid == 31) nrbp[0] = inc < 288 ? inc : 288; }
    __syncthreads();
}
constexpr int LDS_ROWS = RING_BYTES + 3072, ROWS_CAP = (LDS_BYTES - LDS_ROWS) / 512;
template <class Sched> __device__ __forceinline__ void moe_rows(const Args& a, LAS unsigned char* lds, int tid, const Sched& S) {
    const LAS int* off = (const LAS int*)(lds + LDS_MOE); const LAS int* cnt = off + 32; const int* LIST = (const int*)(a.ws + WS_LIST);
    LAS unsigned short* rows = (LAS unsigned short*)(lds + LDS_ROWS); LAS int* uinf = (LAS int*)(lds + LDS_MOE + 1664);
    pg8::Unit u; int n = 0;
    for (; n < ROWS_CAP && S.next(n, u); ++n) { const int e = (u.pn >> 4) & 31; if (tid == 0) uinf[n] = (e << 16) | (((u.pm - (off[e] >> 8)) * 256) & 0xffff); }
    __syncthreads();
    for (int base = tid; base < n * 256; base += 4 * NTHR) {
        int tok[4];
#pragma unroll
        for (int q = 0; q < 4; ++q) { const int k = base + q * NTHR, kc = k < n * 256 ? k : 0, ui = uinf[kc >> 8], e = ui >> 16, idx = (ui & 0xffff) + (kc & 255); const bool ok = idx < cnt[e] && idx < T;
            const int t = LIST[e * T + (ok ? idx : 0)]; tok[q] = ok ? t : 0; }
#pragma unroll
        for (int q = 0; q < 4; ++q) { const int k = base + q * NTHR; if (k < n * 256) rows[k] = (unsigned short)min(max(tok[q], 0), T - 1); } }
    __syncthreads();
}

typedef float f32x2v __attribute__((ext_vector_type(2)));
__device__ __forceinline__ void ph16_acc8(f32x4& a0, f32x4& a1, v2u w) {
    const f32x2v p0 = __builtin_amdgcn_cvt_pk_f32_fp8((int)w.x, false), p1 = __builtin_amdgcn_cvt_pk_f32_fp8((int)w.x, true), p2 = __builtin_amdgcn_cvt_pk_f32_fp8((int)w.y, false), p3 = __builtin_amdgcn_cvt_pk_f32_fp8((int)w.y, true);
    a0[0] += p0[0]; a0[1] += p0[1]; a0[2] += p1[0]; a0[3] += p1[1]; a1[0] += p2[0]; a1[1] += p2[1]; a1[2] += p3[0]; a1[3] += p3[1];
}
__device__ __forceinline__ void ph16_slots(const LAS int* off, const int* ASGE, const int* ASGP, int row, int (&sl)[4]) {
#pragma unroll
    for (int k = 0; k < 4; ++k) sl[k] = min(max(off[ASGE[row * 4 + k] & 31] + ASGP[row * 4 + k], 0), MOE_ROWS - 1);
}
__device__ __forceinline__ void ph16_row(const int (&sl)[4], const unsigned char* YE, const bf16* X1, const float* MOD, int row, int lane, f32x4 (&out)[8]) {
    const v2u* y0 = (const v2u*)(YE + (size_t)sl[0] * DM) + lane; const v2u* y1 = (const v2u*)(YE + (size_t)sl[1] * DM) + lane; const v2u* y2 = (const v2u*)(YE + (size_t)sl[2] * DM) + lane; const v2u* y3 = (const v2u*)(YE + (size_t)sl[3] * DM) + lane;
    const v4u* xi = (const v4u*)(X1 + (size_t)row * DM) + lane; const f32x4* gp = (const f32x4*)(MOD + (size_t)(row >> 11) * MODW + 5 * DM) + 2 * lane;
#pragma unroll
    for (int j = 0; j < 4; ++j) { const v2u w0 = y0[64 * j], w1 = y1[64 * j], w2 = y2[64 * j], w3 = y3[64 * j]; const v4u xw = xi[64 * j]; const f32x4 g0 = gp[128 * j] * (1.0f / F8_YSCALE), g1 = gp[128 * j + 1] * (1.0f / F8_YSCALE);
        f32x4 a0 = {0.f, 0.f, 0.f, 0.f}, a1 = {0.f, 0.f, 0.f, 0.f};
        ph16_acc8(a0, a1, w0); ph16_acc8(a0, a1, w1); ph16_acc8(a0, a1, w2); ph16_acc8(a0, a1, w3);
        out[2 * j] = (f32x4){bflo(xw.x), bfhi(xw.x), bflo(xw.y), bfhi(xw.y)} + g0 * a0; out[2 * j + 1] = (f32x4){bflo(xw.z), bfhi(xw.z), bflo(xw.w), bfhi(xw.w)} + g1 * a1; }
}
__device__ __forceinline__ void ph16_body(const Args& a, LAS unsigned char* lds, int tid, int wave, int lane, int G, int bid, float* OUT) {
    moe_tables(a, lds, tid); const LAS int* off = (const LAS int*)(lds + LDS_MOE);
    const float* MOD = (const float*)(a.ws + WS_MOD); const int* ASGE = (const int*)(a.ws + WS_ASGE); const int* ASGP = (const int*)(a.ws + WS_ASGP); const unsigned char* YE = (const unsigned char*)(a.ws + WS_YE); const bf16* X1 = (const bf16*)(a.ws + WS_X1);
    const int gw = bid * NWAVES + wave, NGW = G * NWAVES;
    int sA[4] = {0, 0, 0, 0}, sB[4] = {0, 0, 0, 0};
    if (gw < T) ph16_slots(off, ASGE, ASGP, gw, sA);
    if (gw + NGW < T) ph16_slots(off, ASGE, ASGP, gw + NGW, sB);
    for (int row = gw; row < T; row += 2 * NGW) {
        const int rowB = row + NGW; const bool hasB = rowB < T;
        f32x4 oA[8], oB[8];
        ph16_row(sA, YE, X1, MOD, row, lane, oA);
        if (hasB) ph16_row(sB, YE, X1, MOD, rowB, lane, oB);
        if (row + 2 * NGW < T) ph16_slots(off, ASGE, ASGP, row + 2 * NGW, sA);
        if (rowB + 2 * NGW < T) ph16_slots(off, ASGE, ASGP, rowB + 2 * NGW, sB);
        { f32x4* xo = (f32x4*)(OUT + (size_t)row * DM) + 2 * lane;
#pragma unroll
          for (int j = 0; j < 4; ++j) { xo[128 * j] = oA[2 * j]; xo[128 * j + 1] = oA[2 * j + 1]; } }
        if (hasB) { f32x4* xo = (f32x4*)(OUT + (size_t)rowB * DM) + 2 * lane;
#pragma unroll
          for (int j = 0; j < 4; ++j) { xo[128 * j] = oB[2 * j]; xo[128 * j + 1] = oB[2 * j + 1]; } }
    }
}

#ifndef PROBE_REP
#define PROBE_REP 0
#endif
#ifndef MK_ONE_LAUNCH
#define MK_ONE_LAUNCH 1
#endif
constexpr int NPH = 13;
__global__ void __launch_bounds__(NTHR, 2) fwd(Args args) {
    extern __shared__ __attribute__((aligned(16))) unsigned char lds_raw[];
    LAS unsigned char* lds = (LAS unsigned char*)lds_raw;
    const int tid = threadIdx.x, lane = tid & 63, wave = __builtin_amdgcn_readfirstlane(tid >> 6);
    const int G = gridDim.x, bid = blockIdx.x;
    volatile LAS unsigned* MISC = (volatile LAS unsigned*)(lds + MISC_OFF);
    for (int u = tid; u < (LDS_BYTES - LDSCTL_OFF) / 4; u += NTHR) ((LAS unsigned*)(lds + LDSCTL_OFF))[u] = 0u;
    __syncthreads();
    unsigned char* ws = args.ws;
    unsigned* ctl = (unsigned*)(ws + WS_CTL);
    const int lo = args.ph_lo, hi = args.ph_hi;
    XcdBarrier bar; bar.bar = ctl + CW_BAR; bar.x = 0; bar.st = nullptr;
    if (hi - lo > 1) bar = xcd_barrier_post(ctl + CW_BAR, MISC + 8);
#define IN(k) (lo <= (k) && (k) < hi)
#define REPS(k) _Pragma("unroll") for (int rep_ = 0; rep_ < 1 + ((PROBE_REP >> (k)) & 1); ++rep_)
#define SEAM(k) do { if (IN(k) && IN((k) + 1)) xcd_barrier(bar); } while (0)

    if (IN(0)) REPS(0) { ph0_ssm_consts(args, tid, G, (bid + 8) % G);
         ph0_adaln(args, lds, tid, G, bid); }
    SEAM(0);
    if (IN(1)) REPS(1) {
        if (bid & 1) { ph1_small(args, tid, wave, lane, G, bid); bts_body(args, tid, G, bid); ph0_transposes(args, lds, wave, lane, G, bid); ph1_norm(args, wave, lane, G, bid); }
        else { ph1_norm(args, wave, lane, G, bid); ph0_transposes(args, lds, wave, lane, G, bid); ph1_small(args, tid, wave, lane, G, bid); bts_body(args, tid, G, bid); } __syncthreads(); }
    SEAM(1);
    if (IN(2)) REPS(2) {
        const int Gg = (G > 2 * NCONV) ? G - NCONV : G;
        if (bid < Gg) {
            { pg8::Gemm g{(const bf16*)(ws + WS_HN), (const bf16*)(ws + WS_WIN), DM, DM, DM}; pg8::StaticOrder S; S.init(T, 2560, Gg, bid);
              EpiInProjA E{(bf16*)(ws + WS_Q), (bf16*)(ws + WS_K), (bf16*)(ws + WS_IQ), (bf16*)(ws + WS_IK), (float*)(ws + WS_IW)};
              pg8::gemm_phase<EpiInProjA, pg8::StaticOrder, true, true>(lds, g, S, E); }
            { pg8::Gemm g{(const bf16*)(ws + WS_HN8), (const bf16*)(ws + WS_WIN8), DM / 2, DM / 2, DM / 2}; pg8::StaticOrder S; S.init(T, 5376, Gg, bid);
              EpiInProjB E{(bf16*)(ws + WS_V), (bf16*)(ws + WS_UA), (unsigned char*)(ws + WS_GATES)};
              pg8::gemm_phase<EpiInProjB, pg8::StaticOrder, true, true, true>(lds, g, S, E); } }
        cv_queue(args, lds, wave, lane); }
    SEAM(2);
    if (IN(3)) REPS(3) {
        ph4a_body(args, lds, tid, wave, lane, G, bid);
        { pg8::Gemm g{(const bf16*)(ws + WS_UA), (const bf16*)(ws + WS_BTS), UA_LD, SL * 16, SL * 16}; SsmSOrder S{G, (G - 1) - bid}; EpiSsmS E{(float*)(ws + WS_SBUF)};
          pg8::gemm_phase<EpiSsmS, SsmSOrder, true, true>(lds, g, S, E); }
        qknorm_body(args, wave, lane, G, bid); bty_body(args, tid, G, bid); }
    SEAM(3);
    if (IN(4)) REPS(4) { ph4b_body(args, wave, lane, G, bid); ph7_body(args, tid, G, bid); }
    SEAM(4);
    if (IN(5)) REPS(5) {
        ph5_body(args, (char*)lds_raw, wave, lane, G, bid);
        { pg8::Gemm g{(const bf16*)(ws + WS_UA), (const bf16*)(ws + WS_BTY), UA_LD, UA_LD, UA_LD}; SsmYOrder S{G, bid}; EpiSsmY E{(bf16*)(ws + WS_YG)};
          pg8::gemm_phase<EpiSsmY, SsmYOrder, true, true>(lds, g, S, E); } }
    SEAM(5);
    if (IN(6)) REPS(6) {
        pg8::Gemm g{(const bf16*)(ws + WS_YG), (const bf16*)(ws + WS_WGLU), 1024, 1024, 1024}; pg8::StaticOrder S; S.init(T, 1024, G, bid);
        EpiGlu E{(const bf16*)(ws + WS_YG), (unsigned char*)(ws + WS_YA + 1024), args.in[I_BGLU]};
        pg8::gemm_phase<EpiGlu, pg8::StaticOrder, true, true>(lds, g, S, E); }
    SEAM(6);
    if (IN(7)) REPS(7) {
        pg8::StaticOrder S; S.init(T, DM, G, bid);
        pg8::Gemm g{(const bf16*)(ws + WS_YA), (const bf16*)(ws + WS_WA), 1024, 1024, 1024}; EpiProjAB E{(const unsigned char*)(ws + WS_GATES), (unsigned char*)(ws + WS_MG)};
        pg8::gemm_phase<EpiProjAB, pg8::StaticOrder, true, true, true>(lds, g, S, E); }
    SEAM(7);
    if (IN(8)) REPS(8) {
        pg8::Gemm g{(const bf16*)(ws + WS_MG), (const bf16*)(ws + WS_WO), DM / 2, DM / 2, DM / 2}; pg8::StaticOrder S; S.init(T, DM, G, bid);
        EpiOut E{args.in[I_X], (const float*)(ws + WS_MOD), (bf16*)(ws + WS_X1)};
        pg8::gemm_phase<EpiOut, pg8::StaticOrder, true, true, true>(lds, g, S, E); }
    SEAM(8);
    if (IN(9)) REPS(9) ph12_body(args, lds, tid, wave, lane, G, bid, (size_t)rep_);
    SEAM(9);
    if (IN(10)) REPS(10) {
        moe_tables(args, lds, tid);
        const LAS int* mt = (const LAS int*)(lds + LDS_MOE); MoeOrder S{mt + 96, mt[64], 4, G, bid};
        moe_rows(args, lds, tid, S);
        pg8::Gemm g{(const bf16*)(ws + WS_XS), (const bf16*)(ws + WS_WGU), DM / 2, DM / 2, DM / 2, (const LAS unsigned short*)(lds + LDS_ROWS)}; EpiGateUp E{args.in[I_BGU], (unsigned char*)(ws + WS_ACT)};
        pg8::gemm_phase<EpiGateUp, MoeOrder, true, true, true, true>(lds, g, S, E); }
    SEAM(10);
    if (IN(11)) REPS(11) {
        moe_tables(args, lds, tid);
        const LAS int* mt = (const LAS int*)(lds + LDS_MOE); MoeOrder S{mt + 96, mt[64], 3, G, bid};
        pg8::Gemm g{(const bf16*)(ws + WS_ACT), (const bf16*)(ws + WS_WD), DM / 2, DM / 2, DM / 2}; EpiDown E{args.in[I_BD], (const float*)(ws + WS_GLIST), mt, (unsigned char*)(ws + WS_YE)};
        pg8::gemm_phase<EpiDown, MoeOrder, true, true, true>(lds, g, S, E); }
    SEAM(11);
    if (IN(12)) REPS(12) ph16_body(args, lds, tid, wave, lane, G, bid, rep_ ? (float*)(ws + WS_SC) : args.out);
#if defined(PROBE_BAR)
    if (hi - lo > 1) { _Pragma("unroll 1") for (int q = 0; q < PROBE_BAR; ++q) xcd_barrier(bar); }
#endif
#undef IN
#undef SEAM
}

extern "C" void kernel_launch(void* const* d_in, const int* in_sizes, int n_in, void* d_out, int out_size, void* d_ws, size_t ws_size, hipStream_t stream) {
    static int grid = 0;
    if (grid == 0) {
        if (n_in != 28 || out_size != T * DM || ws_size < WS_END) { fprintf(stderr, "kernel_launch: unexpected shapes (n_in %d out %d ws %zu)\n", n_in, out_size, ws_size); grid = -1; return; }
        int dev = 0, cus = 0, per_cu = 0;
        if (hipGetDevice(&dev) != hipSuccess || hipDeviceGetAttribute(&cus, hipDeviceAttributeMultiprocessorCount, dev) != hipSuccess) { grid = -1; return; }
        if (hipFuncSetAttribute((const void*)fwd, hipFuncAttributeMaxDynamicSharedMemorySize, LDS_BYTES) != hipSuccess) { fprintf(stderr, "kernel_launch: hipFuncSetAttribute failed\n"); grid = -1; return; }
        if (hipOccupancyMaxActiveBlocksPerMultiprocessor(&per_cu, (const void*)fwd, NTHR, LDS_BYTES) != hipSuccess || per_cu < 1) { fprintf(stderr, "kernel_launch: occupancy query says %d\n", per_cu); (void)hipGetLastError(); grid = -1; return; }
        if (cus * ROWS_CAP < 288 * 16) { fprintf(stderr, "kernel_launch: too few CUs (%d) for the gather lists\n", cus); grid = -1; return; }
        grid = cus;
    }
    if (grid < 0) return;
    (void)hipMemsetAsync((char*)d_ws + WS_CTL, 0, CTL_ZERO_BYTES, stream);
    Args a{};
    for (int i = 0; i < 28; ++i) a.in[i] = (const float*)d_in[i];
    a.out = (float*)d_out; a.ws = (unsigned char*)d_ws;
#if MK_ONE_LAUNCH
    a.ph_lo = 0; a.ph_hi = NPH;
    hipLaunchKernelGGL(fwd, dim3(grid), dim3(NTHR), LDS_BYTES, stream, a);
#else
    for (int p = 0; p < NPH; ++p) { a.ph_lo = p; a.ph_hi = p + 1; hipLaunchKernelGGL(fwd, dim3(grid), dim3(NTHR), LDS_BYTES, stream, a); }
#endif
}
```

```cpp
#include <hip/hip_runtime.h>
#include <cstdio>
#include <cstdint>

#define GAS __attribute__((address_space(1)))
#define LAS __attribute__((address_space(3)))
typedef unsigned short bf16;
typedef unsigned v4u __attribute__((ext_vector_type(4)));
typedef unsigned v2u __attribute__((ext_vector_type(2)));
typedef float f32x2 __attribute__((ext_vector_type(2)));
typedef float f32x4 __attribute__((ext_vector_type(4)));
typedef float f32x16 __attribute__((ext_vector_type(16)));
typedef short bf16x8 __attribute__((ext_vector_type(8)));
typedef short s16x4 __attribute__((ext_vector_type(4)));
typedef __bf16 bf16x2_t __attribute__((ext_vector_type(2)));

constexpr int DM = 2048, NB = 8, SEQ = 2048, T = NB * SEQ;
constexpr int CHUNK = 64, NCHUNK = SEQ / CHUNK;
constexpr int HD = 128, NQH = 8, NKVH = 2, ATTW = 1024, KVW = 256;
constexpr int IDXH = 16, IDXD = 64, TOPK = 256;
constexpr int SSMW = 1024, SSMG = 64, SSMP = 16, SSMN = 64;
constexpr int NEXP = 32, MOEK = 4, DFF = 2048;
constexpr int INW = 7760, INW_PAD = 7936;
constexpr int MODW = 6 * DM;
constexpr float RMS_EPS = 1e-6f;
constexpr int SL = 32, NSC = SEQ / SL, SROWS = NB * NSC;
constexpr int UA_LD = SL * 16 + 128;
constexpr int MOE_ROWS = T * MOEK + NEXP * 256;
constexpr int NWAVES = 8, NTHR = 512;

constexpr size_t MiB = 1u << 20;
constexpr size_t WS_CTL = 0, CTL_ZERO_BYTES = 1 * MiB;
constexpr size_t WS_MOD = 1 * MiB;
constexpr size_t WS_WRP = 2 * MiB;
constexpr size_t WS_BRP = 4 * MiB;
constexpr size_t WS_BBAR = 5 * MiB;
constexpr size_t WS_POW = 6 * MiB;
constexpr size_t WS_KT = 9 * MiB;
constexpr size_t WS_ASGE = 14 * MiB;
constexpr size_t WS_ASGP = WS_ASGE + 256 * 1024;
constexpr size_t WS_ASGG = WS_ASGP + 256 * 1024;
constexpr size_t WS_SLOT = WS_ASGG + 256 * 1024;
constexpr size_t WS_ROWG = 15 * MiB;
constexpr size_t WS_RSTD = 15 * MiB + 512 * 1024;
constexpr size_t WS_WIN = 16 * MiB;
constexpr size_t WS_WIN8 = 27 * MiB;
constexpr size_t WS_WGLU = 47 * MiB;
constexpr size_t WS_WA = 49 * MiB;
constexpr size_t WS_WB = 53 * MiB;
constexpr size_t WS_WO = 57 * MiB;
constexpr size_t WS_BTS = 65 * MiB;
constexpr size_t WS_BTY = 97 * MiB;
constexpr size_t WS_HN = 241 * MiB;
constexpr size_t WS_X1 = 241 * MiB;
constexpr size_t WS_HN8 = 980 * MiB;
constexpr size_t WS_Q = 305 * MiB;
constexpr size_t WS_K = 337 * MiB;
constexpr size_t WS_V = 345 * MiB;
constexpr size_t WS_IQ = 353 * MiB;
constexpr size_t WS_IK = 385 * MiB;
constexpr size_t WS_IW = 387 * MiB;
constexpr size_t WS_UA = 788 * MiB;
constexpr size_t WS_GATES = 424 * MiB;
constexpr size_t WS_SC = 552 * MiB;
constexpr size_t WS_SEL = 680 * MiB;
constexpr size_t WS_YA = 684 * MiB;
constexpr size_t WS_SBUF = 852 * MiB;
constexpr size_t WS_YG = 724 * MiB;
constexpr size_t WS_YS = 756 * MiB;
constexpr size_t WS_MRG = 788 * MiB;
constexpr size_t WS_MG = 916 * MiB;
constexpr size_t WS_H2 = 980 * MiB;
constexpr size_t WS_XS = 1044 * MiB;
constexpr size_t WS_LIST = WS_XS + 64 * MiB;
constexpr size_t WS_GLIST = WS_XS + 66 * MiB;
constexpr size_t WS_ACT = 1332 * MiB;
constexpr size_t WS_YE = 1620 * MiB;
constexpr size_t WS_WGU = 1908 * MiB;
constexpr size_t WS_WD = 2420 * MiB;
constexpr size_t WS_END = 2676 * MiB;
constexpr int CW_CNT = 1024;
constexpr int CW_CVQ = 2048;
constexpr int NCONV = 112;
constexpr int CW_BAR = 4096;
constexpr int RING_BYTES = 131072;
constexpr int LDSCTL_OFF = RING_BYTES, MISC_OFF = LDSCTL_OFF + 320;
constexpr int LDS_BYTES = 147456;

#define LDS_WAIT() asm volatile("s_waitcnt lgkmcnt(0)" ::: "memory")
#define VM_WAIT() asm volatile("s_waitcnt vmcnt(0)" ::: "memory")
#define RLX_AGENT __ATOMIC_RELAXED, __HIP_MEMORY_SCOPE_AGENT

__device__ __forceinline__ unsigned pk2(float lo, float hi) { f32x2 v = {lo, hi}; bf16x2_t b = __builtin_convertvector(v, bf16x2_t); return __builtin_bit_cast(unsigned, b); }
__device__ __forceinline__ float bf2f(unsigned h) { return __builtin_bit_cast(float, h << 16); }
__device__ __forceinline__ float bflo(unsigned w) { return __builtin_bit_cast(float, w << 16); }
__device__ __forceinline__ float bfhi(unsigned w) { return __builtin_bit_cast(float, w & 0xffff0000u); }
__device__ __forceinline__ float wave_sum(float v) {
#pragma unroll
    for (int o = 1; o < 64; o <<= 1) v += __shfl_xor(v, o);
    return v;
}
constexpr float F8_WSCALE = 256.0f, F8_ASCALE = 4.0f, F8_DESCALE = 1.0f / (256.0f * 4.0f);
constexpr float F8_YSCALE = 8.0f;
constexpr float F8_MSCALE = 16.0f, F8_MDESCALE = 1.0f / (256.0f * 16.0f);
__device__ __forceinline__ unsigned pk4_fp8(float a, float b, float c, float d) { int w = 0; a = __builtin_amdgcn_fmed3f(a, -448.f, 448.f); b = __builtin_amdgcn_fmed3f(b, -448.f, 448.f); c = __builtin_amdgcn_fmed3f(c, -448.f, 448.f); d = __builtin_amdgcn_fmed3f(d, -448.f, 448.f);
    w = __builtin_amdgcn_cvt_pk_fp8_f32(a, b, w, false); w = __builtin_amdgcn_cvt_pk_fp8_f32(c, d, w, true); return (unsigned)w; }
__device__ __forceinline__ unsigned pk4_fp8_nc(float a, float b, float c, float d) { int w = 0; w = __builtin_amdgcn_cvt_pk_fp8_f32(a, b, w, false); w = __builtin_amdgcn_cvt_pk_fp8_f32(c, d, w, true); return (unsigned)w; }
__device__ __forceinline__ float sigmoidf_(float x) { return __builtin_amdgcn_rcpf(1.0f + __builtin_amdgcn_exp2f(x * -1.4426950408889634f)); }
__device__ __forceinline__ float sigmoid1702(float x) { return __builtin_amdgcn_rcpf(1.0f + __builtin_amdgcn_exp2f(x * (-1.702f * 1.4426950408889634f))); }

namespace pg8 {
#define PG8_LAS __attribute__((address_space(3)))
typedef unsigned short bf16_t;
typedef short bf16x8 __attribute__((ext_vector_type(8)));
typedef float f32x4 __attribute__((ext_vector_type(4)));
typedef unsigned u32x4 __attribute__((ext_vector_type(4)));
constexpr int BM = 256, BK = 64, HALF = 128, HTB = HALF * BK * 2, STAGE_BYTES = 8 * HTB, NXCD = 8, WGM = 8;

__host__ __device__ __forceinline__ int lds_byte(int r, int c) { const int st = (r >> 4) * 2 + (c >> 5), rr = r & 15, cc = c & 31, ob = rr * 64 + cc * 2; return st * 1024 + (ob ^ (((ob >> 9) & 1) << 5)); }
__host__ __device__ __forceinline__ void stage_rc(int b, int& R, int& C) { const int st = b / 1024, sb = b % 1024, swz = sb ^ (((sb >> 9) & 1) << 5); R = (st >> 1) * 16 + swz / 64; C = (st & 1) * 32 + (swz % 64) / 2; }
__host__ __device__ __forceinline__ int perm32(int rho) { const int n = rho >> 4, i = rho & 15; return 8 * (i >> 2) + 4 * n + (i & 3); }

struct Unit { int pm, pn; };
struct Gemm { const bf16_t* A; const bf16_t* Bt; int lda, ldb, K; const PG8_LAS unsigned short* rows; };

struct StaticOrder {
    int nM, nN, nwg, G, c;
    __host__ __device__ void init(int M, int N, int G_, int c_) { nM = M / BM; nN = N / BM; nwg = nM * nN; G = G_; c = c_; }
    __host__ __device__ bool next(int i, Unit& u) const {
        const long L = (long)i * G + c; if (L >= nwg) return false;
        int wgid = (int)L; { const int q = nwg / NXCD, r = nwg % NXCD, xcd = wgid % NXCD, off = wgid / NXCD; wgid = (xcd < r ? xcd * (q + 1) : r * (q + 1) + (xcd - r) * q) + off; }
        const int nig = WGM * nN, gid = wgid / nig, fm = gid * WGM, gsz = (nM - fm) < WGM ? (nM - fm) : WGM;
        u.pm = fm + ((wgid % nig) % gsz); u.pn = (wgid % nig) / gsz; return true;
    }
    __device__ __forceinline__ void a_ready(const Unit&) const {}
    __device__ __forceinline__ void done(const Unit&) const {}
};

typedef int i32x4 __attribute__((ext_vector_type(4)));
typedef int i32x8 __attribute__((ext_vector_type(8)));
template <bool F8> struct FragT;
template <> struct FragT<false> { bf16x8 k0, k1; };
template <> struct FragT<true> { i32x8 v; };
template <bool F8> __device__ __forceinline__ FragT<F8> ldfrag(const PG8_LAS unsigned char* p) {
    if constexpr (F8) { const i32x4 lo = *(const PG8_LAS i32x4*)p, hi = *(const PG8_LAS i32x4*)(p + 1024); FragT<true> f; f.v = __builtin_shufflevector(lo, hi, 0, 1, 2, 3, 4, 5, 6, 7); return f; }
    else { FragT<false> f; f.k0 = *(const PG8_LAS bf16x8*)p; f.k1 = *(const PG8_LAS bf16x8*)(p + 1024); return f; }
}
template <bool F8> __device__ __forceinline__ f32x4 mma1(const FragT<F8>& b, const FragT<F8>& a, f32x4 c) {
#if defined(__HIP_DEVICE_COMPILE__)
    if constexpr (F8) { asm volatile("v_mfma_f32_16x16x128_f8f6f4 %0, %1, %2, %0" : "+v"(c) : "v"(b.v), "v"(a.v)); return c; }
#else
    if constexpr (F8) { return c; }
#endif
    else { c = __builtin_amdgcn_mfma_f32_16x16x32_bf16(b.k0, a.k0, c, 0, 0, 0); return __builtin_amdgcn_mfma_f32_16x16x32_bf16(b.k1, a.k1, c, 0, 0, 0); }
}
template <class Epi, class Sched, bool ALIGN_EPI = false, bool SP2 = false, bool F8 = false, bool GATHER = false>
__device__ __forceinline__ void gemm_phase(PG8_LAS unsigned char* lds, const Gemm g, const Sched& S, const Epi& E) {
    const int tid = threadIdx.x, wid = __builtin_amdgcn_readfirstlane(tid >> 6), lane = tid & 63, wr = wid >> 2, wc = wid & 3, fr = lane & 15, fq = lane >> 4;
    const int K = g.K, nt = K / BK;
    unsigned voffA[2], voffB[2];
#pragma unroll
    for (int i = 0; i < 2; ++i) { int R, C; stage_rc(tid * 16 + i * 8192, R, C); const int Rb = Epi::PERM ? ((R & ~31) + perm32(R & 31)) : R;
        voffA[i] = (unsigned)(R * g.lda + C) * 2u; voffB[i] = (unsigned)(Rb * g.ldb + C) * 2u; }
    unsigned gC0[2] = {0u, 0u}, gC1[2] = {0u, 0u}, gN0[2] = {0u, 0u}, gN1[2] = {0u, 0u}; int gR[2] = {0, 0}; unsigned gCb[2] = {0u, 0u};
    if constexpr (GATHER) {
#pragma unroll
        for (int i = 0; i < 2; ++i) { int R, C; stage_rc(tid * 16 + i * 8192, R, C); gR[i] = R; gCb[i] = (unsigned)C * 2u; } }
#define PG8_GROWS(d0, d1, slot) do { _Pragma("unroll") for (int _i = 0; _i < 2; ++_i) { \
        d0[_i] = (unsigned)g.rows[(slot) * 256 + gR[_i]] * (unsigned)(g.lda * 2) + gCb[_i]; d1[_i] = (unsigned)g.rows[(slot) * 256 + 128 + gR[_i]] * (unsigned)(g.lda * 2) + gCb[_i]; } } while (0)
    const size_t kstep = (size_t)(BK * 2);
    const size_t hstepA = (size_t)HALF * g.lda * 2, hstepB = (size_t)HALF * g.ldb * 2;
    const size_t tstepA = 2 * hstepA, tstepB = 2 * hstepB;
    const unsigned ldsw = (unsigned)wid * 1024u;
    const int aoff = lds_byte(wr * 64 + fr, fq * 8), boff = lds_byte(wc * 32 + fr, fq * 8);
#define PG8_SA(b, h) (((b) * 2 + (h)) * HTB)
#define PG8_SB(b, h) ((4 + (b) * 2 + (h)) * HTB)
#define PG8_STAGE(bufoff, gbase, voff) do { _Pragma("unroll") for (int _i = 0; _i < 2; ++_i) \
        __builtin_amdgcn_global_load_lds((const unsigned*)((const char*)(gbase) + (voff)[_i]), (PG8_LAS unsigned*)(lds + (bufoff) + ldsw + _i * 8192), 16, 0, 0); } while (0)
#define PG8_STAGE2(bufoff, gbase, o0, o1) do { \
        __builtin_amdgcn_global_load_lds((const unsigned*)((const char*)(gbase) + (o0)), (PG8_LAS unsigned*)(lds + (bufoff) + ldsw), 16, 0, 0); \
        __builtin_amdgcn_global_load_lds((const unsigned*)((const char*)(gbase) + (o1)), (PG8_LAS unsigned*)(lds + (bufoff) + ldsw + 8192), 16, 0, 0); } while (0)
#define PG8_STAGE_A(bufoff, kb, h, nx) do { if constexpr (GATHER) { \
        if ((h) == 0) PG8_STAGE2(bufoff, kb, ((nx) ? gN0[0] : gC0[0]), ((nx) ? gN0[1] : gC0[1])); else PG8_STAGE2(bufoff, kb, ((nx) ? gN1[0] : gC1[0]), ((nx) ? gN1[1] : gC1[1])); \
        } else { PG8_STAGE(bufoff, (kb) + ((h) ? hstepA : (size_t)0), voffA); } } while (0)
#define PG8_LDA(dst, b, h) do { _Pragma("unroll") for (int m = 0; m < 4; ++m) dst[m] = ldfrag<F8>(lds + PG8_SA(b, h) + aoff + m * 2048); } while (0)
#define PG8_LDB(dst, b, h) do { _Pragma("unroll") for (int n = 0; n < 2; ++n) dst[n] = ldfrag<F8>(lds + PG8_SB(b, h) + boff + n * 2048); } while (0)
#define PG8_MMA(ai, bj, At, Bt) do { __builtin_amdgcn_s_setprio(1); _Pragma("unroll") for (int m = 0; m < 4; ++m) _Pragma("unroll") for (int n = 0; n < 2; ++n) \
        acc[ai][bj][m][n] = mma1<F8>(Bt[n], At[m], acc[ai][bj][m][n]); __builtin_amdgcn_s_setprio(0); } while (0)
#define PG8_WAIT_V(n) asm volatile("s_waitcnt vmcnt(" #n ")" ::: "memory")
#define PG8_WAIT_L(n) asm volatile("s_waitcnt lgkmcnt(" #n ")" ::: "memory")
#define PG8_BAR __builtin_amdgcn_s_barrier()
#define PG8_SCHED __builtin_amdgcn_sched_barrier(0)
    Unit cur, nxt; int ui = 0;
    if (!S.next(0, cur)) return;
    f32x4 acc[2][2][4][2];
#pragma unroll
    for (int a = 0; a < 2; ++a)
#pragma unroll
        for (int b = 0; b < 2; ++b)
#pragma unroll
            for (int m = 0; m < 4; ++m)
#pragma unroll
                for (int n = 0; n < 2; ++n) acc[a][b][m][n] = (f32x4){0.f, 0.f, 0.f, 0.f};
    FragT<F8> At[4], B0[2], B1[2];
    const char* cA = (const char*)g.A + (GATHER ? (size_t)0 : (size_t)cur.pm * tstepA); const char* cB = (const char*)g.Bt + (size_t)cur.pn * tstepB;
    if constexpr (GATHER) { PG8_GROWS(gC0, gC1, 0); }
    S.a_ready(cur);
    if constexpr (SP2) {
        PG8_STAGE(PG8_SB(0, 0), cB, voffB); PG8_STAGE(PG8_SB(0, 1), cB + hstepB, voffB); PG8_STAGE_A(PG8_SA(0, 0), cA, 0, false); PG8_STAGE_A(PG8_SA(0, 1), cA, 1, false);
        if (wr == 1) PG8_BAR;
        PG8_WAIT_V(2); PG8_BAR;
        PG8_STAGE(PG8_SB(1, 0), cB + kstep, voffB); PG8_STAGE_A(PG8_SA(1, 0), cA + kstep, 0, false); PG8_STAGE(PG8_SB(1, 1), cB + hstepB + kstep, voffB);
        PG8_WAIT_V(6); PG8_BAR;
    } else {
        PG8_STAGE(PG8_SB(0, 0), cB, voffB); PG8_STAGE_A(PG8_SA(0, 0), cA, 0, false); PG8_STAGE(PG8_SB(0, 1), cB + hstepB, voffB); PG8_STAGE_A(PG8_SA(0, 1), cA, 1, false);
        if (wr == 1) PG8_BAR;
        PG8_WAIT_V(4); PG8_BAR;
        PG8_STAGE(PG8_SB(1, 0), cB + kstep, voffB); PG8_STAGE_A(PG8_SA(1, 0), cA + kstep, 0, false); PG8_STAGE(PG8_SB(1, 1), cB + hstepB + kstep, voffB);
        PG8_WAIT_V(6); PG8_BAR;
    }
    for (;;) {
        const bool has_next = S.next(ui + 1, nxt);
        const char* nA = (has_next && !GATHER) ? (const char*)g.A + (size_t)nxt.pm * tstepA : cA; const char* nB = has_next ? (const char*)g.Bt + (size_t)nxt.pn * tstepB : cB;
        if constexpr (GATHER) { if (has_next) { PG8_GROWS(gN0, gN1, ui + 1); } else { gN0[0] = gC0[0]; gN0[1] = gC0[1]; gN1[0] = gC1[0]; gN1[1] = gC1[1]; } }
        for (int t = 0; t < nt; t += 2) {
            const bool last = (t == nt - 2);
            const char* a1 = cA + (size_t)(t + 1) * kstep;
            const char* a2 = last ? nA : cA + (size_t)(t + 2) * kstep; const char* b2 = last ? nB : cB + (size_t)(t + 2) * kstep;
            const char* a3 = a2 + kstep; const char* b3 = b2 + kstep;
            if (last && has_next) S.a_ready(nxt);
            if constexpr (Epi::CHAIN) { if (t == Epi::MID_T) {
                if constexpr (F8) asm volatile("s_nop 15\n\ts_nop 15" ::: "memory");
                int fr_ = fr, fq_ = fq; asm volatile("" : "+v"(fr_), "+v"(fq_)); E.mid(acc, cur, wr, wc, fr_, fq_); } }
            if constexpr (SP2) {
            PG8_LDB(B0, 0, 0); PG8_LDB(B1, 0, 1); PG8_SCHED; PG8_LDA(At, 0, 0); PG8_STAGE_A(PG8_SA(1, 1), a1, 1, false);
            PG8_WAIT_V(8); PG8_WAIT_L(0); PG8_BAR; PG8_MMA(0, 0, At, B0); PG8_MMA(0, 1, At, B1); PG8_BAR; PG8_SCHED;
            PG8_LDA(At, 0, 1); PG8_STAGE(PG8_SB(0, 0), b2, voffB); PG8_STAGE(PG8_SB(0, 1), b2 + hstepB, voffB); PG8_STAGE_A(PG8_SA(0, 0), a2, 0, last);
            PG8_WAIT_V(8); PG8_WAIT_L(0); PG8_BAR; PG8_MMA(1, 0, At, B0); PG8_MMA(1, 1, At, B1); PG8_BAR; PG8_SCHED;
            PG8_LDB(B0, 1, 0); PG8_LDB(B1, 1, 1); PG8_SCHED; PG8_LDA(At, 1, 0); PG8_STAGE_A(PG8_SA(0, 1), a2, 1, last);
            PG8_WAIT_V(8); PG8_WAIT_L(0); PG8_BAR; PG8_MMA(0, 0, At, B0); PG8_MMA(0, 1, At, B1); PG8_BAR; PG8_SCHED;
            PG8_LDA(At, 1, 1); PG8_STAGE(PG8_SB(1, 0), b3, voffB); PG8_STAGE(PG8_SB(1, 1), b3 + hstepB, voffB); PG8_STAGE_A(PG8_SA(1, 0), a3, 0, last);
            PG8_WAIT_V(8); PG8_WAIT_L(0); PG8_BAR; PG8_MMA(1, 0, At, B0); PG8_MMA(1, 1, At, B1); PG8_BAR; PG8_SCHED;
            } else {
            PG8_LDB(B0, 0, 0); PG8_SCHED; PG8_LDA(At, 0, 0); PG8_STAGE_A(PG8_SA(1, 1), a1, 1, false);
            PG8_WAIT_L(8); PG8_BAR; PG8_WAIT_L(0); PG8_MMA(0, 0, At, B0); PG8_BAR; PG8_SCHED;
            PG8_LDB(B1, 0, 1); PG8_STAGE(PG8_SB(0, 0), b2, voffB);
            PG8_BAR; PG8_WAIT_L(0); PG8_MMA(0, 1, At, B1); PG8_BAR;
            PG8_LDA(At, 0, 1); PG8_STAGE_A(PG8_SA(0, 0), a2, 0, last);
            PG8_BAR; PG8_WAIT_L(0); PG8_MMA(1, 0, At, B0); PG8_BAR; PG8_SCHED;
            PG8_STAGE(PG8_SB(0, 1), b2 + hstepB, voffB);
            PG8_WAIT_V(6); PG8_BAR; PG8_MMA(1, 1, At, B1); PG8_BAR;
            PG8_LDB(B0, 1, 0); PG8_SCHED; PG8_LDA(At, 1, 0); PG8_STAGE_A(PG8_SA(0, 1), a2, 1, last);
            PG8_WAIT_L(8); PG8_BAR; PG8_WAIT_L(0); PG8_MMA(0, 0, At, B0); PG8_BAR; PG8_SCHED;
            PG8_LDB(B1, 1, 1); PG8_STAGE(PG8_SB(1, 0), b3, voffB);
            PG8_BAR; PG8_WAIT_L(0); PG8_MMA(0, 1, At, B1); PG8_BAR;
            PG8_LDA(At, 1, 1); PG8_STAGE_A(PG8_SA(1, 0), a3, 0, last);
            PG8_BAR; PG8_WAIT_L(0); PG8_MMA(1, 0, At, B0); PG8_BAR; PG8_SCHED;
            PG8_STAGE(PG8_SB(1, 1), b3 + hstepB, voffB);
            PG8_WAIT_V(6); PG8_BAR; PG8_MMA(1, 1, At, B1); PG8_BAR;
            }
        }
        if constexpr (ALIGN_EPI) { if (wr == 0) PG8_BAR; }
        if constexpr (F8) asm volatile("s_nop 15\n\ts_nop 15" ::: "memory");
        { int fr_ = fr, fq_ = fq; asm volatile("" : "+v"(fr_), "+v"(fq_));
          E(acc, cur, wr, wc, fr_, fq_); } S.done(cur);
        if (!has_next) break;
#pragma unroll
        for (int a = 0; a < 2; ++a)
#pragma unroll
            for (int b = 0; b < 2; ++b)
#pragma unroll
                for (int m = 0; m < 4; ++m)
#pragma unroll
                    for (int n = 0; n < 2; ++n) acc[a][b][m][n] = (f32x4){0.f, 0.f, 0.f, 0.f};
        cur = nxt; cA = nA; cB = nB; ++ui;
        if constexpr (GATHER) { gC0[0] = gN0[0]; gC0[1] = gN0[1]; gC1[0] = gN1[0]; gC1[1] = gN1[1]; }
        if constexpr (ALIGN_EPI) { if (wr == 1) PG8_BAR; }
    }
    PG8_WAIT_V(0);
    if constexpr (!ALIGN_EPI) { if (wr == 0) PG8_BAR; }
    PG8_BAR;
#undef PG8_SA
#undef PG8_SB
#undef PG8_STAGE
#undef PG8_STAGE2
#undef PG8_STAGE_A
#undef PG8_GROWS
#undef PG8_LDA
#undef PG8_LDB
#undef PG8_MMA
#undef PG8_WAIT_V
#undef PG8_WAIT_L
#undef PG8_BAR
#undef PG8_SCHED
}
}

#define XB_TMO      128
#define XB_XCNT(j)  (256  + 64 * (j))
#define XB_XSUB(j)  (1280 + 64 * (j))
#define XB_XGEN(j)  (2304 + 64 * (j))
#define XB_TOP      3328
#define XB_TOPGEN   3392
#define XCD_BAR_WORDS 3456
#define XB_SPIN_CAP (1u << 18)

__device__ __forceinline__ unsigned xb_ld(unsigned* p)              { return __hip_atomic_load(p, __ATOMIC_RELAXED, __HIP_MEMORY_SCOPE_AGENT); }
__device__ __forceinline__ unsigned xb_add(unsigned* p, unsigned v) { return __hip_atomic_fetch_add(p, v, __ATOMIC_RELAXED, __HIP_MEMORY_SCOPE_AGENT); }
__device__ __forceinline__ unsigned xb_xcc_id() { return (unsigned)__builtin_amdgcn_s_getreg((3 << 11) | 20) & 0xFu; }
#define XB_SPIN(cond, bar) do { unsigned _sp = 0; while (cond) { __builtin_amdgcn_s_sleep(1); \
    if ((++_sp & 255u) == 0u) { if (xb_ld(&(bar)[XB_TMO])) break; if (_sp > XB_SPIN_CAP) { atomicAdd(&(bar)[XB_TMO], 1u); break; } } } } while (0)

struct XcdBarrier { unsigned* bar; unsigned x; volatile LAS unsigned* st; };

__device__ __forceinline__ XcdBarrier xcd_barrier_post(unsigned* bar, volatile LAS unsigned* st) {
    XcdBarrier b; b.bar = bar; b.x = xb_xcc_id(); b.st = st;
    if (threadIdx.x == 0) (void)xb_add(&bar[XB_XCNT(b.x)], 1u);
    return b;
}
__device__ __forceinline__ void xcd_barrier_complete(unsigned* bar, unsigned x, unsigned& nloc, unsigned& nx) {
    const unsigned G = gridDim.x * gridDim.y * gridDim.z;
    unsigned sum, cnt, mine, sp = 0u;
    for (;;) {
        sum = 0u; cnt = 0u; mine = 0u;
#pragma unroll
        for (unsigned j = 0; j < 16; ++j) { const unsigned c = xb_ld(&bar[XB_XCNT(j)]); sum += c; cnt += (c > 0u) ? 1u : 0u; mine = (j == x) ? c : mine; }
        if (sum == G) break;
        __builtin_amdgcn_s_sleep(1);
        if ((++sp & 255u) == 0u) { if (xb_ld(&bar[XB_TMO])) break; if (sp > XB_SPIN_CAP) { atomicAdd(&bar[XB_TMO], 1u); break; } }
    }
    nloc = mine > 0u ? mine : 1u; nx = cnt > 0u ? cnt : 1u;
}
__device__ __forceinline__ void xcd_barrier(const XcdBarrier& b) {
    asm volatile("s_waitcnt vmcnt(0)" ::: "memory");
    __syncthreads();
    if (threadIdx.x == 0) {
        unsigned* bar = b.bar;
        __builtin_amdgcn_s_waitcnt(0);
        unsigned nloc = b.st[0], nx = b.st[1];
        if (nloc == 0u) { xcd_barrier_complete(bar, b.x, nloc, nx); b.st[0] = nloc; b.st[1] = nx; }
        const unsigned old = xb_add(&bar[XB_XSUB(b.x)], 1u);
        const unsigned gen = old / nloc;
        if (old + 1u == (gen + 1u) * nloc) {
            __builtin_amdgcn_fence(__ATOMIC_RELEASE, "agent");
            asm volatile("s_waitcnt vmcnt(0)" ::: "memory");
            const unsigned og = xb_add(&bar[XB_TOP], 1u);
            const unsigned tg = og / nx;
            if (og + 1u == (tg + 1u) * nx) xb_add(&bar[XB_TOPGEN], 1u);
            else XB_SPIN(xb_ld(&bar[XB_TOPGEN]) == tg, bar);
            __builtin_amdgcn_fence(__ATOMIC_ACQUIRE, "agent");
            xb_add(&bar[XB_XGEN(b.x)], 1u);
            asm volatile("s_waitcnt vmcnt(0)" ::: "memory");
        } else {
            XB_SPIN(xb_ld(&bar[XB_XGEN(b.x)]) == gen, bar);
            __builtin_amdgcn_fence(__ATOMIC_ACQUIRE, "agent");
            asm volatile("s_waitcnt vmcnt(0)" ::: "memory");
        }
    }
    __syncthreads();
}

using pg8::Unit;
__device__ __forceinline__ v4u pack8(const f32x4& a, const f32x4& b) { v4u w; w.x = pk2(a[0], a[1]); w.y = pk2(a[2], a[3]); w.z = pk2(b[0], b[1]); w.w = pk2(b[2], b[3]); return w; }
__device__ __forceinline__ float gelu_tanh(float y) { const float u2 = 1.5957691216f * (y + 0.044715f * y * y * y); return y * __builtin_amdgcn_rcpf(1.0f + __builtin_amdgcn_exp2f(u2 * -1.4426950408889634f)); }

struct EpiInProjA {
    static constexpr bool PERM = true, CHAIN = false;
    bf16 *Q, *K, *IQ, *IK; float* IW;
    __device__ __forceinline__ void operator()(const f32x4 (&acc)[2][2][4][2], const Unit& u, int wr, int wc, int fr, int fq) const {
        const int pn = u.pn, row0 = u.pm * 256 + wr * 64 + fr, cl0 = wc * 32 + 8 * fq;
        if (pn < 9) {
            bf16* dst; int ld, coff; float sc = 1.f;
            if (pn < 4) { dst = Q; ld = 1024; coff = pn * 256; } else if (pn == 4) { dst = K; ld = 256; coff = 0; } else { dst = IQ; ld = 1024; coff = (pn - 5) * 256; sc = 0.125f; }
#pragma unroll
            for (int ai = 0; ai < 2; ++ai)
#pragma unroll
                for (int m = 0; m < 4; ++m) { bf16* rowp = dst + (size_t)(row0 + ai * 128 + m * 16) * ld + coff + cl0;
#pragma unroll
                    for (int bj = 0; bj < 2; ++bj) *(v4u*)(rowp + bj * 128) = pack8(acc[ai][bj][m][0] * sc, acc[ai][bj][m][1] * sc); }
        } else {
#pragma unroll
            for (int ai = 0; ai < 2; ++ai)
#pragma unroll
                for (int m = 0; m < 4; ++m) { const int row = row0 + ai * 128 + m * 16;
                    if (cl0 < 64) *(v4u*)(IK + (size_t)row * 64 + cl0) = pack8(acc[ai][0][m][0], acc[ai][0][m][1]);
                    else if (cl0 < 80) { float* p = IW + (size_t)row * 16 + (cl0 - 64); *(f32x4*)p = acc[ai][0][m][0] * 0.25f; *(f32x4*)(p + 4) = acc[ai][0][m][1] * 0.25f; } }
        }
    }
};
struct EpiInProjB {
    static constexpr bool PERM = true, CHAIN = false;
    bf16 *V, *UA; unsigned char* GATES;
    __device__ __forceinline__ void operator()(const f32x4 (&acc)[2][2][4][2], const Unit& u, int wr, int wc, int fr, int fq) const {
        const int pn = u.pn, row0 = u.pm * 256 + wr * 64 + fr, cl0 = wc * 32 + 8 * fq;
        if (pn >= 5) {
            const int coff = (pn - 5) * 256 + cl0;
#pragma unroll
            for (int ai = 0; ai < 2; ++ai)
#pragma unroll
                for (int m = 0; m < 4; ++m) { unsigned char* rowp = GATES + (size_t)(row0 + ai * 128 + m * 16) * 4096 + coff;
#pragma unroll
                    for (int bj = 0; bj < 2; ++bj) { const f32x4 v0 = acc[ai][bj][m][0] * F8_DESCALE, v1 = acc[ai][bj][m][1] * F8_DESCALE; unsigned c[8];
#pragma unroll
                        for (int e = 0; e < 4; ++e) { c[e] = (unsigned)fminf(fmaxf(sigmoidf_(v0[e]) * 255.0f + 0.5f, 1.0f), 255.0f); c[4 + e] = (unsigned)fminf(fmaxf(sigmoidf_(v1[e]) * 255.0f + 0.5f, 1.0f), 255.0f); }
                        v2u w; w.x = c[0] | (c[1] << 8) | (c[2] << 16) | (c[3] << 24); w.y = c[4] | (c[5] << 8) | (c[6] << 16) | (c[7] << 24);
                        *(v2u*)(rowp + bj * 128) = w; } }
        } else if (pn == 0) {
#pragma unroll
            for (int ai = 0; ai < 2; ++ai)
#pragma unroll
                for (int m = 0; m < 4; ++m) { bf16* rowp = V + (size_t)(row0 + ai * 128 + m * 16) * 256 + cl0;
#pragma unroll
                    for (int bj = 0; bj < 2; ++bj) *(v4u*)(rowp + bj * 128) = pack8(acc[ai][bj][m][0] * F8_DESCALE, acc[ai][bj][m][1] * F8_DESCALE); }
        } else {
#pragma unroll
            for (int ai = 0; ai < 2; ++ai)
#pragma unroll
                for (int m = 0; m < 4; ++m) { const int row = row0 + ai * 128 + m * 16, b = row >> 11, t = row & 2047, c = t >> 5, i = t & 31;
#pragma unroll
                    for (int bj = 0; bj < 2; ++bj) { const int ch0 = (pn - 1) * 256 + bj * 128 + cl0, g = ch0 >> 4, p0 = ch0 & 15;
                        *(v4u*)(UA + ((size_t)(g * SROWS + b * NSC + c)) * UA_LD + i * 16 + p0) = pack8(acc[ai][bj][m][0] * F8_DESCALE, acc[ai][bj][m][1] * F8_DESCALE); } }
        }
    }
};

struct EpiSsmS {
    static constexpr bool PERM = false, CHAIN = false;
    float* SBUF;
    __device__ __forceinline__ void operator()(const f32x4 (&acc)[2][2][4][2], const Unit& u, int wr, int wc, int fr, int fq) const {
#pragma unroll
        for (int ai = 0; ai < 2; ++ai)
#pragma unroll
            for (int m = 0; m < 4; ++m) { const int rl = ai * 128 + wr * 64 + m * 16 + fr;
#pragma unroll
                for (int n = 0; n < 2; ++n) *(f32x4*)(SBUF + ((size_t)(u.pm * 256 + rl)) * 128 + wc * 32 + 16 * n + 4 * fq) = acc[ai][0][m][n]; }
    }
};

struct EpiSsmY {
    static constexpr bool PERM = true, CHAIN = false;
    bf16* YG;
    __device__ __forceinline__ void operator()(const f32x4 (&acc)[2][2][4][2], const Unit& u, int wr, int wc, int fr, int fq) const {
        const int g = u.pm >> 1, rt = u.pm & 1, ct = u.pn & 1;
#pragma unroll
        for (int ai = 0; ai < 2; ++ai)
#pragma unroll
            for (int m = 0; m < 4; ++m) { const int r = rt * 256 + ai * 128 + wr * 64 + m * 16 + fr, b = r >> 6, c = r & 63;
#pragma unroll
                for (int bj = 0; bj < 2; ++bj) { const int cl = bj * 128 + wc * 32 + 8 * fq, j = 16 * ct + (cl >> 4), p0 = cl & 15; const int t = b * 2048 + SL * c + j;
                    f32x4 v0 = acc[ai][bj][m][0], v1 = acc[ai][bj][m][1];
#pragma unroll
                    for (int e = 0; e < 4; ++e) { v0[e] = gelu_tanh(v0[e]); v1[e] = gelu_tanh(v1[e]); }
                    *(v4u*)(YG + (size_t)t * 1024 + 16 * g + p0) = pack8(v0, v1); } }
    }
};

struct EpiGlu {
    static constexpr bool PERM = true, CHAIN = false;
    const bf16* YG; unsigned char* YS; const float* bias;
    __device__ __forceinline__ void operator()(const f32x4 (&acc)[2][2][4][2], const Unit& u, int wr, int wc, int fr, int fq) const {
        const int row0 = u.pm * 256 + wr * 64 + fr, col0 = u.pn * 256 + wc * 32 + 8 * fq;
        f32x4 bv[2][2];
#pragma unroll
        for (int bj = 0; bj < 2; ++bj) { bv[bj][0] = *(const f32x4*)(bias + col0 + bj * 128); bv[bj][1] = *(const f32x4*)(bias + col0 + bj * 128 + 4); }
#pragma unroll
        for (int ai = 0; ai < 2; ++ai) { v4u ygv[4][2];
#pragma unroll
            for (int m = 0; m < 4; ++m)
#pragma unroll
                for (int bj = 0; bj < 2; ++bj) ygv[m][bj] = *(const v4u*)(YG + (size_t)(row0 + ai * 128 + m * 16) * 1024 + col0 + bj * 128);
#pragma unroll
            for (int m = 0; m < 4; ++m) { const size_t ro = (size_t)(row0 + ai * 128 + m * 16) * 1024;
#pragma unroll
                for (int bj = 0; bj < 2; ++bj) { const int col = col0 + bj * 128; const v4u yg = ygv[m][bj]; f32x4 z0 = acc[ai][bj][m][0] + bv[bj][0], z1 = acc[ai][bj][m][1] + bv[bj][1];
                    z0[0] = bflo(yg.x) * sigmoidf_(z0[0]); z0[1] = bfhi(yg.x) * sigmoidf_(z0[1]); z0[2] = bflo(yg.y) * sigmoidf_(z0[2]); z0[3] = bfhi(yg.y) * sigmoidf_(z0[3]);
                    z1[0] = bflo(yg.z) * sigmoidf_(z1[0]); z1[1] = bfhi(yg.z) * sigmoidf_(z1[1]); z1[2] = bflo(yg.w) * sigmoidf_(z1[2]); z1[3] = bfhi(yg.w) * sigmoidf_(z1[3]);
                    z0 = z0 * F8_MSCALE; z1 = z1 * F8_MSCALE; v2u w8; w8.x = pk4_fp8(z0[0], z0[1], z0[2], z0[3]); w8.y = pk4_fp8(z1[0], z1[1], z1[2], z1[3]); *(v2u*)(YS + 2 * ro + col) = w8; } } }
    }
};

struct EpiProjAB {
    static constexpr bool PERM = true, CHAIN = true; static constexpr int MID_T = 8;
    const unsigned char* GATES; unsigned char* MG;
    __device__ __forceinline__ void mid(f32x4 (&acc)[2][2][4][2], const Unit& u, int wr, int wc, int fr, int fq) const {
        int row0 = u.pm * 256 + wr * 64 + fr, col0 = u.pn * 256 + wc * 32 + 8 * fq; asm volatile("" : "+v"(row0), "+v"(col0));
#pragma unroll
        for (int ai = 0; ai < 2; ++ai)
#pragma unroll
            for (int m = 0; m < 4; ++m) { const size_t row = (size_t)(row0 + ai * 128 + m * 16);
#pragma unroll
                for (int bj = 0; bj < 2; ++bj) { const int col = col0 + bj * 128; const v2u ga = *(const v2u*)(GATES + row * 4096 + col), gs = *(const v2u*)(GATES + row * 4096 + 2048 + col);
                    f32x4& a0 = acc[ai][bj][m][0]; f32x4& a1 = acc[ai][bj][m][1];
#pragma unroll
                    for (int e = 0; e < 4; ++e) { a0[e] *= (float)((ga.x >> (8 * e)) & 0xffu) * __builtin_amdgcn_rcpf((float)((gs.x >> (8 * e)) & 0xffu));
                                                  a1[e] *= (float)((ga.y >> (8 * e)) & 0xffu) * __builtin_amdgcn_rcpf((float)((gs.y >> (8 * e)) & 0xffu)); } } }
    }
    __device__ __forceinline__ void operator()(const f32x4 (&acc)[2][2][4][2], const Unit& u, int wr, int wc, int fr, int fq) const {
        int row0 = u.pm * 256 + wr * 64 + fr, col0 = u.pn * 256 + wc * 32 + 8 * fq; asm volatile("" : "+v"(row0), "+v"(col0));
        constexpr float SC = F8_MDESCALE * F8_MSCALE * (1.0f / 255.0f);
        v2u gsv[2][4][2];
#pragma unroll
        for (int ai = 0; ai < 2; ++ai)
#pragma unroll
            for (int m = 0; m < 4; ++m)
#pragma unroll
                for (int bj = 0; bj < 2; ++bj) gsv[ai][m][bj] = *(const v2u*)(GATES + (size_t)(row0 + ai * 128 + m * 16) * 4096 + 2048 + col0 + bj * 128);
#pragma unroll
        for (int ai = 0; ai < 2; ++ai)
#pragma unroll
            for (int m = 0; m < 4; ++m) { const size_t row = (size_t)(row0 + ai * 128 + m * 16);
#pragma unroll
                for (int bj = 0; bj < 2; ++bj) { const int col = col0 + bj * 128; const v2u gs = gsv[ai][m][bj]; const f32x4 a0 = acc[ai][bj][m][0] * SC, a1 = acc[ai][bj][m][1] * SC;
                    v2u w8; w8.x = pk4_fp8(a0[0] * (float)(gs.x & 0xffu), a0[1] * (float)((gs.x >> 8) & 0xffu), a0[2] * (float)((gs.x >> 16) & 0xffu), a0[3] * (float)(gs.x >> 24));
                    w8.y = pk4_fp8(a1[0] * (float)(gs.y & 0xffu), a1[1] * (float)((gs.y >> 8) & 0xffu), a1[2] * (float)((gs.y >> 16) & 0xffu), a1[3] * (float)(gs.y >> 24));
                    *(v2u*)(MG + row * 2048 + col) = w8; } }
    }
};

struct EpiOut {
    static constexpr bool PERM = true, CHAIN = false;
    const float* X; const float* MOD; bf16* X1;
    __device__ __forceinline__ void operator()(const f32x4 (&acc)[2][2][4][2], const Unit& u, int wr, int wc, int fr, int fq) const {
        const int row0 = u.pm * 256 + wr * 64 + fr, col0 = u.pn * 256 + wc * 32 + 8 * fq;
        const float* gt1 = MOD + (size_t)(u.pm >> 3) * MODW + 2 * DM;
        f32x4 gv[2][2];
#pragma unroll
        for (int bj = 0; bj < 2; ++bj) { gv[bj][0] = *(const f32x4*)(gt1 + col0 + bj * 128); gv[bj][1] = *(const f32x4*)(gt1 + col0 + bj * 128 + 4); }
#pragma unroll
        for (int ai = 0; ai < 2; ++ai) { f32x4 xv[4][2][2];
#pragma unroll
            for (int m = 0; m < 4; ++m)
#pragma unroll
                for (int bj = 0; bj < 2; ++bj) { const float* xp = X + (size_t)(row0 + ai * 128 + m * 16) * 2048 + col0 + bj * 128; xv[m][bj][0] = *(const f32x4*)xp; xv[m][bj][1] = *(const f32x4*)(xp + 4); }
#pragma unroll
            for (int m = 0; m < 4; ++m) { const size_t ro = (size_t)(row0 + ai * 128 + m * 16) * 2048;
#pragma unroll
                for (int bj = 0; bj < 2; ++bj) { const int col = col0 + bj * 128;
                    const f32x4 o0 = xv[m][bj][0] + gv[bj][0] * (acc[ai][bj][m][0] * F8_MDESCALE), o1 = xv[m][bj][1] + gv[bj][1] * (acc[ai][bj][m][1] * F8_MDESCALE);
                    *(v4u*)(X1 + ro + col) = pack8(o0, o1); } } }
    }
};

struct EpiGateUp {
    static constexpr bool PERM = true, CHAIN = false;
    const float* bgu; unsigned char* ACT;
    __device__ __forceinline__ void operator()(const f32x4 (&acc)[2][2][4][2], const Unit& u, int wr, int wc, int fr, int fq) const {
        const int e = u.pn >> 4, ct = u.pn & 15, row0 = u.pm * 256 + wr * 64 + fr, col = ct * 128 + wc * 32 + 8 * fq;
        const float* bg = bgu + (size_t)e * 4096 + col; const f32x4 g0 = *(const f32x4*)bg, g1 = *(const f32x4*)(bg + 4);
        const f32x4 u0 = (*(const f32x4*)(bg + 2048) + 1.0f) * F8_ASCALE, u1 = (*(const f32x4*)(bg + 2052) + 1.0f) * F8_ASCALE;
        constexpr float D4 = F8_DESCALE * F8_ASCALE;
#pragma unroll
        for (int ai = 0; ai < 2; ++ai)
#pragma unroll
            for (int m = 0; m < 4; ++m) { f32x4 ga = acc[ai][0][m][0] * F8_DESCALE + g0, gb = acc[ai][0][m][1] * F8_DESCALE + g1, ua = acc[ai][1][m][0] * D4 + u0, ub = acc[ai][1][m][1] * D4 + u1;
#pragma unroll
                for (int q = 0; q < 4; ++q) { float gg = fminf(ga[q], 7.0f), uu = __builtin_amdgcn_fmed3f(ua[q], -6.0f * F8_ASCALE, 8.0f * F8_ASCALE); ga[q] = uu * (gg * sigmoid1702(gg));
                    gg = fminf(gb[q], 7.0f); uu = __builtin_amdgcn_fmed3f(ub[q], -6.0f * F8_ASCALE, 8.0f * F8_ASCALE); gb[q] = uu * (gg * sigmoid1702(gg)); }
                v2u w; w.x = pk4_fp8_nc(ga[0], ga[1], ga[2], ga[3]); w.y = pk4_fp8_nc(gb[0], gb[1], gb[2], gb[3]);
                *(v2u*)(ACT + (size_t)(row0 + ai * 128 + m * 16) * 2048 + col) = w; }
    }
};

struct EpiDown {
    static constexpr bool PERM = true, CHAIN = false;
    const float* bd; const float* GLIST; const LAS int* mt; unsigned char* YE;
    __device__ __forceinline__ void operator()(const f32x4 (&acc)[2][2][4][2], const Unit& u, int wr, int wc, int fr, int fq) const {
        const int e = (u.pn >> 3) & 31, ct = u.pn & 7, row0 = u.pm * 256 + wr * 64 + fr, col0 = ct * 256 + wc * 32 + 8 * fq, ne = mt[32 + e], i0 = row0 - mt[e];
        f32x4 bv[2][2]; float grv[2][4];
#pragma unroll
        for (int bj = 0; bj < 2; ++bj) { const float* bp = bd + (size_t)e * 2048 + col0 + bj * 128; bv[bj][0] = *(const f32x4*)bp; bv[bj][1] = *(const f32x4*)(bp + 4); }
#pragma unroll
        for (int ai = 0; ai < 2; ++ai)
#pragma unroll
            for (int m = 0; m < 4; ++m) { const int idx = i0 + ai * 128 + m * 16; const bool ok = idx >= 0 && idx < ne && idx < T; const float gl = GLIST[(size_t)e * T + (ok ? idx : 0)]; grv[ai][m] = ok ? gl * F8_YSCALE : 0.f; }
#pragma unroll
        for (int ai = 0; ai < 2; ++ai)
#pragma unroll
            for (int m = 0; m < 4; ++m) { const size_t row = (size_t)(row0 + ai * 128 + m * 16); const float gr = grv[ai][m];
#pragma unroll
                for (int bj = 0; bj < 2; ++bj) { const int col = col0 + bj * 128;
                    const f32x4 y0 = (acc[ai][bj][m][0] * F8_DESCALE + bv[bj][0]) * gr, y1 = (acc[ai][bj][m][1] * F8_DESCALE + bv[bj][1]) * gr;
                    v2u w8; w8.x = pk4_fp8(y0[0], y0[1], y0[2], y0[3]); w8.y = pk4_fp8(y1[0], y1[1], y1[2], y1[3]); *(v2u*)(YE + row * 2048 + col) = w8; } }
    }
};

struct SsmSOrder {
    int G, c;
    __device__ __forceinline__ bool next(int i, Unit& u) const { const int L = i * G + c; if (L >= 2 * SSMG) return false; u.pm = L; u.pn = L >> 1; return true; }
    __device__ __forceinline__ void a_ready(const Unit&) const {}
    __device__ __forceinline__ void done(const Unit&) const {}
};
struct SsmYOrder {
    int G, c;
    __device__ __forceinline__ bool next(int i, Unit& u) const { const int L = i * G + c; if (L >= 256) return false; const int g = L >> 2; u.pm = 2 * g + ((L >> 1) & 1); u.pn = 2 * g + (L & 1); return true; }
    __device__ __forceinline__ void a_ready(const Unit&) const {}
    __device__ __forceinline__ void done(const Unit&) const {}
};
struct MoeOrder {
    const LAS int* rbe; int nrb, sh, G, c;
    __device__ __forceinline__ bool next(int i, Unit& u) const {
        int rb, ct;
        if (G == 256) { const int x = c & 7, m = c >> 3, st = i * 8 + x, rbq = m >> 3, ctq = m & 7;
            if (sh == 4) { rb = 4 * (st >> 1) + rbq; ct = 8 * (st & 1) + ctq; } else { rb = 4 * st + rbq; ct = ctq; } }
        else { const int L = i * G + c; rb = L >> sh; ct = L & ((1 << sh) - 1); }
        if (rb >= nrb) return false;
        const int e = __builtin_amdgcn_readfirstlane(rbe[rb]);
        u.pm = rb; u.pn = (e << sh) + ct; return true; }
    __device__ __forceinline__ void a_ready(const Unit&) const {}
    __device__ __forceinline__ void done(const Unit&) const {}
};

struct Args { const float* in[28]; float* out; unsigned char* ws; int ph_lo, ph_hi; };
enum { I_X = 0, I_C, I_WADA, I_BADA, I_N1G, I_WIN, I_QG, I_KG, I_ARE, I_AIM, I_LDT, I_BRE, I_BIM, I_CRE, I_CIM, I_SD, I_WGLU, I_BGLU, I_WPA, I_WPB, I_WOUT, I_N2G, I_WR, I_BR, I_WGU, I_BGU, I_WD, I_BD };

__device__ __forceinline__ int crow(int r, int hi) { return (r & 3) + 8 * (r >> 2) + 4 * hi; }

__device__ __forceinline__ void ph0_adaln(const Args& a, LAS unsigned char* lds, int tid, int G, int bid) {
    LAS float* cond = (LAS float*)lds;
    LAS float* red = (LAS float*)(lds + 65536);
    const float* c = a.in[I_C]; const float* W = a.in[I_WADA]; const float* bada = a.in[I_BADA]; float* MOD = (float*)(a.ws + WS_MOD);
    bool have = false;
    for (int ub = bid; ub < MODW / 64; ub += G) {
        if (!have) { for (int i = tid; i < NB * DM; i += NTHR) { const int b = i >> 11, k = i & 2047; const float v = c[i]; cond[k * 8 + b] = v / (1.0f + expf(-v)); } __syncthreads(); have = true; }
        const int cc = tid & 63, col = ub * 64 + cc, kq = tid >> 6;
        float acc[8];
#pragma unroll
        for (int b = 0; b < 8; ++b) acc[b] = 0.f;
        const float* wp = W + (size_t)(kq * 256) * MODW + col;
        for (int k = 0; k < 256; k += 64) {
            float w[64];
#pragma unroll
            for (int q = 0; q < 64; ++q) w[q] = wp[(size_t)(k + q) * MODW];
#pragma unroll
            for (int q = 0; q < 64; ++q) { const f32x4 c0 = *(const LAS f32x4*)(cond + (kq * 256 + k + q) * 8), c1 = *(const LAS f32x4*)(cond + (kq * 256 + k + q) * 8 + 4);
                acc[0] += w[q] * c0[0]; acc[1] += w[q] * c0[1]; acc[2] += w[q] * c0[2]; acc[3] += w[q] * c0[3];
                acc[4] += w[q] * c1[0]; acc[5] += w[q] * c1[1]; acc[6] += w[q] * c1[2]; acc[7] += w[q] * c1[3]; }
        }
#pragma unroll
        for (int b = 0; b < 8; ++b) red[(kq * 8 + b) * 64 + cc] = acc[b];
        __syncthreads();
        { const int b = tid >> 6;
          float s = 0.f;
#pragma unroll
          for (int q = 0; q < 8; ++q) s += red[(q * 8 + b) * 64 + cc];
          MOD[(size_t)b * MODW + col] = s + bada[col]; }
        __syncthreads();
    }
    __syncthreads();
}
__device__ __forceinline__ void tr_item(const float* W, int ldw, int K, int srccol, int nvalid, bf16* WT, size_t dstrow0, int k0, LAS float* scr, int lane) {
    const int nn = lane & 31; const bool ok = nn < nvalid;
    float wv_[32];
#pragma unroll
    for (int i = 0; i < 32; ++i) { const int kk = 2 * i + (lane >> 5); wv_[i] = ok ? W[(size_t)(k0 + kk) * ldw + srccol + nn] : 0.f; }
#pragma unroll
    for (int i = 0; i < 32; ++i) { const int kk = 2 * i + (lane >> 5); scr[kk * 33 + nn] = wv_[i]; }
    LDS_WAIT(); asm volatile("" ::: "memory");
    const int c = lane & 7;
#pragma unroll
    for (int j = 0; j < 4; ++j) { const int n = (lane >> 3) + 8 * j; const LAS float* s = scr + (8 * c) * 33 + n;
        v4u o; o.x = pk2(s[0 * 33], s[1 * 33]); o.y = pk2(s[2 * 33], s[3 * 33]); o.z = pk2(s[4 * 33], s[5 * 33]); o.w = pk2(s[6 * 33], s[7 * 33]);
        *(v4u*)(WT + (dstrow0 + n) * K + k0 + 8 * c) = o; }
    LDS_WAIT(); asm volatile("" ::: "memory");
}
__device__ __forceinline__ void tr128_f8(const float* W, int ldw, int srccol, unsigned char* WT, size_t dstrow0, int K, int k0, LAS unsigned char* tile, int lane) {
    const float* src = W + (size_t)k0 * ldw + srccol + 2 * lane;
    f32x2 va[16], vb[16], vc[16], vd[16];
#define CV_LOAD(v, kb) do { _Pragma("unroll") for (int j = 0; j < 16; ++j) v[j] = __builtin_nontemporal_load((const f32x2*)(src + (size_t)((kb) * 16 + j) * ldw)); } while (0)
#define CV_PUT(v, kb) do { v4u a, b; \
        a.x = pk4_fp8(v[0][0] * F8_WSCALE, v[1][0] * F8_WSCALE, v[2][0] * F8_WSCALE, v[3][0] * F8_WSCALE); a.y = pk4_fp8(v[4][0] * F8_WSCALE, v[5][0] * F8_WSCALE, v[6][0] * F8_WSCALE, v[7][0] * F8_WSCALE); \
        a.z = pk4_fp8(v[8][0] * F8_WSCALE, v[9][0] * F8_WSCALE, v[10][0] * F8_WSCALE, v[11][0] * F8_WSCALE); a.w = pk4_fp8(v[12][0] * F8_WSCALE, v[13][0] * F8_WSCALE, v[14][0] * F8_WSCALE, v[15][0] * F8_WSCALE); \
        b.x = pk4_fp8(v[0][1] * F8_WSCALE, v[1][1] * F8_WSCALE, v[2][1] * F8_WSCALE, v[3][1] * F8_WSCALE); b.y = pk4_fp8(v[4][1] * F8_WSCALE, v[5][1] * F8_WSCALE, v[6][1] * F8_WSCALE, v[7][1] * F8_WSCALE); \
        b.z = pk4_fp8(v[8][1] * F8_WSCALE, v[9][1] * F8_WSCALE, v[10][1] * F8_WSCALE, v[11][1] * F8_WSCALE); b.w = pk4_fp8(v[12][1] * F8_WSCALE, v[13][1] * F8_WSCALE, v[14][1] * F8_WSCALE, v[15][1] * F8_WSCALE); \
        const int n0 = 2 * lane, n1 = 2 * lane + 1; \
        *(LAS v4u*)(tile + n0 * 128 + ((((kb)) ^ (n0 & 7)) << 4)) = a; *(LAS v4u*)(tile + n1 * 128 + ((((kb)) ^ (n1 & 7)) << 4)) = b; } while (0)
    CV_LOAD(va, 0); CV_LOAD(vb, 1); CV_LOAD(vc, 2);
    CV_LOAD(vd, 3); CV_PUT(va, 0); CV_LOAD(va, 4); CV_PUT(vb, 1); CV_LOAD(vb, 5); CV_PUT(vc, 2); CV_LOAD(vc, 6); CV_PUT(vd, 3); CV_LOAD(vd, 7);
    CV_PUT(va, 4); CV_PUT(vb, 5); CV_PUT(vc, 6); CV_PUT(vd, 7);
#undef CV_LOAD
#undef CV_PUT
    LDS_WAIT(); asm volatile("" ::: "memory");
    const int c = lane & 7;
#pragma unroll
    for (int j = 0; j < 16; ++j) { const int n = (lane >> 3) + 8 * j; const v4u o = *(const LAS v4u*)(tile + n * 128 + ((c ^ (n & 7)) << 4));
        __builtin_nontemporal_store(o, (v4u*)(WT + (dstrow0 + n) * K + k0 + 16 * c)); }
    LDS_WAIT(); asm volatile("" ::: "memory");
}
constexpr int CV_GU1 = 16 * 32, CV_GU = 32 * CV_GU1, CV_D1 = 16 * 16, CV_DN = 32 * CV_D1, CV_PA = 8 * 16, CV_PB = 8 * 16, CV_WO = 16 * 16, CV_ITEMS = CV_PA + CV_PB + CV_WO + CV_GU + CV_DN;
__device__ __forceinline__ void cv_item(const Args& a, int it, LAS unsigned char* tile, int lane) {
    if (it < CV_PA) { const int kt = it >> 4, nt = it & 15; tr128_f8(a.in[I_WPA], 2048, 128 * nt, (unsigned char*)(a.ws + WS_WA), (size_t)128 * nt, 2048, 128 * kt, tile, lane); return; } it -= CV_PA;
    if (it < CV_PB) { const int kt = it >> 4, nt = it & 15; tr128_f8(a.in[I_WPB], 2048, 128 * nt, (unsigned char*)(a.ws + WS_WA + 1024), (size_t)128 * nt, 2048, 128 * kt, tile, lane); return; } it -= CV_PB;
    if (it < CV_WO) { const int kt = it >> 4, nt = it & 15; tr128_f8(a.in[I_WOUT], 2048, 128 * nt, (unsigned char*)(a.ws + WS_WO), (size_t)128 * nt, 2048, 128 * kt, tile, lane); return; } it -= CV_WO;
    if (it < CV_GU) { const int e = it / CV_GU1, q = it % CV_GU1, kt = q >> 5, nt = q & 31, d0 = 128 * nt, ct = d0 >> 8; const int src = (d0 & 128) ? (2048 + 128 * ct) : (128 * ct);
        tr128_f8(a.in[I_WGU] + (size_t)e * 2048 * 4096, 4096, src, (unsigned char*)(a.ws + WS_WGU), (size_t)e * 4096 + d0, 2048, 128 * kt, tile, lane); }
    else { const int r = it - CV_GU, e = r / CV_D1, q = r % CV_D1, kt = q >> 4, nt = q & 15;
        tr128_f8(a.in[I_WD] + (size_t)e * 2048 * 2048, 2048, 128 * nt, (unsigned char*)(a.ws + WS_WD), (size_t)e * 2048 + 128 * nt, 2048, 128 * kt, tile, lane); }
}
__device__ __forceinline__ void ph0_transposes(const Args& a, LAS unsigned char* lds, int wave, int lane, int G, int bid) {
    LAS float* scr = (LAS float*)(lds + wave * 16384);
    const int gw = wave * G + bid, NGW = G * NWAVES;
    constexpr int I_IN = 32 * 80, I_GL = 16 * 32, I_IN8 = 16 * 42;
    constexpr int NITEMS = I_IN + I_GL + I_IN8;
    for (int it = gw; it < NITEMS; it += NGW) {
        int r = it;
        if (r < I_IN) { const int kb = r / 80, nb = r % 80, d0 = 32 * nb; int src, nv = 32;
            if (d0 < 1280) src = d0; else if (d0 < 2304) src = 1536 + (d0 - 1280); else if (d0 < 2368) src = 2560 + (d0 - 2304); else if (d0 == 2368) { src = 2624; nv = 16; } else { src = 0; nv = 0; }
            tr_item(a.in[I_WIN], INW, DM, src, nv, (bf16*)(a.ws + WS_WIN), (size_t)d0, 64 * kb, scr, lane); continue; } r -= I_IN;
        if (r < I_GL) { const int kb = r / 32, nb = r % 32; tr_item(a.in[I_WGLU], 1024, 1024, 32 * nb, 32, (bf16*)(a.ws + WS_WGLU), (size_t)32 * nb, 64 * kb, scr, lane); continue; } r -= I_GL;
        { const int kt = r / 42, nt = r % 42; const int src = nt < 2 ? 1280 + 128 * nt : (nt < 10 ? 2640 + 128 * (nt - 2) : 3664 + 128 * (nt - 10));
          tr128_f8(a.in[I_WIN], INW, src, (unsigned char*)(a.ws + WS_WIN8), (size_t)128 * nt, 2048, 128 * kt, lds + wave * 16384, lane); }
    }
}
__device__ __forceinline__ void cv_queue(const Args& a, LAS unsigned char* lds, int wave, int lane) {
    unsigned* ctr = (unsigned*)(a.ws + WS_CTL) + CW_CVQ;
    for (;;) { int it = 0; if (lane == 0) it = (int)__hip_atomic_fetch_add(ctr, 1u, RLX_AGENT); it = __builtin_amdgcn_readfirstlane(it); if (it >= CV_ITEMS) break; cv_item(a, it, lds + wave * 16384, lane); }
}
__device__ __forceinline__ void cexp_d(double zr, double zi, double& er, double& ei) {
    const double s = 1.0 / 1024.0; zr *= s; zi *= s;
    double wr = 1.0, wi = 0.0;
#pragma unroll
    for (int k = 10; k >= 1; --k) { const double tr = (zr * wr - zi * wi) / (double)k, ti = (zr * wi + zi * wr) / (double)k; wr = 1.0 + tr; wi = ti; }
#pragma unroll
    for (int q = 0; q < 10; ++q) { const double tr = wr * wr - wi * wi, ti = 2.0 * wr * wi; wr = tr; wi = ti; }
    er = wr; ei = wi;
}
__device__ __forceinline__ void ph0_ssm_consts(const Args& a, int tid, int G, int bid) {
    float* BBAR = (float*)(a.ws + WS_BBAR); float* POW = (float*)(a.ws + WS_POW);
    for (int idx = bid * NTHR + tid; idx < SSMG * SSMN; idx += G * NTHR) {
        const int g = idx >> 6, n = idx & 63;
        double st, dummy; cexp_d((double)a.in[I_LDT][g], 0.0, st, dummy);
        const double are = (double)a.in[I_ARE][idx], aim = (double)a.in[I_AIM][idx];
        double er, ei; cexp_d(st * are, st * aim, er, ei);
        const double den = are * are + aim * aim, nr = er - 1.0, ni = ei;
        const double cr = (nr * are + ni * aim) / den, ci = (ni * are - nr * aim) / den;
#pragma unroll 4
        for (int p = 0; p < 16; ++p) { const double br = (double)a.in[I_BRE][(size_t)idx * 16 + p], bi = (double)a.in[I_BIM][(size_t)idx * 16 + p];
            BBAR[((size_t)idx * 16 + p) * 2 + 0] = (float)(cr * br - ci * bi); BBAR[((size_t)idx * 16 + p) * 2 + 1] = (float)(cr * bi + ci * br); }
        double pr = 1.0, pi = 0.0;
        for (int t = 0; t <= 64; ++t) { POW[(((size_t)g * 65 + t) * 64 + n) * 2 + 0] = (float)pr; POW[(((size_t)g * 65 + t) * 64 + n) * 2 + 1] = (float)pi;
            const double tr = pr * er - pi * ei, ti = pr * ei + pi * er; pr = tr; pi = ti; }
    }
}

__device__ __forceinline__ void ph1_norm(const Args& a, int wave, int lane, int G, int bid) {
    const float* MOD = (const float*)(a.ws + WS_MOD);
    const int gw = bid * NWAVES + wave, NGW = G * NWAVES;
    {
        const float* X = a.in[I_X]; const float* g1 = a.in[I_N1G]; bf16* HN = (bf16*)(a.ws + WS_HN); unsigned char* HN8 = (unsigned char*)(a.ws + WS_HN8);
        const int RPW = (T + NGW - 1) / NGW, r0 = gw * RPW, r1 = min(T, r0 + RPW);
        f32x4 vn[8], pa[8], pb[8]; int curb = -1;
        if (r0 < r1) { const f32x4* xr = (const f32x4*)(X + (size_t)r0 * DM) + 2 * lane;
#pragma unroll
            for (int j = 0; j < 4; ++j) { vn[2 * j] = xr[128 * j]; vn[2 * j + 1] = xr[128 * j + 1]; } }
        for (int row = r0; row < r1; ++row) {
            const int b = row >> 11;
            f32x4 v[8]; float s = 0.f;
#pragma unroll
            for (int j = 0; j < 8; ++j) { v[j] = vn[j]; s += (v[j][0] * v[j][0] + v[j][1] * v[j][1]) + (v[j][2] * v[j][2] + v[j][3] * v[j][3]); }
            if (row + 1 < r1) { const f32x4* xr = (const f32x4*)(X + (size_t)(row + 1) * DM) + 2 * lane;
#pragma unroll
                for (int j = 0; j < 4; ++j) { vn[2 * j] = xr[128 * j]; vn[2 * j + 1] = xr[128 * j + 1]; } }
            if (b != curb) { curb = b; const f32x4* gp = (const f32x4*)g1 + 2 * lane; const f32x4* shp = (const f32x4*)(MOD + (size_t)b * MODW) + 2 * lane; const f32x4* scp = (const f32x4*)(MOD + (size_t)b * MODW + DM) + 2 * lane;
#pragma unroll
                for (int j = 0; j < 4; ++j) { pa[2 * j] = gp[128 * j] * (scp[128 * j] + 1.0f); pa[2 * j + 1] = gp[128 * j + 1] * (scp[128 * j + 1] + 1.0f); pb[2 * j] = shp[128 * j]; pb[2 * j + 1] = shp[128 * j + 1]; } }
            const float rstd = 1.0f / sqrtf(wave_sum(s) * (1.0f / DM) + RMS_EPS);
            v4u* o16 = (v4u*)(HN + (size_t)row * DM) + lane; v2u* o8 = (v2u*)(HN8 + (size_t)row * DM) + lane; v4u w[4]; v2u w8[4];
#pragma unroll
            for (int j = 0; j < 4; ++j) { const f32x4 y0 = (v[2 * j] * rstd) * pa[2 * j] + pb[2 * j], y1 = (v[2 * j + 1] * rstd) * pa[2 * j + 1] + pb[2 * j + 1];
                w[j].x = pk2(y0[0], y0[1]); w[j].y = pk2(y0[2], y0[3]); w[j].z = pk2(y1[0], y1[1]); w[j].w = pk2(y1[2], y1[3]);
                w8[j].x = pk4_fp8(y0[0] * F8_ASCALE, y0[1] * F8_ASCALE, y0[2] * F8_ASCALE, y0[3] * F8_ASCALE); w8[j].y = pk4_fp8(y1[0] * F8_ASCALE, y1[1] * F8_ASCALE, y1[2] * F8_ASCALE, y1[3] * F8_ASCALE); }
#pragma unroll
            for (int j = 0; j < 4; ++j) { o16[64 * j] = w[j]; o8[64 * j] = w8[j]; }
        }
    }
}
__device__ __forceinline__ void ph1_small(const Args& a, int tid, int wave, int lane, int G, int bid) {
    const float* MOD = (const float*)(a.ws + WS_MOD);
    const int gw = bid * NWAVES + wave, NGW = G * NWAVES;
    {
        const float* g2 = a.in[I_N2G]; const float* wr = a.in[I_WR]; const float* br = a.in[I_BR]; float* WRP = (float*)(a.ws + WS_WRP); float* BRP = (float*)(a.ws + WS_BRP);
        for (int base = bid * NTHR + tid; base < NB * DM * NEXP; base += 4 * G * NTHR) { float v[4];
#pragma unroll
            for (int u = 0; u < 4; ++u) { const int idx = base + u * G * NTHR, ic = idx < NB * DM * NEXP ? idx : 0, b = ic >> 16, k = (ic >> 5) & 2047; v[u] = g2[k] * (1.0f + MOD[(size_t)b * MODW + 4 * DM + k]) * wr[ic & 65535]; }
#pragma unroll
            for (int u = 0; u < 4; ++u) { const int idx = base + u * G * NTHR; if (idx < NB * DM * NEXP) WRP[idx] = v[u]; } }
        for (int o = (wave == 2 ? bid : NB * NEXP); o < NB * NEXP; o += G) { const int b = o >> 5, e = o & 31; float s = 0.f;
#pragma unroll 8
            for (int k = lane; k < DM; k += 64) s += MOD[(size_t)b * MODW + 3 * DM + k] * wr[k * 32 + e];
            s = wave_sum(s); if (lane == 0) BRP[o] = s + br[e]; }
    }
    {
        const float* cre = a.in[I_CRE]; const float* cim = a.in[I_CIM]; const float* BBAR = (const float*)(a.ws + WS_BBAR); const float* POW = (const float*)(a.ws + WS_POW); float* KT = (float*)(a.ws + WS_KT);
        for (int idx = (tid < 128 ? bid * 128 + tid : SSMG * SL * 16); idx < SSMG * SL * 16; idx += G * 128) {
            const int g = idx >> 9, tau = (idx >> 4) & 31, p = idx & 15; float s[16];
#pragma unroll
            for (int q = 0; q < 16; ++q) s[q] = 0.f;
#pragma unroll 8
            for (int n = 0; n < 64; ++n) { const float cr = cre[((size_t)g * 16 + p) * 64 + n], ci = cim[((size_t)g * 16 + p) * 64 + n];
                const float pr = POW[(((size_t)g * 65 + tau) * 64 + n) * 2], pi = POW[(((size_t)g * 65 + tau) * 64 + n) * 2 + 1];
                const float er = cr * pr - ci * pi, ei = cr * pi + ci * pr;
                const f32x4* bp = (const f32x4*)(BBAR + ((size_t)g * 64 + n) * 32);
#pragma unroll
                for (int q = 0; q < 8; ++q) { const f32x4 bb = bp[q]; s[2 * q] += er * bb[0] - ei * bb[1]; s[2 * q + 1] += er * bb[2] - ei * bb[3]; } }
            { const float dv = (tau == 0) ? a.in[I_SD][g * 16 + p] : 0.0f;
#pragma unroll
              for (int q = 0; q < 16; ++q) s[q] += (q == p) ? dv : 0.0f; }
            float* kp = KT + (((size_t)g * 64 + tau) * 16 + p) * 16;
#pragma unroll
            for (int q = 0; q < 4; ++q) *(f32x4*)(kp + 4 * q) = (f32x4){s[4 * q], s[4 * q + 1], s[4 * q + 2], s[4 * q + 3]}; }
    }
}

__device__ __forceinline__ void qknorm_body(const Args& a, int wave, int lane, int G, int bid) {
    const int gw = bid * NWAVES + wave, NGW = G * NWAVES;
    {   bf16* Q = (bf16*)(a.ws + WS_Q); bf16* K = (bf16*)(a.ws + WS_K); const float* qg = a.in[I_QG]; const float* kg = a.in[I_KG];
        const float qs = 0.08838834764831845f * 1.4426950408889634f;
        const int l32 = lane & 31; float qgv[16], kgv[8];
#pragma unroll
        for (int e = 0; e < 16; ++e) qgv[e] = qg[((16 * lane) & 127) + e];
#pragma unroll
        for (int e = 0; e < 8; ++e) kgv[e] = kg[((8 * l32) & 127) + e];
        for (int row0 = gw; row0 < T; row0 += 4 * NGW) {
            v4u qa[4], qb[4], ka[4];
#pragma unroll
            for (int u = 0; u < 4; ++u) { const int row = min(row0 + u * NGW, T - 1); const v4u* qp = (const v4u*)(Q + (size_t)row * 1024 + 16 * lane); qa[u] = qp[0]; qb[u] = qp[1]; ka[u] = *(const v4u*)(K + (size_t)row * 256 + 8 * l32); }
#pragma unroll
            for (int u = 0; u < 4; ++u) { const int row = row0 + u * NGW; if (row < T) {
                {   v4u* qp = (v4u*)(Q + (size_t)row * 1024 + 16 * lane); const v4u w0 = qa[u], w1 = qb[u]; float f[16];
                    f[0] = bflo(w0.x); f[1] = bfhi(w0.x); f[2] = bflo(w0.y); f[3] = bfhi(w0.y); f[4] = bflo(w0.z); f[5] = bfhi(w0.z); f[6] = bflo(w0.w); f[7] = bfhi(w0.w);
                    f[8] = bflo(w1.x); f[9] = bfhi(w1.x); f[10] = bflo(w1.y); f[11] = bfhi(w1.y); f[12] = bflo(w1.z); f[13] = bfhi(w1.z); f[14] = bflo(w1.w); f[15] = bfhi(w1.w);
                    float s = 0.f;
#pragma unroll
                    for (int e = 0; e < 16; ++e) s += f[e] * f[e];
                    s += __shfl_xor(s, 1); s += __shfl_xor(s, 2); s += __shfl_xor(s, 4);
                    const float rs = qs / sqrtf(s * (1.0f / 128.0f) + RMS_EPS);
#pragma unroll
                    for (int e = 0; e < 16; ++e) f[e] = f[e] * rs * qgv[e];
                    v4u o0, o1; o0.x = pk2(f[0], f[1]); o0.y = pk2(f[2], f[3]); o0.z = pk2(f[4], f[5]); o0.w = pk2(f[6], f[7]); o1.x = pk2(f[8], f[9]); o1.y = pk2(f[10], f[11]); o1.z = pk2(f[12], f[13]); o1.w = pk2(f[14], f[15]);
                    qp[0] = o0; qp[1] = o1; }
                {   v4u* kp = (v4u*)(K + (size_t)row * 256 + 8 * l32); const v4u w0 = ka[u]; float f[8];
                    f[0] = bflo(w0.x); f[1] = bfhi(w0.x); f[2] = bflo(w0.y); f[3] = bfhi(w0.y); f[4] = bflo(w0.z); f[5] = bfhi(w0.z); f[6] = bflo(w0.w); f[7] = bfhi(w0.w);
                    float s = 0.f;
#pragma unroll
                    for (int e = 0; e < 8; ++e) s += f[e] * f[e];
                    s += __shfl_xor(s, 1); s += __shfl_xor(s, 2); s += __shfl_xor(s, 4); s += __shfl_xor(s, 8);
                    const float rs = 1.0f / sqrtf(s * (1.0f / 128.0f) + RMS_EPS);
#pragma unroll
                    for (int e = 0; e < 8; ++e) f[e] = f[e] * rs * kgv[e];
                    v4u o0; o0.x = pk2(f[0], f[1]); o0.y = pk2(f[2], f[3]); o0.z = pk2(f[4], f[5]); o0.w = pk2(f[6], f[7]);
                    if (lane < 32) kp[0] = o0; } } }
        }
    }
}
__device__ __forceinline__ void bty_body(const Args& a, int tid, int G, int bid) {
    const float* KT = (const float*)(a.ws + WS_KT); const float* POW = (const float*)(a.ws + WS_POW); const float* cre = a.in[I_CRE]; const float* cim = a.in[I_CIM]; bf16* BTY = (bf16*)(a.ws + WS_BTY);
    constexpr int RPG = SL * 16; const int NA = SSMG * RPG * 64, NBC = SSMG * RPG * 16, ST = G * NTHR;
    for (int base = bid * NTHR + tid; base < NA; base += 4 * ST) {
        f32x4 lo[4], hi[4];
#pragma unroll
        for (int u = 0; u < 4; ++u) { const int idx = base + u * ST, ic = idx < NA ? idx : 0, cc = ic & 63, rr = (ic >> 6) & (RPG - 1), g = ic >> 15, j = rr >> 4, p = rr & 15, i = cc >> 1, d = j >= i ? j - i : 0;
            const float* kp = KT + (((size_t)g * 64 + d) * 16 + p) * 16 + (cc & 1) * 8; lo[u] = *(const f32x4*)kp; hi[u] = *(const f32x4*)(kp + 4); }
#pragma unroll
        for (int u = 0; u < 4; ++u) { const int idx = base + u * ST; if (idx < NA) { const int cc = idx & 63, rr = (idx >> 6) & (RPG - 1), g = idx >> 15, j = rr >> 4, i = cc >> 1; const bool ok = j >= i;
            v4u o; o.x = ok ? pk2(lo[u][0], lo[u][1]) : 0u; o.y = ok ? pk2(lo[u][2], lo[u][3]) : 0u; o.z = ok ? pk2(hi[u][0], hi[u][1]) : 0u; o.w = ok ? pk2(hi[u][2], hi[u][3]) : 0u;
            *(v4u*)(BTY + ((size_t)g * RPG + rr) * UA_LD + 8 * cc) = o; } }
    }
    for (int base = bid * NTHR + tid; base < NBC; base += 4 * ST) {
        f32x4 cr[4], ci[4], p0[4], p1[4];
#pragma unroll
        for (int u = 0; u < 4; ++u) { const int idx = base + u * ST, ic = idx < NBC ? idx : 0, cq = ic & 15, rr = (ic >> 4) & (RPG - 1), g = ic >> 13, j = rr >> 4, p = rr & 15;
            cr[u] = *(const f32x4*)(cre + ((size_t)g * 16 + p) * 64 + 4 * cq); ci[u] = *(const f32x4*)(cim + ((size_t)g * 16 + p) * 64 + 4 * cq);
            const float* pw = POW + (((size_t)g * 65 + (j + 1)) * 64 + 4 * cq) * 2; p0[u] = *(const f32x4*)pw; p1[u] = *(const f32x4*)(pw + 4); }
#pragma unroll
        for (int u = 0; u < 4; ++u) { const int idx = base + u * ST; if (idx < NBC) { const int cq = idx & 15, rr = (idx >> 4) & (RPG - 1), g = idx >> 13;
            v4u o; o.x = pk2(cr[u][0] * p0[u][0] - ci[u][0] * p0[u][1], -(cr[u][0] * p0[u][1] + ci[u][0] * p0[u][0])); o.y = pk2(cr[u][1] * p0[u][2] - ci[u][1] * p0[u][3], -(cr[u][1] * p0[u][3] + ci[u][1] * p0[u][2]));
            o.z = pk2(cr[u][2] * p1[u][0] - ci[u][2] * p1[u][1], -(cr[u][2] * p1[u][1] + ci[u][2] * p1[u][0])); o.w = pk2(cr[u][3] * p1[u][2] - ci[u][3] * p1[u][3], -(cr[u][3] * p1[u][3] + ci[u][3] * p1[u][2]));
            *(v4u*)(BTY + ((size_t)g * RPG + rr) * UA_LD + SL * 16 + 8 * cq) = o; } }
    }
}
__device__ __forceinline__ void bts_body(const Args& a, int tid, int G, int bid) {
    const float* BBAR = (const float*)(a.ws + WS_BBAR); const float* POW = (const float*)(a.ws + WS_POW); bf16* BTS = (bf16*)(a.ws + WS_BTS);
    constexpr int CPR = SL * 16 / 8; const int NCH = SSMG * 256 * CPR, ST = G * NTHR;
    for (int base = bid * NTHR + tid; base < NCH; base += 4 * ST) {
        f32x4 bb[4][4]; f32x2 pw[4];
#pragma unroll
        for (int u = 0; u < 4; ++u) { const int idx = base + u * ST, ic = idx < NCH ? idx : 0, cc = ic % CPR, rr = (ic / CPR) & 127, g = ic / (CPR * 256), col0 = 8 * cc, i = col0 >> 4, pp0 = col0 & 15, n = rr >> 1;
            pw[u] = *(const f32x2*)(POW + (((size_t)g * 65 + (SL - 1 - i)) * 64 + n) * 2); const f32x4* bp = (const f32x4*)(BBAR + (((size_t)g * 64 + n) * 16 + pp0) * 2);
#pragma unroll
            for (int q = 0; q < 4; ++q) bb[u][q] = bp[q]; }
#pragma unroll
        for (int u = 0; u < 4; ++u) { const int idx = base + u * ST; if (idx < NCH) { const int cc = idx % CPR, rr = (idx / CPR) & 255, g = idx / (CPR * 256); const bool live = rr < 128, part = rr & 1; const float pr = pw[u][0], pi = pw[u][1]; float f[8];
#pragma unroll
            for (int q = 0; q < 4; ++q) { f[2 * q] = part ? (pr * bb[u][q][1] + pi * bb[u][q][0]) : (pr * bb[u][q][0] - pi * bb[u][q][1]); f[2 * q + 1] = part ? (pr * bb[u][q][3] + pi * bb[u][q][2]) : (pr * bb[u][q][2] - pi * bb[u][q][3]); }
            v4u o; o.x = live ? pk2(f[0], f[1]) : 0u; o.y = live ? pk2(f[2], f[3]) : 0u; o.z = live ? pk2(f[4], f[5]) : 0u; o.w = live ? pk2(f[6], f[7]) : 0u;
            *(v4u*)(BTS + ((size_t)g * 256 + rr) * (SL * 16) + 8 * cc) = o; } }
    }
}

namespace att {
constexpr int D = 128, NW = 8, QBLK = 32, KVBLK = 64, LDK = 256;
constexpr float THR2 = 11.5415603f;
constexpr size_t SHM_V = KVBLK * D * 2, SHM_K = KVBLK * D * 2, SHM_ATTN = 2 * SHM_V + 2 * SHM_K + NW * 64 * 4;
using u32x4 = __attribute__((ext_vector_type(4))) unsigned;
#define KSWZ(row, colB) ((row) * 256 + ((colB) ^ (((row) & 7) << 4)))
#define SBAR() __builtin_amdgcn_sched_barrier(0)
__device__ __forceinline__ unsigned cvtpk(float lo, float hi) { unsigned r; asm volatile("v_cvt_pk_bf16_f32 %0, %1, %2" : "=v"(r) : "v"(lo), "v"(hi)); return r; }

__device__ __forceinline__ void amask(f32x16& p0, f32x16& p1, unsigned mw0, unsigned mw1, float dq, float nslope, int hi) {
  const unsigned s0 = mw0 >> (4 * hi), s1 = mw1 >> (4 * hi);
#pragma unroll
  for (int r = 0; r < 16; ++r) { const int c = (r & 3) + 8 * (r >> 2);
    const float v = fmaf(nslope, fabsf(dq - (float)c), p0[r]); p0[r] = (s0 & (1u << c)) ? v : -INFINITY;
    const float w = fmaf(nslope, fabsf(dq - (float)(c + 32)), p1[r]); p1[r] = (s1 & (1u << c)) ? w : -INFINITY; }
}
__device__ __forceinline__ void partialSM(f32x16& p0, f32x16& p1, float& m_reg, float& mn, float& alpha) {
  float pmax = p0[0];
#pragma unroll
  for (int r = 1; r < 16; ++r) pmax = fmaxf(pmax, p0[r]);
#pragma unroll
  for (int r = 0; r < 16; ++r) pmax = fmaxf(pmax, p1[r]);
  { auto rr = __builtin_amdgcn_permlane32_swap(__float_as_uint(pmax), __float_as_uint(pmax), false, false);
    pmax = fmaxf(__uint_as_float(rr[0]), __uint_as_float(rr[1])); }
  if (__builtin_expect(__all(pmax - m_reg <= THR2), 1)) { mn = m_reg; alpha = 1.f; }
  else { mn = fmaxf(m_reg, pmax); alpha = __builtin_amdgcn_exp2f(m_reg - mn); m_reg = mn; }
#pragma unroll
  for (int r = 0; r < 16; ++r) p0[r] = p0[r] - mn;
#pragma unroll
  for (int r = 0; r < 16; ++r) p1[r] = p1[r] - mn;
#pragma unroll
  for (int r = 0; r < 16; ++r) p0[r] = __builtin_amdgcn_exp2f(p0[r]);
}
__device__ __forceinline__ void finishSM(f32x16& p0, f32x16& p1, float alpha, float& l_reg, bf16x8& pa0, bf16x8& pa1, bf16x8& pa2, bf16x8& pa3) {
#pragma unroll
  for (int r = 0; r < 16; ++r) p1[r] = __builtin_amdgcn_exp2f(p1[r]);
  float ps = 0;
#pragma unroll
  for (int r = 0; r < 16; ++r) ps += p0[r];
#pragma unroll
  for (int r = 0; r < 16; ++r) ps += p1[r];
  { auto rr = __builtin_amdgcn_permlane32_swap(__float_as_uint(ps), __float_as_uint(ps), false, false);
    ps = __uint_as_float(rr[0]) + __uint_as_float(rr[1]); }
  l_reg = l_reg * alpha + ps;
#define PK4(P, BASE, OUT) do { unsigned a0 = cvtpk(P[BASE + 0], P[BASE + 1]), a1 = cvtpk(P[BASE + 2], P[BASE + 3]);   \
    unsigned b0 = cvtpk(P[BASE + 4], P[BASE + 5]), b1 = cvtpk(P[BASE + 6], P[BASE + 7]);                              \
    auto r0 = __builtin_amdgcn_permlane32_swap(a0, b0, false, false); auto r1 = __builtin_amdgcn_permlane32_swap(a1, b1, false, false); \
    u32x4 w = {r0[0], r1[0], r0[1], r1[1]}; OUT = *reinterpret_cast<bf16x8*>(&w); } while (0)
  PK4(p0, 0, pa0); PK4(p0, 8, pa1); PK4(p1, 0, pa2); PK4(p1, 8, pa3);
#undef PK4
}
__device__ __forceinline__ void qkt(f32x16& p0, f32x16& p1, const bf16* Ks, const bf16x8* qr, int r32, int hi) {
  p0 = f32x16{}; p1 = f32x16{};
#pragma unroll
  for (int d0 = 0; d0 < 8; ++d0) { int cb = (d0 * 16 + hi * 8) * 2;
    bf16x8 b0 = *reinterpret_cast<const bf16x8*>((const char*)Ks + KSWZ(r32, cb));
    bf16x8 b1 = *reinterpret_cast<const bf16x8*>((const char*)Ks + KSWZ(32 + r32, cb));
    p0 = __builtin_amdgcn_mfma_f32_32x32x16_bf16(b0, qr[d0], p0, 0, 0, 0);
    p1 = __builtin_amdgcn_mfma_f32_32x32x16_bf16(b1, qr[d0], p1, 0, 0, 0); }
}
__device__ __forceinline__ int v_st(int k, int c) { const int kk = (k & ~0xC) | ((k & 4) << 1) | ((k & 8) >> 1); return ((kk >> 3) * 4 + (c >> 5)) * 512 + ((kk & 7) * 32 + (c & 31)) * 2; }
__device__ __forceinline__ int v_rd_base(int lane) { return ((lane & 3) << 3) | (((lane >> 2) & 3) << 6) | (((lane >> 4) & 1) << 5) | (((lane >> 5) & 1) << 8); }
constexpr int v_rd_off(int d0, int ks, int half) { return d0 * 512 + ks * 4096 + half * 2048; }
template <int OFF> __device__ __forceinline__ s16x4 tr_read(int vb) {
  s16x4 r; asm volatile("ds_read_b64_tr_b16 %0, %1 offset:%2" : "=&v"(r) : "v"(vb), "i"(OFF) : "memory"); return r;
}
template <int D0> __device__ __forceinline__ void pv_one(f32x16& od, int vb, bf16x8 pa0, bf16x8 pa1, bf16x8 pa2, bf16x8 pa3) {
  const s16x4 l0 = tr_read<v_rd_off(D0, 0, 0)>(vb), h0 = tr_read<v_rd_off(D0, 0, 1)>(vb), l1 = tr_read<v_rd_off(D0, 1, 0)>(vb), h1 = tr_read<v_rd_off(D0, 1, 1)>(vb);
  const s16x4 l2 = tr_read<v_rd_off(D0, 2, 0)>(vb), h2 = tr_read<v_rd_off(D0, 2, 1)>(vb), l3 = tr_read<v_rd_off(D0, 3, 0)>(vb), h3 = tr_read<v_rd_off(D0, 3, 1)>(vb);
  asm volatile("s_waitcnt lgkmcnt(0)" ::: "memory"); SBAR();
#define PK(L, H) (bf16x8){L[0], L[1], L[2], L[3], H[0], H[1], H[2], H[3]}
  od = __builtin_amdgcn_mfma_f32_32x32x16_bf16(pa0, PK(l0, h0), od, 0, 0, 0);
  od = __builtin_amdgcn_mfma_f32_32x32x16_bf16(pa1, PK(l1, h1), od, 0, 0, 0);
  od = __builtin_amdgcn_mfma_f32_32x32x16_bf16(pa2, PK(l2, h2), od, 0, 0, 0);
  od = __builtin_amdgcn_mfma_f32_32x32x16_bf16(pa3, PK(l3, h3), od, 0, 0, 0);
#undef PK
}
__device__ __forceinline__ void pv_d0(f32x16* o, int vb, bf16x8 pa0, bf16x8 pa1, bf16x8 pa2, bf16x8 pa3) {
  pv_one<0>(o[0], vb, pa0, pa1, pa2, pa3); pv_one<1>(o[1], vb, pa0, pa1, pa2, pa3); pv_one<2>(o[2], vb, pa0, pa1, pa2, pa3); pv_one<3>(o[3], vb, pa0, pa1, pa2, pa3);
}

__device__ __forceinline__ void attn_unit(const bf16* __restrict__ Qlane, const bf16* __restrict__ Kh, const bf16* __restrict__ Vh, unsigned char* __restrict__ Ow, int ldo,
                                          const unsigned* __restrict__ selbase, unsigned selo, int qpos, float nslope, int NT, int NTreal, char* lds) {
  const int tid = threadIdx.x, wid = tid >> 6, lane = tid & 63, r32 = lane & 31, hi = lane >> 5;
  bf16* V_lds = (bf16*)lds; bf16* K_lds = (bf16*)(lds + 2 * SHM_V);
  float* ws = (float*)(lds + 2 * SHM_V + 2 * SHM_K) + wid * 64; float* li_l = ws; float* al_l = ws + 32;
  float m_reg = -1e30f, l_reg = 0; f32x16 o[4] = {}; bf16x8 qr[8];
#pragma unroll
  for (int d0 = 0; d0 < 8; ++d0) qr[d0] = *reinterpret_cast<const bf16x8*>(Qlane + d0 * 16);
  const int sr = tid >> 4, sc = (tid & 15) * 8, vst0 = v_st(sr, sc), vst1 = v_st(32 + sr, sc);
  const int vb0 = (int)(uintptr_t)V_lds + v_rd_base(lane);
  const int soffb = (sr * LDK + sc) * 2;
  const __amdgpu_buffer_rsrc_t rsK = __builtin_amdgcn_make_buffer_rsrc((void*)Kh, 0, 1 << 20, 0x00020000), rsV = __builtin_amdgcn_make_buffer_rsrc((void*)Vh, 0, 1 << 20, 0x00020000);
  const float dqb = (float)(qpos - 4 * hi);
  struct { bf16x8 vs0, vs1, ks0, ks1; } sr_[2];
#define SLOAD(i, k0) do { const int so_ = (k0) * (LDK * 2); \
    sr_[i].vs0 = __builtin_bit_cast(bf16x8, __builtin_amdgcn_raw_buffer_load_b128(rsV, soffb, so_, 0)); sr_[i].vs1 = __builtin_bit_cast(bf16x8, __builtin_amdgcn_raw_buffer_load_b128(rsV, soffb, so_ + 32 * LDK * 2, 0)); \
    sr_[i].ks0 = __builtin_bit_cast(bf16x8, __builtin_amdgcn_raw_buffer_load_b128(rsK, soffb, so_, 0)); sr_[i].ks1 = __builtin_bit_cast(bf16x8, __builtin_amdgcn_raw_buffer_load_b128(rsK, soffb, so_ + 32 * LDK * 2, 0)); } while (0)
#define SWRITE(b, i) do { *(bf16x8*)((char*)V_lds + (b) * SHM_V + vst0) = sr_[i].vs0;          \
    *(bf16x8*)((char*)V_lds + (b) * SHM_V + vst1) = sr_[i].vs1; int kc = sc * 2;               \
    *(bf16x8*)((char*)K_lds + (b) * SHM_K + KSWZ(sr, kc)) = sr_[i].ks0;                       \
    *(bf16x8*)((char*)K_lds + (b) * SHM_K + KSWZ(32 + sr, kc)) = sr_[i].ks1; } while (0)
#define SWAIT() asm volatile("s_waitcnt vmcnt(4)" ::: "memory")
#define RESC(a) do { if (__any((a) < 1.f)) { if (hi == 0) al_l[r32] = (a); asm volatile("s_waitcnt lgkmcnt(0)" ::: "memory"); \
    _Pragma("unroll") for (int d = 0; d < 4; ++d) _Pragma("unroll") for (int r = 0; r < 16; ++r) o[d][r] *= al_l[crow(r, hi)]; } } while (0)
#define MASKW(j, m0, m1) do { const v2u mm_ = *reinterpret_cast<const v2u*>(selbase + (selo + 2u * (unsigned)(j))); const bool in_ = (j) < NTreal; m0 = in_ ? mm_.x : 0u; m1 = in_ ? mm_.y : 0u; } while (0)
  f32x16 pA0, pA1, pB0, pB1; float mnA, mnB, alA, alB; bf16x8 pa0, pa1, pa2, pa3; unsigned ma0, ma1, mb0, mb1;
  constexpr int SE = 0, SO = 1;
  SLOAD(SE, 0); MASKW(0, ma0, ma1); MASKW(1, mb0, mb1); asm volatile("s_waitcnt vmcnt(0)" ::: "memory"); SWRITE(0, SE); __syncthreads();
  qkt(pA0, pA1, K_lds, qr, r32, hi); amask(pA0, pA1, ma0, ma1, dqb, nslope, hi); partialSM(pA0, pA1, m_reg, mnA, alA);
  SLOAD(SO, KVBLK); if (2 < NT) SLOAD(SE, 2 * KVBLK);
  SWAIT(); SWRITE(1, SO); __syncthreads();
  for (int j = 1; j + 1 < NT; j += 2) {
    SBAR(); qkt(pB0, pB1, (bf16*)((char*)K_lds + SHM_K), qr, r32, hi);
    finishSM(pA0, pA1, alA, l_reg, pa0, pa1, pa2, pa3); SBAR();
    MASKW(j + 1, ma0, ma1); SLOAD(SO, (j + 2) * KVBLK); SBAR();
    pv_d0(o, vb0, pa0, pa1, pa2, pa3); amask(pB0, pB1, mb0, mb1, dqb - (float)(64 * j), nslope, hi); partialSM(pB0, pB1, m_reg, mnB, alB);
    __syncthreads(); SWAIT(); SWRITE(0, SE);
    RESC(alB); __syncthreads();
    SBAR(); qkt(pA0, pA1, K_lds, qr, r32, hi);
    finishSM(pB0, pB1, alB, l_reg, pa0, pa1, pa2, pa3); SBAR();
    MASKW(j + 2, mb0, mb1); if (j + 3 < NT) SLOAD(SE, (j + 3) * KVBLK); SBAR();
    pv_d0(o, vb0 + (int)SHM_V, pa0, pa1, pa2, pa3); amask(pA0, pA1, ma0, ma1, dqb - (float)(64 * (j + 1)), nslope, hi); partialSM(pA0, pA1, m_reg, mnA, alA);
    __syncthreads(); SWAIT(); SWRITE(1, SO);
    RESC(alA); __syncthreads();
  }
  SBAR(); qkt(pB0, pB1, (bf16*)((char*)K_lds + SHM_K), qr, r32, hi);
  finishSM(pA0, pA1, alA, l_reg, pa0, pa1, pa2, pa3); SBAR();
  SBAR();
  pv_d0(o, vb0, pa0, pa1, pa2, pa3); amask(pB0, pB1, mb0, mb1, dqb - (float)(64 * (NT - 1)), nslope, hi); partialSM(pB0, pB1, m_reg, mnB, alB);
  __syncthreads(); RESC(alB);
  finishSM(pB0, pB1, alB, l_reg, pa0, pa1, pa2, pa3); SBAR();
  pv_d0(o, vb0 + (int)SHM_V, pa0, pa1, pa2, pa3);
  if (hi == 0) li_l[r32] = l_reg; asm volatile("s_waitcnt lgkmcnt(0)" ::: "memory");
  float rli[16];
#pragma unroll
  for (int r = 0; r < 16; ++r) rli[r] = __builtin_amdgcn_rcpf(li_l[crow(r, hi)]);
  unsigned ob = (unsigned)(4 * hi * ldo + r32); asm volatile("" : "+v"(ob));
#pragma unroll
  for (int r = 0; r < 16; ++r) { const int orow0 = crow(r, 0);
#pragma unroll
    for (int d0 = 0; d0 < 4; ++d0) Ow[ob + (unsigned)(orow0 * ldo + d0 * 32)] = (unsigned char)(__builtin_amdgcn_cvt_pk_fp8_f32(__builtin_amdgcn_fmed3f(o[d0][r] * rli[r] * F8_MSCALE, -448.f, 448.f), 0.f, 0, false) & 0xff); }
  __syncthreads();
#undef SLOAD
#undef SWRITE
#undef SWAIT
#undef RESC
#undef MASKW
}
#undef KSWZ
#undef SBAR
}

__device__ __forceinline__ void ph4a_unit(const Args& a, LAS unsigned char* lds, int tid, int wave, int lane, int b, int ci, int p0, int np) {
    const bf16* IQ = (const bf16*)(a.ws + WS_IQ); const bf16* IK = (const bf16*)(a.ws + WS_IK); const float* IW = (const float*)(a.ws + WS_IW); float* SC = (float*)(a.ws + WS_SC);
    const int tok0 = b * SEQ + ci * CHUNK;
    __syncthreads();
    for (int i = tid; i < 64 * 128; i += NTHR) { const int q = i >> 7, ch = i & 127, head = ch >> 3, c8 = ch & 7;
        const v4u v = *(const v4u*)(IQ + ((size_t)tok0 + q) * 1024 + ch * 8);
        *(LAS v4u*)(lds + q * 2048 + ((head ^ ((q >> 3) & 1)) * 128) + ((c8 ^ (q & 7)) * 16)) = v; }
    __syncthreads();
    const int qt = wave & 1, q = qt * 32 + (lane & 31), hh = lane >> 5; const size_t tokq = (size_t)tok0 + q;
    float wgt[16];
#pragma unroll
    for (int h4 = 0; h4 < 4; ++h4) { const f32x4 w4 = *(const f32x4*)(IW + tokq * 16 + 4 * h4); wgt[4 * h4] = w4[0]; wgt[4 * h4 + 1] = w4[1]; wgt[4 * h4 + 2] = w4[2]; wgt[4 * h4 + 3] = w4[3]; }
    const LAS unsigned char* qb = lds + q * 2048; const int hx = ((q >> 3) & 1) * 128; int offk[4];
#pragma unroll
    for (int kk = 0; kk < 4; ++kk) offk[kk] = ((2 * kk + hh) ^ (q & 7)) * 16;
    int it = wave >> 1;
    bf16x8 ak[2][4];
    if (it < np) { const bf16* kp = IK + ((size_t)b * SEQ + (p0 + it) * 64 + (lane & 31)) * 64 + hh * 8;
#pragma unroll
        for (int kk = 0; kk < 4; ++kk) { ak[0][kk] = *(const bf16x8*)(kp + kk * 16); ak[1][kk] = *(const bf16x8*)(kp + 32 * 64 + kk * 16); } }
    for (; it < np; it += 4) {
        bf16x8 an[2][4]; const bool more = it + 4 < np;
        { const int itn = more ? it + 4 : it; const bf16* kp = IK + ((size_t)b * SEQ + (p0 + itn) * 64 + (lane & 31)) * 64 + hh * 8;
#pragma unroll
          for (int kk = 0; kk < 4; ++kk) { an[0][kk] = *(const bf16x8*)(kp + kk * 16); an[1][kk] = *(const bf16x8*)(kp + 32 * 64 + kk * 16); } }
        float s0[16], s1[16];
#pragma unroll
        for (int i = 0; i < 16; ++i) { s0[i] = 0.f; s1[i] = 0.f; }
        bf16x8 bfc[4]; f32x16 a0, a1;
#pragma unroll
        for (int kk = 0; kk < 4; ++kk) bfc[kk] = *(const LAS bf16x8*)(qb + hx + offk[kk]);
#pragma unroll
        for (int i = 0; i < 16; ++i) { a0[i] = 0.f; a1[i] = 0.f; }
#pragma unroll
        for (int kk = 0; kk < 4; ++kk) { a0 = __builtin_amdgcn_mfma_f32_32x32x16_bf16(ak[0][kk], bfc[kk], a0, 0, 0, 0); a1 = __builtin_amdgcn_mfma_f32_32x32x16_bf16(ak[1][kk], bfc[kk], a1, 0, 0, 0); }
#pragma unroll
        for (int kk = 0; kk < 4; ++kk) bfc[kk] = *(const LAS bf16x8*)(qb + ((1 * 128) ^ hx) + offk[kk]);
#pragma unroll
        for (int h = 0; h < 16; ++h) { f32x16 b0, b1; bf16x8 bfn[4];
            if (h + 1 < 16) {
#pragma unroll
                for (int i = 0; i < 16; ++i) { b0[i] = 0.f; b1[i] = 0.f; }
#pragma unroll
                for (int kk = 0; kk < 4; ++kk) { b0 = __builtin_amdgcn_mfma_f32_32x32x16_bf16(ak[0][kk], bfc[kk], b0, 0, 0, 0); b1 = __builtin_amdgcn_mfma_f32_32x32x16_bf16(ak[1][kk], bfc[kk], b1, 0, 0, 0); }
                if (h + 2 < 16) { const int hb = ((h + 2) * 128) ^ hx;
#pragma unroll
                    for (int kk = 0; kk < 4; ++kk) bfn[kk] = *(const LAS bf16x8*)(qb + hb + offk[kk]); } }
            __builtin_amdgcn_sched_barrier(0);
            const float wh = wgt[h];
#pragma unroll
            for (int i = 0; i < 16; ++i) { s0[i] = fmaf(wh, fmaxf(a0[i], 0.f), s0[i]); asm volatile("" : "+v"(s0[i])); s1[i] = fmaf(wh, fmaxf(a1[i], 0.f), s1[i]); asm volatile("" : "+v"(s1[i])); }
            if (h + 1 < 16) { a0 = b0; a1 = b1; }
            if (h + 2 < 16) {
#pragma unroll
                for (int kk = 0; kk < 4; ++kk) bfc[kk] = bfn[kk]; }
            __builtin_amdgcn_sched_barrier(0); }
        float* op = SC + tokq * 2048 + (p0 + it) * 64 + 4 * hh;
#pragma unroll
        for (int i4 = 0; i4 < 4; ++i4) { *(f32x4*)(op + 8 * i4) = (f32x4){s0[4 * i4], s0[4 * i4 + 1], s0[4 * i4 + 2], s0[4 * i4 + 3]};
            *(f32x4*)(op + 32 + 8 * i4) = (f32x4){s1[4 * i4], s1[4 * i4 + 1], s1[4 * i4 + 2], s1[4 * i4 + 3]}; }
#pragma unroll
        for (int kk = 0; kk < 4; ++kk) { ak[0][kk] = an[0][kk]; ak[1][kk] = an[1][kk]; }
    }
}
__device__ __forceinline__ void ph4a_decode(int u, int& b, int& ci, int& p0, int& np) {
    if (u < 128) { b = u & 7; ci = 16 + (u >> 3); p0 = 0; np = 16; }
    else { const int v = 16 - ((u - 128) >> 4), w = (u - 128) & 15; b = w & 7; if (w >> 3) { ci = 15 + v; p0 = 16; np = v; } else { ci = v - 1; p0 = 0; np = v; } }
}
__device__ __forceinline__ void ph4a_body(const Args& a, LAS unsigned char* lds, int tid, int wave, int lane, int G, int bid) {
    int b, ci, p0, np;
    if (G == 256) { ph4a_decode(bid, b, ci, p0, np); ph4a_unit(a, lds, tid, wave, lane, b, ci, p0, np);
        if (bid >= 128) { ph4a_decode(511 - bid, b, ci, p0, np); ph4a_unit(a, lds, tid, wave, lane, b, ci, p0, np); } }
    else for (int u = bid; u < 384; u += G) { ph4a_decode(u, b, ci, p0, np); ph4a_unit(a, lds, tid, wave, lane, b, ci, p0, np); }
    __syncthreads();
}
template <int NVM> __device__ __forceinline__ int cnt_ge(const unsigned (&key)[32], unsigned cand) {
    unsigned c0 = 0, c1 = 0, c2 = 0, c3 = 0;
#pragma unroll
    for (int i = 0; i < NVM; i += 4) {
        asm("v_cmp_ge_u32 vcc, %1, %2\n\tv_addc_co_u32 %0, vcc, 0, %0, vcc" : "+v"(c0) : "v"(key[i]), "v"(cand) : "vcc");
        asm("v_cmp_ge_u32 vcc, %1, %2\n\tv_addc_co_u32 %0, vcc, 0, %0, vcc" : "+v"(c1) : "v"(key[i + 1]), "v"(cand) : "vcc");
        asm("v_cmp_ge_u32 vcc, %1, %2\n\tv_addc_co_u32 %0, vcc, 0, %0, vcc" : "+v"(c2) : "v"(key[i + 2]), "v"(cand) : "vcc");
        asm("v_cmp_ge_u32 vcc, %1, %2\n\tv_addc_co_u32 %0, vcc, 0, %0, vcc" : "+v"(c3) : "v"(key[i + 3]), "v"(cand) : "vcc"); }
    const unsigned c = (c0 + c1) + (c2 + c3);
    int tot = 0;
#pragma unroll
    for (int b = 0; b < 6; ++b) tot += __builtin_popcountll(__ballot((c >> b) & 1u)) << b;
    return tot;
}
template <int NVM> __device__ __forceinline__ unsigned sel_thr(const unsigned (&key)[32]) {
    unsigned Tt = 0u;
    for (int bit = 31; bit >= 0; --bit) { const unsigned cand = Tt | (1u << bit); const int cnt = cnt_ge<NVM>(key, cand);
        if (cnt >= TOPK) { Tt = cand; if (cnt == TOPK) break; } }
    return Tt;
}
__device__ __forceinline__ void ph4b_body(const Args& a, int wave, int lane, int G, int bid) {
    const float* SC = (const float*)(a.ws + WS_SC); unsigned long long* SEL = (unsigned long long*)(a.ws + WS_SEL);
    const int gw = bid * NWAVES + wave, NGW = G * NWAVES;
    float raw[32]; unsigned key[32];
#define SEL_ROW(idx, row, nv) const int bb_ = (idx) >> 11; int t_ = (idx) & 2047; if (bb_ & 1) t_ = 2047 - t_; const size_t row = (size_t)bb_ * SEQ + t_; const int nv = (t_ >> 6) + 1;
    int idx = gw;
    if (idx < T) { SEL_ROW(idx, row, nv) const float* sp = SC + row * 2048 + lane;
#pragma unroll
        for (int i = 0; i < 32; ++i) raw[i] = sp[64 * (i < nv ? i : nv - 1)]; }
    for (; idx < T; idx += NGW) {
        SEL_ROW(idx, row, nv)
#pragma unroll
        for (int i = 0; i < 32; ++i) { const unsigned uu = __float_as_uint(raw[i]); const unsigned kk = (uu & 0x80000000u) ? ~uu : (uu | 0x80000000u); key[i] = (i < nv) ? kk : 0u; }
        if (idx + NGW < T) { SEL_ROW(idx + NGW, rown, nvn) const float* sp = SC + rown * 2048 + lane;
#pragma unroll
            for (int i = 0; i < 32; ++i) raw[i] = sp[64 * (i < nvn ? i : nvn - 1)]; }
        unsigned Tt = 0u;
        if (nv > 4) { if (nv <= 8) Tt = sel_thr<8>(key); else if (nv <= 16) Tt = sel_thr<16>(key); else if (nv <= 24) Tt = sel_thr<24>(key); else Tt = sel_thr<32>(key); }
        unsigned long long myw = 0ull;
#pragma unroll
        for (int i = 0; i < 32; ++i) { const unsigned long long bm = __ballot(key[i] >= Tt); if (lane == i) myw = bm; }
        if (lane < nv) SEL[row * 32 + lane] = myw;
    }
#undef SEL_ROW
}

__device__ __forceinline__ void ph5_body(const Args& a, char* ldsg, int wave, int lane, int G, int bid) {
    const bf16* Q = (const bf16*)(a.ws + WS_Q); const bf16* K = (const bf16*)(a.ws + WS_K); const bf16* V = (const bf16*)(a.ws + WS_V);
    const unsigned* SELW = (const unsigned*)(a.ws + WS_SEL); unsigned char* YA = (unsigned char*)(a.ws + WS_YA);
    for (int L = bid; L < NB * NCHUNK * NKVH; L += G) {
        const int Lr = L & 255, ci = (L < 256) ? 31 - (Lr >> 4) : (Lr >> 4), b = (Lr >> 1) & 7, g = Lr & 1;
        const int head = g * 4 + (wave >> 1), qpos = ci * 64 + (wave & 1) * 32 + (lane & 31); const size_t tokq = (size_t)b * SEQ + qpos;
        const int NTreal = ci + 1, NT = NTreal + (NTreal & 1);
        const float nslope = -1.4426950408889634f * exp2f(-(float)(head + 1));
        att::attn_unit(Q + tokq * 1024 + head * 128 + (lane >> 5) * 8, K + (size_t)b * SEQ * 256 + g * 128, V + (size_t)b * SEQ * 256 + g * 128,
                       YA + ((size_t)b * SEQ + ci * 64 + (wave & 1) * 32) * 2048 + head * 128, 2048, SELW + ((size_t)b * SEQ + ci * 64) * 64, (unsigned)(((wave & 1) * 32 + (lane & 31)) * 64), qpos, nslope, NT, NTreal, ldsg);
    }
}

__device__ __forceinline__ void ph7_body(const Args& a, int tid, int G, int bid) {
    const float* POW = (const float*)(a.ws + WS_POW); const float* SBUF = (const float*)(a.ws + WS_SBUF); bf16* UA = (bf16*)(a.ws + WS_UA);
    for (int idx = (tid < 128 ? bid * 128 + tid : SSMG * NB * SSMN); idx < SSMG * NB * SSMN; idx += G * 128) {
        const int n = idx & 63, b = (idx >> 6) & 7, g = idx >> 9;
        const float ar = POW[(((size_t)g * 65 + SL) * 64 + n) * 2], ai = POW[(((size_t)g * 65 + SL) * 64 + n) * 2 + 1];
        float hr = 0.f, hi = 0.f;
#pragma unroll 1
        for (int c0 = 0; c0 < NSC; c0 += 64) {
            f32x2 sv[64];
#pragma unroll
            for (int c = 0; c < 64; ++c) sv[c] = *(const f32x2*)(SBUF + ((size_t)g * SROWS + b * NSC + c0 + c) * 128 + 2 * n);
#pragma unroll
            for (int c = 0; c < 64; ++c) { const size_t row = (size_t)g * SROWS + b * NSC + c0 + c;
                *(unsigned*)(UA + row * UA_LD + SL * 16 + 2 * n) = pk2(hr, hi);
                const float nr = ar * hr - ai * hi + sv[c][0], ni = ar * hi + ai * hr + sv[c][1]; hr = nr; hi = ni; }
        }
    }
}

__device__ __forceinline__ void ph12_body(const Args& a, LAS unsigned char* lds, int tid, int wave, int lane, int G, int bid, size_t alt) {
    const bf16* X1 = (const bf16*)(a.ws + WS_X1); const float* WRP = (const float*)(a.ws + WS_WRP); const float* BRP = (const float*)(a.ws + WS_BRP); float* RSTD = (float*)(a.ws + (alt ? WS_SC : WS_RSTD));
    unsigned* CNT = (unsigned*)(a.ws + WS_CTL) + CW_CNT + (alt ? 64 : 0); int* ASGE = (int*)(a.ws + (alt ? WS_SC + MiB : WS_ASGE)); int* ASGP = (int*)(a.ws + (alt ? WS_SC + 2 * MiB : WS_ASGP));
    int* LIST = (int*)(a.ws + (alt ? WS_SC + 4 * MiB : WS_LIST)); float* GLIST = (float*)(a.ws + (alt ? WS_SC + 8 * MiB : WS_GLIST)); unsigned char* XS = (unsigned char*)(a.ws + (alt ? WS_SC + 16 * MiB : WS_XS));
    const float* MOD = (const float*)(a.ws + WS_MOD); const float* g2 = a.in[I_N2G];
    LAS float* xs = (LAS float*)lds;
    LAS float* part = (LAS float*)(lds + 65792); LAS float* logit = (LAS float*)(lds + 65792 + 32768);
    LAS float* rstdL = (LAS float*)(lds + 65792 + 32768 + 4352); LAS unsigned* lcnt = (LAS unsigned*)(rstdL + 32); LAS unsigned* base = lcnt + 32;
    for (int tile = bid; tile < T / 32; tile += G) {
        const int t0 = tile * 32, b = t0 >> 11; const int lrow = tid >> 4, cg = tid & 15;
        f32x16 acc;
#pragma unroll
        for (int i = 0; i < 16; ++i) acc[i] = 0.f;
        float ss = 0.f;
        if (tid < 32) lcnt[tid] = 0u;
        for (int ch = 0; ch < 4; ++ch) {
            f32x4 v[8]; const v2u* xr = (const v2u*)(X1 + (size_t)(t0 + lrow) * DM + ch * 512) + cg;
#pragma unroll
            for (int j = 0; j < 8; ++j) { const v2u w = xr[16 * j]; v[j] = (f32x4){bflo(w.x), bfhi(w.x), bflo(w.y), bfhi(w.y)}; ss += (v[j][0] * v[j][0] + v[j][1] * v[j][1]) + (v[j][2] * v[j][2] + v[j][3] * v[j][3]); }
            float wv[32]; const float* wp = WRP + (size_t)b * (DM * NEXP) + (size_t)(ch * 512 + 64 * wave + (lane >> 5)) * NEXP + (lane & 31);
#pragma unroll
            for (int q = 0; q < 32; ++q) wv[q] = wp[2 * q * NEXP];
            __syncthreads();
#pragma unroll
            for (int j = 0; j < 8; ++j)
#pragma unroll
                for (int e = 0; e < 4; ++e) xs[lrow * 513 + cg * 4 + 64 * j + e] = v[j][e];
            __syncthreads();
            const LAS float* xq = xs + (lane & 31) * 513 + 64 * wave + (lane >> 5);
#pragma unroll
            for (int q = 0; q < 32; ++q) acc = __builtin_amdgcn_mfma_f32_32x32x2f32(xq[2 * q], wv[q], acc, 0, 0, 0);
        }
        ss += __shfl_xor(ss, 1); ss += __shfl_xor(ss, 2); ss += __shfl_xor(ss, 4); ss += __shfl_xor(ss, 8);
        if (cg == 0) { const float rstd = 1.0f / sqrtf(ss * (1.0f / DM) + RMS_EPS); rstdL[lrow] = rstd; RSTD[t0 + lrow] = rstd; }
#pragma unroll
        for (int i = 0; i < 16; ++i) part[(wave * 16 + i) * 64 + lane] = acc[i];
        __syncthreads();
#pragma unroll
        for (int z = 0; z < 2; ++z) { const int o = tid + 512 * z, tk = o >> 5, e = o & 31, hh = (tk >> 2) & 1, i = (tk & 3) + 4 * (tk >> 3), ln = e + 32 * hh; float s = 0.f;
#pragma unroll
            for (int w = 0; w < 8; ++w) s += part[(w * 16 + i) * 64 + ln];
            logit[tk * 33 + e] = rstdL[tk] * s + BRP[b * 32 + e]; }
        __syncthreads();
        LAS float* selv = (LAS float*)(base + 32);
        int rk[4]; float mv[4], gt[4]; unsigned rr[4];
        const int ex = lane & 31;
#pragma unroll
        for (int j = 0; j < 4; ++j) { const int tk = wave * 4 + j; const float v = logit[tk * 33 + ex]; int r = 0;
#pragma unroll
            for (int e2 = 0; e2 < 32; ++e2) { const float u = logit[tk * 33 + e2]; r += ((u > v) || (u == v && e2 < ex)) ? 1 : 0; }
            rk[j] = r; mv[j] = v; if (lane < 32 && r < 4) selv[tk * 4 + r] = v; }
        LDS_WAIT(); asm volatile("" ::: "memory");
#pragma unroll
        for (int j = 0; j < 4; ++j) { const int tk = wave * 4 + j; gt[j] = 0.f; rr[j] = 0u;
            if (lane < 32 && rk[j] < 4) { const float v0 = selv[tk * 4], v1 = selv[tk * 4 + 1], v2 = selv[tk * 4 + 2], v3 = selv[tk * 4 + 3];
                const float den = 1.0f + expf(v1 - v0) + expf(v2 - v0) + expf(v3 - v0); gt[j] = expf(mv[j] - v0) / den;
                rr[j] = __hip_atomic_fetch_add(lcnt + ex, 1u, __ATOMIC_RELAXED, __HIP_MEMORY_SCOPE_WORKGROUP); } }
        __syncthreads();
        if (tid < 32) base[tid] = __hip_atomic_fetch_add(CNT + tid, lcnt[tid], RLX_AGENT);
        __syncthreads();
#pragma unroll
        for (int j = 0; j < 4; ++j) if (lane < 32 && rk[j] < 4) { const int tk = t0 + wave * 4 + j, as = tk * 4 + rk[j], pos = (int)(base[ex] + rr[j]); ASGE[as] = ex; ASGP[as] = pos;
            if (pos < T) { LIST[ex * T + pos] = tk; GLIST[ex * T + pos] = gt[j]; } }
        { const f32x4* gp = (const f32x4*)g2 + 2 * lane; const f32x4* shp = (const f32x4*)(MOD + (size_t)b * MODW + 3 * DM) + 2 * lane; const f32x4* scp = (const f32x4*)(MOD + (size_t)b * MODW + 4 * DM) + 2 * lane;
          v4u xw[4][4]; f32x4 pa[8], pb[8];
#pragma unroll
          for (int j = 0; j < 4; ++j) { const v4u* xr = (const v4u*)(X1 + (size_t)(t0 + wave * 4 + j) * DM) + lane;
#pragma unroll
              for (int q = 0; q < 4; ++q) xw[j][q] = xr[64 * q]; }
#pragma unroll
          for (int q = 0; q < 4; ++q)
#pragma unroll
              for (int h = 0; h < 2; ++h) { pa[2 * q + h] = gp[128 * q + h] * (scp[128 * q + h] + 1.0f) * F8_ASCALE; pb[2 * q + h] = shp[128 * q + h] * F8_ASCALE; }
#pragma unroll
          for (int j = 0; j < 4; ++j) { const int tk = wave * 4 + j; const float rstd = rstdL[tk]; v2u o[4];
#pragma unroll
              for (int q = 0; q < 4; ++q) { const v4u w = xw[j][q]; const f32x4 x0 = {bflo(w.x), bfhi(w.x), bflo(w.y), bfhi(w.y)}, x1 = {bflo(w.z), bfhi(w.z), bflo(w.w), bfhi(w.w)};
                  const f32x4 y0 = (x0 * rstd) * pa[2 * q] + pb[2 * q], y1 = (x1 * rstd) * pa[2 * q + 1] + pb[2 * q + 1];
                  o[q].x = pk4_fp8(y0[0], y0[1], y0[2], y0[3]); o[q].y = pk4_fp8(y1[0], y1[1], y1[2], y1[3]); }
              v2u* dst = (v2u*)(XS + (size_t)(t0 + tk) * DM) + lane;
#pragma unroll
              for (int q = 0; q < 4; ++q) dst[64 * q] = o[q]; } }
        __syncthreads();
    }
}

constexpr int LDS_MOE = RING_BYTES + 1024;
__device__ __forceinline__ void moe_tables(const Args& a, LAS unsigned char* lds, int tid) {
    LAS int* off = (LAS int*)(lds + LDS_MOE); LAS int* cnt = off + 32; LAS int* nrbp = off + 64; LAS int* rbe = off + 96;
    if (tid < 32) {
        unsigned* CNT = (unsigned*)(a.ws + WS_CTL) + CW_CNT; const int c = (int)__hip_atomic_load(CNT + tid, RLX_AGENT), nb = (c + 255) >> 8; int inc = nb;
#pragma unroll
        for (int d = 1; d < 32; d <<= 1) { const int t = __shfl_up(inc, d); if (tid >= d) inc += t; }
        const int ex = inc - nb; cnt[tid] = c; off[tid] = ex * 256;
        for (int q = 0; q < nb; ++q) if (ex + q < 320) rbe[ex + q] = tid;
        if (tid == 31) nrbp[0] = inc < 288 ? inc : 288; }
    __syncthreads();
}
constexpr int LDS_ROWS = RING_BYTES + 3072, ROWS_CAP = (LDS_BYTES - LDS_ROWS) / 512;
template <class Sched> __device__ __forceinline__ void moe_rows(const Args& a, LAS unsigned char* lds, int tid, const Sched& S) {
    const LAS int* off = (const LAS int*)(lds + LDS_MOE); const LAS int* cnt = off + 32; const int* LIST = (const int*)(a.ws + WS_LIST);
    LAS unsigned short* rows = (LAS unsigned short*)(lds + LDS_ROWS); LAS int* uinf = (LAS int*)(lds + LDS_MOE + 1664);
    pg8::Unit u; int n = 0;
    for (; n < ROWS_CAP && S.next(n, u); ++n) { const int e = (u.pn >> 4) & 31; if (tid == 0) uinf[n] = (e << 16) | (((u.pm - (off[e] >> 8)) * 256) & 0xffff); }
    __syncthreads();
    for (int base = tid; base < n * 256; base += 4 * NTHR) {
        int tok[4];
#pragma unroll
        for (int q = 0; q < 4; ++q) { const int k = base + q * NTHR, kc = k < n * 256 ? k : 0, ui = uinf[kc >> 8], e = ui >> 16, idx = (ui & 0xffff) + (kc & 255); const bool ok = idx < cnt[e] && idx < T;
            const int t = LIST[e * T + (ok ? idx : 0)]; tok[q] = ok ? t : 0; }
#pragma unroll
        for (int q = 0; q < 4; ++q) { const int k = base + q * NTHR; if (k < n * 256) rows[k] = (unsigned short)min(max(tok[q], 0), T - 1); } }
    __syncthreads();
}

typedef float f32x2v __attribute__((ext_vector_type(2)));
__device__ __forceinline__ void ph16_acc8(f32x4& a0, f32x4& a1, v2u w) {
    const f32x2v p0 = __builtin_amdgcn_cvt_pk_f32_fp8((int)w.x, false), p1 = __builtin_amdgcn_cvt_pk_f32_fp8((int)w.x, true), p2 = __builtin_amdgcn_cvt_pk_f32_fp8((int)w.y, false), p3 = __builtin_amdgcn_cvt_pk_f32_fp8((int)w.y, true);
    a0[0] += p0[0]; a0[1] += p0[1]; a0[2] += p1[0]; a0[3] += p1[1]; a1[0] += p2[0]; a1[1] += p2[1]; a1[2] += p3[0]; a1[3] += p3[1];
}
__device__ __forceinline__ void ph16_slots(const LAS int* off, const int* ASGE, const int* ASGP, int row, int (&sl)[4]) {
#pragma unroll
    for (int k = 0; k < 4; ++k) sl[k] = min(max(off[ASGE[row * 4 + k] & 31] + ASGP[row * 4 + k], 0), MOE_ROWS - 1);
}
__device__ __forceinline__ void ph16_row(const int (&sl)[4], const unsigned char* YE, const bf16* X1, const float* MOD, int row, int lane, f32x4 (&out)[8]) {
    const v2u* y0 = (const v2u*)(YE + (size_t)sl[0] * DM) + lane; const v2u* y1 = (const v2u*)(YE + (size_t)sl[1] * DM) + lane; const v2u* y2 = (const v2u*)(YE + (size_t)sl[2] * DM) + lane; const v2u* y3 = (const v2u*)(YE + (size_t)sl[3] * DM) + lane;
    const v4u* xi = (const v4u*)(X1 + (size_t)row * DM) + lane; const f32x4* gp = (const f32x4*)(MOD + (size_t)(row >> 11) * MODW + 5 * DM) + 2 * lane;
#pragma unroll
    for (int j = 0; j < 4; ++j) { const v2u w0 = y0[64 * j], w1 = y1[64 * j], w2 = y2[64 * j], w3 = y3[64 * j]; const v4u xw = xi[64 * j]; const f32x4 g0 = gp[128 * j] * (1.0f / F8_YSCALE), g1 = gp[128 * j + 1] * (1.0f / F8_YSCALE);
        f32x4 a0 = {0.f, 0.f, 0.f, 0.f}, a1 = {0.f, 0.f, 0.f, 0.f};
        ph16_acc8(a0, a1, w0); ph16_acc8(a0, a1, w1); ph16_acc8(a0, a1, w2); ph16_acc8(a0, a1, w3);
        out[2 * j] = (f32x4){bflo(xw.x), bfhi(xw.x), bflo(xw.y), bfhi(xw.y)} + g0 * a0; out[2 * j + 1] = (f32x4){bflo(xw.z), bfhi(xw.z), bflo(xw.w), bfhi(xw.w)} + g1 * a1; }
}
__device__ __forceinline__ void ph16_body(const Args& a, LAS unsigned char* lds, int tid, int wave, int lane, int G, int bid, float* OUT) {
    moe_tables(a, lds, tid); const LAS int* off = (const LAS int*)(lds + LDS_MOE);
    const float* MOD = (const float*)(a.ws + WS_MOD); const int* ASGE = (const int*)(a.ws + WS_ASGE); const int* ASGP = (const int*)(a.ws + WS_ASGP); const unsigned char* YE = (const unsigned char*)(a.ws + WS_YE); const bf16* X1 = (const bf16*)(a.ws + WS_X1);
    const int gw = bid * NWAVES + wave, NGW = G * NWAVES;
    int sA[4] = {0, 0, 0, 0}, sB[4] = {0, 0, 0, 0};
    if (gw < T) ph16_slots(off, ASGE, ASGP, gw, sA);
    if (gw + NGW < T) ph16_slots(off, ASGE, ASGP, gw + NGW, sB);
    for (int row = gw; row < T; row += 2 * NGW) {
        const int rowB = row + NGW; const bool hasB = rowB < T;
        f32x4 oA[8], oB[8];
        ph16_row(sA, YE, X1, MOD, row, lane, oA);
        if (hasB) ph16_row(sB, YE, X1, MOD, rowB, lane, oB);
        if (row + 2 * NGW < T) ph16_slots(off, ASGE, ASGP, row + 2 * NGW, sA);
        if (rowB + 2 * NGW < T) ph16_slots(off, ASGE, ASGP, rowB + 2 * NGW, sB);
        { f32x4* xo = (f32x4*)(OUT + (size_t)row * DM) + 2 * lane;
#pragma unroll
          for (int j = 0; j < 4; ++j) { xo[128 * j] = oA[2 * j]; xo[128 * j + 1] = oA[2 * j + 1]; } }
        if (hasB) { f32x4* xo = (f32x4*)(OUT + (size_t)rowB * DM) + 2 * lane;
#pragma unroll
          for (int j = 0; j < 4; ++j) { xo[128 * j] = oB[2 * j]; xo[128 * j + 1] = oB[2 * j + 1]; } }
    }
}

#ifndef PROBE_REP
#define PROBE_REP 0
#endif
#ifndef MK_ONE_LAUNCH
#define MK_ONE_LAUNCH 1
#endif
constexpr int NPH = 13;
__global__ void __launch_bounds__(NTHR, 2) fwd(Args args) {
    extern __shared__ __attribute__((aligned(16))) unsigned char lds_raw[];
    LAS unsigned char* lds = (LAS unsigned char*)lds_raw;
    const int tid = threadIdx.x, lane = tid & 63, wave = __builtin_amdgcn_readfirstlane(tid >> 6);
    const int G = gridDim.x, bid = blockIdx.x;
    volatile LAS unsigned* MISC = (volatile LAS unsigned*)(lds + MISC_OFF);
    for (int u = tid; u < (LDS_BYTES - LDSCTL_OFF) / 4; u += NTHR) ((LAS unsigned*)(lds + LDSCTL_OFF))[u] = 0u;
    __syncthreads();
    unsigned char* ws = args.ws;
    unsigned* ctl = (unsigned*)(ws + WS_CTL);
    const int lo = args.ph_lo, hi = args.ph_hi;
    XcdBarrier bar; bar.bar = ctl + CW_BAR; bar.x = 0; bar.st = nullptr;
    if (hi - lo > 1) bar = xcd_barrier_post(ctl + CW_BAR, MISC + 8);
#define IN(k) (lo <= (k) && (k) < hi)
#define REPS(k) _Pragma("unroll") for (int rep_ = 0; rep_ < 1 + ((PROBE_REP >> (k)) & 1); ++rep_)
#define SEAM(k) do { if (IN(k) && IN((k) + 1)) xcd_barrier(bar); } while (0)

    if (IN(0)) REPS(0) { ph0_ssm_consts(args, tid, G, (bid + 8) % G);
         ph0_adaln(args, lds, tid, G, bid); }
    SEAM(0);
    if (IN(1)) REPS(1) {
        if (bid & 1) { ph1_small(args, tid, wave, lane, G, bid); bts_body(args, tid, G, bid); ph0_transposes(args, lds, wave, lane, G, bid); ph1_norm(args, wave, lane, G, bid); }
        else { ph1_norm(args, wave, lane, G, bid); ph0_transposes(args, lds, wave, lane, G, bid); ph1_small(args, tid, wave, lane, G, bid); bts_body(args, tid, G, bid); } __syncthreads(); }
    SEAM(1);
    if (IN(2)) REPS(2) {
        const int Gg = (G > 2 * NCONV) ? G - NCONV : G;
        if (bid < Gg) {
            { pg8::Gemm g{(const bf16*)(ws + WS_HN), (const bf16*)(ws + WS_WIN), DM, DM, DM}; pg8::StaticOrder S; S.init(T, 2560, Gg, bid);
              EpiInProjA E{(bf16*)(ws + WS_Q), (bf16*)(ws + WS_K), (bf16*)(ws + WS_IQ), (bf16*)(ws + WS_IK), (float*)(ws + WS_IW)};
              pg8::gemm_phase<EpiInProjA, pg8::StaticOrder, true, true>(lds, g, S, E); }
            { pg8::Gemm g{(const bf16*)(ws + WS_HN8), (const bf16*)(ws + WS_WIN8), DM / 2, DM / 2, DM / 2}; pg8::StaticOrder S; S.init(T, 5376, Gg, bid);
              EpiInProjB E{(bf16*)(ws + WS_V), (bf16*)(ws + WS_UA), (unsigned char*)(ws + WS_GATES)};
              pg8::gemm_phase<EpiInProjB, pg8::StaticOrder, true, true, true>(lds, g, S, E); } }
        cv_queue(args, lds, wave, lane); }
    SEAM(2);
    if (IN(3)) REPS(3) {
        ph4a_body(args, lds, tid, wave, lane, G, bid);
        { pg8::Gemm g{(const bf16*)(ws + WS_UA), (const bf16*)(ws + WS_BTS), UA_LD, SL * 16, SL * 16}; SsmSOrder S{G, (G - 1) - bid}; EpiSsmS E{(float*)(ws + WS_SBUF)};
          pg8::gemm_phase<EpiSsmS, SsmSOrder, true, true>(lds, g, S, E); }
        qknorm_body(args, wave, lane, G, bid); bty_body(args, tid, G, bid); }
    SEAM(3);
    if (IN(4)) REPS(4) { ph4b_body(args, wave, lane, G, bid); ph7_body(args, tid, G, bid); }
    SEAM(4);
    if (IN(5)) REPS(5) {
        ph5_body(args, (char*)lds_raw, wave, lane, G, bid);
        { pg8::Gemm g{(const bf16*)(ws + WS_UA), (const bf16*)(ws + WS_BTY), UA_LD, UA_LD, UA_LD}; SsmYOrder S{G, bid}; EpiSsmY E{(bf16*)(ws + WS_YG)};
          pg8::gemm_phase<EpiSsmY, SsmYOrder, true, true>(lds, g, S, E); } }
    SEAM(5);
    if (IN(6)) REPS(6) {
        pg8::Gemm g{(const bf16*)(ws + WS_YG), (const bf16*)(ws + WS_WGLU), 1024, 1024, 1024}; pg8::StaticOrder S; S.init(T, 1024, G, bid);
        EpiGlu E{(const bf16*)(ws + WS_YG), (unsigned char*)(ws + WS_YA + 1024), args.in[I_BGLU]};
        pg8::gemm_phase<EpiGlu, pg8::StaticOrder, true, true>(lds, g, S, E); }
    SEAM(6);
    if (IN(7)) REPS(7) {
        pg8::StaticOrder S; S.init(T, DM, G, bid);
        pg8::Gemm g{(const bf16*)(ws + WS_YA), (const bf16*)(ws + WS_WA), 1024, 1024, 1024}; EpiProjAB E{(const unsigned char*)(ws + WS_GATES), (unsigned char*)(ws + WS_MG)};
        pg8::gemm_phase<EpiProjAB, pg8::StaticOrder, true, true, true>(lds, g, S, E); }
    SEAM(7);
    if (IN(8)) REPS(8) {
        pg8::Gemm g{(const bf16*)(ws + WS_MG), (const bf16*)(ws + WS_WO), DM / 2, DM / 2, DM / 2}; pg8::StaticOrder S; S.init(T, DM, G, bid);
        EpiOut E{args.in[I_X], (const float*)(ws + WS_MOD), (bf16*)(ws + WS_X1)};
        pg8::gemm_phase<EpiOut, pg8::StaticOrder, true, true, true>(lds, g, S, E); }
    SEAM(8);
    if (IN(9)) REPS(9) ph12_body(args, lds, tid, wave, lane, G, bid, (size_t)rep_);
    SEAM(9);
    if (IN(10)) REPS(10) {
        moe_tables(args, lds, tid);
        const LAS int* mt = (const LAS int*)(lds + LDS_MOE); MoeOrder S{mt + 96, mt[64], 4, G, bid};
        moe_rows(args, lds, tid, S);
        pg8::Gemm g{(const bf16*)(ws + WS_XS), (const bf16*)(ws + WS_WGU), DM / 2, DM / 2, DM / 2, (const LAS unsigned short*)(lds + LDS_ROWS)}; EpiGateUp E{args.in[I_BGU], (unsigned char*)(ws + WS_ACT)};
        pg8::gemm_phase<EpiGateUp, MoeOrder, true, true, true, true>(lds, g, S, E); }
    SEAM(10);
    if (IN(11)) REPS(11) {
        moe_tables(args, lds, tid);
        const LAS int* mt = (const LAS int*)(lds + LDS_MOE); MoeOrder S{mt + 96, mt[64], 3, G, bid};
        pg8::Gemm g{(const bf16*)(ws + WS_ACT), (const bf16*)(ws + WS_WD), DM / 2, DM / 2, DM / 2}; EpiDown E{args.in[I_BD], (const float*)(ws + WS_GLIST), mt, (unsigned char*)(ws + WS_YE)};
        pg8::gemm_phase<EpiDown, MoeOrder, true, true, true>(lds, g, S, E); }
    SEAM(11);
    if (IN(12)) REPS(12) ph16_body(args, lds, tid, wave, lane, G, bid, rep_ ? (float*)(ws + WS_SC) : args.out);
#if defined(PROBE_BAR)
    if (hi - lo > 1) { _Pragma("unroll 1") for (int q = 0; q < PROBE_BAR; ++q) xcd_barrier(bar); }
#endif
#undef IN
#undef SEAM
}

extern "C" void kernel_launch(void* const* d_in, const int* in_sizes, int n_in, void* d_out, int out_size, void* d_ws, size_t ws_size, hipStream_t stream) {
    static int grid = 0;
    if (grid == 0) {
        if (n_in != 28 || out_size != T * DM || ws_size < WS_END) { fprintf(stderr, "kernel_launch: unexpected shapes (n_in %d out %d ws %zu)\n", n_in, out_size, ws_size); grid = -1; return; }
        int dev = 0, cus = 0, per_cu = 0;
        if (hipGetDevice(&dev) != hipSuccess || hipDeviceGetAttribute(&cus, hipDeviceAttributeMultiprocessorCount, dev) != hipSuccess) { grid = -1; return; }
        if (hipFuncSetAttribute((const void*)fwd, hipFuncAttributeMaxDynamicSharedMemorySize, LDS_BYTES) != hipSuccess) { fprintf(stderr, "kernel_launch: hipFuncSetAttribute failed\n"); grid = -1; return; }
        if (hipOccupancyMaxActiveBlocksPerMultiprocessor(&per_cu, (const void*)fwd, NTHR, LDS_BYTES) != hipSuccess || per_cu < 1) { fprintf(stderr, "kernel_launch: occupancy query says %d\n", per_cu); (void)hipGetLastError(); grid = -1; return; }
        if (cus * ROWS_CAP < 288 * 16) { fprintf(stderr, "kernel_launch: too few CUs (%d) for the gather lists\n", cus); grid = -1; return; }
        grid = cus;
    }
    if (grid < 0) return;
    (void)hipMemsetAsync((char*)d_ws + WS_CTL, 0, CTL_ZERO_BYTES, stream);
    Args a{};
    for (int i = 0; i < 28; ++i) a.in[i] = (const float*)d_in[i];
    a.out = (float*)d_out; a.ws = (unsigned char*)d_ws;
#if MK_ONE_LAUNCH
    a.ph_lo = 0; a.ph_hi = NPH;
    hipLaunchKernelGGL(fwd, dim3(grid), dim3(NTHR), LDS_BYTES, stream, a);
#else
    for (int p = 0; p < NPH; ++p) { a.ph_lo = p; a.ph_hi = p + 1; hipLaunchKernelGGL(fwd, dim3(grid), dim3(NTHR), LDS_BYTES, stream, a); }
#endif
}
```

```cpp
#include <hip/hip_runtime.h>
#include <cstdio>
#include <cstdint>

#define GAS __attribute__((address_space(1)))
#define LAS __attribute__((address_space(3)))
typedef unsigned short bf16;
typedef unsigned v4u __attribute__((ext_vector_type(4)));
typedef unsigned v2u __attribute__((ext_vector_type(2)));
typedef float f32x2 __attribute__((ext_vector_type(2)));
typedef float f32x4 __attribute__((ext_vector_type(4)));
typedef float f32x16 __attribute__((ext_vector_type(16)));
typedef short bf16x8 __attribute__((ext_vector_type(8)));
typedef short s16x4 __attribute__((ext_vector_type(4)));
typedef __bf16 bf16x2_t __attribute__((ext_vector_type(2)));

constexpr int DM = 2048, NB = 8, SEQ = 2048, T = NB * SEQ;
constexpr int CHUNK = 64, NCHUNK = SEQ / CHUNK;
constexpr int HD = 128, NQH = 8, NKVH = 2, ATTW = 1024, KVW = 256;
constexpr int IDXH = 16, IDXD = 64, TOPK = 256;
constexpr int SSMW = 1024, SSMG = 64, SSMP = 16, SSMN = 64;
constexpr int NEXP = 32, MOEK = 4, DFF = 2048;
constexpr int INW = 7760, INW_PAD = 7936;
constexpr int MODW = 6 * DM;
constexpr float RMS_EPS = 1e-6f;
constexpr int SL = 32, NSC = SEQ / SL, SROWS = NB * NSC;
constexpr int UA_LD = SL * 16 + 128;
constexpr int MOE_ROWS = T * MOEK + NEXP * 256;
constexpr int NWAVES = 8, NTHR = 512;

constexpr size_t MiB = 1u << 20;
constexpr size_t WS_CTL = 0, CTL_ZERO_BYTES = 1 * MiB;
constexpr size_t WS_MOD = 1 * MiB;
constexpr size_t WS_WRP = 2 * MiB;
constexpr size_t WS_BRP = 4 * MiB;
constexpr size_t WS_BBAR = 5 * MiB;
constexpr size_t WS_POW = 6 * MiB;
constexpr size_t WS_KT = 9 * MiB;
constexpr size_t WS_ASGE = 14 * MiB;
constexpr size_t WS_ASGP = WS_ASGE + 256 * 1024;
constexpr size_t WS_ASGG = WS_ASGP + 256 * 1024;
constexpr size_t WS_SLOT = WS_ASGG + 256 * 1024;
constexpr size_t WS_ROWG = 15 * MiB;
constexpr size_t WS_RSTD = 15 * MiB + 512 * 1024;
constexpr size_t WS_WIN = 16 * MiB;
constexpr size_t WS_WIN8 = 27 * MiB;
constexpr size_t WS_WGLU = 47 * MiB;
constexpr size_t WS_WA = 49 * MiB;
constexpr size_t WS_WB = 53 * MiB;
constexpr size_t WS_WO = 57 * MiB;
constexpr size_t WS_BTS = 65 * MiB;
constexpr size_t WS_BTY = 97 * MiB;
constexpr size_t WS_HN = 241 * MiB;
constexpr size_t WS_X1 = 241 * MiB;
constexpr size_t WS_HN8 = 980 * MiB;
constexpr size_t WS_Q = 305 * MiB;
constexpr size_t WS_K = 337 * MiB;
constexpr size_t WS_V = 345 * MiB;
constexpr size_t WS_IQ = 353 * MiB;
constexpr size_t WS_IK = 385 * MiB;
constexpr size_t WS_IW = 387 * MiB;
constexpr size_t WS_UA = 788 * MiB;
constexpr size_t WS_GATES = 424 * MiB;
constexpr size_t WS_SC = 552 * MiB;
constexpr size_t WS_SEL = 680 * MiB;
constexpr size_t WS_YA = 684 * MiB;
constexpr size_t WS_SBUF = 852 * MiB;
constexpr size_t WS_YG = 724 * MiB;
constexpr size_t WS_YS = 756 * MiB;
constexpr size_t WS_MRG = 788 * MiB;
constexpr size_t WS_MG = 916 * MiB;
constexpr size_t WS_H2 = 980 * MiB;
constexpr size_t WS_XS = 1044 * MiB;
constexpr size_t WS_LIST = WS_XS + 64 * MiB;
constexpr size_t WS_GLIST = WS_XS + 66 * MiB;
constexpr size_t WS_ACT = 1332 * MiB;
constexpr size_t WS_YE = 1620 * MiB;
constexpr size_t WS_WGU = 1908 * MiB;
constexpr size_t WS_WD = 2420 * MiB;
constexpr size_t WS_END = 2676 * MiB;
constexpr int CW_CNT = 1024;
constexpr int CW_CVQ = 2048;
constexpr int NCONV = 112;
constexpr int CW_BAR = 4096;
constexpr int RING_BYTES = 131072;
constexpr int LDSCTL_OFF = RING_BYTES, MISC_OFF = LDSCTL_OFF + 320;
constexpr int LDS_BYTES = 147456;

#define LDS_WAIT() asm volatile("s_waitcnt lgkmcnt(0)" ::: "memory")
#define VM_WAIT() asm volatile("s_waitcnt vmcnt(0)" ::: "memory")
#define RLX_AGENT __ATOMIC_RELAXED, __HIP_MEMORY_SCOPE_AGENT

__device__ __forceinline__ unsigned pk2(float lo, float hi) { f32x2 v = {lo, hi}; bf16x2_t b = __builtin_convertvector(v, bf16x2_t); return __builtin_bit_cast(unsigned, b); }
__device__ __forceinline__ float bf2f(unsigned h) { return __builtin_bit_cast(float, h << 16); }
__device__ __forceinline__ float bflo(unsigned w) { return __builtin_bit_cast(float, w << 16); }
__device__ __forceinline__ float bfhi(unsigned w) { return __builtin_bit_cast(float, w & 0xffff0000u); }
__device__ __forceinline__ float wave_sum(float v) {
#pragma unroll
    for (int o = 1; o < 64; o <<= 1) v += __shfl_xor(v, o);
    return v;
}
constexpr float F8_WSCALE = 256.0f, F8_ASCALE = 4.0f, F8_DESCALE = 1.0f / (256.0f * 4.0f);
constexpr float F8_YSCALE = 8.0f;
constexpr float F8_MSCALE = 16.0f, F8_MDESCALE = 1.0f / (256.0f * 16.0f);
__device__ __forceinline__ unsigned pk4_fp8(float a, float b, float c, float d) { int w = 0; a = __builtin_amdgcn_fmed3f(a, -448.f, 448.f); b = __builtin_amdgcn_fmed3f(b, -448.f, 448.f); c = __builtin_amdgcn_fmed3f(c, -448.f, 448.f); d = __builtin_amdgcn_fmed3f(d, -448.f, 448.f);
    w = __builtin_amdgcn_cvt_pk_fp8_f32(a, b, w, false); w = __builtin_amdgcn_cvt_pk_fp8_f32(c, d, w, true); return (unsigned)w; }
__device__ __forceinline__ unsigned pk4_fp8_nc(float a, float b, float c, float d) { int w = 0; w = __builtin_amdgcn_cvt_pk_fp8_f32(a, b, w, false); w = __builtin_amdgcn_cvt_pk_fp8_f32(c, d, w, true); return (unsigned)w; }
__device__ __forceinline__ float sigmoidf_(float x) { return __builtin_amdgcn_rcpf(1.0f + __builtin_amdgcn_exp2f(x * -1.4426950408889634f)); }
__device__ __forceinline__ float sigmoid1702(float x) { return __builtin_amdgcn_rcpf(1.0f + __builtin_amdgcn_exp2f(x * (-1.702f * 1.4426950408889634f))); }

namespace pg8 {
#define PG8_LAS __attribute__((address_space(3)))
typedef unsigned short bf16_t;
typedef short bf16x8 __attribute__((ext_vector_type(8)));
typedef float f32x4 __attribute__((ext_vector_type(4)));
typedef unsigned u32x4 __attribute__((ext_vector_type(4)));
constexpr int BM = 256, BK = 64, HALF = 128, HTB = HALF * BK * 2, STAGE_BYTES = 8 * HTB, NXCD = 8, WGM = 8;

__host__ __device__ __forceinline__ int lds_byte(int r, int c) { const int st = (r >> 4) * 2 + (c >> 5), rr = r & 15, cc = c & 31, ob = rr * 64 + cc * 2; return st * 1024 + (ob ^ (((ob >> 9) & 1) << 5)); }
__host__ __device__ __forceinline__ void stage_rc(int b, int& R, int& C) { const int st = b / 1024, sb = b % 1024, swz = sb ^ (((sb >> 9) & 1) << 5); R = (st >> 1) * 16 + swz / 64; C = (st & 1) * 32 + (swz % 64) / 2; }
__host__ __device__ __forceinline__ int perm32(int rho) { const int n = rho >> 4, i = rho & 15; return 8 * (i >> 2) + 4 * n + (i & 3); }

struct Unit { int pm, pn; };
struct Gemm { const bf16_t* A; const bf16_t* Bt; int lda, ldb, K; const PG8_LAS unsigned short* rows; };

struct StaticOrder {
    int nM, nN, nwg, G, c;
    __host__ __device__ void init(int M, int N, int G_, int c_) { nM = M / BM; nN = N / BM; nwg = nM * nN; G = G_; c = c_; }
    __host__ __device__ bool next(int i, Unit& u) const {
        const long L = (long)i * G + c; if (L >= nwg) return false;
        int wgid = (int)L; { const int q = nwg / NXCD, r = nwg % NXCD, xcd = wgid % NXCD, off = wgid / NXCD; wgid = (xcd < r ? xcd * (q + 1) : r * (q + 1) + (xcd - r) * q) + off; }
        const int nig = WGM * nN, gid = wgid / nig, fm = gid * WGM, gsz = (nM - fm) < WGM ? (nM - fm) : WGM;
        u.pm = fm + ((wgid % nig) % gsz); u.pn = (wgid % nig) / gsz; return true;
    }
    __device__ __forceinline__ void a_ready(const Unit&) const {}
    __device__ __forceinline__ void done(const Unit&) const {}
};

typedef int i32x4 __attribute__((ext_vector_type(4)));
typedef int i32x8 __attribute__((ext_vector_type(8)));
template <bool F8> struct FragT;
template <> struct FragT<false> { bf16x8 k0, k1; };
template <> struct FragT<true> { i32x8 v; };
template <bool F8> __device__ __forceinline__ FragT<F8> ldfrag(const PG8_LAS unsigned char* p) {
    if constexpr (F8) { const i32x4 lo = *(const PG8_LAS i32x4*)p, hi = *(const PG8_LAS i32x4*)(p + 1024); FragT<true> f; f.v = __builtin_shufflevector(lo, hi, 0, 1, 2, 3, 4, 5, 6, 7); return f; }
    else { FragT<false> f; f.k0 = *(const PG8_LAS bf16x8*)p; f.k1 = *(const PG8_LAS bf16x8*)(p + 1024); return f; }
}
template <bool F8> __device__ __forceinline__ f32x4 mma1(const FragT<F8>& b, const FragT<F8>& a, f32x4 c) {
#if defined(__HIP_DEVICE_COMPILE__)
    if constexpr (F8) { asm volatile("v_mfma_f32_16x16x128_f8f6f4 %0, %1, %2, %0" : "+v"(c) : "v"(b.v), "v"(a.v)); return c; }
#else
    if constexpr (F8) { return c; }
#endif
    else { c = __builtin_amdgcn_mfma_f32_16x16x32_bf16(b.k0, a.k0, c, 0, 0, 0); return __builtin_amdgcn_mfma_f32_16x16x32_bf16(b.k1, a.k1, c, 0, 0, 0); }
}
template <class Epi, class Sched, bool ALIGN_EPI = false, bool SP2 = false, bool F8 = false, bool GATHER = false>
__device__ __forceinline__ void gemm_phase(PG8_LAS unsigned char* lds, const Gemm g, const Sched& S, const Epi& E) {
    const int tid = threadIdx.x, wid = __builtin_amdgcn_readfirstlane(tid >> 6), lane = tid & 63, wr = wid >> 2, wc = wid & 3, fr = lane & 15, fq = lane >> 4;
    const int K = g.K, nt = K / BK;
    unsigned voffA[2], voffB[2];
#pragma unroll
    for (int i = 0; i < 2; ++i) { int R, C; stage_rc(tid * 16 + i * 8192, R, C); const int Rb = Epi::PERM ? ((R & ~31) + perm32(R & 31)) : R;
        voffA[i] = (unsigned)(R * g.lda + C) * 2u; voffB[i] = (unsigned)(Rb * g.ldb + C) * 2u; }
    unsigned gC0[2] = {0u, 0u}, gC1[2] = {0u, 0u}, gN0[2] = {0u, 0u}, gN1[2] = {0u, 0u}; int gR[2] = {0, 0}; unsigned gCb[2] = {0u, 0u};
    if constexpr (GATHER) {
#pragma unroll
        for (int i = 0; i < 2; ++i) { int R, C; stage_rc(tid * 16 + i * 8192, R, C); gR[i] = R; gCb[i] = (unsigned)C * 2u; } }
#define PG8_GROWS(d0, d1, slot) do { _Pragma("unroll") for (int _i = 0; _i < 2; ++_i) { \
        d0[_i] = (unsigned)g.rows[(slot) * 256 + gR[_i]] * (unsigned)(g.lda * 2) + gCb[_i]; d1[_i] = (unsigned)g.rows[(slot) * 256 + 128 + gR[_i]] * (unsigned)(g.lda * 2) + gCb[_i]; } } while (0)
    const size_t kstep = (size_t)(BK * 2);
    const size_t hstepA = (size_t)HALF * g.lda * 2, hstepB = (size_t)HALF * g.ldb * 2;
    const size_t tstepA = 2 * hstepA, tstepB = 2 * hstepB;
    const unsigned ldsw = (unsigned)wid * 1024u;
    const int aoff = lds_byte(wr * 64 + fr, fq * 8), boff = lds_byte(wc * 32 + fr, fq * 8);
#define PG8_SA(b, h) (((b) * 2 + (h)) * HTB)
#define PG8_SB(b, h) ((4 + (b) * 2 + (h)) * HTB)
#define PG8_STAGE(bufoff, gbase, voff) do { _Pragma("unroll") for (int _i = 0; _i < 2; ++_i) \
        __builtin_amdgcn_global_load_lds((const unsigned*)((const char*)(gbase) + (voff)[_i]), (PG8_LAS unsigned*)(lds + (bufoff) + ldsw + _i * 8192), 16, 0, 0); } while (0)
#define PG8_STAGE2(bufoff, gbase, o0, o1) do { \
        __builtin_amdgcn_global_load_lds((const unsigned*)((const char*)(gbase) + (o0)), (PG8_LAS unsigned*)(lds + (bufoff) + ldsw), 16, 0, 0); \
        __builtin_amdgcn_global_load_lds((const unsigned*)((const char*)(gbase) + (o1)), (PG8_LAS unsigned*)(lds + (bufoff) + ldsw + 8192), 16, 0, 0); } while (0)
#define PG8_STAGE_A(bufoff, kb, h, nx) do { if constexpr (GATHER) { \
        if ((h) == 0) PG8_STAGE2(bufoff, kb, ((nx) ? gN0[0] : gC0[0]), ((nx) ? gN0[1] : gC0[1])); else PG8_STAGE2(bufoff, kb, ((nx) ? gN1[0] : gC1[0]), ((nx) ? gN1[1] : gC1[1])); \
        } else { PG8_STAGE(bufoff, (kb) + ((h) ? hstepA : (size_t)0), voffA); } } while (0)
#define PG8_LDA(dst, b, h) do { _Pragma("unroll") for (int m = 0; m < 4; ++m) dst[m] = ldfrag<F8>(lds + PG8_SA(b, h) + aoff + m * 2048); } while (0)
#define PG8_LDB(dst, b, h) do { _Pragma("unroll") for (int n = 0; n < 2; ++n) dst[n] = ldfrag<F8>(lds + PG8_SB(b, h) + boff + n * 2048); } while (0)
#define PG8_MMA(ai, bj, At, Bt) do { __builtin_amdgcn_s_setprio(1); _Pragma("unroll") for (int m = 0; m < 4; ++m) _Pragma("unroll") for (int n = 0; n < 2; ++n) \
        acc[ai][bj][m][n] = mma1<F8>(Bt[n], At[m], acc[ai][bj][m][n]); __builtin_amdgcn_s_setprio(0); } while (0)
#define PG8_WAIT_V(n) asm volatile("s_waitcnt vmcnt(" #n ")" ::: "memory")
#define PG8_WAIT_L(n) asm volatile("s_waitcnt lgkmcnt(" #n ")" ::: "memory")
#define PG8_BAR __builtin_amdgcn_s_barrier()
#define PG8_SCHED __builtin_amdgcn_sched_barrier(0)
    Unit cur, nxt; int ui = 0;
    if (!S.next(0, cur)) return;
    f32x4 acc[2][2][4][2];
#pragma unroll
    for (int a = 0; a < 2; ++a)
#pragma unroll
        for (int b = 0; b < 2; ++b)
#pragma unroll
            for (int m = 0; m < 4; ++m)
#pragma unroll
                for (int n = 0; n < 2; ++n) acc[a][b][m][n] = (f32x4){0.f, 0.f, 0.f, 0.f};
    FragT<F8> At[4], B0[2], B1[2];
    const char* cA = (const char*)g.A + (GATHER ? (size_t)0 : (size_t)cur.pm * tstepA); const char* cB = (const char*)g.Bt + (size_t)cur.pn * tstepB;
    if constexpr (GATHER) { PG8_GROWS(gC0, gC1, 0); }
    S.a_ready(cur);
    if constexpr (SP2) {
        PG8_STAGE(PG8_SB(0, 0), cB, voffB); PG8_STAGE(PG8_SB(0, 1), cB + hstepB, voffB); PG8_STAGE_A(PG8_SA(0, 0), cA, 0, false); PG8_STAGE_A(PG8_SA(0, 1), cA, 1, false);
        if (wr == 1) PG8_BAR;
        PG8_WAIT_V(2); PG8_BAR;
        PG8_STAGE(PG8_SB(1, 0), cB + kstep, voffB); PG8_STAGE_A(PG8_SA(1, 0), cA + kstep, 0, false); PG8_STAGE(PG8_SB(1, 1), cB + hstepB + kstep, voffB);
        PG8_WAIT_V(6); PG8_BAR;
    } else {
        PG8_STAGE(PG8_SB(0, 0), cB, voffB); PG8_STAGE_A(PG8_SA(0, 0), cA, 0, false); PG8_STAGE(PG8_SB(0, 1), cB + hstepB, voffB); PG8_STAGE_A(PG8_SA(0, 1), cA, 1, false);
        if (wr == 1) PG8_BAR;
        PG8_WAIT_V(4); PG8_BAR;
        PG8_STAGE(PG8_SB(1, 0), cB + kstep, voffB); PG8_STAGE_A(PG8_SA(1, 0), cA + kstep, 0, false); PG8_STAGE(PG8_SB(1, 1), cB + hstepB + kstep, voffB);
        PG8_WAIT_V(6); PG8_BAR;
    }
    for (;;) {
        const bool has_next = S.next(ui + 1, nxt);
        const char* nA = (has_next && !GATHER) ? (const char*)g.A + (size_t)nxt.pm * tstepA : cA; const char* nB = has_next ? (const char*)g.Bt + (size_t)nxt.pn * tstepB : cB;
        if constexpr (GATHER) { if (has_next) { PG8_GROWS(gN0, gN1, ui + 1); } else { gN0[0] = gC0[0]; gN0[1] = gC0[1]; gN1[0] = gC1[0]; gN1[1] = gC1[1]; } }
        for (int t = 0; t < nt; t += 2) {
            const bool last = (t == nt - 2);
            const char* a1 = cA + (size_t)(t + 1) * kstep;
            const char* a2 = last ? nA : cA + (size_t)(t + 2) * kstep; const char* b2 = last ? nB : cB + (size_t)(t + 2) * kstep;
            const char* a3 = a2 + kstep; const char* b3 = b2 + kstep;
            if (last && has_next) S.a_ready(nxt);
            if constexpr (Epi::CHAIN) { if (t == Epi::MID_T) {
                if constexpr (F8) asm volatile("s_nop 15\n\ts_nop 15" ::: "memory");
                int fr_ = fr, fq_ = fq; asm volatile("" : "+v"(fr_), "+v"(fq_)); E.mid(acc, cur, wr, wc, fr_, fq_); } }
            if constexpr (SP2) {
            PG8_LDB(B0, 0, 0); PG8_LDB(B1, 0, 1); PG8_SCHED; PG8_LDA(At, 0, 0); PG8_STAGE_A(PG8_SA(1, 1), a1, 1, false);
            PG8_WAIT_V(8); PG8_WAIT_L(0); PG8_BAR; PG8_MMA(0, 0, At, B0); PG8_MMA(0, 1, At, B1); PG8_BAR; PG8_SCHED;
            PG8_LDA(At, 0, 1); PG8_STAGE(PG8_SB(0, 0), b2, voffB); PG8_STAGE(PG8_SB(0, 1), b2 + hstepB, voffB); PG8_STAGE_A(PG8_SA(0, 0), a2, 0, last);
            PG8_WAIT_V(8); PG8_WAIT_L(0); PG8_BAR; PG8_MMA(1, 0, At, B0); PG8_MMA(1, 1, At, B1); PG8_BAR; PG8_SCHED;
            PG8_LDB(B0, 1, 0); PG8_LDB(B1, 1, 1); PG8_SCHED; PG8_LDA(At, 1, 0); PG8_STAGE_A(PG8_SA(0, 1), a2, 1, last);
            PG8_WAIT_V(8); PG8_WAIT_L(0); PG8_BAR; PG8_MMA(0, 0, At, B0); PG8_MMA(0, 1, At, B1); PG8_BAR; PG8_SCHED;
            PG8_LDA(At, 1, 1); PG8_STAGE(PG8_SB(1, 0), b3, voffB); PG8_STAGE(PG8_SB(1, 1), b3 + hstepB, voffB); PG8_STAGE_A(PG8_SA(1, 0), a3, 0, last);
            PG8_WAIT_V(8); PG8_WAIT_L(0); PG8_BAR; PG8_MMA(1, 0, At, B0); PG8_MMA(1, 1, At, B1); PG8_BAR; PG8_SCHED;
            } else {
            PG8_LDB(B0, 0, 0); PG8_SCHED; PG8_LDA(At, 0, 0); PG8_STAGE_A(PG8_SA(1, 1), a1, 1, false);
            PG8_WAIT_L(8); PG8_BAR; PG8_WAIT_L(0); PG8_MMA(0, 0, At, B0); PG8_BAR; PG8_SCHED;
            PG8_LDB(B1, 0, 1); PG8_STAGE(PG8_SB(0, 0), b2, voffB);
            PG8_BAR; PG8_WAIT_L(0); PG8_MMA(0, 1, At, B1); PG8_BAR;
            PG8_LDA(At, 0, 1); PG8_STAGE_A(PG8_SA(0, 0), a2, 0, last);
            PG8_BAR; PG8_WAIT_L(0); PG8_MMA(1, 0, At, B0); PG8_BAR; PG8_SCHED;
            PG8_STAGE(PG8_SB(0, 1), b2 + hstepB, voffB);
            PG8_WAIT_V(6); PG8_BAR; PG8_MMA(1, 1, At, B1); PG8_BAR;
            PG8_LDB(B0, 1, 0); PG8_SCHED; PG8_LDA(At, 1, 0); PG8_STAGE_A(PG8_SA(0, 1), a2, 1, last);
            PG8_WAIT_L(8); PG8_BAR; PG8_WAIT_L(0); PG8_MMA(0, 0, At, B0); PG8_BAR; PG8_SCHED;
            PG8_LDB(B1, 1, 1); PG8_STAGE(PG8_SB(1, 0), b3, voffB);
            PG8_BAR; PG8_WAIT_L(0); PG8_MMA(0, 1, At, B1); PG8_BAR;
            PG8_LDA(At, 1, 1); PG8_STAGE_A(PG8_SA(1, 0), a3, 0, last);
            PG8_BAR; PG8_WAIT_L(0); PG8_MMA(1, 0, At, B0); PG8_BAR; PG8_SCHED;
            PG8_STAGE(PG8_SB(1, 1), b3 + hstepB, voffB);
            PG8_WAIT_V(6); PG8_BAR; PG8_MMA(1, 1, At, B1); PG8_BAR;
            }
        }
        if constexpr (ALIGN_EPI) { if (wr == 0) PG8_BAR; }
        if constexpr (F8) asm volatile("s_nop 15\n\ts_nop 15" ::: "memory");
        { int fr_ = fr, fq_ = fq; asm volatile("" : "+v"(fr_), "+v"(fq_));
          E(acc, cur, wr, wc, fr_, fq_); } S.done(cur);
        if (!has_next) break;
#pragma unroll
        for (int a = 0; a < 2; ++a)
#pragma unroll
            for (int b = 0; b < 2; ++b)
#pragma unroll
                for (int m = 0; m < 4; ++m)
#pragma unroll
                    for (int n = 0; n < 2; ++n) acc[a][b][m][n] = (f32x4){0.f, 0.f, 0.f, 0.f};
        cur = nxt; cA = nA; cB = nB; ++ui;
        if constexpr (GATHER) { gC0[0] = gN0[0]; gC0[1] = gN0[1]; gC1[0] = gN1[0]; gC1[1] = gN1[1]; }
        if constexpr (ALIGN_EPI) { if (wr == 1) PG8_BAR; }
    }
    PG8_WAIT_V(0);
    if constexpr (!ALIGN_EPI) { if (wr == 0) PG8_BAR; }
    PG8_BAR;
#undef PG8_SA
#undef PG8_SB
#undef PG8_STAGE
#undef PG8_STAGE2
#undef PG8_STAGE_A
#undef PG8_GROWS
#undef PG8_LDA
#undef PG8_LDB
#undef PG8_MMA
#undef PG8_WAIT_V
#undef PG8_WAIT_L
#undef PG8_BAR
#undef PG8_SCHED
}
}

#define XB_TMO      128
#define XB_XCNT(j)  (256  + 64 * (j))
#define XB_XSUB(j)  (1280 + 64 * (j))
#define XB_XGEN(j)  (2304 + 64 * (j))
#define XB_TOP      3328
#define XB_TOPGEN   3392
#define XCD_BAR_WORDS 3456
#define XB_SPIN_CAP (1u << 18)

__device__ __forceinline__ unsigned xb_ld(unsigned* p)              { return __hip_atomic_load(p, __ATOMIC_RELAXED, __HIP_MEMORY_SCOPE_AGENT); }
__device__ __forceinline__ unsigned xb_add(unsigned* p, unsigned v) { return __hip_atomic_fetch_add(p, v, __ATOMIC_RELAXED, __HIP_MEMORY_SCOPE_AGENT); }
__device__ __forceinline__ unsigned xb_xcc_id() { return (unsigned)__builtin_amdgcn_s_getreg((3 << 11) | 20) & 0xFu; }
#define XB_SPIN(cond, bar) do { unsigned _sp = 0; while (cond) { __builtin_amdgcn_s_sleep(1); \
    if ((++_sp & 255u) == 0u) { if (xb_ld(&(bar)[XB_TMO])) break; if (_sp > XB_SPIN_CAP) { atomicAdd(&(bar)[XB_TMO], 1u); break; } } } } while (0)

struct XcdBarrier { unsigned* bar; unsigned x; volatile LAS unsigned* st; };

__device__ __forceinline__ XcdBarrier xcd_barrier_post(unsigned* bar, volatile LAS unsigned* st) {
    XcdBarrier b; b.bar = bar; b.x = xb_xcc_id(); b.st = st;
    if (threadIdx.x == 0) (void)xb_add(&bar[XB_XCNT(b.x)], 1u);
    return b;
}
__device__ __forceinline__ void xcd_barrier_complete(unsigned* bar, unsigned x, unsigned& nloc, unsigned& nx) {
    const unsigned G = gridDim.x * gridDim.y * gridDim.z;
    unsigned sum, cnt, mine, sp = 0u;
    for (;;) {
        sum = 0u; cnt = 0u; mine = 0u;
#pragma unroll
        for (unsigned j = 0; j < 16; ++j) { const unsigned c = xb_ld(&bar[XB_XCNT(j)]); sum += c; cnt += (c > 0u) ? 1u : 0u; mine = (j == x) ? c : mine; }
        if (sum == G) break;
        __builtin_amdgcn_s_sleep(1);
        if ((++sp & 255u) == 0u) { if (xb_ld(&bar[XB_TMO])) break; if (sp > XB_SPIN_CAP) { atomicAdd(&bar[XB_TMO], 1u); break; } }
    }
    nloc = mine > 0u ? mine : 1u; nx = cnt > 0u ? cnt : 1u;
}
__device__ __forceinline__ void xcd_barrier(const XcdBarrier& b) {
    asm volatile("s_waitcnt vmcnt(0)" ::: "memory");
    __syncthreads();
    if (threadIdx.x == 0) {
        unsigned* bar = b.bar;
        __builtin_amdgcn_s_waitcnt(0);
        unsigned nloc = b.st[0], nx = b.st[1];
        if (nloc == 0u) { xcd_barrier_complete(bar, b.x, nloc, nx); b.st[0] = nloc; b.st[1] = nx; }
        const unsigned old = xb_add(&bar[XB_XSUB(b.x)], 1u);
        const unsigned gen = old / nloc;
        if (old + 1u == (gen + 1u) * nloc) {
            __builtin_amdgcn_fence(__ATOMIC_RELEASE, "agent");
            asm volatile("s_waitcnt vmcnt(0)" ::: "memory");
            const unsigned og = xb_add(&bar[XB_TOP], 1u);
            const unsigned tg = og / nx;
            if (og + 1u == (tg + 1u) * nx) xb_add(&bar[XB_TOPGEN], 1u);
            else XB_SPIN(xb_ld(&bar[XB_TOPGEN]) == tg, bar);
            __builtin_amdgcn_fence(__ATOMIC_ACQUIRE, "agent");
            xb_add(&bar[XB_XGEN(b.x)], 1u);
            asm volatile("s_waitcnt vmcnt(0)" ::: "memory");
        } else {
            XB_SPIN(xb_ld(&bar[XB_XGEN(b.x)]) == gen, bar);
            __builtin_amdgcn_fence(__ATOMIC_ACQUIRE, "agent");
            asm volatile("s_waitcnt vmcnt(0)" ::: "memory");
        }
    }
    __syncthreads();
}

using pg8::Unit;
__device__ __forceinline__ v4u pack8(const f32x4& a, const f32x4& b) { v4u w; w.x = pk2(a[0], a[1]); w.y = pk2(a[2], a[3]); w.z = pk2(b[0], b[1]); w.w = pk2(b[2], b[3]); return w; }
__device__ __forceinline__ float gelu_tanh(float y) { const float u2 = 1.5957691216f * (y + 0.044715f * y * y * y); return y * __builtin_amdgcn_rcpf(1.0f + __builtin_amdgcn_exp2f(u2 * -1.4426950408889634f)); }

struct EpiInProjA {
    static constexpr bool PERM = true, CHAIN = false;
    bf16 *Q, *K, *IQ, *IK; float* IW;
    __device__ __forceinline__ void operator()(const f32x4 (&acc)[2][2][4][2], const Unit& u, int wr, int wc, int fr, int fq) const {
        const int pn = u.pn, row0 = u.pm * 256 + wr * 64 + fr, cl0 = wc * 32 + 8 * fq;
        if (pn < 9) {
            bf16* dst; int ld, coff; float sc = 1.f;
            if (pn < 4) { dst = Q; ld = 1024; coff = pn * 256; } else if (pn == 4) { dst = K; ld = 256; coff = 0; } else { dst = IQ; ld = 1024; coff = (pn - 5) * 256; sc = 0.125f; }
#pragma unroll
            for (int ai = 0; ai < 2; ++ai)
#pragma unroll
                for (int m = 0; m < 4; ++m) { bf16* rowp = dst + (size_t)(row0 + ai * 128 + m * 16) * ld + coff + cl0;
#pragma unroll
                    for (int bj = 0; bj < 2; ++bj) *(v4u*)(rowp + bj * 128) = pack8(acc[ai][bj][m][0] * sc, acc[ai][bj][m][1] * sc); }
        } else {
#pragma unroll
            for (int ai = 0; ai < 2; ++ai)
#pragma unroll
                for (int m = 0; m < 4; ++m) { const int row = row0 + ai * 128 + m * 16;
                    if (cl0 < 64) *(v4u*)(IK + (size_t)row * 64 + cl0) = pack8(acc[ai][0][m][0], acc[ai][0][m][1]);
                    else if (cl0 < 80) { float* p = IW + (size_t)row * 16 + (cl0 - 64); *(f32x4*)p = acc[ai][0][m][0] * 0.25f; *(f32x4*)(p + 4) = acc[ai][0][m][1] * 0.25f; } }
        }
    }
};
struct EpiInProjB {
    static constexpr bool PERM = true, CHAIN = false;
    bf16 *V, *UA; unsigned char* GATES;
    __device__ __forceinline__ void operator()(const f32x4 (&acc)[2][2][4][2], const Unit& u, int wr, int wc, int fr, int fq) const {
        const int pn = u.pn, row0 = u.pm * 256 + wr * 64 + fr, cl0 = wc * 32 + 8 * fq;
        if (pn >= 5) {
            const int coff = (pn - 5) * 256 + cl0;
#pragma unroll
            for (int ai = 0; ai < 2; ++ai)
#pragma unroll
                for (int m = 0; m < 4; ++m) { unsigned char* rowp = GATES + (size_t)(row0 + ai * 128 + m * 16) * 4096 + coff;
#pragma unroll
                    for (int bj = 0; bj < 2; ++bj) { const f32x4 v0 = acc[ai][bj][m][0] * F8_DESCALE, v1 = acc[ai][bj][m][1] * F8_DESCALE; unsigned c[8];
#pragma unroll
                        for (int e = 0; e < 4; ++e) { c[e] = (unsigned)fminf(fmaxf(sigmoidf_(v0[e]) * 255.0f + 0.5f, 1.0f), 255.0f); c[4 + e] = (unsigned)fminf(fmaxf(sigmoidf_(v1[e]) * 255.0f + 0.5f, 1.0f), 255.0f); }
                        v2u w; w.x = c[0] | (c[1] << 8) | (c[2] << 16) | (c[3] << 24); w.y = c[4] | (c[5] << 8) | (c[6] << 16) | (c[7] << 24);
                        *(v2u*)(rowp + bj * 128) = w; } }
        } else if (pn == 0) {
#pragma unroll
            for (int ai = 0; ai < 2; ++ai)
#pragma unroll
                for (int m = 0; m < 4; ++m) { bf16* rowp = V + (size_t)(row0 + ai * 128 + m * 16) * 256 + cl0;
#pragma unroll
                    for (int bj = 0; bj < 2; ++bj) *(v4u*)(rowp + bj * 128) = pack8(acc[ai][bj][m][0] * F8_DESCALE, acc[ai][bj][m][1] * F8_DESCALE); }
        } else {
#pragma unroll
            for (int ai = 0; ai < 2; ++ai)
#pragma unroll
                for (int m = 0; m < 4; ++m) { const int row = row0 + ai * 128 + m * 16, b = row >> 11, t = row & 2047, c = t >> 5, i = t & 31;
#pragma unroll
                    for (int bj = 0; bj < 2; ++bj) { const int ch0 = (pn - 1) * 256 + bj * 128 + cl0, g = ch0 >> 4, p0 = ch0 & 15;
                        *(v4u*)(UA + ((size_t)(g * SROWS + b * NSC + c)) * UA_LD + i * 16 + p0) = pack8(acc[ai][bj][m][0] * F8_DESCALE, acc[ai][bj][m][1] * F8_DESCALE); } }
        }
    }
};

struct EpiSsmS {
    static constexpr bool PERM = false, CHAIN = false;
    float* SBUF;
    __device__ __forceinline__ void operator()(const f32x4 (&acc)[2][2][4][2], const Unit& u, int wr, int wc, int fr, int fq) const {
#pragma unroll
        for (int ai = 0; ai < 2; ++ai)
#pragma unroll
            for (int m = 0; m < 4; ++m) { const int rl = ai * 128 + wr * 64 + m * 16 + fr;
#pragma unroll
                for (int n = 0; n < 2; ++n) *(f32x4*)(SBUF + ((size_t)(u.pm * 256 + rl)) * 128 + wc * 32 + 16 * n + 4 * fq) = acc[ai][0][m][n]; }
    }
};

struct EpiSsmY {
    static constexpr bool PERM = true, CHAIN = false;
    bf16* YG;
    __device__ __forceinline__ void operator()(const f32x4 (&acc)[2][2][4][2], const Unit& u, int wr, int wc, int fr, int fq) const {
        const int g = u.pm >> 1, rt = u.pm & 1, ct = u.pn & 1;
#pragma unroll
        for (int ai = 0; ai < 2; ++ai)
#pragma unroll
            for (int m = 0; m < 4; ++m) { const int r = rt * 256 + ai * 128 + wr * 64 + m * 16 + fr, b = r >> 6, c = r & 63;
#pragma unroll
                for (int bj = 0; bj < 2; ++bj) { const int cl = bj * 128 + wc * 32 + 8 * fq, j = 16 * ct + (cl >> 4), p0 = cl & 15; const int t = b * 2048 + SL * c + j;
                    f32x4 v0 = acc[ai][bj][m][0], v1 = acc[ai][bj][m][1];
#pragma unroll
                    for (int e = 0; e < 4; ++e) { v0[e] = gelu_tanh(v0[e]); v1[e] = gelu_tanh(v1[e]); }
                    *(v4u*)(YG + (size_t)t * 1024 + 16 * g + p0) = pack8(v0, v1); } }
    }
};

struct EpiGlu {
    static constexpr bool PERM = true, CHAIN = false;
    const bf16* YG; unsigned char* YS; const float* bias;
    __device__ __forceinline__ void operator()(const f32x4 (&acc)[2][2][4][2], const Unit& u, int wr, int wc, int fr, int fq) const {
        const int row0 = u.pm * 256 + wr * 64 + fr, col0 = u.pn * 256 + wc * 32 + 8 * fq;
        f32x4 bv[2][2];
#pragma unroll
        for (int bj = 0; bj < 2; ++bj) { bv[bj][0] = *(const f32x4*)(bias + col0 + bj * 128); bv[bj][1] = *(const f32x4*)(bias + col0 + bj * 128 + 4); }
#pragma unroll
        for (int ai = 0; ai < 2; ++ai) { v4u ygv[4][2];
#pragma unroll
            for (int m = 0; m < 4; ++m)
#pragma unroll
                for (int bj = 0; bj < 2; ++bj) ygv[m][bj] = *(const v4u*)(YG + (size_t)(row0 + ai * 128 + m * 16) * 1024 + col0 + bj * 128);
#pragma unroll
            for (int m = 0; m < 4; ++m) { const size_t ro = (size_t)(row0 + ai * 128 + m * 16) * 1024;
#pragma unroll
                for (int bj = 0; bj < 2; ++bj) { const int col = col0 + bj * 128; const v4u yg = ygv[m][bj]; f32x4 z0 = acc[ai][bj][m][0] + bv[bj][0], z1 = acc[ai][bj][m][1] + bv[bj][1];
                    z0[0] = bflo(yg.x) * sigmoidf_(z0[0]); z0[1] = bfhi(yg.x) * sigmoidf_(z0[1]); z0[2] = bflo(yg.y) * sigmoidf_(z0[2]); z0[3] = bfhi(yg.y) * sigmoidf_(z0[3]);
                    z1[0] = bflo(yg.z) * sigmoidf_(z1[0]); z1[1] = bfhi(yg.z) * sigmoidf_(z1[1]); z1[2] = bflo(yg.w) * sigmoidf_(z1[2]); z1[3] = bfhi(yg.w) * sigmoidf_(z1[3]);
                    z0 = z0 * F8_MSCALE; z1 = z1 * F8_MSCALE; v2u w8; w8.x = pk4_fp8(z0[0], z0[1], z0[2], z0[3]); w8.y = pk4_fp8(z1[0], z1[1], z1[2], z1[3]); *(v2u*)(YS + 2 * ro + col) = w8; } } }
    }
};

struct EpiProjAB {
    static constexpr bool PERM = true, CHAIN = true; static constexpr int MID_T = 8;
    const unsigned char* GATES; unsigned char* MG;
    __device__ __forceinline__ void mid(f32x4 (&acc)[2][2][4][2], const Unit& u, int wr, int wc, int fr, int fq) const {
        int row0 = u.pm * 256 + wr * 64 + fr, col0 = u.pn * 256 + wc * 32 + 8 * fq; asm volatile("" : "+v"(row0), "+v"(col0));
#pragma unroll
        for (int ai = 0; ai < 2; ++ai)
#pragma unroll
            for (int m = 0; m < 4; ++m) { const size_t row = (size_t)(row0 + ai * 128 + m * 16);
#pragma unroll
                for (int bj = 0; bj < 2; ++bj) { const int col = col0 + bj * 128; const v2u ga = *(const v2u*)(GATES + row * 4096 + col), gs = *(const v2u*)(GATES + row * 4096 + 2048 + col);
                    f32x4& a0 = acc[ai][bj][m][0]; f32x4& a1 = acc[ai][bj][m][1];
#pragma unroll
                    for (int e = 0; e < 4; ++e) { a0[e] *= (float)((ga.x >> (8 * e)) & 0xffu) * __builtin_amdgcn_rcpf((float)((gs.x >> (8 * e)) & 0xffu));
                                                  a1[e] *= (float)((ga.y >> (8 * e)) & 0xffu) * __builtin_amdgcn_rcpf((float)((gs.y >> (8 * e)) & 0xffu)); } } }
    }
    __device__ __forceinline__ void operator()(const f32x4 (&acc)[2][2][4][2], const Unit& u, int wr, int wc, int fr, int fq) const {
        int row0 = u.pm * 256 + wr * 64 + fr, col0 = u.pn * 256 + wc * 32 + 8 * fq; asm volatile("" : "+v"(row0), "+v"(col0));
        constexpr float SC = F8_MDESCALE * F8_MSCALE * (1.0f / 255.0f);
        v2u gsv[2][4][2];
#pragma unroll
        for (int ai = 0; ai < 2; ++ai)
#pragma unroll
            for (int m = 0; m < 4; ++m)
#pragma unroll
                for (int bj = 0; bj < 2; ++bj) gsv[ai][m][bj] = *(const v2u*)(GATES + (size_t)(row0 + ai * 128 + m * 16) * 4096 + 2048 + col0 + bj * 128);
#pragma unroll
        for (int ai = 0; ai < 2; ++ai)
#pragma unroll
            for (int m = 0; m < 4; ++m) { const size_t row = (size_t)(row0 + ai * 128 + m * 16);
#pragma unroll
                for (int bj = 0; bj < 2; ++bj) { const int col = col0 + bj * 128; const v2u gs = gsv[ai][m][bj]; const f32x4 a0 = acc[ai][bj][m][0] * SC, a1 = acc[ai][bj][m][1] * SC;
                    v2u w8; w8.x = pk4_fp8(a0[0] * (float)(gs.x & 0xffu), a0[1] * (float)((gs.x >> 8) & 0xffu), a0[2] * (float)((gs.x >> 16) & 0xffu), a0[3] * (float)(gs.x >> 24));
                    w8.y = pk4_fp8(a1[0] * (float)(gs.y & 0xffu), a1[1] * (float)((gs.y >> 8) & 0xffu), a1[2] * (float)((gs.y >> 16) & 0xffu), a1[3] * (float)(gs.y >> 24));
                    *(v2u*)(MG + row * 2048 + col) = w8; } }
    }
};

struct EpiOut {
    static constexpr bool PERM = true, CHAIN = false;
    const float* X; const float* MOD; bf16* X1;
    __device__ __forceinline__ void operator()(const f32x4 (&acc)[2][2][4][2], const Unit& u, int wr, int wc, int fr, int fq) const {
        const int row0 = u.pm * 256 + wr * 64 + fr, col0 = u.pn * 256 + wc * 32 + 8 * fq;
        const float* gt1 = MOD + (size_t)(u.pm >> 3) * MODW + 2 * DM;
        f32x4 gv[2][2];
#pragma unroll
        for (int bj = 0; bj < 2; ++bj) { gv[bj][0] = *(const f32x4*)(gt1 + col0 + bj * 128); gv[bj][1] = *(const f32x4*)(gt1 + col0 + bj * 128 + 4); }
#pragma unroll
        for (int ai = 0; ai < 2; ++ai) { f32x4 xv[4][2][2];
#pragma unroll
            for (int m = 0; m < 4; ++m)
#pragma unroll
                for (int bj = 0; bj < 2; ++bj) { const float* xp = X + (size_t)(row0 + ai * 128 + m * 16) * 2048 + col0 + bj * 128; xv[m][bj][0] = *(const f32x4*)xp; xv[m][bj][1] = *(const f32x4*)(xp + 4); }
#pragma unroll
            for (int m = 0; m < 4; ++m) { const size_t ro = (size_t)(row0 + ai * 128 + m * 16) * 2048;
#pragma unroll
                for (int bj = 0; bj < 2; ++bj) { const int col = col0 + bj * 128;
                    const f32x4 o0 = xv[m][bj][0] + gv[bj][0] * (acc[ai][bj][m][0] * F8_MDESCALE), o1 = xv[m][bj][1] + gv[bj][1] * (acc[ai][bj][m][1] * F8_MDESCALE);
                    *(v4u*)(X1 + ro + col) = pack8(o0, o1); } } }
    }
};

struct EpiGateUp {
    static constexpr bool PERM = true, CHAIN = false;
    const float* bgu; unsigned char* ACT;
    __device__ __forceinline__ void operator()(const f32x4 (&acc)[2][2][4][2], const Unit& u, int wr, int wc, int fr, int fq) const {
        const int e = u.pn >> 4, ct = u.pn & 15, row0 = u.pm * 256 + wr * 64 + fr, col = ct * 128 + wc * 32 + 8 * fq;
        const float* bg = bgu + (size_t)e * 4096 + col; const f32x4 g0 = *(const f32x4*)bg, g1 = *(const f32x4*)(bg + 4);
        const f32x4 u0 = (*(const f32x4*)(bg + 2048) + 1.0f) * F8_ASCALE, u1 = (*(const f32x4*)(bg + 2052) + 1.0f) * F8_ASCALE;
        constexpr float D4 = F8_DESCALE * F8_ASCALE;
#pragma unroll
        for (int ai = 0; ai < 2; ++ai)
#pragma unroll
            for (int m = 0; m < 4; ++m) { f32x4 ga = acc[ai][0][m][0] * F8_DESCALE + g0, gb = acc[ai][0][m][1] * F8_DESCALE + g1, ua = acc[ai][1][m][0] * D4 + u0, ub = acc[ai][1][m][1] * D4 + u1;
#pragma unroll
                for (int q = 0; q < 4; ++q) { float gg = fminf(ga[q], 7.0f), uu = __builtin_amdgcn_fmed3f(ua[q], -6.0f * F8_ASCALE, 8.0f * F8_ASCALE); ga[q] = uu * (gg * sigmoid1702(gg));
                    gg = fminf(gb[q], 7.0f); uu = __builtin_amdgcn_fmed3f(ub[q], -6.0f * F8_ASCALE, 8.0f * F8_ASCALE); gb[q] = uu * (gg * sigmoid1702(gg)); }
                v2u w; w.x = pk4_fp8_nc(ga[0], ga[1], ga[2], ga[3]); w.y = pk4_fp8_nc(gb[0], gb[1], gb[2], gb[3]);
                *(v2u*)(ACT + (size_t)(row0 + ai * 128 + m * 16) * 2048 + col) = w; }
    }
};

struct EpiDown {
    static constexpr bool PERM = true, CHAIN = false;
    const float* bd; const float* GLIST; const LAS int* mt; unsigned char* YE;
    __device__ __forceinline__ void operator()(const f32x4 (&acc)[2][2][4][2], const Unit& u, int wr, int wc, int fr, int fq) const {
        const int e = (u.pn >> 3) & 31, ct = u.pn & 7, row0 = u.pm * 256 + wr * 64 + fr, col0 = ct * 256 + wc * 32 + 8 * fq, ne = mt[32 + e], i0 = row0 - mt[e];
        f32x4 bv[2][2]; float grv[2][4];
#pragma unroll
        for (int bj = 0; bj < 2; ++bj) { const float* bp = bd + (size_t)e * 2048 + col0 + bj * 128; bv[bj][0] = *(const f32x4*)bp; bv[bj][1] = *(const f32x4*)(bp + 4); }
#pragma unroll
        for (int ai = 0; ai < 2; ++ai)
#pragma unroll
            for (int m = 0; m < 4; ++m) { const int idx = i0 + ai * 128 + m * 16; const bool ok = idx >= 0 && idx < ne && idx < T; const float gl = GLIST[(size_t)e * T + (ok ? idx : 0)]; grv[ai][m] = ok ? gl * F8_YSCALE : 0.f; }
#pragma unroll
        for (int ai = 0; ai < 2; ++ai)
#pragma unroll
            for (int m = 0; m < 4; ++m) { const size_t row = (size_t)(row0 + ai * 128 + m * 16); const float gr = grv[ai][m];
#pragma unroll
                for (int bj = 0; bj < 2; ++bj) { const int col = col0 + bj * 128;
                    const f32x4 y0 = (acc[ai][bj][m][0] * F8_DESCALE + bv[bj][0]) * gr, y1 = (acc[ai][bj][m][1] * F8_DESCALE + bv[bj][1]) * gr;
                    v2u w8; w8.x = pk4_fp8(y0[0], y0[1], y0[2], y0[3]); w8.y = pk4_fp8(y1[0], y1[1], y1[2], y1[3]); *(v2u*)(YE + row * 2048 + col) = w8; } }
    }
};

struct SsmSOrder {
    int G, c;
    __device__ __forceinline__ bool next(int i, Unit& u) const { const int L = i * G + c; if (L >= 2 * SSMG) return false; u.pm = L; u.pn = L >> 1; return true; }
    __device__ __forceinline__ void a_ready(const Unit&) const {}
    __device__ __forceinline__ void done(const Unit&) const {}
};
struct SsmYOrder {
    int G, c;
    __device__ __forceinline__ bool next(int i, Unit& u) const { const int L = i * G + c; if (L >= 256) return false; const int g = L >> 2; u.pm = 2 * g + ((L >> 1) & 1); u.pn = 2 * g + (L & 1); return true; }
    __device__ __forceinline__ void a_ready(const Unit&) const {}
    __device__ __forceinline__ void done(const Unit&) const {}
};
struct MoeOrder {
    const LAS int* rbe; int nrb, sh, G, c;
    __device__ __forceinline__ bool next(int i, Unit& u) const {
        int rb, ct;
        if (G == 256) { const int x = c & 7, m = c >> 3, st = i * 8 + x, rbq = m >> 3, ctq = m & 7;
            if (sh == 4) { rb = 4 * (st >> 1) + rbq; ct = 8 * (st & 1) + ctq; } else { rb = 4 * st + rbq; ct = ctq; } }
        else { const int L = i * G + c; rb = L >> sh; ct = L & ((1 << sh) - 1); }
        if (rb >= nrb) return false;
        const int e = __builtin_amdgcn_readfirstlane(rbe[rb]);
        u.pm = rb; u.pn = (e << sh) + ct; return true; }
    __device__ __forceinline__ void a_ready(const Unit&) const {}
    __device__ __forceinline__ void done(const Unit&) const {}
};

struct Args { const float* in[28]; float* out; unsigned char* ws; int ph_lo, ph_hi; };
enum { I_X = 0, I_C, I_WADA, I_BADA, I_N1G, I_WIN, I_QG, I_KG, I_ARE, I_AIM, I_LDT, I_BRE, I_BIM, I_CRE, I_CIM, I_SD, I_WGLU, I_BGLU, I_WPA, I_WPB, I_WOUT, I_N2G, I_WR, I_BR, I_WGU, I_BGU, I_WD, I_BD };

__device__ __forceinline__ int crow(int r, int hi) { return (r & 3) + 8 * (r >> 2) + 4 * hi; }

__device__ __forceinline__ void ph0_adaln(const Args& a, LAS unsigned char* lds, int tid, int G, int bid) {
    LAS float* cond = (LAS float*)lds;
    LAS float* red = (LAS float*)(lds + 65536);
    const float* c = a.in[I_C]; const float* W = a.in[I_WADA]; const float* bada = a.in[I_BADA]; float* MOD = (float*)(a.ws + WS_MOD);
    bool have = false;
    for (int ub = bid; ub < MODW / 64; ub += G) {
        if (!have) { for (int i = tid; i < NB * DM; i += NTHR) { const int b = i >> 11, k = i & 2047; const float v = c[i]; cond[k * 8 + b] = v / (1.0f + expf(-v)); } __syncthreads(); have = true; }
        const int cc = tid & 63, col = ub * 64 + cc, kq = tid >> 6;
        float acc[8];
#pragma unroll
        for (int b = 0; b < 8; ++b) acc[b] = 0.f;
        const float* wp = W + (size_t)(kq * 256) * MODW + col;
        for (int k = 0; k < 256; k += 64) {
            float w[64];
#pragma unroll
            for (int q = 0; q < 64; ++q) w[q] = wp[(size_t)(k + q) * MODW];
#pragma unroll
            for (int q = 0; q < 64; ++q) { const f32x4 c0 = *(const LAS f32x4*)(cond + (kq * 256 + k + q) * 8), c1 = *(const LAS f32x4*)(cond + (kq * 256 + k + q) * 8 + 4);
                acc[0] += w[q] * c0[0]; acc[1] += w[q] * c0[1]; acc[2] += w[q] * c0[2]; acc[3] += w[q] * c0[3];
                acc[4] += w[q] * c1[0]; acc[5] += w[q] * c1[1]; acc[6] += w[q] * c1[2]; acc[7] += w[q] * c1[3]; }
        }
#pragma unroll
        for (int b = 0; b < 8; ++b) red[(kq * 8 + b) * 64 + cc] = acc[b];
        __syncthreads();
        { const int b = tid >> 6;
          float s = 0.f;
#pragma unroll
          for (int q = 0; q < 8; ++q) s += red[(q * 8 + b) * 64 + cc];
          MOD[(size_t)b * MODW + col] = s + bada[col]; }
        __syncthreads();
    }
    __syncthreads();
}
__device__ __forceinline__ void tr_item(const float* W, int ldw, int K, int srccol, int nvalid, bf16* WT, size_t dstrow0, int k0, LAS float* scr, int lane) {
    const int nn = lane & 31; const bool ok = nn < nvalid;
    float wv_[32];
#pragma unroll
    for (int i = 0; i < 32; ++i) { const int kk = 2 * i + (lane >> 5); wv_[i] = ok ? W[(size_t)(k0 + kk) * ldw + srccol + nn] : 0.f; }
#pragma unroll
    for (int i = 0; i < 32; ++i) { const int kk = 2 * i + (lane >> 5); scr[kk * 33 + nn] = wv_[i]; }
    LDS_WAIT(); asm volatile("" ::: "memory");
    const int c = lane & 7;
#pragma unroll
    for (int j = 0; j < 4; ++j) { const int n = (lane >> 3) + 8 * j; const LAS float* s = scr + (8 * c) * 33 + n;
        v4u o; o.x = pk2(s[0 * 33], s[1 * 33]); o.y = pk2(s[2 * 33], s[3 * 33]); o.z = pk2(s[4 * 33], s[5 * 33]); o.w = pk2(s[6 * 33], s[7 * 33]);
        *(v4u*)(WT + (dstrow0 + n) * K + k0 + 8 * c) = o; }
    LDS_WAIT(); asm volatile("" ::: "memory");
}
__device__ __forceinline__ void tr128_f8(const float* W, int ldw, int srccol, unsigned char* WT, size_t dstrow0, int K, int k0, LAS unsigned char* tile, int lane) {
    const float* src = W + (size_t)k0 * ldw + srccol + 2 * lane;
    f32x2 va[16], vb[16], vc[16], vd[16];
#define CV_LOAD(v, kb) do { _Pragma("unroll") for (int j = 0; j < 16; ++j) v[j] = __builtin_nontemporal_load((const f32x2*)(src + (size_t)((kb) * 16 + j) * ldw)); } while (0)
#define CV_PUT(v, kb) do { v4u a, b; \
        a.x = pk4_fp8(v[0][0] * F8_WSCALE, v[1][0] * F8_WSCALE, v[2][0] * F8_WSCALE, v[3][0] * F8_WSCALE); a.y = pk4_fp8(v[4][0] * F8_WSCALE, v[5][0] * F8_WSCALE, v[6][0] * F8_WSCALE, v[7][0] * F8_WSCALE); \
        a.z = pk4_fp8(v[8][0] * F8_WSCALE, v[9][0] * F8_WSCALE, v[10][0] * F8_WSCALE, v[11][0] * F8_WSCALE); a.w = pk4_fp8(v[12][0] * F8_WSCALE, v[13][0] * F8_WSCALE, v[14][0] * F8_WSCALE, v[15][0] * F8_WSCALE); \
        b.x = pk4_fp8(v[0][1] * F8_WSCALE, v[1][1] * F8_WSCALE, v[2][1] * F8_WSCALE, v[3][1] * F8_WSCALE); b.y = pk4_fp8(v[4][1] * F8_WSCALE, v[5][1] * F8_WSCALE, v[6][1] * F8_WSCALE, v[7][1] * F8_WSCALE); \
        b.z = pk4_fp8(v[8][1] * F8_WSCALE, v[9][1] * F8_WSCALE, v[10][1] * F8_WSCALE, v[11][1] * F8_WSCALE); b.w = pk4_fp8(v[12][1] * F8_WSCALE, v[13][1] * F8_WSCALE, v[14][1] * F8_WSCALE, v[15][1] * F8_WSCALE); \
        const int n0 = 2 * lane, n1 = 2 * lane + 1; \
        *(LAS v4u*)(tile + n0 * 128 + ((((kb)) ^ (n0 & 7)) << 4)) = a; *(LAS v4u*)(tile + n1 * 128 + ((((kb)) ^ (n1 & 7)) << 4)) = b; } while (0)
    CV_LOAD(va, 0); CV_LOAD(vb, 1); CV_LOAD(vc, 2);
    CV_LOAD(vd, 3); CV_PUT(va, 0); CV_LOAD(va, 4); CV_PUT(vb, 1); CV_LOAD(vb, 5); CV_PUT(vc, 2); CV_LOAD(vc, 6); CV_PUT(vd, 3); CV_LOAD(vd, 7);
    CV_PUT(va, 4); CV_PUT(vb, 5); CV_PUT(vc, 6); CV_PUT(vd, 7);
#undef CV_LOAD
#undef CV_PUT
    LDS_WAIT(); asm volatile("" ::: "memory");
    const int c = lane & 7;
#pragma unroll
    for (int j = 0; j < 16; ++j) { const int n = (lane >> 3) + 8 * j; const v4u o = *(const LAS v4u*)(tile + n * 128 + ((c ^ (n & 7)) << 4));
        __builtin_nontemporal_store(o, (v4u*)(WT + (dstrow0 + n) * K + k0 + 16 * c)); }
    LDS_WAIT(); asm volatile("" ::: "memory");
}
constexpr int CV_GU1 = 16 * 32, CV_GU = 32 * CV_GU1, CV_D1 = 16 * 16, CV_DN = 32 * CV_D1, CV_PA = 8 * 16, CV_PB = 8 * 16, CV_WO = 16 * 16, CV_ITEMS = CV_PA + CV_PB + CV_WO + CV_GU + CV_DN;
__device__ __forceinline__ void cv_item(const Args& a, int it, LAS unsigned char* tile, int lane) {
    if (it < CV_PA) { const int kt = it >> 4, nt = it & 15; tr128_f8(a.in[I_WPA], 2048, 128 * nt, (unsigned char*)(a.ws + WS_WA), (size_t)128 * nt, 2048, 128 * kt, tile, lane); return; } it -= CV_PA;
    if (it < CV_PB) { const int kt = it >> 4, nt = it & 15; tr128_f8(a.in[I_WPB], 2048, 128 * nt, (unsigned char*)(a.ws + WS_WA + 1024), (size_t)128 * nt, 2048, 128 * kt, tile, lane); return; } it -= CV_PB;
    if (it < CV_WO) { const int kt = it >> 4, nt = it & 15; tr128_f8(a.in[I_WOUT], 2048, 128 * nt, (unsigned char*)(a.ws + WS_WO), (size_t)128 * nt, 2048, 128 * kt, tile, lane); return; } it -= CV_WO;
    if (it < CV_GU) { const int e = it / CV_GU1, q = it % CV_GU1, kt = q >> 5, nt = q & 31, d0 = 128 * nt, ct = d0 >> 8; const int src = (d0 & 128) ? (2048 + 128 * ct) : (128 * ct);
        tr128_f8(a.in[I_WGU] + (size_t)e * 2048 * 4096, 4096, src, (unsigned char*)(a.ws + WS_WGU), (size_t)e * 4096 + d0, 2048, 128 * kt, tile, lane); }
    else { const int r = it - CV_GU, e = r / CV_D1, q = r % CV_D1, kt = q >> 4, nt = q & 15;
        tr128_f8(a.in[I_WD] + (size_t)e * 2048 * 2048, 2048, 128 * nt, (unsigned char*)(a.ws + WS_WD), (size_t)e * 2048 + 128 * nt, 2048, 128 * kt, tile, lane); }
}
__device__ __forceinline__ void ph0_transposes(const Args& a, LAS unsigned char* lds, int wave, int lane, int G, int bid) {
    LAS float* scr = (LAS float*)(lds + wave * 16384);
    const int gw = wave * G + bid, NGW = G * NWAVES;
    constexpr int I_IN = 32 * 80, I_GL = 16 * 32, I_IN8 = 16 * 42;
    constexpr int NITEMS = I_IN + I_GL + I_IN8;
    for (int it = gw; it < NITEMS; it += NGW) {
        int r = it;
        if (r < I_IN) { const int kb = r / 80, nb = r % 80, d0 = 32 * nb; int src, nv = 32;
            if (d0 < 1280) src = d0; else if (d0 < 2304) src = 1536 + (d0 - 1280); else if (d0 < 2368) src = 2560 + (d0 - 2304); else if (d0 == 2368) { src = 2624; nv = 16; } else { src = 0; nv = 0; }
            tr_item(a.in[I_WIN], INW, DM, src, nv, (bf16*)(a.ws + WS_WIN), (size_t)d0, 64 * kb, scr, lane); continue; } r -= I_IN;
        if (r < I_GL) { const int kb = r / 32, nb = r % 32; tr_item(a.in[I_WGLU], 1024, 1024, 32 * nb, 32, (bf16*)(a.ws + WS_WGLU), (size_t)32 * nb, 64 * kb, scr, lane); continue; } r -= I_GL;
        { const int kt = r / 42, nt = r % 42; const int src = nt < 2 ? 1280 + 128 * nt : (nt < 10 ? 2640 + 128 * (nt - 2) : 3664 + 128 * (nt - 10));
          tr128_f8(a.in[I_WIN], INW, src, (unsigned char*)(a.ws + WS_WIN8), (size_t)128 * nt, 2048, 128 * kt, lds + wave * 16384, lane); }
    }
}
__device__ __forceinline__ void cv_queue(const Args& a, LAS unsigned char* lds, int wave, int lane) {
    unsigned* ctr = (unsigned*)(a.ws + WS_CTL) + CW_CVQ;
    for (;;) { int it = 0; if (lane == 0) it = (int)__hip_atomic_fetch_add(ctr, 1u, RLX_AGENT); it = __builtin_amdgcn_readfirstlane(it); if (it >= CV_ITEMS) break; cv_item(a, it, lds + wave * 16384, lane); }
}
__device__ __forceinline__ void cexp_d(double zr, double zi, double& er, double& ei) {
    const double s = 1.0 / 1024.0; zr *= s; zi *= s;
    double wr = 1.0, wi = 0.0;
#pragma unroll
    for (int k = 10; k >= 1; --k) { const double tr = (zr * wr - zi * wi) / (double)k, ti = (zr * wi + zi * wr) / (double)k; wr = 1.0 + tr; wi = ti; }
#pragma unroll
    for (int q = 0; q < 10; ++q) { const double tr = wr * wr - wi * wi, ti = 2.0 * wr * wi; wr = tr; wi = ti; }
    er = wr; ei = wi;
}
__device__ __forceinline__ void ph0_ssm_consts(const Args& a, int tid, int G, int bid) {
    float* BBAR = (float*)(a.ws + WS_BBAR); float* POW = (float*)(a.ws + WS_POW);
    for (int idx = bid * NTHR + tid; idx < SSMG * SSMN; idx += G * NTHR) {
        const int g = idx >> 6, n = idx & 63;
        double st, dummy; cexp_d((double)a.in[I_LDT][g], 0.0, st, dummy);
        const double are = (double)a.in[I_ARE][idx], aim = (double)a.in[I_AIM][idx];
        double er, ei; cexp_d(st * are, st * aim, er, ei);
        const double den = are * are + aim * aim, nr = er - 1.0, ni = ei;
        const double cr = (nr * are + ni * aim) / den, ci = (ni * are - nr * aim) / den;
#pragma unroll 4
        for (int p = 0; p < 16; ++p) { const double br = (double)a.in[I_BRE][(size_t)idx * 16 + p], bi = (double)a.in[I_BIM][(size_t)idx * 16 + p];
            BBAR[((size_t)idx * 16 + p) * 2 + 0] = (float)(cr * br - ci * bi); BBAR[((size_t)idx * 16 + p) * 2 + 1] = (float)(cr * bi + ci * br); }
        double pr = 1.0, pi = 0.0;
        for (int t = 0; t <= 64; ++t) { POW[(((size_t)g * 65 + t) * 64 + n) * 2 + 0] = (float)pr; POW[(((size_t)g * 65 + t) * 64 + n) * 2 + 1] = (float)pi;
            const double tr = pr * er - pi * ei, ti = pr * ei + pi * er; pr = tr; pi = ti; }
    }
}

__device__ __forceinline__ void ph1_norm(const Args& a, int wave, int lane, int G, int bid) {
    const float* MOD = (const float*)(a.ws + WS_MOD);
    const int gw = bid * NWAVES + wave, NGW = G * NWAVES;
    {
        const float* X = a.in[I_X]; const float* g1 = a.in[I_N1G]; bf16* HN = (bf16*)(a.ws + WS_HN); unsigned char* HN8 = (unsigned char*)(a.ws + WS_HN8);
        const int RPW = (T + NGW - 1) / NGW, r0 = gw * RPW, r1 = min(T, r0 + RPW);
        f32x4 vn[8], pa[8], pb[8]; int curb = -1;
        if (r0 < r1) { const f32x4* xr = (const f32x4*)(X + (size_t)r0 * DM) + 2 * lane;
#pragma unroll
            for (int j = 0; j < 4; ++j) { vn[2 * j] = xr[128 * j]; vn[2 * j + 1] = xr[128 * j + 1]; } }
        for (int row = r0; row < r1; ++row) {
            const int b = row >> 11;
            f32x4 v[8]; float s = 0.f;
#pragma unroll
            for (int j = 0; j < 8; ++j) { v[j] = vn[j]; s += (v[j][0] * v[j][0] + v[j][1] * v[j][1]) + (v[j][2] * v[j][2] + v[j][3] * v[j][3]); }
            if (row + 1 < r1) { const f32x4* xr = (const f32x4*)(X + (size_t)(row + 1) * DM) + 2 * lane;
#pragma unroll
                for (int j = 0; j < 4; ++j) { vn[2 * j] = xr[128 * j]; vn[2 * j + 1] = xr[128 * j + 1]; } }
            if (b != curb) { curb = b; const f32x4* gp = (const f32x4*)g1 + 2 * lane; const f32x4* shp = (const f32x4*)(MOD + (size_t)b * MODW) + 2 * lane; const f32x4* scp = (const f32x4*)(MOD + (size_t)b * MODW + DM) + 2 * lane;
#pragma unroll
                for (int j = 0; j < 4; ++j) { pa[2 * j] = gp[128 * j] * (scp[128 * j] + 1.0f); pa[2 * j + 1] = gp[128 * j + 1] * (scp[128 * j + 1] + 1.0f); pb[2 * j] = shp[128 * j]; pb[2 * j + 1] = shp[128 * j + 1]; } }
            const float rstd = 1.0f / sqrtf(wave_sum(s) * (1.0f / DM) + RMS_EPS);
            v4u* o16 = (v4u*)(HN + (size_t)row * DM) + lane; v2u* o8 = (v2u*)(HN8 + (size_t)row * DM) + lane; v4u w[4]; v2u w8[4];
#pragma unroll
            for (int j = 0; j < 4; ++j) { const f32x4 y0 = (v[2 * j] * rstd) * pa[2 * j] + pb[2 * j], y1 = (v[2 * j + 1] * rstd) * pa[2 * j + 1] + pb[2 * j + 1];
                w[j].x = pk2(y0[0], y0[1]); w[j].y = pk2(y0[2], y0[3]); w[j].z = pk2(y1[0], y1[1]); w[j].w = pk2(y1[2], y1[3]);
                w8[j].x = pk4_fp8(y0[0] * F8_ASCALE, y0[1] * F8_ASCALE, y0[2] * F8_ASCALE, y0[3] * F8_ASCALE); w8[j].y = pk4_fp8(y1[0] * F8_ASCALE, y1[1] * F8_ASCALE, y1[2] * F8_ASCALE, y1[3] * F8_ASCALE); }
#pragma unroll
            for (int j = 0; j < 4; ++j) { o16[64 * j] = w[j]; o8[64 * j] = w8[j]; }
        }
    }
}
__device__ __forceinline__ void ph1_small(const Args& a, int tid, int wave, int lane, int G, int bid) {
    const float* MOD = (const float*)(a.ws + WS_MOD);
    const int gw = bid * NWAVES + wave, NGW = G * NWAVES;
    {
        const float* g2 = a.in[I_N2G]; const float* wr = a.in[I_WR]; const float* br = a.in[I_BR]; float* WRP = (float*)(a.ws + WS_WRP); float* BRP = (float*)(a.ws + WS_BRP);
        for (int base = bid * NTHR + tid; base < NB * DM * NEXP; base += 4 * G * NTHR) { float v[4];
#pragma unroll
            for (int u = 0; u < 4; ++u) { const int idx = base + u * G * NTHR, ic = idx < NB * DM * NEXP ? idx : 0, b = ic >> 16, k = (ic >> 5) & 2047; v[u] = g2[k] * (1.0f + MOD[(size_t)b * MODW + 4 * DM + k]) * wr[ic & 65535]; }
#pragma unroll
            for (int u = 0; u < 4; ++u) { const int idx = base + u * G * NTHR; if (idx < NB * DM * NEXP) WRP[idx] = v[u]; } }
        for (int o = (wave == 2 ? bid : NB * NEXP); o < NB * NEXP; o += G) { const int b = o >> 5, e = o & 31; float s = 0.f;
#pragma unroll 8
            for (int k = lane; k < DM; k += 64) s += MOD[(size_t)b * MODW + 3 * DM + k] * wr[k * 32 + e];
            s = wave_sum(s); if (lane == 0) BRP[o] = s + br[e]; }
    }
    {
        const float* cre = a.in[I_CRE]; const float* cim = a.in[I_CIM]; const float* BBAR = (const float*)(a.ws + WS_BBAR); const float* POW = (const float*)(a.ws + WS_POW); float* KT = (float*)(a.ws + WS_KT);
        for (int idx = (tid < 128 ? bid * 128 + tid : SSMG * SL * 16); idx < SSMG * SL * 16; idx += G * 128) {
            const int g = idx >> 9, tau = (idx >> 4) & 31, p = idx & 15; float s[16];
#pragma unroll
            for (int q = 0; q < 16; ++q) s[q] = 0.f;
#pragma unroll 8
            for (int n = 0; n < 64; ++n) { const float cr = cre[((size_t)g * 16 + p) * 64 + n], ci = cim[((size_t)g * 16 + p) * 64 + n];
                const float pr = POW[(((size_t)g * 65 + tau) * 64 + n) * 2], pi = POW[(((size_t)g * 65 + tau) * 64 + n) * 2 + 1];
                const float er = cr * pr - ci * pi, ei = cr * pi + ci * pr;
                const f32x4* bp = (const f32x4*)(BBAR + ((size_t)g * 64 + n) * 32);
#pragma unroll
                for (int q = 0; q < 8; ++q) { const f32x4 bb = bp[q]; s[2 * q] += er * bb[0] - ei * bb[1]; s[2 * q + 1] += er * bb[2] - ei * bb[3]; } }
            { const float dv = (tau == 0) ? a.in[I_SD][g * 16 + p] : 0.0f;
#pragma unroll
              for (int q = 0; q < 16; ++q) s[q] += (q == p) ? dv : 0.0f; }
            float* kp = KT + (((size_t)g * 64 + tau) * 16 + p) * 16;
#pragma unroll
            for (int q = 0; q < 4; ++q) *(f32x4*)(kp + 4 * q) = (f32x4){s[4 * q], s[4 * q + 1], s[4 * q + 2], s[4 * q + 3]}; }
    }
}

__device__ __forceinline__ void qknorm_body(const Args& a, int wave, int lane, int G, int bid) {
    const int gw = bid * NWAVES + wave, NGW = G * NWAVES;
    {   bf16* Q = (bf16*)(a.ws + WS_Q); bf16* K = (bf16*)(a.ws + WS_K); const float* qg = a.in[I_QG]; const float* kg = a.in[I_KG];
        const float qs = 0.08838834764831845f * 1.4426950408889634f;
        const int l32 = lane & 31; float qgv[16], kgv[8];
#pragma unroll
        for (int e = 0; e < 16; ++e) qgv[e] = qg[((16 * lane) & 127) + e];
#pragma unroll
        for (int e = 0; e < 8; ++e) kgv[e] = kg[((8 * l32) & 127) + e];
        for (int row0 = gw; row0 < T; row0 += 4 * NGW) {
            v4u qa[4], qb[4], ka[4];
#pragma unroll
            for (int u = 0; u < 4; ++u) { const int row = min(row0 + u * NGW, T - 1); const v4u* qp = (const v4u*)(Q + (size_t)row * 1024 + 16 * lane); qa[u] = qp[0]; qb[u] = qp[1]; ka[u] = *(const v4u*)(K + (size_t)row * 256 + 8 * l32); }
#pragma unroll
            for (int u = 0; u < 4; ++u) { const int row = row0 + u * NGW; if (row < T) {
                {   v4u* qp = (v4u*)(Q + (size_t)row * 1024 + 16 * lane); const v4u w0 = qa[u], w1 = qb[u]; float f[16];
                    f[0] = bflo(w0.x); f[1] = bfhi(w0.x); f[2] = bflo(w0.y); f[3] = bfhi(w0.y); f[4] = bflo(w0.z); f[5] = bfhi(w0.z); f[6] = bflo(w0.w); f[7] = bfhi(w0.w);
                    f[8] = bflo(w1.x); f[9] = bfhi(w1.x); f[10] = bflo(w1.y); f[11] = bfhi(w1.y); f[12] = bflo(w1.z); f[13] = bfhi(w1.z); f[14] = bflo(w1.w); f[15] = bfhi(w1.w);
                    float s = 0.f;
#pragma unroll
                    for (int e = 0; e < 16; ++e) s += f[e] * f[e];
                    s += __shfl_xor(s, 1); s += __shfl_xor(s, 2); s += __shfl_xor(s, 4);
                    const float rs = qs / sqrtf(s * (1.0f / 128.0f) + RMS_EPS);
#pragma unroll
                    for (int e = 0; e < 16; ++e) f[e] = f[e] * rs * qgv[e];
                    v4u o0, o1; o0.x = pk2(f[0], f[1]); o0.y = pk2(f[2], f[3]); o0.z = pk2(f[4], f[5]); o0.w = pk2(f[6], f[7]); o1.x = pk2(f[8], f[9]); o1.y = pk2(f[10], f[11]); o1.z = pk2(f[12], f[13]); o1.w = pk2(f[14], f[15]);
                    qp[0] = o0; qp[1] = o1; }
                {   v4u* kp = (v4u*)(K + (size_t)row * 256 + 8 * l32); const v4u w0 = ka[u]; float f[8];
                    f[0] = bflo(w0.x); f[1] = bfhi(w0.x); f[2] = bflo(w0.y); f[3] = bfhi(w0.y); f[4] = bflo(w0.z); f[5] = bfhi(w0.z); f[6] = bflo(w0.w); f[7] = bfhi(w0.w);
                    float s = 0.f;
#pragma unroll
                    for (int e = 0; e < 8; ++e) s += f[e] * f[e];
                    s += __shfl_xor(s, 1); s += __shfl_xor(s, 2); s += __shfl_xor(s, 4); s += __shfl_xor(s, 8);
                    const float rs = 1.0f / sqrtf(s * (1.0f / 128.0f) + RMS_EPS);
#pragma unroll
                    for (int e = 0; e < 8; ++e) f[e] = f[e] * rs * kgv[e];
                    v4u o0; o0.x = pk2(f[0], f[1]); o0.y = pk2(f[2], f[3]); o0.z = pk2(f[4], f[5]); o0.w = pk2(f[6], f[7]);
                    if (lane < 32) kp[0] = o0; } } }
        }
    }
}
__device__ __forceinline__ void bty_body(const Args& a, int tid, int G, int bid) {
    const float* KT = (const float*)(a.ws + WS_KT); const float* POW = (const float*)(a.ws + WS_POW); const float* cre = a.in[I_CRE]; const float* cim = a.in[I_CIM]; bf16* BTY = (bf16*)(a.ws + WS_BTY);
    constexpr int RPG = SL * 16; const int NA = SSMG * RPG * 64, NBC = SSMG * RPG * 16, ST = G * NTHR;
    for (int base = bid * NTHR + tid; base < NA; base += 4 * ST) {
        f32x4 lo[4], hi[4];
#pragma unroll
        for (int u = 0; u < 4; ++u) { const int idx = base + u * ST, ic = idx < NA ? idx : 0, cc = ic & 63, rr = (ic >> 6) & (RPG - 1), g = ic >> 15, j = rr >> 4, p = rr & 15, i = cc >> 1, d = j >= i ? j - i : 0;
            const float* kp = KT + (((size_t)g * 64 + d) * 16 + p) * 16 + (cc & 1) * 8; lo[u] = *(const f32x4*)kp; hi[u] = *(const f32x4*)(kp + 4); }
#pragma unroll
        for (int u = 0; u < 4; ++u) { const int idx = base + u * ST; if (idx < NA) { const int cc = idx & 63, rr = (idx >> 6) & (RPG - 1), g = idx >> 15, j = rr >> 4, i = cc >> 1; const bool ok = j >= i;
            v4u o; o.x = ok ? pk2(lo[u][0], lo[u][1]) : 0u; o.y = ok ? pk2(lo[u][2], lo[u][3]) : 0u; o.z = ok ? pk2(hi[u][0], hi[u][1]) : 0u; o.w = ok ? pk2(hi[u][2], hi[u][3]) : 0u;
            *(v4u*)(BTY + ((size_t)g * RPG + rr) * UA_LD + 8 * cc) = o; } }
    }
    for (int base = bid * NTHR + tid; base < NBC; base += 4 * ST) {
        f32x4 cr[4], ci[4], p0[4], p1[4];
#pragma unroll
        for (int u = 0; u < 4; ++u) { const int idx = base + u * ST, ic = idx < NBC ? idx : 0, cq = ic & 15, rr = (ic >> 4) & (RPG - 1), g = ic >> 13, j = rr >> 4, p = rr & 15;
            cr[u] = *(const f32x4*)(cre + ((size_t)g * 16 + p) * 64 + 4 * cq); ci[u] = *(const f32x4*)(cim + ((size_t)g * 16 + p) * 64 + 4 * cq);
            const float* pw = POW + (((size_t)g * 65 + (j + 1)) * 64 + 4 * cq) * 2; p0[u] = *(const f32x4*)pw; p1[u] = *(const f32x4*)(pw + 4); }
#pragma unroll
        for (int u = 0; u < 4; ++u) { const int idx = base + u * ST; if (idx < NBC) { const int cq = idx & 15, rr = (idx >> 4) & (RPG - 1), g = idx >> 13;
            v4u o; o.x = pk2(cr[u][0] * p0[u][0] - ci[u][0] * p0[u][1], -(cr[u][0] * p0[u][1] + ci[u][0] * p0[u][0])); o.y = pk2(cr[u][1] * p0[u][2] - ci[u][1] * p0[u][3], -(cr[u][1] * p0[u][3] + ci[u][1] * p0[u][2]));
            o.z = pk2(cr[u][2] * p1[u][0] - ci[u][2] * p1[u][1], -(cr[u][2] * p1[u][1] + ci[u][2] * p1[u][0])); o.w = pk2(cr[u][3] * p1[u][2] - ci[u][3] * p1[u][3], -(cr[u][3] * p1[u][3] + ci[u][3] * p1[u][2]));
            *(v4u*)(BTY + ((size_t)g * RPG + rr) * UA_LD + SL * 16 + 8 * cq) = o; } }
    }
}
__device__ __forceinline__ void bts_body(const Args& a, int tid, int G, int bid) {
    const float* BBAR = (const float*)(a.ws + WS_BBAR); const float* POW = (const float*)(a.ws + WS_POW); bf16* BTS = (bf16*)(a.ws + WS_BTS);
    constexpr int CPR = SL * 16 / 8; const int NCH = SSMG * 256 * CPR, ST = G * NTHR;
    for (int base = bid * NTHR + tid; base < NCH; base += 4 * ST) {
        f32x4 bb[4][4]; f32x2 pw[4];
#pragma unroll
        for (int u = 0; u < 4; ++u) { const int idx = base + u * ST, ic = idx < NCH ? idx : 0, cc = ic % CPR, rr = (ic / CPR) & 127, g = ic / (CPR * 256), col0 = 8 * cc, i = col0 >> 4, pp0 = col0 & 15, n = rr >> 1;
            pw[u] = *(const f32x2*)(POW + (((size_t)g * 65 + (SL - 1 - i)) * 64 + n) * 2); const f32x4* bp = (const f32x4*)(BBAR + (((size_t)g * 64 + n) * 16 + pp0) * 2);
#pragma unroll
            for (int q = 0; q < 4; ++q) bb[u][q] = bp[q]; }
#pragma unroll
        for (int u = 0; u < 4; ++u) { const int idx = base + u * ST; if (idx < NCH) { const int cc = idx % CPR, rr = (idx / CPR) & 255, g = idx / (CPR * 256); const bool live = rr < 128, part = rr & 1; const float pr = pw[u][0], pi = pw[u][1]; float f[8];
#pragma unroll
            for (int q = 0; q < 4; ++q) { f[2 * q] = part ? (pr * bb[u][q][1] + pi * bb[u][q][0]) : (pr * bb[u][q][0] - pi * bb[u][q][1]); f[2 * q + 1] = part ? (pr * bb[u][q][3] + pi * bb[u][q][2]) : (pr * bb[u][q][2] - pi * bb[u][q][3]); }
            v4u o; o.x = live ? pk2(f[0], f[1]) : 0u; o.y = live ? pk2(f[2], f[3]) : 0u; o.z = live ? pk2(f[4], f[5]) : 0u; o.w = live ? pk2(f[6], f[7]) : 0u;
            *(v4u*)(BTS + ((size_t)g * 256 + rr) * (SL * 16) + 8 * cc) = o; } }
    }
}

namespace att {
constexpr int D = 128, NW = 8, QBLK = 32, KVBLK = 64, LDK = 256;
constexpr float THR2 = 11.5415603f;
constexpr size_t SHM_V = KVBLK * D * 2, SHM_K = KVBLK * D * 2, SHM_ATTN = 2 * SHM_V + 2 * SHM_K + NW * 64 * 4;
using u32x4 = __attribute__((ext_vector_type(4))) unsigned;
#define KSWZ(row, colB) ((row) * 256 + ((colB) ^ (((row) & 7) << 4)))
#define SBAR() __builtin_amdgcn_sched_barrier(0)
__device__ __forceinline__ unsigned cvtpk(float lo, float hi) { unsigned r; asm volatile("v_cvt_pk_bf16_f32 %0, %1, %2" : "=v"(r) : "v"(lo), "v"(hi)); return r; }

__device__ __forceinline__ void amask(f32x16& p0, f32x16& p1, unsigned mw0, unsigned mw1, float dq, float nslope, int hi) {
  const unsigned s0 = mw0 >> (4 * hi), s1 = mw1 >> (4 * hi);
#pragma unroll
  for (int r = 0; r < 16; ++r) { const int c = (r & 3) + 8 * (r >> 2);
    const float v = fmaf(nslope, fabsf(dq - (float)c), p0[r]); p0[r] = (s0 & (1u << c)) ? v : -INFINITY;
    const float w = fmaf(nslope, fabsf(dq - (float)(c + 32)), p1[r]); p1[r] = (s1 & (1u << c)) ? w : -INFINITY; }
}
__device__ __forceinline__ void partialSM(f32x16& p0, f32x16& p1, float& m_reg, float& mn, float& alpha) {
  float pmax = p0[0];
#pragma unroll
  for (int r = 1; r < 16; ++r) pmax = fmaxf(pmax, p0[r]);
#pragma unroll
  for (int r = 0; r < 16; ++r) pmax = fmaxf(pmax, p1[r]);
  { auto rr = __builtin_amdgcn_permlane32_swap(__float_as_uint(pmax), __float_as_uint(pmax), false, false);
    pmax = fmaxf(__uint_as_float(rr[0]), __uint_as_float(rr[1])); }
  if (__builtin_expect(__all(pmax - m_reg <= THR2), 1)) { mn = m_reg; alpha = 1.f; }
  else { mn = fmaxf(m_reg, pmax); alpha = __builtin_amdgcn_exp2f(m_reg - mn); m_reg = mn; }
#pragma unroll
  for (int r = 0; r < 16; ++r) p0[r] = p0[r] - mn;
#pragma unroll
  for (int r = 0; r < 16; ++r) p1[r] = p1[r] - mn;
#pragma unroll
  for (int r = 0; r < 16; ++r) p0[r] = __builtin_amdgcn_exp2f(p0[r]);
}
__device__ __forceinline__ void finishSM(f32x16& p0, f32x16& p1, float alpha, float& l_reg, bf16x8& pa0, bf16x8& pa1, bf16x8& pa2, bf16x8& pa3) {
#pragma unroll
  for (int r = 0; r < 16; ++r) p1[r] = __builtin_amdgcn_exp2f(p1[r]);
  float ps = 0;
#pragma unroll
  for (int r = 0; r < 16; ++r) ps += p0[r];
#pragma unroll
  for (int r = 0; r < 16; ++r) ps += p1[r];
  { auto rr = __builtin_amdgcn_permlane32_swap(__float_as_uint(ps), __float_as_uint(ps), false, false);
    ps = __uint_as_float(rr[0]) + __uint_as_float(rr[1]); }
  l_reg = l_reg * alpha + ps;
#define PK4(P, BASE, OUT) do { unsigned a0 = cvtpk(P[BASE + 0], P[BASE + 1]), a1 = cvtpk(P[BASE + 2], P[BASE + 3]);   \
    unsigned b0 = cvtpk(P[BASE + 4], P[BASE + 5]), b1 = cvtpk(P[BASE + 6], P[BASE + 7]);                              \
    auto r0 = __builtin_amdgcn_permlane32_swap(a0, b0, false, false); auto r1 = __builtin_amdgcn_permlane32_swap(a1, b1, false, false); \
    u32x4 w = {r0[0], r1[0], r0[1], r1[1]}; OUT = *reinterpret_cast<bf16x8*>(&w); } while (0)
  PK4(p0, 0, pa0); PK4(p0, 8, pa1); PK4(p1, 0, pa2); PK4(p1, 8, pa3);
#undef PK4
}
__device__ __forceinline__ void qkt(f32x16& p0, f32x16& p1, const bf16* Ks, const bf16x8* qr, int r32, int hi) {
  p0 = f32x16{}; p1 = f32x16{};
#pragma unroll
  for (int d0 = 0; d0 < 8; ++d0) { int cb = (d0 * 16 + hi * 8) * 2;
    bf16x8 b0 = *reinterpret_cast<const bf16x8*>((const char*)Ks + KSWZ(r32, cb));
    bf16x8 b1 = *reinterpret_cast<const bf16x8*>((const char*)Ks + KSWZ(32 + r32, cb));
    p0 = __builtin_amdgcn_mfma_f32_32x32x16_bf16(b0, qr[d0], p0, 0, 0, 0);
    p1 = __builtin_amdgcn_mfma_f32_32x32x16_bf16(b1, qr[d0], p1, 0, 0, 0); }
}
__device__ __forceinline__ int v_st(int k, int c) { const int kk = (k & ~0xC) | ((k & 4) << 1) | ((k & 8) >> 1); return ((kk >> 3) * 4 + (c >> 5)) * 512 + ((kk & 7) * 32 + (c & 31)) * 2; }
__device__ __forceinline__ int v_rd_base(int lane) { return ((lane & 3) << 3) | (((lane >> 2) & 3) << 6) | (((lane >> 4) & 1) << 5) | (((lane >> 5) & 1) << 8); }
constexpr int v_rd_off(int d0, int ks, int half) { return d0 * 512 + ks * 4096 + half * 2048; }
template <int OFF> __device__ __forceinline__ s16x4 tr_read(int vb) {
  s16x4 r; asm volatile("ds_read_b64_tr_b16 %0, %1 offset:%2" : "=&v"(r) : "v"(vb), "i"(OFF) : "memory"); return r;
}
template <int D0> __device__ __forceinline__ void pv_one(f32x16& od, int vb, bf16x8 pa0, bf16x8 pa1, bf16x8 pa2, bf16x8 pa3) {
  const s16x4 l0 = tr_read<v_rd_off(D0, 0, 0)>(vb), h0 = tr_read<v_rd_off(D0, 0, 1)>(vb), l1 = tr_read<v_rd_off(D0, 1, 0)>(vb), h1 = tr_read<v_rd_off(D0, 1, 1)>(vb);
  const s16x4 l2 = tr_read<v_rd_off(D0, 2, 0)>(vb), h2 = tr_read<v_rd_off(D0, 2, 1)>(vb), l3 = tr_read<v_rd_off(D0, 3, 0)>(vb), h3 = tr_read<v_rd_off(D0, 3, 1)>(vb);
  asm volatile("s_waitcnt lgkmcnt(0)" ::: "memory"); SBAR();
#define PK(L, H) (bf16x8){L[0], L[1], L[2], L[3], H[0], H[1], H[2], H[3]}
  od = __builtin_amdgcn_mfma_f32_32x32x16_bf16(pa0, PK(l0, h0), od, 0, 0, 0);
  od = __builtin_amdgcn_mfma_f32_32x32x16_bf16(pa1, PK(l1, h1), od, 0, 0, 0);
  od = __builtin_amdgcn_mfma_f32_32x32x16_bf16(pa2, PK(l2, h2), od, 0, 0, 0);
  od = __builtin_amdgcn_mfma_f32_32x32x16_bf16(pa3, PK(l3, h3), od, 0, 0, 0);
#undef PK
}
__device__ __forceinline__ void pv_d0(f32x16* o, int vb, bf16x8 pa0, bf16x8 pa1, bf16x8 pa2, bf16x8 pa3) {
  pv_one<0>(o[0], vb, pa0, pa1, pa2, pa3); pv_one<1>(o[1], vb, pa0, pa1, pa2, pa3); pv_one<2>(o[2], vb, pa0, pa1, pa2, pa3); pv_one<3>(o[3], vb, pa0, pa1, pa2, pa3);
}

__device__ __forceinline__ void attn_unit(const bf16* __restrict__ Qlane, const bf16* __restrict__ Kh, const bf16* __restrict__ Vh, unsigned char* __restrict__ Ow, int ldo,
                                          const unsigned* __restrict__ selbase, unsigned selo, int qpos, float nslope, int NT, int NTreal, char* lds) {
  const int tid = threadIdx.x, wid = tid >> 6, lane = tid & 63, r32 = lane & 31, hi = lane >> 5;
  bf16* V_lds = (bf16*)lds; bf16* K_lds = (bf16*)(lds + 2 * SHM_V);
  float* ws = (float*)(lds + 2 * SHM_V + 2 * SHM_K) + wid * 64; float* li_l = ws; float* al_l = ws + 32;
  float m_reg = -1e30f, l_reg = 0; f32x16 o[4] = {}; bf16x8 qr[8];
#pragma unroll
  for (int d0 = 0; d0 < 8; ++d0) qr[d0] = *reinterpret_cast<const bf16x8*>(Qlane + d0 * 16);
  const int sr = tid >> 4, sc = (tid & 15) * 8, vst0 = v_st(sr, sc), vst1 = v_st(32 + sr, sc);
  const int vb0 = (int)(uintptr_t)V_lds + v_rd_base(lane);
  const int soffb = (sr * LDK + sc) * 2;
  const __amdgpu_buffer_rsrc_t rsK = __builtin_amdgcn_make_buffer_rsrc((void*)Kh, 0, 1 << 20, 0x00020000), rsV = __builtin_amdgcn_make_buffer_rsrc((void*)Vh, 0, 1 << 20, 0x00020000);
  const float dqb = (float)(qpos - 4 * hi);
  struct { bf16x8 vs0, vs1, ks0, ks1; } sr_[2];
#define SLOAD(i, k0) do { const int so_ = (k0) * (LDK * 2); \
    sr_[i].vs0 = __builtin_bit_cast(bf16x8, __builtin_amdgcn_raw_buffer_load_b128(rsV, soffb, so_, 0)); sr_[i].vs1 = __builtin_bit_cast(bf16x8, __builtin_amdgcn_raw_buffer_load_b128(rsV, soffb, so_ + 32 * LDK * 2, 0)); \
    sr_[i].ks0 = __builtin_bit_cast(bf16x8, __builtin_amdgcn_raw_buffer_load_b128(rsK, soffb, so_, 0)); sr_[i].ks1 = __builtin_bit_cast(bf16x8, __builtin_amdgcn_raw_buffer_load_b128(rsK, soffb, so_ + 32 * LDK * 2, 0)); } while (0)
#define SWRITE(b, i) do { *(bf16x8*)((char*)V_lds + (b) * SHM_V + vst0) = sr_[i].vs0;          \
    *(bf16x8*)((char*)V_lds + (b) * SHM_V + vst1) = sr_[i].vs1; int kc = sc * 2;               \
    *(bf16x8*)((char*)K_lds + (b) * SHM_K + KSWZ(sr, kc)) = sr_[i].ks0;                       \
    *(bf16x8*)((char*)K_lds + (b) * SHM_K + KSWZ(32 + sr, kc)) = sr_[i].ks1; } while (0)
#define SWAIT() asm volatile("s_waitcnt vmcnt(4)" ::: "memory")
#define RESC(a) do { if (__any((a) < 1.f)) { if (hi == 0) al_l[r32] = (a); asm volatile("s_waitcnt lgkmcnt(0)" ::: "memory"); \
    _Pragma("unroll") for (int d = 0; d < 4; ++d) _Pragma("unroll") for (int r = 0; r < 16; ++r) o[d][r] *= al_l[crow(r, hi)]; } } while (0)
#define MASKW(j, m0, m1) do { const v2u mm_ = *reinterpret_cast<const v2u*>(selbase + (selo + 2u * (unsigned)(j))); const bool in_ = (j) < NTreal; m0 = in_ ? mm_.x : 0u; m1 = in_ ? mm_.y : 0u; } while (0)
  f32x16 pA0, pA1, pB0, pB1; float mnA, mnB, alA, alB; bf16x8 pa0, pa1, pa2, pa3; unsigned ma0, ma1, mb0, mb1;
  constexpr int SE = 0, SO = 1;
  SLOAD(SE, 0); MASKW(0, ma0, ma1); MASKW(1, mb0, mb1); asm volatile("s_waitcnt vmcnt(0)" ::: "memory"); SWRITE(0, SE); __syncthreads();
  qkt(pA0, pA1, K_lds, qr, r32, hi); amask(pA0, pA1, ma0, ma1, dqb, nslope, hi); partialSM(pA0, pA1, m_reg, mnA, alA);
  SLOAD(SO, KVBLK); if (2 < NT) SLOAD(SE, 2 * KVBLK);
  SWAIT(); SWRITE(1, SO); __syncthreads();
  for (int j = 1; j + 1 < NT; j += 2) {
    SBAR(); qkt(pB0, pB1, (bf16*)((char*)K_lds + SHM_K), qr, r32, hi);
    finishSM(pA0, pA1, alA, l_reg, pa0, pa1, pa2, pa3); SBAR();
    MASKW(j + 1, ma0, ma1); SLOAD(SO, (j + 2) * KVBLK); SBAR();
    pv_d0(o, vb0, pa0, pa1, pa2, pa3); amask(pB0, pB1, mb0, mb1, dqb - (float)(64 * j), nslope, hi); partialSM(pB0, pB1, m_reg, mnB, alB);
    __syncthreads(); SWAIT(); SWRITE(0, SE);
    RESC(alB); __syncthreads();
    SBAR(); qkt(pA0, pA1, K_lds, qr, r32, hi);
    finishSM(pB0, pB1, alB, l_reg, pa0, pa1, pa2, pa3); SBAR();
    MASKW(j + 2, mb0, mb1); if (j + 3 < NT) SLOAD(SE, (j + 3) * KVBLK); SBAR();
    pv_d0(o, vb0 + (int)SHM_V, pa0, pa1, pa2, pa3); amask(pA0, pA1, ma0, ma1, dqb - (float)(64 * (j + 1)), nslope, hi); partialSM(pA0, pA1, m_reg, mnA, alA);
    __syncthreads(); SWAIT(); SWRITE(1, SO);
    RESC(alA); __syncthreads();
  }
  SBAR(); qkt(pB0, pB1, (bf16*)((char*)K_lds + SHM_K), qr, r32, hi);
  finishSM(pA0, pA1, alA, l_reg, pa0, pa1, pa2, pa3); SBAR();
  SBAR();
  pv_d0(o, vb0, pa0, pa1, pa2, pa3); amask(pB0, pB1, mb0, mb1, dqb - (float)(64 * (NT - 1)), nslope, hi); partialSM(pB0, pB1, m_reg, mnB, alB);
  __syncthreads(); RESC(alB);
  finishSM(pB0, pB1, alB, l_reg, pa0, pa1, pa2, pa3); SBAR();
  pv_d0(o, vb0 + (int)SHM_V, pa0, pa1, pa2, pa3);
  if (hi == 0) li_l[r32] = l_reg; asm volatile("s_waitcnt lgkmcnt(0)" ::: "memory");
  float rli[16];
#pragma unroll
  for (int r = 0; r < 16; ++r) rli[r] = __builtin_amdgcn_rcpf(li_l[crow(r, hi)]);
  unsigned ob = (unsigned)(4 * hi * ldo + r32); asm volatile("" : "+v"(ob));
#pragma unroll
  for (int r = 0; r < 16; ++r) { const int orow0 = crow(r, 0);
#pragma unroll
    for (int d0 = 0; d0 < 4; ++d0) Ow[ob + (unsigned)(orow0 * ldo + d0 * 32)] = (unsigned char)(__builtin_amdgcn_cvt_pk_fp8_f32(__builtin_amdgcn_fmed3f(o[d0][r] * rli[r] * F8_MSCALE, -448.f, 448.f), 0.f, 0, false) & 0xff); }
  __syncthreads();
#undef SLOAD
#undef SWRITE
#undef SWAIT
#undef RESC
#undef MASKW
}
#undef KSWZ
#undef SBAR
}

__device__ __forceinline__ void ph4a_unit(const Args& a, LAS unsigned char* lds, int tid, int wave, int lane, int b, int ci, int p0, int np) {
    const bf16* IQ = (const bf16*)(a.ws + WS_IQ); const bf16* IK = (const bf16*)(a.ws + WS_IK); const float* IW = (const float*)(a.ws + WS_IW); float* SC = (float*)(a.ws + WS_SC);
    const int tok0 = b * SEQ + ci * CHUNK;
    __syncthreads();
    for (int i = tid; i < 64 * 128; i += NTHR) { const int q = i >> 7, ch = i & 127, head = ch >> 3, c8 = ch & 7;
        const v4u v = *(const v4u*)(IQ + ((size_t)tok0 + q) * 1024 + ch * 8);
        *(LAS v4u*)(lds + q * 2048 + ((head ^ ((q >> 3) & 1)) * 128) + ((c8 ^ (q & 7)) * 16)) = v; }
    __syncthreads();
    const int qt = wave & 1, q = qt * 32 + (lane & 31), hh = lane >> 5; const size_t tokq = (size_t)tok0 + q;
    float wgt[16];
#pragma unroll
    for (int h4 = 0; h4 < 4; ++h4) { const f32x4 w4 = *(const f32x4*)(IW + tokq * 16 + 4 * h4); wgt[4 * h4] = w4[0]; wgt[4 * h4 + 1] = w4[1]; wgt[4 * h4 + 2] = w4[2]; wgt[4 * h4 + 3] = w4[3]; }
    const LAS unsigned char* qb = lds + q * 2048; const int hx = ((q >> 3) & 1) * 128; int offk[4];
#pragma unroll
    for (int kk = 0; kk < 4; ++kk) offk[kk] = ((2 * kk + hh) ^ (q & 7)) * 16;
    int it = wave >> 1;
    bf16x8 ak[2][4];
    if (it < np) { const bf16* kp = IK + ((size_t)b * SEQ + (p0 + it) * 64 + (lane & 31)) * 64 + hh * 8;
#pragma unroll
        for (int kk = 0; kk < 4; ++kk) { ak[0][kk] = *(const bf16x8*)(kp + kk * 16); ak[1][kk] = *(const bf16x8*)(kp + 32 * 64 + kk * 16); } }
    for (; it < np; it += 4) {
        bf16x8 an[2][4]; const bool more = it + 4 < np;
        { const int itn = more ? it + 4 : it; const bf16* kp = IK + ((size_t)b * SEQ + (p0 + itn) * 64 + (lane & 31)) * 64 + hh * 8;
#pragma unroll
          for (int kk = 0; kk < 4; ++kk) { an[0][kk] = *(const bf16x8*)(kp + kk * 16); an[1][kk] = *(const bf16x8*)(kp + 32 * 64 + kk * 16); } }
        float s0[16], s1[16];
#pragma unroll
        for (int i = 0; i < 16; ++i) { s0[i] = 0.f; s1[i] = 0.f; }
        bf16x8 bfc[4]; f32x16 a0, a1;
#pragma unroll
        for (int kk = 0; kk < 4; ++kk) bfc[kk] = *(const LAS bf16x8*)(qb + hx + offk[kk]);
#pragma unroll
        for (int i = 0; i < 16; ++i) { a0[i] = 0.f; a1[i] = 0.f; }
#pragma unroll
        for (int kk = 0; kk < 4; ++kk) { a0 = __builtin_amdgcn_mfma_f32_32x32x16_bf16(ak[0][kk], bfc[kk], a0, 0, 0, 0); a1 = __builtin_amdgcn_mfma_f32_32x32x16_bf16(ak[1][kk], bfc[kk], a1, 0, 0, 0); }
#pragma unroll
        for (int kk = 0; kk < 4; ++kk) bfc[kk] = *(const LAS bf16x8*)(qb + ((1 * 128) ^ hx) + offk[kk]);
#pragma unroll
        for (int h = 0; h < 16; ++h) { f32x16 b0, b1; bf16x8 bfn[4];
            if (h + 1 < 16) {
#pragma unroll
                for (int i = 0; i < 16; ++i) { b0[i] = 0.f; b1[i] = 0.f; }
#pragma unroll
                for (int kk = 0; kk < 4; ++kk) { b0 = __builtin_amdgcn_mfma_f32_32x32x16_bf16(ak[0][kk], bfc[kk], b0, 0, 0, 0); b1 = __builtin_amdgcn_mfma_f32_32x32x16_bf16(ak[1][kk], bfc[kk], b1, 0, 0, 0); }
                if (h + 2 < 16) { const int hb = ((h + 2) * 128) ^ hx;
#pragma unroll
                    for (int kk = 0; kk < 4; ++kk) bfn[kk] = *(const LAS bf16x8*)(qb + hb + offk[kk]); } }
            __builtin_amdgcn_sched_barrier(0);
            const float wh = wgt[h];
#pragma unroll
            for (int i = 0; i < 16; ++i) { s0[i] = fmaf(wh, fmaxf(a0[i], 0.f), s0[i]); asm volatile("" : "+v"(s0[i])); s1[i] = fmaf(wh, fmaxf(a1[i], 0.f), s1[i]); asm volatile("" : "+v"(s1[i])); }
            if (h + 1 < 16) { a0 = b0; a1 = b1; }
            if (h + 2 < 16) {
#pragma unroll
                for (int kk = 0; kk < 4; ++kk) bfc[kk] = bfn[kk]; }
            __builtin_amdgcn_sched_barrier(0); }
        float* op = SC + tokq * 2048 + (p0 + it) * 64 + 4 * hh;
#pragma unroll
        for (int i4 = 0; i4 < 4; ++i4) { *(f32x4*)(op + 8 * i4) = (f32x4){s0[4 * i4], s0[4 * i4 + 1], s0[4 * i4 + 2], s0[4 * i4 + 3]};
            *(f32x4*)(op + 32 + 8 * i4) = (f32x4){s1[4 * i4], s1[4 * i4 + 1], s1[4 * i4 + 2], s1[4 * i4 + 3]}; }
#pragma unroll
        for (int kk = 0; kk < 4; ++kk) { ak[0][kk] = an[0][kk]; ak[1][kk] = an[1][kk]; }
    }
}
__device__ __forceinline__ void ph4a_decode(int u, int& b, int& ci, int& p0, int& np) {
    if (u < 128) { b = u & 7; ci = 16 + (u >> 3); p0 = 0; np = 16; }
    else { const int v = 16 - ((u - 128) >> 4), w = (u - 128) & 15; b = w & 7; if (w >> 3) { ci = 15 + v; p0 = 16; np = v; } else { ci = v - 1; p0 = 0; np = v; } }
}
__device__ __forceinline__ void ph4a_body(const Args& a, LAS unsigned char* lds, int tid, int wave, int lane, int G, int bid) {
    int b, ci, p0, np;
    if (G == 256) { ph4a_decode(bid, b, ci, p0, np); ph4a_unit(a, lds, tid, wave, lane, b, ci, p0, np);
        if (bid >= 128) { ph4a_decode(511 - bid, b, ci, p0, np); ph4a_unit(a, lds, tid, wave, lane, b, ci, p0, np); } }
    else for (int u = bid; u < 384; u += G) { ph4a_decode(u, b, ci, p0, np); ph4a_unit(a, lds, tid, wave, lane, b, ci, p0, np); }
    __syncthreads();
}
template <int NVM> __device__ __forceinline__ int cnt_ge(const unsigned (&key)[32], unsigned cand) {
    unsigned c0 = 0, c1 = 0, c2 = 0, c3 = 0;
#pragma unroll
    for (int i = 0; i < NVM; i += 4) {
        asm("v_cmp_ge_u32 vcc, %1, %2\n\tv_addc_co_u32 %0, vcc, 0, %0, vcc" : "+v"(c0) : "v"(key[i]), "v"(cand) : "vcc");
        asm("v_cmp_ge_u32 vcc, %1, %2\n\tv_addc_co_u32 %0, vcc, 0, %0, vcc" : "+v"(c1) : "v"(key[i + 1]), "v"(cand) : "vcc");
        asm("v_cmp_ge_u32 vcc, %1, %2\n\tv_addc_co_u32 %0, vcc, 0, %0, vcc" : "+v"(c2) : "v"(key[i + 2]), "v"(cand) : "vcc");
        asm("v_cmp_ge_u32 vcc, %1, %2\n\tv_addc_co_u32 %0, vcc, 0, %0, vcc" : "+v"(c3) : "v"(key[i + 3]), "v"(cand) : "vcc"); }
    const unsigned c = (c0 + c1) + (c2 + c3);
    int tot = 0;
#pragma unroll
    for (int b = 0; b < 6; ++b) tot += __builtin_popcountll(__ballot((c >> b) & 1u)) << b;
    return tot;
}
template <int NVM> __device__ __forceinline__ unsigned sel_thr(const unsigned (&key)[32]) {
    unsigned Tt = 0u;
    for (int bit = 31; bit >= 0; --bit) { const unsigned cand = Tt | (1u << bit); const int cnt = cnt_ge<NVM>(key, cand);
        if (cnt >= TOPK) { Tt = cand; if (cnt == TOPK) break; } }
    return Tt;
}
__device__ __forceinline__ void ph4b_body(const Args& a, int wave, int lane, int G, int bid) {
    const float* SC = (const float*)(a.ws + WS_SC); unsigned long long* SEL = (unsigned long long*)(a.ws + WS_SEL);
    const int gw = bid * NWAVES + wave, NGW = G * NWAVES;
    float raw[32]; unsigned key[32];
#define SEL_ROW(idx, row, nv) const int bb_ = (idx) >> 11; int t_ = (idx) & 2047; if (bb_ & 1) t_ = 2047 - t_; const size_t row = (size_t)bb_ * SEQ + t_; const int nv = (t_ >> 6) + 1;
    int idx = gw;
    if (idx < T) { SEL_ROW(idx, row, nv) const float* sp = SC + row * 2048 + lane;
#pragma unroll
        for (int i = 0; i < 32; ++i) raw[i] = sp[64 * (i < nv ? i : nv - 1)]; }
    for (; idx < T; idx += NGW) {
        SEL_ROW(idx, row, nv)
#pragma unroll
        for (int i = 0; i < 32; ++i) { const unsigned uu = __float_as_uint(raw[i]); const unsigned kk = (uu & 0x80000000u) ? ~uu : (uu | 0x80000000u); key[i] = (i < nv) ? kk : 0u; }
        if (idx + NGW < T) { SEL_ROW(idx + NGW, rown, nvn) const float* sp = SC + rown * 2048 + lane;
#pragma unroll
            for (int i = 0; i < 32; ++i) raw[i] = sp[64 * (i < nvn ? i : nvn - 1)]; }
        unsigned Tt = 0u;
        if (nv > 4) { if (nv <= 8) Tt = sel_thr<8>(key); else if (nv <= 16) Tt = sel_thr<16>(key); else if (nv <= 24) Tt = sel_thr<24>(key); else Tt = sel_thr<32>(key); }
        unsigned long long myw = 0ull;
#pragma unroll
        for (int i = 0; i < 32; ++i) { const unsigned long long bm = __ballot(key[i] >= Tt); if (lane == i) myw = bm; }
        if (lane < nv) SEL[row * 32 + lane] = myw;
    }
#undef SEL_ROW
}

__device__ __forceinline__ void ph5_body(const Args& a, char* ldsg, int wave, int lane, int G, int bid) {
    const bf16* Q = (const bf16*)(a.ws + WS_Q); const bf16* K = (const bf16*)(a.ws + WS_K); const bf16* V = (const bf16*)(a.ws + WS_V);
    const unsigned* SELW = (const unsigned*)(a.ws + WS_SEL); unsigned char* YA = (unsigned char*)(a.ws + WS_YA);
    for (int L = bid; L < NB * NCHUNK * NKVH; L += G) {
        const int Lr = L & 255, ci = (L < 256) ? 31 - (Lr >> 4) : (Lr >> 4), b = (Lr >> 1) & 7, g = Lr & 1;
        const int head = g * 4 + (wave >> 1), qpos = ci * 64 + (wave & 1) * 32 + (lane & 31); const size_t tokq = (size_t)b * SEQ + qpos;
        const int NTreal = ci + 1, NT = NTreal + (NTreal & 1);
        const float nslope = -1.4426950408889634f * exp2f(-(float)(head + 1));
        att::attn_unit(Q + tokq * 1024 + head * 128 + (lane >> 5) * 8, K + (size_t)b * SEQ * 256 + g * 128, V + (size_t)b * SEQ * 256 + g * 128,
                       YA + ((size_t)b * SEQ + ci * 64 + (wave & 1) * 32) * 2048 + head * 128, 2048, SELW + ((size_t)b * SEQ + ci * 64) * 64, (unsigned)(((wave & 1) * 32 + (lane & 31)) * 64), qpos, nslope, NT, NTreal, ldsg);
    }
}

__device__ __forceinline__ void ph7_body(const Args& a, int tid, int G, int bid) {
    const float* POW = (const float*)(a.ws + WS_POW); const float* SBUF = (const float*)(a.ws + WS_SBUF); bf16* UA = (bf16*)(a.ws + WS_UA);
    for (int idx = (tid < 128 ? bid * 128 + tid : SSMG * NB * SSMN); idx < SSMG * NB * SSMN; idx += G * 128) {
        const int n = idx & 63, b = (idx >> 6) & 7, g = idx >> 9;
        const float ar = POW[(((size_t)g * 65 + SL) * 64 + n) * 2], ai = POW[(((size_t)g * 65 + SL) * 64 + n) * 2 + 1];
        float hr = 0.f, hi = 0.f;
#pragma unroll 1
        for (int c0 = 0; c0 < NSC; c0 += 64) {
            f32x2 sv[64];
#pragma unroll
            for (int c = 0; c < 64; ++c) sv[c] = *(const f32x2*)(SBUF + ((size_t)g * SROWS + b * NSC + c0 + c) * 128 + 2 * n);
#pragma unroll
            for (int c = 0; c < 64; ++c) { const size_t row = (size_t)g * SROWS + b * NSC + c0 + c;
                *(unsigned*)(UA + row * UA_LD + SL * 16 + 2 * n) = pk2(hr, hi);
                const float nr = ar * hr - ai * hi + sv[c][0], ni = ar * hi + ai * hr + sv[c][1]; hr = nr; hi = ni; }
        }
    }
}

__device__ __forceinline__ void ph12_body(const Args& a, LAS unsigned char* lds, int tid, int wave, int lane, int G, int bid, size_t alt) {
    const bf16* X1 = (const bf16*)(a.ws + WS_X1); const float* WRP = (const float*)(a.ws + WS_WRP); const float* BRP = (const float*)(a.ws + WS_BRP); float* RSTD = (float*)(a.ws + (alt ? WS_SC : WS_RSTD));
    unsigned* CNT = (unsigned*)(a.ws + WS_CTL) + CW_CNT + (alt ? 64 : 0); int* ASGE = (int*)(a.ws + (alt ? WS_SC + MiB : WS_ASGE)); int* ASGP = (int*)(a.ws + (alt ? WS_SC + 2 * MiB : WS_ASGP));
    int* LIST = (int*)(a.ws + (alt ? WS_SC + 4 * MiB : WS_LIST)); float* GLIST = (float*)(a.ws + (alt ? WS_SC + 8 * MiB : WS_GLIST)); unsigned char* XS = (unsigned char*)(a.ws + (alt ? WS_SC + 16 * MiB : WS_XS));
    const float* MOD = (const float*)(a.ws + WS_MOD); const float* g2 = a.in[I_N2G];
    LAS float* xs = (LAS float*)lds;
    LAS float* part = (LAS float*)(lds + 65792); LAS float* logit = (LAS float*)(lds + 65792 + 32768);
    LAS float* rstdL = (LAS float*)(lds + 65792 + 32768 + 4352); LAS unsigned* lcnt = (LAS unsigned*)(rstdL + 32); LAS unsigned* base = lcnt + 32;
    for (int tile = bid; tile < T / 32; tile += G) {
        const int t0 = tile * 32, b = t0 >> 11; const int lrow = tid >> 4, cg = tid & 15;
        f32x16 acc;
#pragma unroll
        for (int i = 0; i < 16; ++i) acc[i] = 0.f;
        float ss = 0.f;
        if (tid < 32) lcnt[tid] = 0u;
        for (int ch = 0; ch < 4; ++ch) {
            f32x4 v[8]; const v2u* xr = (const v2u*)(X1 + (size_t)(t0 + lrow) * DM + ch * 512) + cg;
#pragma unroll
            for (int j = 0; j < 8; ++j) { const v2u w = xr[16 * j]; v[j] = (f32x4){bflo(w.x), bfhi(w.x), bflo(w.y), bfhi(w.y)}; ss += (v[j][0] * v[j][0] + v[j][1] * v[j][1]) + (v[j][2] * v[j][2] + v[j][3] * v[j][3]); }
            float wv[32]; const float* wp = WRP + (size_t)b * (DM * NEXP) + (size_t)(ch * 512 + 64 * wave + (lane >> 5)) * NEXP + (lane & 31);
#pragma unroll
            for (int q = 0; q < 32; ++q) wv[q] = wp[2 * q * NEXP];
            __syncthreads();
#pragma unroll
            for (int j = 0; j < 8; ++j)
#pragma unroll
                for (int e = 0; e < 4; ++e) xs[lrow * 513 + cg * 4 + 64 * j + e] = v[j][e];
            __syncthreads();
            const LAS float* xq = xs + (lane & 31) * 513 + 64 * wave + (lane >> 5);
#pragma unroll
            for (int q = 0; q < 32; ++q) acc = __builtin_amdgcn_mfma_f32_32x32x2f32(xq[2 * q], wv[q], acc, 0, 0, 0);
        }
        ss += __shfl_xor(ss, 1); ss += __shfl_xor(ss, 2); ss += __shfl_xor(ss, 4); ss += __shfl_xor(ss, 8);
        if (cg == 0) { const float rstd = 1.0f / sqrtf(ss * (1.0f / DM) + RMS_EPS); rstdL[lrow] = rstd; RSTD[t0 + lrow] = rstd; }
#pragma unroll
        for (int i = 0; i < 16; ++i) part[(wave * 16 + i) * 64 + lane] = acc[i];
        __syncthreads();
#pragma unroll
        for (int z = 0; z < 2; ++z) { const int o = tid + 512 * z, tk = o >> 5, e = o & 31, hh = (tk >> 2) & 1, i = (tk & 3) + 4 * (tk >> 3), ln = e + 32 * hh; float s = 0.f;
#pragma unroll
            for (int w = 0; w < 8; ++w) s += part[(w * 16 + i) * 64 + ln];
            logit[tk * 33 + e] = rstdL[tk] * s + BRP[b * 32 + e]; }
        __syncthreads();
        LAS float* selv = (LAS float*)(base + 32);
        int rk[4]; float mv[4], gt[4]; unsigned rr[4];
        const int ex = lane & 31;
#pragma unroll
        for (int j = 0; j < 4; ++j) { const int tk = wave * 4 + j; const float v = logit[tk * 33 + ex]; int r = 0;
#pragma unroll
            for (int e2 = 0; e2 < 32; ++e2) { const float u = logit[tk * 33 + e2]; r += ((u > v) || (u == v && e2 < ex)) ? 1 : 0; }
            rk[j] = r; mv[j] = v; if (lane < 32 && r < 4) selv[tk * 4 + r] = v; }
        LDS_WAIT(); asm volatile("" ::: "memory");
#pragma unroll
        for (int j = 0; j < 4; ++j) { const int tk = wave * 4 + j; gt[j] = 0.f; rr[j] = 0u;
            if (lane < 32 && rk[j] < 4) { const float v0 = selv[tk * 4], v1 = selv[tk * 4 + 1], v2 = selv[tk * 4 + 2], v3 = selv[tk * 4 + 3];
                const float den = 1.0f + expf(v1 - v0) + expf(v2 - v0) + expf(v3 - v0); gt[j] = expf(mv[j] - v0) / den;
                rr[j] = __hip_atomic_fetch_add(lcnt + ex, 1u, __ATOMIC_RELAXED, __HIP_MEMORY_SCOPE_WORKGROUP); } }
        __syncthreads();
        if (tid < 32) base[tid] = __hip_atomic_fetch_add(CNT + tid, lcnt[tid], RLX_AGENT);
        __syncthreads();
#pragma unroll
        for (int j = 0; j < 4; ++j) if (lane < 32 && rk[j] < 4) { const int tk = t0 + wave * 4 + j, as = tk * 4 + rk[j], pos = (int)(base[ex] + rr[j]); ASGE[as] = ex; ASGP[as] = pos;
            if (pos < T) { LIST[ex * T + pos] = tk; GLIST[ex * T + pos] = gt[j]; } }
        { const f32x4* gp = (const f32x4*)g2 + 2 * lane; const f32x4* shp = (const f32x4*)(MOD + (size_t)b * MODW + 3 * DM) + 2 * lane; const f32x4* scp = (const f32x4*)(MOD + (size_t)b * MODW + 4 * DM) + 2 * lane;
          v4u xw[4][4]; f32x4 pa[8], pb[8];
#pragma unroll
          for (int j = 0; j < 4; ++j) { const v4u* xr = (const v4u*)(X1 + (size_t)(t0 + wave * 4 + j) * DM) + lane;
#pragma unroll
              for (int q = 0; q < 4; ++q) xw[j][q] = xr[64 * q]; }
#pragma unroll
          for (int q = 0; q < 4; ++q)
#pragma unroll
              for (int h = 0; h < 2; ++h) { pa[2 * q + h] = gp[128 * q + h] * (scp[128 * q + h] + 1.0f) * F8_ASCALE; pb[2 * q + h] = shp[128 * q + h] * F8_ASCALE; }
#pragma unroll
          for (int j = 0; j < 4; ++j) { const int tk = wave * 4 + j; const float rstd = rstdL[tk]; v2u o[4];
#pragma unroll
              for (int q = 0; q < 4; ++q) { const v4u w = xw[j][q]; const f32x4 x0 = {bflo(w.x), bfhi(w.x), bflo(w.y), bfhi(w.y)}, x1 = {bflo(w.z), bfhi(w.z), bflo(w.w), bfhi(w.w)};
                  const f32x4 y0 = (x0 * rstd) * pa[2 * q] + pb[2 * q], y1 = (x1 * rstd) * pa[2 * q + 1] + pb[2 * q + 1];
                  o[q].x = pk4_fp8(y0[0], y0[1], y0[2], y0[3]); o[q].y = pk4_fp8(y1[0], y1[1], y1[2], y1[3]); }
              v2u* dst = (v2u*)(XS + (size_t)(t0 + tk) * DM) + lane;
#pragma unroll
              for (int q = 0; q < 4; ++q) dst[64 * q] = o[q]; } }
        __syncthreads();
    }
}

constexpr int LDS_MOE = RING_BYTES + 1024;
__device__ __forceinline__ void moe_tables(const Args& a, LAS unsigned char* lds, int tid) {
    LAS int* off = (LAS int*)(lds + LDS_MOE); LAS int* cnt = off + 32; LAS int* nrbp = off + 64; LAS int* rbe = off + 96;
    if (tid < 32) {
        unsigned* CNT = (unsigned*)(a.ws + WS_CTL) + CW_CNT; const int c = (int)__hip_atomic_load(CNT + tid, RLX_AGENT), nb = (c + 255) >> 8; int inc = nb;
#pragma unroll
        for (int d = 1; d < 32; d <<= 1) { const int t = __shfl_up(inc, d); if (tid >= d) inc += t; }
        const int ex = inc - nb; cnt[tid] = c; off[tid] = ex * 256;
        for (int q = 0; q < nb; ++q) if (ex + q < 320) rbe[ex + q] = tid;
        if (tid == 31) nrbp[0] = inc < 288 ? inc : 288; }
    __syncthreads();
}
constexpr int LDS_ROWS = RING_BYTES + 3072, ROWS_CAP = (LDS_BYTES - LDS_ROWS) / 512;
template <class Sched> __device__ __forceinline__ void moe_rows(const Args& a, LAS unsigned char* lds, int tid, const Sched& S) {
    const LAS int* off = (const LAS int*)(lds + LDS_MOE); const LAS int* cnt = off + 32; const int* LIST = (const int*)(a.ws + WS_LIST);
    LAS unsigned short* rows = (LAS unsigned short*)(lds + LDS_ROWS); LAS int* uinf = (LAS int*)(lds + LDS_MOE + 1664);
    pg8::Unit u; int n = 0;
    for (; n < ROWS_CAP && S.next(n, u); ++n) { const int e = (u.pn >> 4) & 31; if (tid == 0) uinf[n] = (e << 16) | (((u.pm - (off[e] >> 8)) * 256) & 0xffff); }
    __syncthreads();
    for (int base = tid; base < n * 256; base += 4 * NTHR) {
        int tok[4];
#pragma unroll
        for (int q = 0; q < 4; ++q) { const int k = base + q * NTHR, kc = k < n * 256 ? k : 0, ui = uinf[kc >> 8], e = ui >> 16, idx = (ui & 0xffff) + (kc & 255); const bool ok = idx < cnt[e] && idx < T;
            const int t = LIST[e * T + (ok ? idx : 0)]; tok[q] = ok ? t : 0; }
#pragma unroll
        for (int q = 0; q < 4; ++q) { const int k = base + q * NTHR; if (k < n * 256) rows[k] = (unsigned short)min(max(tok[q], 0), T - 1); } }
    __syncthreads();
}

typedef float f32x2v __attribute__((ext_vector_type(2)));
__device__ __forceinline__ void ph16_acc8(f32x4& a0, f32x4& a1, v2u w) {
    const f32x2v p0 = __builtin_amdgcn_cvt_pk_f32_fp8((int)w.x, false), p1 = __builtin_amdgcn_cvt_pk_f32_fp8((int)w.x, true), p2 = __builtin_amdgcn_cvt_pk_f32_fp8((int)w.y, false), p3 = __builtin_amdgcn_cvt_pk_f32_fp8((int)w.y, true);
    a0[0] += p0[0]; a0[1] += p0[1]; a0[2] += p1[0]; a0[3] += p1[1]; a1[0] += p2[0]; a1[1] += p2[1]; a1[2] += p3[0]; a1[3] += p3[1];
}
__device__ __forceinline__ void ph16_slots(const LAS int* off, const int* ASGE, const int* ASGP, int row, int (&sl)[4]) {
#pragma unroll
    for (int k = 0; k < 4; ++k) sl[k] = min(max(off[ASGE[row * 4 + k] & 31] + ASGP[row * 4 + k], 0), MOE_ROWS - 1);
}
__device__ __forceinline__ void ph16_row(const int (&sl)[4], const unsigned char* YE, const bf16* X1, const float* MOD, int row, int lane, f32x4 (&out)[8]) {
    const v2u* y0 = (const v2u*)(YE + (size_t)sl[0] * DM) + lane; const v2u* y1 = (const v2u*)(YE + (size_t)sl[1] * DM) + lane; const v2u* y2 = (const v2u*)(YE + (size_t)sl[2] * DM) + lane; const v2u* y3 = (const v2u*)(YE + (size_t)sl[3] * DM) + lane;
    const v4u* xi = (const v4u*)(X1 + (size_t)row * DM) + lane; const f32x4* gp = (const f32x4*)(MOD + (size_t)(row >> 11) * MODW + 5 * DM) + 2 * lane;
#pragma unroll
    for (int j = 0; j < 4; ++j) { const v2u w0 = y0[64 * j], w1 = y1[64 * j], w2 = y2[64 * j], w3 = y3[64 * j]; const v4u xw = xi[64 * j]; const f32x4 g0 = gp[128 * j] * (1.0f / F8_YSCALE), g1 = gp[128 * j + 1] * (1.0f / F8_YSCALE);
        f32x4 a0 = {0.f, 0.f, 0.f, 0.f}, a1 = {0.f, 0.f, 0.f, 0.f};
        ph16_acc8(a0, a1, w0); ph16_acc8(a0, a1, w1); ph16_acc8(a0, a1, w2); ph16_acc8(a0, a1, w3);
        out[2 * j] = (f32x4){bflo(xw.x), bfhi(xw.x), bflo(xw.y), bfhi(xw.y)} + g0 * a0; out[2 * j + 1] = (f32x4){bflo(xw.z), bfhi(xw.z), bflo(xw.w), bfhi(xw.w)} + g1 * a1; }
}
__device__ __forceinline__ void ph16_body(const Args& a, LAS unsigned char* lds, int tid, int wave, int lane, int G, int bid, float* OUT) {
    moe_tables(a, lds, tid); const LAS int* off = (const LAS int*)(lds + LDS_MOE);
    const float* MOD = (const float*)(a.ws + WS_MOD); const int* ASGE = (const int*)(a.ws + WS_ASGE); const int* ASGP = (const int*)(a.ws + WS_ASGP); const unsigned char* YE = (const unsigned char*)(a.ws + WS_YE); const bf16* X1 = (const bf16*)(a.ws + WS_X1);
    const int gw = bid * NWAVES + wave, NGW = G * NWAVES;
    int sA[4] = {0, 0, 0, 0}, sB[4] = {0, 0, 0, 0};
    if (gw < T) ph16_slots(off, ASGE, ASGP, gw, sA);
    if (gw + NGW < T) ph16_slots(off, ASGE, ASGP, gw + NGW, sB);
    for (int row = gw; row < T; row += 2 * NGW) {
        const int rowB = row + NGW; const bool hasB = rowB < T;
        f32x4 oA[8], oB[8];
        ph16_row(sA, YE, X1, MOD, row, lane, oA);
        if (hasB) ph16_row(sB, YE, X1, MOD, rowB, lane, oB);
        if (row + 2 * NGW < T) ph16_slots(off, ASGE, ASGP, row + 2 * NGW, sA);
        if (rowB + 2 * NGW < T) ph16_slots(off, ASGE, ASGP, rowB + 2 * NGW, sB);
        { f32x4* xo = (f32x4*)(OUT + (size_t)row * DM) + 2 * lane;
#pragma unroll
          for (int j = 0; j < 4; ++j) { __builtin_nontemporal_store(oA[2 * j], xo + 128 * j); __builtin_nontemporal_store(oA[2 * j + 1], xo + 128 * j + 1); } }
        if (hasB) { f32x4* xo = (f32x4*)(OUT + (size_t)rowB * DM) + 2 * lane;
#pragma unroll
          for (int j = 0; j < 4; ++j) { __builtin_nontemporal_store(oB[2 * j], xo + 128 * j); __builtin_nontemporal_store(oB[2 * j + 1], xo + 128 * j + 1); } }
    }
}

#ifndef PROBE_REP
#define PROBE_REP 0
#endif
#ifndef MK_ONE_LAUNCH
#define MK_ONE_LAUNCH 1
#endif
constexpr int NPH = 13;
__global__ void __launch_bounds__(NTHR, 2) fwd(Args args) {
    extern __shared__ __attribute__((aligned(16))) unsigned char lds_raw[];
    LAS unsigned char* lds = (LAS unsigned char*)lds_raw;
    const int tid = threadIdx.x, lane = tid & 63, wave = __builtin_amdgcn_readfirstlane(tid >> 6);
    const int G = gridDim.x, bid = blockIdx.x;
    volatile LAS unsigned* MISC = (volatile LAS unsigned*)(lds + MISC_OFF);
    for (int u = tid; u < (LDS_BYTES - LDSCTL_OFF) / 4; u += NTHR) ((LAS unsigned*)(lds + LDSCTL_OFF))[u] = 0u;
    __syncthreads();
    unsigned char* ws = args.ws;
    unsigned* ctl = (unsigned*)(ws + WS_CTL);
    const int lo = args.ph_lo, hi = args.ph_hi;
    XcdBarrier bar; bar.bar = ctl + CW_BAR; bar.x = 0; bar.st = nullptr;
    if (hi - lo > 1) bar = xcd_barrier_post(ctl + CW_BAR, MISC + 8);
#define IN(k) (lo <= (k) && (k) < hi)
#define REPS(k) _Pragma("unroll") for (int rep_ = 0; rep_ < 1 + ((PROBE_REP >> (k)) & 1); ++rep_)
#define SEAM(k) do { if (IN(k) && IN((k) + 1)) xcd_barrier(bar); } while (0)

    if (IN(0)) REPS(0) { ph0_ssm_consts(args, tid, G, (bid + 8) % G);
         ph0_adaln(args, lds, tid, G, bid); }
    SEAM(0);
    if (IN(1)) REPS(1) {
        if (bid & 1) { ph1_small(args, tid, wave, lane, G, bid); bts_body(args, tid, G, bid); ph0_transposes(args, lds, wave, lane, G, bid); ph1_norm(args, wave, lane, G, bid); }
        else { ph1_norm(args, wave, lane, G, bid); ph0_transposes(args, lds, wave, lane, G, bid); ph1_small(args, tid, wave, lane, G, bid); bts_body(args, tid, G, bid); } __syncthreads(); }
    SEAM(1);
    if (IN(2)) REPS(2) {
        const int Gg = (G > 2 * NCONV) ? G - NCONV : G;
        if (bid < Gg) {
            { pg8::Gemm g{(const bf16*)(ws + WS_HN), (const bf16*)(ws + WS_WIN), DM, DM, DM}; pg8::StaticOrder S; S.init(T, 2560, Gg, bid);
              EpiInProjA E{(bf16*)(ws + WS_Q), (bf16*)(ws + WS_K), (bf16*)(ws + WS_IQ), (bf16*)(ws + WS_IK), (float*)(ws + WS_IW)};
              pg8::gemm_phase<EpiInProjA, pg8::StaticOrder, true, true>(lds, g, S, E); }
            { pg8::Gemm g{(const bf16*)(ws + WS_HN8), (const bf16*)(ws + WS_WIN8), DM / 2, DM / 2, DM / 2}; pg8::StaticOrder S; S.init(T, 5376, Gg, bid);
              EpiInProjB E{(bf16*)(ws + WS_V), (bf16*)(ws + WS_UA), (unsigned char*)(ws + WS_GATES)};
              pg8::gemm_phase<EpiInProjB, pg8::StaticOrder, true, true, true>(lds, g, S, E); } }
        cv_queue(args, lds, wave, lane); }
    SEAM(2);
    if (IN(3)) REPS(3) {
        ph4a_body(args, lds, tid, wave, lane, G, bid);
        { pg8::Gemm g{(const bf16*)(ws + WS_UA), (const bf16*)(ws + WS_BTS), UA_LD, SL * 16, SL * 16}; SsmSOrder S{G, (G - 1) - bid}; EpiSsmS E{(float*)(ws + WS_SBUF)};
          pg8::gemm_phase<EpiSsmS, SsmSOrder, true, true>(lds, g, S, E); }
        qknorm_body(args, wave, lane, G, bid); bty_body(args, tid, G, bid); }
    SEAM(3);
    if (IN(4)) REPS(4) { ph4b_body(args, wave, lane, G, bid); ph7_body(args, tid, G, bid); }
    SEAM(4);
    if (IN(5)) REPS(5) {
        ph5_body(args, (char*)lds_raw, wave, lane, G, bid);
        { pg8::Gemm g{(const bf16*)(ws + WS_UA), (const bf16*)(ws + WS_BTY), UA_LD, UA_LD, UA_LD}; SsmYOrder S{G, bid}; EpiSsmY E{(bf16*)(ws + WS_YG)};
          pg8::gemm_phase<EpiSsmY, SsmYOrder, true, true>(lds, g, S, E); } }
    SEAM(5);
    if (IN(6)) REPS(6) {
        pg8::Gemm g{(const bf16*)(ws + WS_YG), (const bf16*)(ws + WS_WGLU), 1024, 1024, 1024}; pg8::StaticOrder S; S.init(T, 1024, G, bid);
        EpiGlu E{(const bf16*)(ws + WS_YG), (unsigned char*)(ws + WS_YA + 1024), args.in[I_BGLU]};
        pg8::gemm_phase<EpiGlu, pg8::StaticOrder, true, true>(lds, g, S, E); }
    SEAM(6);
    if (IN(7)) REPS(7) {
        pg8::StaticOrder S; S.init(T, DM, G, bid);
        pg8::Gemm g{(const bf16*)(ws + WS_YA), (const bf16*)(ws + WS_WA), 1024, 1024, 1024}; EpiProjAB E{(const unsigned char*)(ws + WS_GATES), (unsigned char*)(ws + WS_MG)};
        pg8::gemm_phase<EpiProjAB, pg8::StaticOrder, true, true, true>(lds, g, S, E); }
    SEAM(7);
    if (IN(8)) REPS(8) {
        pg8::Gemm g{(const bf16*)(ws + WS_MG), (const bf16*)(ws + WS_WO), DM / 2, DM / 2, DM / 2}; pg8::StaticOrder S; S.init(T, DM, G, bid);
        EpiOut E{args.in[I_X], (const float*)(ws + WS_MOD), (bf16*)(ws + WS_X1)};
        pg8::gemm_phase<EpiOut, pg8::StaticOrder, true, true, true>(lds, g, S, E); }
    SEAM(8);
    if (IN(9)) REPS(9) ph12_body(args, lds, tid, wave, lane, G, bid, (size_t)rep_);
    SEAM(9);
    if (IN(10)) REPS(10) {
        moe_tables(args, lds, tid);
        const LAS int* mt = (const LAS int*)(lds + LDS_MOE); MoeOrder S{mt + 96, mt[64], 4, G, bid};
        moe_rows(args, lds, tid, S);
        pg8::Gemm g{(const bf16*)(ws + WS_XS), (const bf16*)(ws + WS_WGU), DM / 2, DM / 2, DM / 2, (const LAS unsigned short*)(lds + LDS_ROWS)}; EpiGateUp E{args.in[I_BGU], (unsigned char*)(ws + WS_ACT)};
        pg8::gemm_phase<EpiGateUp, MoeOrder, true, true, true, true>(lds, g, S, E); }
    SEAM(10);
    if (IN(11)) REPS(11) {
        moe_tables(args, lds, tid);
        const LAS int* mt = (const LAS int*)(lds + LDS_MOE); MoeOrder S{mt + 96, mt[64], 3, G, bid};
        pg8::Gemm g{(const bf16*)(ws + WS_ACT), (const bf16*)(ws + WS_WD), DM / 2, DM / 2, DM / 2}; EpiDown E{args.in[I_BD], (const float*)(ws + WS_GLIST), mt, (unsigned char*)(ws + WS_YE)};
        pg8::gemm_phase<EpiDown, MoeOrder, true, true, true>(lds, g, S, E); }
    SEAM(11);
    if (IN(12)) REPS(12) ph16_body(args, lds, tid, wave, lane, G, bid, rep_ ? (float*)(ws + WS_SC) : args.out);
#if defined(PROBE_BAR)
    if (hi - lo > 1) { _Pragma("unroll 1") for (int q = 0; q < PROBE_BAR; ++q) xcd_barrier(bar); }
#endif
#undef IN
#undef SEAM
}

extern "C" void kernel_launch(void* const* d_in, const int* in_sizes, int n_in, void* d_out, int out_size, void* d_ws, size_t ws_size, hipStream_t stream) {
    static int grid = 0;
    if (grid == 0) {
        if (n_in != 28 || out_size != T * DM || ws_size < WS_END) { fprintf(stderr, "kernel_launch: unexpected shapes (n_in %d out %d ws %zu)\n", n_in, out_size, ws_size); grid = -1; return; }
        int dev = 0, cus = 0, per_cu = 0;
        if (hipGetDevice(&dev) != hipSuccess || hipDeviceGetAttribute(&cus, hipDeviceAttributeMultiprocessorCount, dev) != hipSuccess) { grid = -1; return; }
        if (hipFuncSetAttribute((const void*)fwd, hipFuncAttributeMaxDynamicSharedMemorySize, LDS_BYTES) != hipSuccess) { fprintf(stderr, "kernel_launch: hipFuncSetAttribute failed\n"); grid = -1; return; }
        if (hipOccupancyMaxActiveBlocksPerMultiprocessor(&per_cu, (const void*)fwd, NTHR, LDS_BYTES) != hipSuccess || per_cu < 1) { fprintf(stderr, "kernel_launch: occupancy query says %d\n", per_cu); (void)hipGetLastError(); grid = -1; return; }
        if (cus * ROWS_CAP < 288 * 16) { fprintf(stderr, "kernel_launch: too few CUs (%d) for the gather lists\n", cus); grid = -1; return; }
        grid = cus;
    }
    if (grid < 0) return;
    (void)hipMemsetAsync((char*)d_ws + WS_CTL, 0, CTL_ZERO_BYTES, stream);
    Args a{};
    for (int i = 0; i < 28; ++i) a.in[i] = (const float*)d_in[i];
    a.out = (float*)d_out; a.ws = (unsigned char*)d_ws;
#if MK_ONE_LAUNCH
    a.ph_lo = 0; a.ph_hi = NPH;
    hipLaunchKernelGGL(fwd, dim3(grid), dim3(NTHR), LDS_BYTES, stream, a);
#else
    for (int p = 0; p < NPH; ++p) { a.ph_lo = p; a.ph_hi = p + 1; hipLaunchKernelGGL(fwd, dim3(grid), dim3(NTHR), LDS_BYTES, stream, a); }
#endif
}
```
